# Optimizing an MI355X kernel written in HIP

```python
import jax, jax.numpy as jnp
from jax import lax
import numpy as np

D_MODEL = 1024
BATCH = 8
SEQ = 4096
DEPTH = 2

GRID_W = 64
CTX_LEN = 256
ROPE_BASE = 10000.0
EPS = 1e-6
N_MOD = 6

MLA_HEADS = 8
MLA_NOPE = 64
MLA_ROPE = 32
MLA_QK = MLA_NOPE + MLA_ROPE
MLA_V = 64
MLA_Q_RANK = 384
MLA_KV_RANK = 256
Q_BLOCK = 128

SWA_HEADS = 8
SWA_KV_HEADS = 2
SWA_GROUP = SWA_HEADS // SWA_KV_HEADS
SWA_DIM = 64
WINDOW = 128
WIN_BLOCK = 128
N_NEIGH = 2 * (WINDOW // WIN_BLOCK) + 1

D_MIX = MLA_HEADS * MLA_V + SWA_HEADS * SWA_DIM
Q_COLS = MLA_Q_RANK + SWA_HEADS * SWA_DIM
KV_COLS = MLA_KV_RANK + MLA_ROPE + 2 * SWA_KV_HEADS * SWA_DIM
D_IN = Q_COLS + KV_COLS

PEER_HEADS = 8
PEER_NKEYS = 128
PEER_EXPERTS = PEER_NKEYS * PEER_NKEYS
PEER_DQ = 256
PEER_DHALF = PEER_DQ // 2
PEER_TOPK = 16
PEER_CHUNK = 128

kernel_name = "hymba_mla_swa_peer_dit_block"


def rms_norm(x, g):
    x32 = x.astype(jnp.float32)
    y = x32 * lax.rsqrt(jnp.mean(x32 * x32, axis=-1, keepdims=True) + EPS)
    return (y * g.astype(jnp.float32)).astype(x.dtype)


def modulate(x, g, shift, scale):
    return rms_norm(x, g) * (1 + scale) + shift


def axial_cos_sin(rows, cols, rot_dim):
    quarter = rot_dim // 4
    inv = ROPE_BASE ** (-jnp.arange(quarter, dtype=jnp.float32) / quarter)
    ar = rows[:, None] * inv
    ac = cols[:, None] * inv
    ang = jnp.concatenate([ar, ar, ac, ac], axis=-1)
    return jnp.cos(ang), jnp.sin(ang)


def apply_rope(x, cs):
    cos, sin = cs
    x32 = x.astype(jnp.float32)
    a, b, c, d = jnp.split(x32, 4, axis=-1)
    rot = jnp.concatenate([-b, a, -d, c], axis=-1)
    return (x32 * cos[:, None, :] + rot * sin[:, None, :]).astype(x.dtype)


def rope_tail(x, cs):
    return jnp.concatenate([x[..., :MLA_NOPE], apply_rope(x[..., MLA_NOPE:], cs)], axis=-1)


def split_kv_cols(p):
    b0 = MLA_KV_RANK
    b1 = b0 + MLA_ROPE
    b2 = b1 + SWA_KV_HEADS * SWA_DIM
    return p[..., :b0], p[..., b0:b1], p[..., b1:b2], p[..., b2:]


def mla_queries(qa, qa_g, wuq, qn_g, cs):
    B, T = qa.shape[:2]
    q = (rms_norm(qa, qa_g) @ wuq).reshape(B, T, MLA_HEADS, MLA_QK)
    q = rms_norm(q, qn_g)
    return q if cs is None else rope_tail(q, cs)


def mla_keys_values(kva, kr, kva_g, wukv, kn_g, cs):
    B, T = kva.shape[:2]
    kv = (rms_norm(kva, kva_g) @ wukv).reshape(B, T, MLA_HEADS, MLA_NOPE + MLA_V)
    k_rope = jnp.broadcast_to(kr[:, :, None, :], (B, T, MLA_HEADS, MLA_ROPE))
    k = rms_norm(jnp.concatenate([kv[..., :MLA_NOPE], k_rope], axis=-1), kn_g)
    if cs is not None:
        k = rope_tail(k, cs)
    return k, kv[..., MLA_NOPE:]


def mla_latent_attend(q, k, v, kc, vc):
    B, S = q.shape[:2]
    nb = S // Q_BLOCK
    k_all = jnp.concatenate([kc, k], axis=1)
    v_all = jnp.concatenate([vc, v], axis=1)
    qb = q.reshape(B, nb, Q_BLOCK, MLA_HEADS, MLA_QK).transpose(1, 0, 2, 3, 4)
    scale = MLA_QK ** -0.5

    def block(qblk):
        s = jnp.einsum('bqhd,bkhd->bhqk', qblk, k_all).astype(jnp.float32) * scale
        p = jax.nn.softmax(s, axis=-1).astype(v_all.dtype)
        return jnp.einsum('bhqk,bkhd->bqhd', p, v_all)

    o = lax.map(block, qb)
    return o.transpose(1, 0, 2, 3, 4).reshape(B, S, MLA_HEADS * MLA_V)


def mla_ctx_attend(q, kc, vc):
    B, C = q.shape[:2]
    s = jnp.einsum('bqhd,bkhd->bhqk', q, kc).astype(jnp.float32) * (MLA_QK ** -0.5)
    p = jax.nn.softmax(s, axis=-1).astype(vc.dtype)
    return jnp.einsum('bhqk,bkhd->bqhd', p, vc).reshape(B, C, MLA_HEADS * MLA_V)


def swa_queries(sq, qn_g, cs):
    B, T = sq.shape[:2]
    q = rms_norm(sq.reshape(B, T, SWA_HEADS, SWA_DIM), qn_g)
    return q if cs is None else apply_rope(q, cs)


def swa_keys_values(sk, sv, kn_g, cs):
    B, T = sk.shape[:2]
    k = rms_norm(sk.reshape(B, T, SWA_KV_HEADS, SWA_DIM), kn_g)
    if cs is not None:
        k = apply_rope(k, cs)
    return k, sv.reshape(B, T, SWA_KV_HEADS, SWA_DIM)


def window_attend(q, k, v, kc, vc, sink):
    B, S = q.shape[:2]
    nb = S // WIN_BLOCK
    nk = N_NEIGH * WIN_BLOCK
    C = kc.shape[1]
    scale = SWA_DIM ** -0.5
    qb = q.reshape(B, nb, WIN_BLOCK, SWA_KV_HEADS, SWA_GROUP, SWA_DIM).transpose(1, 0, 2, 3, 4, 5)
    pad = ((0, 0), (WINDOW, WINDOW), (0, 0), (0, 0))
    kp, vp = jnp.pad(k, pad), jnp.pad(v, pad)

    def band(xp):
        parts = [xp[:, i * WIN_BLOCK: i * WIN_BLOCK + S].reshape(B, nb, WIN_BLOCK, SWA_KV_HEADS, SWA_DIM)
                 for i in range(N_NEIGH)]
        return jnp.concatenate(parts, axis=2).transpose(1, 0, 2, 3, 4)

    kb, vb = band(kp), band(vp)
    qi = jnp.arange(WIN_BLOCK)[:, None]
    kj = jnp.arange(nk)[None, :]
    k_abs = jnp.arange(nb)[:, None, None] * WIN_BLOCK - WINDOW + kj
    mask = (jnp.abs(kj - WINDOW - qi) <= WINDOW) & (k_abs >= 0) & (k_abs < S)
    sink_col = sink.reshape(SWA_KV_HEADS, SWA_GROUP, 1, 1).astype(jnp.float32)

    def block(args):
        qblk, kblk, vblk, m = args
        s_ctx = jnp.einsum('bqgrd,bcgd->bgrqc', qblk, kc).astype(jnp.float32) * scale
        s_loc = jnp.einsum('bqgrd,bkgd->bgrqk', qblk, kblk).astype(jnp.float32) * scale
        s_loc = jnp.where(m, s_loc, -jnp.inf)
        s_sink = jnp.broadcast_to(sink_col, s_ctx.shape[:-1] + (1,))
        p = jax.nn.softmax(jnp.concatenate([s_ctx, s_loc, s_sink], axis=-1), axis=-1).astype(vblk.dtype)
        return (jnp.einsum('bgrqc,bcgd->bqgrd', p[..., :C], vc)
                + jnp.einsum('bgrqk,bkgd->bqgrd', p[..., C:C + nk], vblk))

    o = lax.map(block, (qb, kb, vb, mask))
    return o.transpose(1, 0, 2, 3, 4, 5).reshape(B, S, SWA_HEADS * SWA_DIM)


def swa_ctx_attend(q, kc, vc, sink):
    B, C = q.shape[:2]
    qg = q.reshape(B, C, SWA_KV_HEADS, SWA_GROUP, SWA_DIM)
    s = jnp.einsum('bqgrd,bkgd->bgrqk', qg, kc).astype(jnp.float32) * (SWA_DIM ** -0.5)
    s_sink = jnp.broadcast_to(sink.reshape(SWA_KV_HEADS, SWA_GROUP, 1, 1).astype(jnp.float32),
                              s.shape[:-1] + (1,))
    p = jax.nn.softmax(jnp.concatenate([s, s_sink], axis=-1), axis=-1)[..., :C].astype(vc.dtype)
    return jnp.einsum('bgrqk,bkgd->bqgrd', p, vc).reshape(B, C, SWA_HEADS * SWA_DIM)


def peer(h, wq, sub_keys, u, v):
    shp = h.shape
    chunks = h.reshape(-1, PEER_CHUNK, shp[-1])

    def chunk(xc):
        q = (xc @ wq).reshape(PEER_CHUNK, PEER_HEADS, 2, PEER_DHALF)
        s = jnp.einsum('thpd,hpkd->thpk', q, sub_keys).astype(jnp.float32)
        sv, si = lax.top_k(s, PEER_TOPK)
        cand = sv[:, :, 0, :, None] + sv[:, :, 1, None, :]
        cv, ci = lax.top_k(cand.reshape(PEER_CHUNK, PEER_HEADS, PEER_TOPK * PEER_TOPK), PEER_TOPK)
        i1 = jnp.take_along_axis(si[:, :, 0], ci // PEER_TOPK, axis=-1)
        i2 = jnp.take_along_axis(si[:, :, 1], ci % PEER_TOPK, axis=-1)
        idx = i1 * PEER_NKEYS + i2
        g = jax.nn.softmax(cv, axis=-1)
        u_sel = u[idx]
        v_sel = v[idx]
        a = jax.nn.gelu(jnp.einsum('td,thkd->thk', xc, u_sel).astype(jnp.float32), approximate=False)
        return jnp.einsum('thk,thkd->td', (g * a).astype(xc.dtype), v_sel)

    return lax.map(chunk, chunks).reshape(shp)


def setup_inputs(seed: int = 0) -> dict:
    key = jax.random.key(seed)
    ks = jax.random.split(key, 24)
    f32 = jnp.float32

    def nrm(k, shape, s):
        return s * jax.random.normal(k, shape, f32)

    L, D = DEPTH, D_MODEL
    return {
        "x": nrm(ks[0], (BATCH, SEQ, D), 1.0),
        "c": nrm(ks[1], (BATCH, D), 1.0),
        "ctx": nrm(ks[2], (BATCH, CTX_LEN, D), 1.0),
        "c_ctx": nrm(ks[3], (D,), 1.0),
        "ada_w": nrm(ks[4], (L, D, N_MOD * D), D ** -0.5),
        "ada_b": nrm(ks[5], (L, N_MOD * D), 0.01),
        "norm1_g": 1.0 + nrm(ks[6], (L, D), 0.02),
        "norm2_g": 1.0 + nrm(ks[7], (L, D), 0.02),
        "w_in": nrm(ks[8], (L, D, D_IN), D ** -0.5),
        "mla_qa_g": 1.0 + nrm(ks[9], (L, MLA_Q_RANK), 0.02),
        "mla_wuq": nrm(ks[10], (L, MLA_Q_RANK, MLA_HEADS * MLA_QK), MLA_Q_RANK ** -0.5),
        "mla_kva_g": 1.0 + nrm(ks[11], (L, MLA_KV_RANK), 0.02),
        "mla_wukv": nrm(ks[12], (L, MLA_KV_RANK, MLA_HEADS * (MLA_NOPE + MLA_V)), MLA_KV_RANK ** -0.5),
        "mla_qn_g": 1.0 + nrm(ks[13], (L, MLA_QK), 0.02),
        "mla_kn_g": 1.0 + nrm(ks[14], (L, MLA_QK), 0.02),
        "swa_qn_g": 1.0 + nrm(ks[15], (L, SWA_DIM), 0.02),
        "swa_kn_g": 1.0 + nrm(ks[16], (L, SWA_DIM), 0.02),
        "swa_sink": nrm(ks[17], (L, SWA_HEADS), 0.5),
        "w_out": nrm(ks[18], (L, D_MIX, D), D_MIX ** -0.5),
        "peer_wq": nrm(ks[19], (L, D, PEER_HEADS * PEER_DQ), D ** -0.5),
        "peer_keys": nrm(ks[20], (L, PEER_HEADS, 2, PEER_NKEYS, PEER_DHALF), PEER_DHALF ** -0.5),
        "peer_u": nrm(ks[21], (L, PEER_EXPERTS, D), D ** -0.5),
        "peer_v": nrm(ks[22], (L, PEER_EXPERTS, D), PEER_HEADS ** -0.5),
    }


def reference(x, c, ctx, c_ctx, ada_w, ada_b, norm1_g, norm2_g, w_in, mla_qa_g, mla_wuq,
              mla_kva_g, mla_wukv, mla_qn_g, mla_kn_g, swa_qn_g, swa_kn_g, swa_sink, w_out,
              peer_wq, peer_keys, peer_u, peer_v):
    B, S, D = x.shape
    ROWS = S // GRID_W
    rows = jnp.repeat(jnp.arange(ROWS, dtype=jnp.float32), GRID_W)
    cols = jnp.tile(jnp.arange(GRID_W, dtype=jnp.float32), ROWS)
    cs_mla = axial_cos_sin(rows, cols, MLA_ROPE)
    cs_swa = axial_cos_sin(rows, cols, SWA_DIM)
    s_c = jax.nn.silu(c)
    s_cctx = jax.nn.silu(c_ctx)

    h_lat, h_ctx = x, ctx
    for l in range(DEPTH):
        last = l == DEPTH - 1
        mod = (s_c @ ada_w[l] + ada_b[l]).reshape(B, N_MOD, D)
        sh1, sc1, g1, sh2, sc2, g2 = [mod[:, i][:, None, :] for i in range(N_MOD)]
        mod_c = (s_cctx @ ada_w[l] + ada_b[l]).reshape(N_MOD, D)

        a_lat = modulate(h_lat, norm1_g[l], sh1, sc1)
        a_ctx = modulate(h_ctx, norm1_g[l], mod_c[0], mod_c[1])
        p_lat = a_lat @ w_in[l]
        p_ctx = a_ctx @ (w_in[l][:, Q_COLS:] if last else w_in[l])

        qa, sq = p_lat[..., :MLA_Q_RANK], p_lat[..., MLA_Q_RANK:Q_COLS]
        kva, kr, sk, sv = split_kv_cols(p_lat[..., Q_COLS:])
        kva_c, kr_c, sk_c, sv_c = split_kv_cols(p_ctx[..., -KV_COLS:])

        q_m = mla_queries(qa, mla_qa_g[l], mla_wuq[l], mla_qn_g[l], cs_mla)
        k_m, v_m = mla_keys_values(kva, kr, mla_kva_g[l], mla_wukv[l], mla_kn_g[l], cs_mla)
        kc_m, vc_m = mla_keys_values(kva_c, kr_c, mla_kva_g[l], mla_wukv[l], mla_kn_g[l], None)
        o_mla = mla_latent_attend(q_m, k_m, v_m, kc_m, vc_m)

        q_s = swa_queries(sq, swa_qn_g[l], cs_swa)
        k_s, v_s = swa_keys_values(sk, sv, swa_kn_g[l], cs_swa)
        kc_s, vc_s = swa_keys_values(sk_c, sv_c, swa_kn_g[l], None)
        o_swa = window_attend(q_s, k_s, v_s, kc_s, vc_s, swa_sink[l])

        h_lat = h_lat + g1 * (jnp.concatenate([o_mla, o_swa], axis=-1) @ w_out[l])

        if not last:
            qa_c, sq_c = p_ctx[..., :MLA_Q_RANK], p_ctx[..., MLA_Q_RANK:Q_COLS]
            qc_m = mla_queries(qa_c, mla_qa_g[l], mla_wuq[l], mla_qn_g[l], None)
            qc_s = swa_queries(sq_c, swa_qn_g[l], None)
            oc = jnp.concatenate([mla_ctx_attend(qc_m, kc_m, vc_m),
                                  swa_ctx_attend(qc_s, kc_s, vc_s, swa_sink[l])], axis=-1)
            h_ctx = h_ctx + mod_c[2] * (oc @ w_out[l])

        b_lat = modulate(h_lat, norm2_g[l], sh2, sc2)
        h_lat = h_lat + g2 * peer(b_lat, peer_wq[l], peer_keys[l], peer_u[l], peer_v[l])
        if not last:
            b_ctx = modulate(h_ctx, norm2_g[l], mod_c[3], mod_c[4])
            h_ctx = h_ctx + mod_c[5] * peer(b_ctx, peer_wq[l], peer_keys[l], peer_u[l], peer_v[l])

    return h_lat
```

```cpp
#define MK_ONE_LAUNCH 1
#include <hip/hip_runtime.h>
#include <hip/hip_cooperative_groups.h>
#include <cstdio>
#include <cstdint>
#include <cmath>
namespace cg = cooperative_groups;
namespace pg8 {
#define PG8_LAS __attribute__((address_space(3)))
typedef unsigned short bf16_t;
typedef short bf16x8 __attribute__((ext_vector_type(8)));
typedef float f32x4 __attribute__((ext_vector_type(4)));
typedef unsigned u32x4 __attribute__((ext_vector_type(4)));
constexpr int BM = 256, BK = 64, HALF = 128, HTB = HALF * BK * 2  , STAGE_BYTES = 8 * HTB, NXCD = 8, WGM = 8;

__host__ __device__ __forceinline__ int lds_byte(int r, int c) { const int st = (r >> 4) * 2 + (c >> 5), rr = r & 15, cc = c & 31, ob = rr * 64 + cc * 2; return st * 1024 + (ob ^ (((ob >> 9) & 1) << 5)); }
__host__ __device__ __forceinline__ void stage_rc(int b, int& R, int& C) { const int st = b / 1024, sb = b % 1024, swz = sb ^ (((sb >> 9) & 1) << 5); R = (st >> 1) * 16 + swz / 64; C = (st & 1) * 32 + (swz % 64) / 2; }
__host__ __device__ __forceinline__ int perm32(int rho) { const int n = rho >> 4, i = rho & 15; return 8 * (i >> 2) + 4 * n + (i & 3); }

struct Unit { int pm, pn; };
struct Gemm { const bf16_t* A; const bf16_t* Bt; int M, N, K; };

struct StaticOrder {
    int nM, nN, nwg, G, c;
    __host__ __device__ void init(int M, int N, int G_, int c_) { nM = M / BM; nN = N / BM; nwg = nM * nN; G = G_; c = c_; }
    __host__ __device__ bool next(int i, Unit& u) const {
        const long L = (long)i * G + c; if (L >= nwg) return false;
        int wgid = (int)L; { const int q = nwg / NXCD, r = nwg % NXCD, xcd = wgid % NXCD, off = wgid / NXCD; wgid = (xcd < r ? xcd * (q + 1) : r * (q + 1) + (xcd - r) * q) + off; }
        const int nig = WGM * nN, gid = wgid / nig, fm = gid * WGM, gsz = (nM - fm) < WGM ? (nM - fm) : WGM;
        u.pm = fm + ((wgid % nig) % gsz); u.pn = (wgid % nig) / gsz; return true;
    }
    __device__ __forceinline__ void a_ready(const Unit&) const {}
    __device__ __forceinline__ void done(const Unit&) const {}
};

__device__ __forceinline__ unsigned cvt_pk_bf16(float lo, float hi) { unsigned r; asm volatile("v_cvt_pk_bf16_f32 %0, %1, %2" : "=v"(r) : "v"(lo), "v"(hi)); return r; }
typedef float f32x2 __attribute__((ext_vector_type(2)));
typedef unsigned u32x2 __attribute__((ext_vector_type(2)));
struct EpiStore {
    static constexpr bool PERM = true, AFTER_DRAIN = false;
    int mode; bf16_t* O; int ldc; int ncols; bf16_t* VM;
    __device__ __forceinline__ void operator()(const f32x4 (&acc)[2][2][4][2], const Unit& u, int wr, int wc, int fr, int fq) const {
        const int row0 = u.pm * BM + wr * 64 + fr;
        bf16_t* base; int rstride, hstride; bool on0, on1;
        if (mode == 0) { const int col0 = u.pn * BM + wc * 32 + 8 * fq; base = O + (size_t)row0 * ldc + col0; rstride = ldc; hstride = HALF; on0 = col0 < ncols; on1 = col0 + HALF < ncols; }
        else {
            const int j = wc * 32 + 8 * fq; const bool isk = wc < 2;
            base = isk ? (O + (size_t)row0 * 768 + (2 * u.pn) * 96 + j) : (VM + (size_t)row0 * 512 + (2 * u.pn) * 64 + (j - 64));
            rstride = isk ? 768 : 512; hstride = isk ? 96 : 64; on0 = true; on1 = true; }
#pragma unroll
        for (int ai = 0; ai < 2; ++ai)
#pragma unroll
            for (int m = 0; m < 4; ++m) { bf16_t* rowp = base + (size_t)(ai * HALF + m * 16) * rstride;
#pragma unroll
                for (int bj = 0; bj < 2; ++bj) {
                    if (bj == 0 ? on0 : on1) { const f32x4 v0 = acc[ai][bj][m][0], v1 = acc[ai][bj][m][1]; u32x4 w;
                        w.x = cvt_pk_bf16(v0[0], v0[1]); w.y = cvt_pk_bf16(v0[2], v0[3]); w.z = cvt_pk_bf16(v1[0], v1[1]); w.w = cvt_pk_bf16(v1[2], v1[3]);
                        *(u32x4*)(rowp + bj * hstride) = w; } } }
    }
};
struct EpiResid {
    static constexpr bool PERM = false, AFTER_DRAIN = false;
    const float* hin_lat; const float* hin_ctx; float* hout_lat; float* hout_ctx; const float* gate; int nlat;
    __device__ __forceinline__ void operator()(const f32x4 (&acc)[2][2][4][2], const Unit& u, int wr, int wc, int fr, int fq) const {
        const int rowt = u.pm * BM; const bool lat = rowt < nlat; const int sample = lat ? (rowt >> 12) : 8;
        const float* src = lat ? hin_lat + (size_t)rowt * 1024 : hin_ctx + (size_t)(rowt - nlat) * 1024;
        float* dst = lat ? hout_lat + (size_t)rowt * 1024 : hout_ctx + (size_t)(rowt - nlat) * 1024;
        const float* g = gate + (size_t)sample * 6144;
        const int col0 = u.pn * BM + wc * 32 + 4 * fq;
#pragma unroll
        for (int bj = 0; bj < 2; ++bj)
#pragma unroll
            for (int n = 0; n < 2; ++n) { const int c = col0 + bj * HALF + n * 16; const f32x4 gv = *(const f32x4*)(g + c);
#pragma unroll
                for (int ai = 0; ai < 2; ++ai)
#pragma unroll
                    for (int m = 0; m < 4; ++m) { const size_t off = (size_t)(ai * HALF + wr * 64 + m * 16 + fr) * 1024 + c;
                        const f32x4 hv = *(const f32x4*)(src + off); *(f32x4*)(dst + off) = hv + gv * acc[ai][bj][m][n]; } }
    }
};
template <class Epi, class Sched, bool ALIGN_EPI = false, bool SP2 = false>
__device__ __forceinline__ void gemm_phase(PG8_LAS unsigned char* lds, const Gemm g, const Sched& S, const Epi& E, const int tid_in) {
    const int tid = tid_in, wid = __builtin_amdgcn_readfirstlane(tid >> 6), lane = tid & 63, wr = wid >> 2, wc = wid & 3, fr = lane & 15, fq = lane >> 4;
    const int K = g.K, nt = K / BK;
    unsigned voffA[2], voffB[2];
#pragma unroll
    for (int i = 0; i < 2; ++i) { int R, C; stage_rc(tid * 16 + i * 8192, R, C); const int Rb = Epi::PERM ? ((R & ~31) + perm32(R & 31)) : R;
        voffA[i] = (unsigned)(R * K + C) * 2u; voffB[i] = (unsigned)(Rb * K + C) * 2u; }
    const size_t kstep = (size_t)(BK * 2);
    const size_t hstep = (size_t)HALF * K * 2;
    const size_t tstep = 2 * hstep;
    const unsigned ldsw = (unsigned)wid * 1024u;
    const int aoff = lds_byte(wr * 64 + fr, fq * 8), boff = lds_byte(wc * 32 + fr, fq * 8);
#define PG8_SA(b, h) (((b) * 2 + (h)) * HTB)
#define PG8_SB(b, h) ((4 + (b) * 2 + (h)) * HTB)
#define PG8_STAGE(bufoff, gbase, voff) do { _Pragma("unroll") for (int _i = 0; _i < 2; ++_i) \
        __builtin_amdgcn_global_load_lds((const unsigned*)((const char*)(gbase) + (voff)[_i]), (PG8_LAS unsigned*)(lds + (bufoff) + ldsw + _i * 8192), 16, 0, 0); } while (0)
#define PG8_LDA(dst, b, h) do { _Pragma("unroll") for (int m = 0; m < 4; ++m) _Pragma("unroll") for (int k = 0; k < 2; ++k) dst[m][k] = *(const PG8_LAS bf16x8*)(lds + PG8_SA(b, h) + aoff + m * 2048 + k * 1024); } while (0)
#define PG8_LDB(dst, b, h) do { _Pragma("unroll") for (int n = 0; n < 2; ++n) _Pragma("unroll") for (int k = 0; k < 2; ++k) dst[n][k] = *(const PG8_LAS bf16x8*)(lds + PG8_SB(b, h) + boff + n * 2048 + k * 1024); } while (0)
#define PG8_MMA(ai, bj, At, Bt) do { __builtin_amdgcn_s_setprio(1); _Pragma("unroll") for (int m = 0; m < 4; ++m) _Pragma("unroll") for (int n = 0; n < 2; ++n) _Pragma("unroll") for (int k = 0; k < 2; ++k) \
        acc[ai][bj][m][n] = __builtin_amdgcn_mfma_f32_16x16x32_bf16(Bt[n][k], At[m][k], acc[ai][bj][m][n], 0, 0, 0); __builtin_amdgcn_s_setprio(0); } while (0)
#define PG8_WAIT_V(n) asm volatile("s_waitcnt vmcnt(" #n ")" ::: "memory")
#define PG8_WAIT_L(n) asm volatile("s_waitcnt lgkmcnt(" #n ")" ::: "memory")
#define PG8_BAR __builtin_amdgcn_s_barrier()
#define PG8_SCHED __builtin_amdgcn_sched_barrier(0)
    Unit cur, nxt; int ui = 0;
    if (!S.next(0, cur)) return;
    f32x4 acc[2][2][4][2];
#pragma unroll
    for (int a = 0; a < 2; ++a)
#pragma unroll
        for (int b = 0; b < 2; ++b)
#pragma unroll
            for (int m = 0; m < 4; ++m)
#pragma unroll
                for (int n = 0; n < 2; ++n) acc[a][b][m][n] = (f32x4){0.f, 0.f, 0.f, 0.f};
    bf16x8 At[4][2], B0[2][2], B1[2][2];
    const char* cA = (const char*)g.A + (size_t)cur.pm * tstep; const char* cB = (const char*)g.Bt + (size_t)cur.pn * tstep;
    S.a_ready(cur);
    if constexpr (SP2) {
        PG8_STAGE(PG8_SB(0, 0), cB, voffB); PG8_STAGE(PG8_SB(0, 1), cB + hstep, voffB); PG8_STAGE(PG8_SA(0, 0), cA, voffA); PG8_STAGE(PG8_SA(0, 1), cA + hstep, voffA);
        if (wr == 1) PG8_BAR;
        PG8_WAIT_V(2); PG8_BAR;
        PG8_STAGE(PG8_SB(1, 0), cB + kstep, voffB); PG8_STAGE(PG8_SA(1, 0), cA + kstep, voffA); PG8_STAGE(PG8_SB(1, 1), cB + hstep + kstep, voffB);
        PG8_WAIT_V(6); PG8_BAR;
    } else {
        PG8_STAGE(PG8_SB(0, 0), cB, voffB); PG8_STAGE(PG8_SA(0, 0), cA, voffA); PG8_STAGE(PG8_SB(0, 1), cB + hstep, voffB); PG8_STAGE(PG8_SA(0, 1), cA + hstep, voffA);
        if (wr == 1) PG8_BAR;
        PG8_WAIT_V(4); PG8_BAR;
        PG8_STAGE(PG8_SB(1, 0), cB + kstep, voffB); PG8_STAGE(PG8_SA(1, 0), cA + kstep, voffA); PG8_STAGE(PG8_SB(1, 1), cB + hstep + kstep, voffB);
        PG8_WAIT_V(6); PG8_BAR;
    }
    for (;;) {
        const bool has_next = S.next(ui + 1, nxt);
        const char* nA = has_next ? (const char*)g.A + (size_t)nxt.pm * tstep : cA; const char* nB = has_next ? (const char*)g.Bt + (size_t)nxt.pn * tstep : cB;
        _Pragma("unroll 1") for (int t = 0; t < nt; t += 2) {
            const bool last = (t == nt - 2);
            const char* a1 = cA + (size_t)(t + 1) * kstep;
            const char* a2 = last ? nA : cA + (size_t)(t + 2) * kstep; const char* b2 = last ? nB : cB + (size_t)(t + 2) * kstep;
            const char* a3 = a2 + kstep; const char* b3 = b2 + kstep;
            if (last && has_next) S.a_ready(nxt);
            if constexpr (SP2) {
            PG8_LDB(B0, 0, 0); PG8_LDB(B1, 0, 1); PG8_SCHED; PG8_LDA(At, 0, 0); PG8_STAGE(PG8_SA(1, 1), a1 + hstep, voffA);
            PG8_WAIT_V(8); PG8_WAIT_L(0); PG8_BAR; PG8_MMA(0, 0, At, B0); PG8_MMA(0, 1, At, B1); PG8_BAR; PG8_SCHED;
            PG8_LDA(At, 0, 1); PG8_STAGE(PG8_SB(0, 0), b2, voffB); PG8_STAGE(PG8_SB(0, 1), b2 + hstep, voffB); PG8_STAGE(PG8_SA(0, 0), a2, voffA);
            PG8_WAIT_V(8); PG8_WAIT_L(0); PG8_BAR; PG8_MMA(1, 0, At, B0); PG8_MMA(1, 1, At, B1); PG8_BAR; PG8_SCHED;
            PG8_LDB(B0, 1, 0); PG8_LDB(B1, 1, 1); PG8_SCHED; PG8_LDA(At, 1, 0); PG8_STAGE(PG8_SA(0, 1), a2 + hstep, voffA);
            PG8_WAIT_V(8); PG8_WAIT_L(0); PG8_BAR; PG8_MMA(0, 0, At, B0); PG8_MMA(0, 1, At, B1); PG8_BAR; PG8_SCHED;
            PG8_LDA(At, 1, 1); PG8_STAGE(PG8_SB(1, 0), b3, voffB); PG8_STAGE(PG8_SB(1, 1), b3 + hstep, voffB); PG8_STAGE(PG8_SA(1, 0), a3, voffA);
            PG8_WAIT_V(8); PG8_WAIT_L(0); PG8_BAR; PG8_MMA(1, 0, At, B0); PG8_MMA(1, 1, At, B1); PG8_BAR; PG8_SCHED;
            } else {
            PG8_LDB(B0, 0, 0); PG8_SCHED; PG8_LDA(At, 0, 0); PG8_STAGE(PG8_SA(1, 1), a1 + hstep, voffA);
            PG8_WAIT_L(8); PG8_BAR; PG8_WAIT_L(0); PG8_MMA(0, 0, At, B0); PG8_BAR; PG8_SCHED;
            PG8_LDB(B1, 0, 1); PG8_STAGE(PG8_SB(0, 0), b2, voffB);
            PG8_BAR; PG8_WAIT_L(0); PG8_MMA(0, 1, At, B1); PG8_BAR;
            PG8_LDA(At, 0, 1); PG8_STAGE(PG8_SA(0, 0), a2, voffA);
            PG8_BAR; PG8_WAIT_L(0); PG8_MMA(1, 0, At, B0); PG8_BAR; PG8_SCHED;
            PG8_STAGE(PG8_SB(0, 1), b2 + hstep, voffB);
            PG8_WAIT_V(6); PG8_BAR; PG8_MMA(1, 1, At, B1); PG8_BAR;
            PG8_LDB(B0, 1, 0); PG8_SCHED; PG8_LDA(At, 1, 0); PG8_STAGE(PG8_SA(0, 1), a2 + hstep, voffA);
            PG8_WAIT_L(8); PG8_BAR; PG8_WAIT_L(0); PG8_MMA(0, 0, At, B0); PG8_BAR; PG8_SCHED;
            PG8_LDB(B1, 1, 1); PG8_STAGE(PG8_SB(1, 0), b3, voffB);
            PG8_BAR; PG8_WAIT_L(0); PG8_MMA(0, 1, At, B1); PG8_BAR;
            PG8_LDA(At, 1, 1); PG8_STAGE(PG8_SA(1, 0), a3, voffA);
            PG8_BAR; PG8_WAIT_L(0); PG8_MMA(1, 0, At, B0); PG8_BAR; PG8_SCHED;
            PG8_STAGE(PG8_SB(1, 1), b3 + hstep, voffB);
            PG8_WAIT_V(6); PG8_BAR; PG8_MMA(1, 1, At, B1); PG8_BAR;
            }
        }
        if constexpr (ALIGN_EPI) { if (wr == 0) PG8_BAR; }
        if constexpr (!Epi::AFTER_DRAIN) { E(acc, cur, wr, wc, fr, fq); S.done(cur); }
        if (!has_next) break;
#pragma unroll
        for (int a = 0; a < 2; ++a)
#pragma unroll
            for (int b = 0; b < 2; ++b)
#pragma unroll
                for (int m = 0; m < 4; ++m)
#pragma unroll
                    for (int n = 0; n < 2; ++n) acc[a][b][m][n] = (f32x4){0.f, 0.f, 0.f, 0.f};
        cur = nxt; cA = nA; cB = nB; ++ui;
        if constexpr (ALIGN_EPI) { if (wr == 1) PG8_BAR; }
    }
    PG8_WAIT_V(0);
    if constexpr (!ALIGN_EPI) { if (wr == 0) PG8_BAR; }
    PG8_BAR;
    if constexpr (Epi::AFTER_DRAIN) { E.fused(acc, cur, wr, wc, fr, fq, lds, wid, lane); S.done(cur); }
#undef PG8_SA
#undef PG8_SB
#undef PG8_STAGE
#undef PG8_LDA
#undef PG8_LDB
#undef PG8_MMA
#undef PG8_WAIT_V
#undef PG8_WAIT_L
#undef PG8_BAR
#undef PG8_SCHED
}
}
constexpr int DM = 1024, NB = 8, SEQ = 4096, CTXL = 256, DEPTH = 2;
constexpr int NLAT = NB * SEQ, NCTX = NB * CTXL, NROWS = NLAT + NCTX;
constexpr int DIN = 1440, DINP = 1536, QRANK = 384, KVRANK = 256;
constexpr int PH = 8, PNK = 128, PDH = 128, PTOPK = 16, PEXP = PNK * PNK;
constexpr float EPS = 1e-6f;
constexpr float LOG2E = 1.4426950408889634f;
constexpr float C_MLA = 0.10206207261596577f * LOG2E;
constexpr float C_SWA = 0.125f * LOG2E;

typedef unsigned short bf16;
typedef short bf16x8 __attribute__((ext_vector_type(8)));
typedef short s16x4 __attribute__((ext_vector_type(4)));
typedef float f32x4 __attribute__((ext_vector_type(4)));
typedef float f32x16 __attribute__((ext_vector_type(16)));
typedef unsigned u32x4 __attribute__((ext_vector_type(4)));
typedef unsigned u32x2v __attribute__((ext_vector_type(2)));
#define LAS __attribute__((address_space(3)))

constexpr size_t MiB = 1u << 20;
constexpr size_t WS_CTL = 0, CTL_ZERO_BYTES = 64 * 1024;
constexpr size_t WS_MOD = 1 * MiB;
constexpr size_t WS_RTS = WS_MOD + 512 * 1024;
constexpr size_t WS_RTM = WS_RTS + 64 * 16 * 2 * 4;
constexpr size_t WS_WIN = 2 * MiB;
constexpr size_t WS_WUQ = WS_WIN + 2ull * DINP * DM * 2;
constexpr size_t WS_WUKV = WS_WUQ + 2ull * 768 * QRANK * 2;
constexpr size_t WS_WOUT = WS_WUKV + 2ull * 1024 * KVRANK * 2;
constexpr size_t WS_PWQ = WS_WOUT + 2ull * 1024 * 1024 * 2;
constexpr size_t WS_PKEY = WS_PWQ + 2ull * 2048 * 1024 * 2;
constexpr size_t WS_HCTX = WS_PKEY + 2ull * 8 * 2 * 128 * 128 * 2;
constexpr size_t WS_U = 32 * MiB;
constexpr size_t WS_V = WS_U + 64 * MiB;
constexpr size_t WS_AB = WS_V + 64 * MiB;
constexpr size_t WS_P = WS_AB + (size_t)NROWS * 1024 * 2;
constexpr size_t WS_X5 = WS_P + (size_t)NROWS * DIN * 2;
constexpr size_t WS_QM = WS_X5, WS_KM = WS_QM + (size_t)NROWS * 768 * 2, WS_VM = WS_KM + (size_t)NROWS * 768 * 2, WS_QS = WS_VM + (size_t)NROWS * 512 * 2,
                 WS_KS = WS_QS + (size_t)NROWS * 512 * 2, WS_END = WS_KS + (size_t)NROWS * 128 * 2;
static_assert(WS_HCTX + (size_t)NCTX * 1024 * 4 <= WS_U, "ws map (weights)");
static_assert(WS_END <= 512 * MiB, "ws map");
static_assert((size_t)NROWS * 2048 * 2 <= WS_END - WS_X5, "QP overlay");
static_assert((size_t)NROWS * 1024 <= (size_t)NROWS * DIN * 2, "TK overlay");

constexpr int LDS_BYTES = 135168;

__constant__ float ROPE_INV[24] = {1.0f, 0.5623413324356079f, 0.3162277638912201f, 0.17782793939113617f, 0.10000000149011612f, 0.05623413249850273f, 0.03162277489900589f, 0.017782794311642647f, 0.009999999776482582f, 0.005623413249850273f, 0.003162277629598975f, 0.0017782794311642647f, 0.0010000000474974513f, 0.000562341301701963f, 0.0003162277571391314f, 0.00017782794020604342f, 1.0f, 0.3162277638912201f, 0.10000000149011612f, 0.03162277489900589f, 0.009999999776482582f, 0.003162277629598975f, 0.0010000000474974513f, 0.0003162277571391314f};
struct Args {
    const float* in[23]; float* out; unsigned char* ws; int ph_lo, ph_hi;
};
typedef const __attribute__((address_space(4))) Args* ArgsP;

struct Frame {
    int tid, lane, wave, G, bid, vcu, gw, ngw, zv;
};

__device__ __forceinline__ float bf_lo(unsigned w) { return __uint_as_float(w << 16); }
__device__ __forceinline__ float bf_hi(unsigned w) { return __uint_as_float(w & 0xffff0000u); }
__device__ __forceinline__ unsigned pk2(float lo, float hi) { return pg8::cvt_pk_bf16(lo, hi); }
__device__ __forceinline__ float wave_sum(float v) {
#pragma unroll
    for (int o = 1; o < 64; o <<= 1) v += __shfl_xor(v, o);
    return v;
}
__device__ __forceinline__ void unpack8(const u32x4 w, float (&x)[8]) {
    x[0] = bf_lo(w.x); x[1] = bf_hi(w.x); x[2] = bf_lo(w.y); x[3] = bf_hi(w.y); x[4] = bf_lo(w.z); x[5] = bf_hi(w.z); x[6] = bf_lo(w.w); x[7] = bf_hi(w.w);
}
__device__ __forceinline__ u32x4 pack8(const float (&x)[8]) {
    u32x4 w; w.x = pk2(x[0], x[1]); w.y = pk2(x[2], x[3]); w.z = pk2(x[4], x[5]); w.w = pk2(x[6], x[7]); return w;
}

__device__ __forceinline__ void p0_transpose_item(const float* W, int K, int N, bf16* WT, LAS float* scr, int item, int lane) {
    const int nblk = N / 32, kb = item / nblk, nb = item % nblk, k0 = 64 * kb, n0 = 32 * nb;
#pragma unroll 8
    for (int i = 0; i < 32; ++i) { const int kk = 2 * i + (lane >> 5); scr[kk * 33 + (lane & 31)] = W[(size_t)(k0 + kk) * N + n0 + (lane & 31)]; }
    asm volatile("s_waitcnt lgkmcnt(0)" ::: "memory");
    const int c = lane & 7;
#pragma unroll
    for (int j = 0; j < 4; ++j) { const int n = (lane >> 3) + 8 * j; const LAS float* s = scr + (8 * c) * 33 + n;
        u32x4 o; o.x = pk2(s[0 * 33], s[1 * 33]); o.y = pk2(s[2 * 33], s[3 * 33]); o.z = pk2(s[4 * 33], s[5 * 33]); o.w = pk2(s[6 * 33], s[7 * 33]);
        *(u32x4*)(WT + (size_t)(n0 + n) * K + k0 + 8 * c) = o; }
    asm volatile("s_waitcnt lgkmcnt(0)" ::: "memory");
}

__device__ __forceinline__ void p0_prologue(const Frame& F, ArgsP Ap, LAS unsigned char* lds) {
    unsigned char* ws = Ap->ws;
    const float* c_in = Ap->in[1]; const float* cctx_in = Ap->in[3]; const float* ada_w = Ap->in[4]; const float* ada_b = Ap->in[5];
    for (int task = F.bid; task < 48; task += F.G) {
        const int l = task / 24, cc = task % 24;
        LAS float* sl = (LAS float*)lds;
        LAS float* red = (LAS float*)(lds + 9 * 1024 * 4);
        __syncthreads();
        for (int i = F.tid; i < 9 * 1024; i += 512) { const int s = i >> 10, k = i & 1023; const float x = (s < 8) ? c_in[s * 1024 + k] : cctx_in[k]; sl[i] = x / (1.f + __expf(-x)); }
        __syncthreads();
        const int c0 = cc * 256 + F.lane * 4; const int kbase = F.wave * 128;
        f32x4 acc[9];
#pragma unroll
        for (int s = 0; s < 9; ++s) acc[s] = (f32x4){0.f, 0.f, 0.f, 0.f};
        const float* wp = ada_w + ((size_t)l * 1024 + kbase) * 6144 + c0;
#pragma unroll 4
        for (int kk = 0; kk < 128; ++kk) { const f32x4 w = *(const f32x4*)(wp + (size_t)kk * 6144);
#pragma unroll
            for (int s = 0; s < 9; ++s) acc[s] += w * sl[s * 1024 + kbase + kk]; }
#pragma unroll
        for (int s = 0; s < 9; ++s) *(LAS f32x4*)(red + (F.wave * 9 + s) * 256 + F.lane * 4) = acc[s];
        __syncthreads();
        float* MOD = (float*)(ws + WS_MOD);
        for (int i = F.tid; i < 9 * 256; i += 512) { const int s = i >> 8, ci = i & 255; float v = ada_b[l * 6144 + cc * 256 + ci];
#pragma unroll
            for (int w = 0; w < 8; ++w) v += red[(w * 9 + s) * 256 + ci];
            MOD[((size_t)l * 9 + s) * 6144 + cc * 256 + ci] = v; }
        __syncthreads();
    }
    __syncthreads();
    if (F.bid == F.G - 1) {
        float* rts = (float*)(ws + WS_RTS); float* rtm = (float*)(ws + WS_RTM);
        for (int i = F.tid; i < 64 * 24; i += 512) {
            const int pos = i / 24, k = i % 24; const float a = (float)pos * ROPE_INV[k];
            const float rev = a * 0.15915494309189535f;
            const float cs = __builtin_amdgcn_cosf(rev), sn = __builtin_amdgcn_sinf(rev);
            if (k < 16) { rts[(pos * 16 + k) * 2] = cs; rts[(pos * 16 + k) * 2 + 1] = sn; } else { rtm[(pos * 8 + (k - 16)) * 2] = cs; rtm[(pos * 8 + (k - 16)) * 2 + 1] = sn; }
        }
    }
    LAS float* scr = (LAS float*)(lds + F.wave * 16384);
    constexpr int I_WIN = (DM / 64) * (DIN / 32), I_WUQ = (QRANK / 64) * (768 / 32), I_WUKV = (KVRANK / 64) * (1024 / 32), I_WOUT = (DM / 64) * (DM / 32), I_PWQ = (DM / 64) * (2048 / 32);
    constexpr int I_L = I_WIN + I_WUQ + I_WUKV + I_WOUT + I_PWQ;
    for (int it = F.gw; it < 2 * I_L; it += F.ngw) {
        const int l = it / I_L; int r = it % I_L;
        if (r < I_WIN) { p0_transpose_item(Ap->in[8] + (size_t)l * DM * DIN, DM, DIN, (bf16*)(ws + WS_WIN) + (size_t)l * DINP * DM, scr, r, F.lane); continue; } r -= I_WIN;
        if (r < I_WUQ) { p0_transpose_item(Ap->in[10] + (size_t)l * QRANK * 768, QRANK, 768, (bf16*)(ws + WS_WUQ) + (size_t)l * 768 * QRANK, scr, r, F.lane); continue; } r -= I_WUQ;
        if (r < I_WUKV) { p0_transpose_item(Ap->in[12] + (size_t)l * KVRANK * 1024, KVRANK, 1024, (bf16*)(ws + WS_WUKV) + (size_t)l * 1024 * KVRANK, scr, r, F.lane); continue; } r -= I_WUKV;
        if (r < I_WOUT) { p0_transpose_item(Ap->in[18] + (size_t)l * DM * DM, DM, DM, (bf16*)(ws + WS_WOUT) + (size_t)l * DM * DM, scr, r, F.lane); continue; } r -= I_WOUT;
        p0_transpose_item(Ap->in[19] + (size_t)l * DM * 2048, DM, 2048, (bf16*)(ws + WS_PWQ) + (size_t)l * 2048 * DM, scr, r, F.lane);
    }
    { const size_t gt = (size_t)F.bid * 512 + F.tid, nt = (size_t)F.G * 512;
      for (size_t i = gt; i < 2ull * 96 * DM / 8; i += nt) { const size_t l = i / (96 * DM / 8), e = i % (96 * DM / 8);
          *(u32x4*)((bf16*)(ws + WS_WIN) + l * DINP * DM + (size_t)DIN * DM + e * 8) = (u32x4){(unsigned)F.zv, (unsigned)F.zv, (unsigned)F.zv, (unsigned)F.zv}; }
      const size_t NKEY8 = 2ull * 8 * 2 * 128 * 128 / 8, NU8 = 2ull * PEXP * DM / 8;
      for (size_t i = gt; i < NKEY8 + 2 * NU8; i += nt) {
          const float* src; bf16* dst; size_t j;
          if (i < NKEY8) { src = Ap->in[20]; dst = (bf16*)(ws + WS_PKEY); j = i; }
          else if (i < NKEY8 + NU8) { src = Ap->in[21]; dst = (bf16*)(ws + WS_U); j = i - NKEY8; }
          else { src = Ap->in[22]; dst = (bf16*)(ws + WS_V); j = i - NKEY8 - NU8; }
          const f32x4 a = *(const f32x4*)(src + j * 8), b = *(const f32x4*)(src + j * 8 + 4);
          u32x4 o; o.x = pk2(a[0], a[1]); o.y = pk2(a[2], a[3]); o.z = pk2(b[0], b[1]); o.w = pk2(b[2], b[3]);
          *(u32x4*)(dst + j * 8) = o; }
    }
}

__device__ __forceinline__ void norm_mod_phase(const Frame& F, ArgsP Ap, int l, int which, int nrows) {
    unsigned char* ws = Ap->ws;
    const float* MOD = (const float*)(ws + WS_MOD);
    const float* gn = Ap->in[which ? 7 : 6] + l * DM;
    bf16* AB = (bf16*)(ws + WS_AB);
    const bool from_input = (which == 0 && l == 0);
    for (int r = F.gw; r < nrows; r += F.ngw) {
        const bool lat = r < NLAT;
        const float* hr = lat ? ((from_input ? Ap->in[0] : Ap->out) + (size_t)r * DM) : ((from_input ? Ap->in[2] : (const float*)(ws + WS_HCTX)) + (size_t)(r - NLAT) * DM);
        const int s = lat ? (r >> 12) : 8;
        const float* mp = MOD + ((size_t)l * 9 + s) * 6144 + (which ? 3 * DM : 0);
        f32x4 v[4]; float ss = 0.f;
#pragma unroll
        for (int j = 0; j < 4; ++j) { v[j] = *(const f32x4*)(hr + 256 * j + 4 * F.lane); ss += (v[j][0] * v[j][0] + v[j][1] * v[j][1]) + (v[j][2] * v[j][2] + v[j][3] * v[j][3]); }
        ss = wave_sum(ss);
        const float rinv = rsqrtf(ss * (1.f / DM) + EPS);
#pragma unroll
        for (int j = 0; j < 4; ++j) { const int c = 256 * j + 4 * F.lane;
            const f32x4 g = *(const f32x4*)(gn + c), sh = *(const f32x4*)(mp + c), sc = *(const f32x4*)(mp + DM + c);
            const f32x4 y = v[j] * rinv * g; const f32x4 a = y * (sc + 1.f) + sh;
            u32x2v o; o.x = pk2(a[0], a[1]); o.y = pk2(a[2], a[3]);
            *(u32x2v*)(AB + (size_t)r * DM + c) = o; }
    }
}

__device__ __forceinline__ void e2_phase(const Frame& F, ArgsP Ap, int l, int nrows) {
    unsigned char* ws = Ap->ws;
    const bf16* P = (const bf16*)(ws + WS_P);
    bf16* QAN = (bf16*)(ws + WS_AB); bf16* KVAN = QAN + (size_t)NROWS * QRANK;
    bf16* QS = (bf16*)(ws + WS_QS); bf16* KS = (bf16*)(ws + WS_KS);
    const float* qa_g = Ap->in[9] + l * QRANK; const float* kva_g = Ap->in[11] + l * KVRANK;
    const float* sqn_g = Ap->in[15] + l * 64; const float* skn_g = Ap->in[16] + l * 64;
    const float* rts = (const float*)(ws + WS_RTS);
    const int lane = F.lane;
    for (int r = F.gw; r < nrows; r += F.ngw) {
        const bf16* pr = P + (size_t)r * DIN;
        const bool lat = r < NLAT; const int pos = r & (SEQ - 1), rp = pos >> 6, cp = pos & 63;
        u32x4 wqa = (u32x4){0u, 0u, 0u, 0u}, wkva = (u32x4){0u, 0u, 0u, 0u}, wsk = (u32x4){0u, 0u, 0u, 0u};
        if (lane < 48) wqa = *(const u32x4*)(pr + 8 * lane);
        const u32x4 wsq = *(const u32x4*)(pr + QRANK + 8 * lane);
        if (lane < 32) wkva = *(const u32x4*)(pr + 896 + 8 * lane);
        if (lane < 16) wsk = *(const u32x4*)(pr + 1184 + 8 * lane);
        float x[8];
        { unpack8(wqa, x); float ss = 0.f;
#pragma unroll
          for (int e = 0; e < 8; ++e) ss += x[e] * x[e];
          ss = wave_sum(ss); const float rinv = rsqrtf(ss * (1.f / QRANK) + EPS);
          if (lane < 48) { float y[8];
#pragma unroll
              for (int e = 0; e < 8; ++e) y[e] = x[e] * rinv * qa_g[8 * lane + e];
              *(u32x4*)(QAN + (size_t)r * QRANK + 8 * lane) = pack8(y); } }
        { unpack8(wkva, x); float ss = 0.f;
#pragma unroll
          for (int e = 0; e < 8; ++e) ss += x[e] * x[e];
          ss = wave_sum(ss); const float rinv = rsqrtf(ss * (1.f / KVRANK) + EPS);
          if (lane < 32) { float y[8];
#pragma unroll
              for (int e = 0; e < 8; ++e) y[e] = x[e] * rinv * kva_g[8 * lane + e];
              *(u32x4*)(KVAN + (size_t)r * KVRANK + 8 * lane) = pack8(y); } }
        const int ch = lane & 7;
        const float* tab = rts + (size_t)((ch < 4) ? rp : cp) * 32 + (ch & 1) * 16;
#pragma unroll
        for (int which = 0; which < 2; ++which) {
            unpack8(which ? wsk : wsq, x); float ss = 0.f;
#pragma unroll
            for (int e = 0; e < 8; ++e) ss += x[e] * x[e];
            ss += __shfl_xor(ss, 1); ss += __shfl_xor(ss, 2); ss += __shfl_xor(ss, 4);
            const float rinv = rsqrtf(ss * (1.f / 64.f) + EPS);
            const float* gg = which ? skn_g : sqn_g;
            float y[8], o[8];
#pragma unroll
            for (int e = 0; e < 8; ++e) y[e] = x[e] * rinv * gg[8 * ch + e];
#pragma unroll
            for (int e = 0; e < 8; ++e) { const float py = __shfl_xor(y[e], 2);
                if (lat) { const float cs = tab[2 * e], sn = tab[2 * e + 1]; o[e] = (ch & 2) ? (y[e] * cs + py * sn) : (y[e] * cs - py * sn); } else o[e] = y[e]; }
            if (which == 0) {
#pragma unroll
                for (int e = 0; e < 8; ++e) o[e] *= C_SWA;
                *(u32x4*)(QS + (size_t)r * 512 + 8 * lane) = pack8(o);
            } else if (lane < 16) *(u32x4*)(KS + (size_t)r * 128 + 8 * lane) = pack8(o);
        }
    }
}

__device__ __forceinline__ void e3_phase(const Frame& F, ArgsP Ap, int l, int nrows) {
    unsigned char* ws = Ap->ws;
    const bf16* P = (const bf16*)(ws + WS_P);
    bf16* QM = (bf16*)(ws + WS_QM); bf16* KM = (bf16*)(ws + WS_KM);
    const float* qn_g = Ap->in[13] + l * 96; const float* kn_g = Ap->in[14] + l * 96;
    const float* rtm = (const float*)(ws + WS_RTM);
    const int lane = F.lane, hl = lane / 12, ch = lane % 12, gbase = hl * 12;
    for (int r = F.gw; r < nrows; r += F.ngw) {
        const bool lat = r < NLAT; const int pos = r & (SEQ - 1), rp = pos >> 6, cp = pos & 63;
        const float* tab = rtm + (size_t)((ch < 10) ? rp : cp) * 16;
#pragma unroll
        for (int pass = 0; pass < 2; ++pass) {
            const int head = pass * 5 + hl; const bool valid = (lane < 60) && (head < 8);
#pragma unroll
            for (int which = 0; which < 2; ++which) {
                u32x4 w = (u32x4){0u, 0u, 0u, 0u};
                bf16* dstp = (which ? KM : QM) + (size_t)r * 768 + head * 96 + ch * 8;
                if (valid) { if (which == 1 && ch >= 8) w = *(const u32x4*)(P + (size_t)r * DIN + 1152 + (ch - 8) * 8); else w = *(const u32x4*)dstp; }
                float x[8]; unpack8(w, x); float ss = 0.f;
#pragma unroll
                for (int e = 0; e < 8; ++e) ss += x[e] * x[e];
                float tot = 0.f;
#pragma unroll
                for (int i = 0; i < 12; ++i) tot += __shfl(ss, (gbase + i) & 63);
                const float rinv = rsqrtf(tot * (1.f / 96.f) + EPS);
                const float* gg = which ? kn_g : qn_g;
                float y[8], o[8];
#pragma unroll
                for (int e = 0; e < 8; ++e) y[e] = x[e] * rinv * gg[8 * ch + e];
#pragma unroll
                for (int e = 0; e < 8; ++e) { const float py = __shfl_xor(y[e], 1);
                    if (lat && ch >= 8) { const float cs = tab[2 * e], sn = tab[2 * e + 1]; o[e] = (ch & 1) ? (y[e] * cs + py * sn) : (y[e] * cs - py * sn); } else o[e] = y[e]; }
                if (which == 0) {
#pragma unroll
                    for (int e = 0; e < 8; ++e) o[e] *= C_MLA;
                }
                if (valid) *(u32x4*)dstp = pack8(o);
            }
        }
    }
}
namespace att {
constexpr int SHM_V = 64 * 64 * 2, SHM_K = 64 * 256, LDS_ATT = 2 * SHM_V + 2 * SHM_K + 8 * 64 * 4;
#define KSWZ(row, colB) ((row) * 256 + ((colB) ^ (((row) & 7) << 4)))
#define SBAR() __builtin_amdgcn_sched_barrier(0)
__device__ __forceinline__ int crow(int r, int hi) { return (r & 3) + 8 * (r >> 2) + 4 * hi; }
__device__ __forceinline__ int v_st(int k, int c) { const int kk = (k & ~0xC) | ((k & 4) << 1) | ((k & 8) >> 1); return ((kk >> 3) * 2 + (c >> 5)) * 512 + ((kk & 7) * 32 + (c & 31)) * 2; }
__device__ __forceinline__ int v_rd_base(int lane) { return ((lane & 3) << 3) | (((lane >> 2) & 3) << 6) | (((lane >> 4) & 1) << 5) | (((lane >> 5) & 1) << 8); }
constexpr int v_rd_off(int d0, int ks, int half) { return d0 * 512 + ks * 2048 + half * 1024; }
template <int OFF> __device__ __forceinline__ s16x4 tr_read(int vb) {
    s16x4 r; asm volatile("ds_read_b64_tr_b16 %0, %1 offset:%2" : "=&v"(r) : "v"(vb), "i"(OFF) : "memory"); return r;
}
template <int D0> __device__ __forceinline__ void pv_one(f32x16& od, int vb, bf16x8 pa0, bf16x8 pa1, bf16x8 pa2, bf16x8 pa3) {
    const s16x4 l0 = tr_read<v_rd_off(D0, 0, 0)>(vb), h0 = tr_read<v_rd_off(D0, 0, 1)>(vb), l1 = tr_read<v_rd_off(D0, 1, 0)>(vb), h1 = tr_read<v_rd_off(D0, 1, 1)>(vb);
    const s16x4 l2 = tr_read<v_rd_off(D0, 2, 0)>(vb), h2 = tr_read<v_rd_off(D0, 2, 1)>(vb), l3 = tr_read<v_rd_off(D0, 3, 0)>(vb), h3 = tr_read<v_rd_off(D0, 3, 1)>(vb);
    asm volatile("s_waitcnt lgkmcnt(0)" ::: "memory"); SBAR();
#define PK(L, H) (bf16x8){L[0], L[1], L[2], L[3], H[0], H[1], H[2], H[3]}
    od = __builtin_amdgcn_mfma_f32_32x32x16_bf16(pa0, PK(l0, h0), od, 0, 0, 0);
    od = __builtin_amdgcn_mfma_f32_32x32x16_bf16(pa1, PK(l1, h1), od, 0, 0, 0);
    od = __builtin_amdgcn_mfma_f32_32x32x16_bf16(pa2, PK(l2, h2), od, 0, 0, 0);
    od = __builtin_amdgcn_mfma_f32_32x32x16_bf16(pa3, PK(l3, h3), od, 0, 0, 0);
#undef PK
}
__device__ __forceinline__ void pv2(f32x16* o, int vb, bf16x8 pa0, bf16x8 pa1, bf16x8 pa2, bf16x8 pa3) {
    pv_one<0>(o[0], vb, pa0, pa1, pa2, pa3); pv_one<1>(o[1], vb, pa0, pa1, pa2, pa3);
}
template <int ND0> __device__ __forceinline__ void qkt(f32x16& p0, f32x16& p1, const char* Ks, const bf16x8* qr, int r32, int hi) {
    p0 = f32x16{}; p1 = f32x16{};
#pragma unroll
    for (int d0 = 0; d0 < ND0; ++d0) { const int cb = (d0 * 16 + hi * 8) * 2;
        const bf16x8 b0 = *reinterpret_cast<const bf16x8*>(Ks + KSWZ(r32, cb));
        const bf16x8 b1 = *reinterpret_cast<const bf16x8*>(Ks + KSWZ(32 + r32, cb));
        p0 = __builtin_amdgcn_mfma_f32_32x32x16_bf16(b0, qr[d0], p0, 0, 0, 0);
        p1 = __builtin_amdgcn_mfma_f32_32x32x16_bf16(b1, qr[d0], p1, 0, 0, 0); }
}
__device__ __forceinline__ void wmask(f32x16& p0, f32x16& p1, int kp0, int qp, int hi) {
#pragma unroll
    for (int r = 0; r < 16; ++r) { const int d0 = kp0 + crow(r, hi) - qp; const int d1 = d0 + 32;
        if (d0 > 128 || d0 < -128) p0[r] = -INFINITY; if (d1 > 128 || d1 < -128) p1[r] = -INFINITY; }
}
__device__ __forceinline__ void smpack(f32x16& p0, f32x16& p1, float& l_reg, bf16x8& pa0, bf16x8& pa1, bf16x8& pa2, bf16x8& pa3) {
#pragma unroll
    for (int r = 0; r < 16; ++r) p0[r] = __builtin_amdgcn_exp2f(p0[r]);
#pragma unroll
    for (int r = 0; r < 16; ++r) p1[r] = __builtin_amdgcn_exp2f(p1[r]);
    float ps = 0.f;
#pragma unroll
    for (int r = 0; r < 16; ++r) ps += p0[r];
#pragma unroll
    for (int r = 0; r < 16; ++r) ps += p1[r];
    l_reg += ps;
#define PK4(P, BASE, OUT) do { unsigned a0 = pk2(P[BASE + 0], P[BASE + 1]), a1 = pk2(P[BASE + 2], P[BASE + 3]);   \
    unsigned b0 = pk2(P[BASE + 4], P[BASE + 5]), b1 = pk2(P[BASE + 6], P[BASE + 7]);                              \
    auto r0 = __builtin_amdgcn_permlane32_swap(a0, b0, false, false); auto r1 = __builtin_amdgcn_permlane32_swap(a1, b1, false, false); \
    u32x4 w = {r0[0], r1[0], r0[1], r1[1]}; OUT = *reinterpret_cast<bf16x8*>(&w); } while (0)
    PK4(p0, 0, pa0); PK4(p0, 8, pa1); PK4(p1, 0, pa2); PK4(p1, 8, pa3);
#undef PK4
}

struct Unit {
    const bf16* Q; int ldq;
    const bf16* K; int ldk;
    const bf16* V; int ldv;
    bf16* O;
    int qrow0;
    int ctx_row0;
    int lat_row0;
    int nt;
    int qpos0;
    int kpos0;
    int masked;
    float l_init;
};

template <int DQK, bool MASKED>
__device__ __forceinline__ void attn_unit(const Unit& U, char* lds, const int tid) {
    constexpr int ND0 = DQK / 16, NCH = DQK / 8;
    const int wid = tid >> 6, lane = tid & 63, r32 = lane & 31, hi = lane >> 5;
    char* V_lds = lds; char* K_lds = lds + 2 * SHM_V;
    float* wsf = (float*)(lds + 2 * SHM_V + 2 * SHM_K) + wid * 64;
    float l_reg = (hi == 0) ? U.l_init : 0.f; f32x16 o[2] = {}; bf16x8 qr[ND0];
    const bf16* Qw = U.Q + (size_t)(U.qrow0 + wid * 32 + r32) * U.ldq + hi * 8;
#pragma unroll
    for (int d0 = 0; d0 < ND0; ++d0) qr[d0] = *reinterpret_cast<const bf16x8*>(Qw + d0 * 16);
    const int vk = tid >> 3, vc = (tid & 7) * 8, vst = v_st(vk, vc);
    const int k0r = tid / NCH, k0c = tid % NCH;
    const bool k1on = (NCH == 12) && (tid < 256);
    const int k1i = k1on ? (tid + 512) : tid, k1r = k1i / NCH, k1c = k1i % NCH;
    const int vb0 = (int)(uintptr_t)V_lds + v_rd_base(lane);
    struct Slot { bf16x8 v, k0, k1; } s0, s1;
    auto tile_row = [&](int t) -> int { return (t < 4) ? (U.ctx_row0 + 64 * t) : (U.lat_row0 + 64 * (t - 4)); };
#define SLOAD(S, t) do { const int kr_ = tile_row(t); \
        S.v = *reinterpret_cast<const bf16x8*>(U.V + (size_t)(kr_ + vk) * U.ldv + vc); \
        S.k0 = *reinterpret_cast<const bf16x8*>(U.K + (size_t)(kr_ + k0r) * U.ldk + k0c * 8); \
        if (NCH == 12) S.k1 = *reinterpret_cast<const bf16x8*>(U.K + (size_t)(kr_ + k1r) * U.ldk + k1c * 8); } while (0)
#define SWRITE(b, S) do { *reinterpret_cast<bf16x8*>(V_lds + (b) * SHM_V + vst) = S.v; \
        *reinterpret_cast<bf16x8*>(K_lds + (b) * SHM_K + KSWZ(k0r, k0c * 16)) = S.k0; \
        if (NCH == 12) { if (k1on) *reinterpret_cast<bf16x8*>(K_lds + (b) * SHM_K + KSWZ(k1r, k1c * 16)) = S.k1; } } while (0)
#define MASK(P0, P1, t) do { if (MASKED && (t) >= 4) wmask(P0, P1, U.kpos0 + 64 * ((t) - 4), U.qpos0 + wid * 32 + r32, hi); } while (0)
    f32x16 pA0, pA1, pB0, pB1; bf16x8 pa0, pa1, pa2, pa3; const int NT = U.nt;
    __syncthreads();
    SLOAD(s0, 0); SWRITE(0, s0); __syncthreads();
    qkt<ND0>(pA0, pA1, K_lds, qr, r32, hi); MASK(pA0, pA1, 0);
    SLOAD(s1, 1); if (2 < NT) SLOAD(s0, 2);
    SWRITE(1, s1); __syncthreads();
    for (int j = 1; j + 1 < NT; j += 2) {
        SBAR(); qkt<ND0>(pB0, pB1, K_lds + SHM_K, qr, r32, hi); MASK(pB0, pB1, j);
        smpack(pA0, pA1, l_reg, pa0, pa1, pa2, pa3); SBAR();
        SLOAD(s1, j + 2); SBAR();
        pv2(o, vb0, pa0, pa1, pa2, pa3);
        __syncthreads(); SWRITE(0, s0); __syncthreads();
        SBAR(); qkt<ND0>(pA0, pA1, K_lds, qr, r32, hi); MASK(pA0, pA1, j + 1);
        smpack(pB0, pB1, l_reg, pa0, pa1, pa2, pa3); SBAR();
        if (j + 3 < NT) SLOAD(s0, j + 3); SBAR();
        pv2(o, vb0 + SHM_V, pa0, pa1, pa2, pa3);
        __syncthreads(); SWRITE(1, s1); __syncthreads();
    }
    SBAR(); qkt<ND0>(pB0, pB1, K_lds + SHM_K, qr, r32, hi); MASK(pB0, pB1, NT - 1);
    smpack(pA0, pA1, l_reg, pa0, pa1, pa2, pa3); SBAR();
    pv2(o, vb0, pa0, pa1, pa2, pa3);
    smpack(pB0, pB1, l_reg, pa0, pa1, pa2, pa3); SBAR();
    pv2(o, vb0 + SHM_V, pa0, pa1, pa2, pa3);
    { auto rr = __builtin_amdgcn_permlane32_swap(__float_as_uint(l_reg), __float_as_uint(l_reg), false, false);
      l_reg = __uint_as_float(rr[0]) + __uint_as_float(rr[1]); }
    if (hi == 0) wsf[r32] = l_reg;
    asm volatile("s_waitcnt lgkmcnt(0)" ::: "memory");
    float rli[16];
#pragma unroll
    for (int r = 0; r < 16; ++r) rli[r] = 1.f / wsf[crow(r, hi)];
    bf16* Ow = U.O + (size_t)(U.qrow0 + wid * 32) * 1024;
#pragma unroll
    for (int r = 0; r < 16; ++r) { const int orow = crow(r, hi);
#pragma unroll
        for (int d0 = 0; d0 < 2; ++d0) { const unsigned w = pk2(o[d0][r] * rli[r], 0.f); Ow[(size_t)orow * 1024 + d0 * 32 + r32] = (bf16)(w & 0xffffu); } }
#undef SLOAD
#undef SWRITE
#undef MASK
}
#undef KSWZ
}

__device__ __forceinline__ void attn_phase(const Frame& F, ArgsP Ap, int l, char* lds) {
    unsigned char* ws = Ap->ws;
    const bf16* QM = (const bf16*)(ws + WS_QM); const bf16* KM = (const bf16*)(ws + WS_KM); const bf16* VM = (const bf16*)(ws + WS_VM);
    const bf16* QS = (const bf16*)(ws + WS_QS); const bf16* KS = (const bf16*)(ws + WS_KS); const bf16* VS = (const bf16*)(ws + WS_P) + 1312;
    bf16* OB = (bf16*)(ws + WS_AB);
    const float* sink = Ap->in[17] + l * 8;
    const int nunits = (l == 0) ? 1024 + 64 : 1024;
    for (int u = F.vcu; u < nunits; u += F.G) {
        const bool isl = u < 1024;
        const int i = u >> 8, c = u & 31, b = isl ? ((u & 255) >> 5) : ((u - 1024) >> 3), h = isl ? (2 * i + (c >> 4)) : (u & 7), qb = c & 15;
        att::Unit U; U.Q = QM + h * 96; U.ldq = 768; U.K = KM + h * 96; U.ldk = 768; U.V = VM + h * 64; U.ldv = 512; U.O = OB + h * 64;
        U.qrow0 = isl ? (b * SEQ + qb * 256) : (NLAT + b * CTXL); U.ctx_row0 = NLAT + b * CTXL; U.lat_row0 = b * SEQ; U.nt = isl ? (4 + SEQ / 64) : 4; U.qpos0 = 0; U.kpos0 = 0; U.masked = 0; U.l_init = 0.f;
        att::attn_unit<96, false>(U, lds, F.tid);
    }
    for (int u = F.vcu; u < nunits; u += F.G) {
        const bool isl = u < 1024;
        const int i = u >> 8, c = u & 31, b = isl ? ((u & 255) >> 5) : ((u - 1024) >> 3), h = isl ? (2 * i + (c >> 4)) : (u & 7), qb = c & 15, g = h >> 2;
        const int q0 = qb * 256; int k_lo = q0 - 128; if (k_lo < 0) k_lo = 0; int k_hi = q0 + 256 + 128; if (k_hi > SEQ) k_hi = SEQ;
        att::Unit U; U.Q = QS + h * 64; U.ldq = 512; U.K = KS + g * 64; U.ldk = 128; U.V = VS + g * 64; U.ldv = DIN; U.O = OB + 512 + h * 64;
        U.qrow0 = isl ? (b * SEQ + q0) : (NLAT + b * CTXL); U.ctx_row0 = NLAT + b * CTXL; U.lat_row0 = b * SEQ + k_lo; U.nt = isl ? (4 + (k_hi - k_lo) / 64) : 4; U.qpos0 = q0; U.kpos0 = k_lo; U.masked = 1;
        U.l_init = __builtin_amdgcn_exp2f(sink[h] * LOG2E);
        att::attn_unit<64, true>(U, lds, F.tid);
    }
}
__device__ __forceinline__ unsigned f2key(float f) { const unsigned u = __float_as_uint(f); return (u & 0x80000000u) ? ~u : (u | 0x80000000u); }
__device__ __forceinline__ float key2f(unsigned k) { const unsigned u = (k & 0x80000000u) ? (k & 0x7fffffffu) : ~k; return __uint_as_float(u); }
#define CE_DESC(a, b) do { const unsigned _hi = max(a, b), _lo = min(a, b); a = _hi; b = _lo; } while (0)
__device__ __forceinline__ void sort16_desc(unsigned (&a)[16]) {
#pragma unroll
    for (int k = 2; k <= 16; k <<= 1)
#pragma unroll
        for (int j = k >> 1; j > 0; j >>= 1)
#pragma unroll
            for (int i = 0; i < 16; ++i) { const int p = i ^ j;
                if (p > i) { if ((i & k) == 0) { CE_DESC(a[i], a[p]); } else { CE_DESC(a[p], a[i]); } } }
}
__device__ __forceinline__ void merge16_desc(unsigned (&t)[16], const unsigned (&c)[16]) {
#pragma unroll
    for (int i = 0; i < 16; ++i) t[i] = max(t[i], c[15 - i]);
#pragma unroll
    for (int j = 8; j > 0; j >>= 1)
#pragma unroll
        for (int i = 0; i < 16; ++i) { const int p = i ^ j; if (p > i) CE_DESC(t[i], t[p]); }
}

__device__ __forceinline__ void topk_phase(const Frame& F, ArgsP Ap, int l, int nrows) {
    unsigned char* ws = Ap->ws;
    const bf16* QP = (const bf16*)(ws + WS_X5);
    const bf16* PK = (const bf16*)(ws + WS_PKEY) + (size_t)l * 16 * 128 * 128;
    unsigned* TK = (unsigned*)(ws + WS_P);
    const int lane = F.lane, r32 = lane & 31, hi = lane >> 5;
    const int nunits = (nrows / 32) * 16;
    for (int u = F.gw; u < nunits; u += F.ngw) {
        const int hp = u & 15, rg = u >> 4, row = rg * 32 + r32;
        const bf16* qrow = QP + (size_t)row * 2048 + hp * 128 + hi * 8;
        bf16x8 bq[8];
#pragma unroll
        for (int s = 0; s < 8; ++s) bq[s] = *reinterpret_cast<const bf16x8*>(qrow + s * 16);
        const bf16* kb = PK + (size_t)hp * 128 * 128 + (size_t)r32 * 128 + hi * 8;
        unsigned top[16];
#pragma unroll
        for (int blk = 0; blk < 4; ++blk) {
            f32x16 acc = f32x16{};
#pragma unroll
            for (int s = 0; s < 8; ++s) { const bf16x8 ka = *reinterpret_cast<const bf16x8*>(kb + (size_t)blk * 32 * 128 + s * 16);
                acc = __builtin_amdgcn_mfma_f32_32x32x16_bf16(ka, bq[s], acc, 0, 0, 0); }
            unsigned c[16];
#pragma unroll
            for (int r = 0; r < 16; ++r) { const int kidx = blk * 32 + (r & 3) + 8 * (r >> 2) + 4 * hi; c[r] = (f2key(acc[r]) & ~127u) | (unsigned)(127 - kidx); }
            sort16_desc(c);
            if (blk == 0) {
#pragma unroll
                for (int i = 0; i < 16; ++i) top[i] = c[i];
            } else merge16_desc(top, c);
        }
        unsigned oth[16];
#pragma unroll
        for (int i = 0; i < 16; ++i) oth[i] = (unsigned)__shfl_xor((int)top[i], 32);
        merge16_desc(top, oth);
        if (hi == 0) { u32x4* dst = (u32x4*)(TK + ((size_t)row * 16 + hp) * 16);
            dst[0] = (u32x4){top[0], top[1], top[2], top[3]}; dst[1] = (u32x4){top[4], top[5], top[6], top[7]};
            dst[2] = (u32x4){top[8], top[9], top[10], top[11]}; dst[3] = (u32x4){top[12], top[13], top[14], top[15]}; }
    }
}

typedef __bf16 bf16x2_t __attribute__((ext_vector_type(2)));
__device__ __forceinline__ float dot2(unsigned w, unsigned x, float acc) { return __builtin_amdgcn_fdot2_f32_bf16(__builtin_bit_cast(bf16x2_t, w), __builtin_bit_cast(bf16x2_t, x), acc, false); }
__device__ __forceinline__ float dot16(const u32x4 a0, const u32x4 a1, const u32x4 x0, const u32x4 x1) {
    float s0 = dot2(a0.x, x0.x, 0.f), s1 = dot2(a0.y, x0.y, 0.f), s2 = dot2(a0.z, x0.z, 0.f), s3 = dot2(a0.w, x0.w, 0.f);
    s0 = dot2(a1.x, x1.x, s0); s1 = dot2(a1.y, x1.y, s1); s2 = dot2(a1.z, x1.z, s2); s3 = dot2(a1.w, x1.w, s3);
    return (s0 + s1) + (s2 + s3);
}
__device__ __forceinline__ void fma8(float (&o)[8], const u32x4 v, float w) {
    o[0] += w * bf_lo(v.x); o[1] += w * bf_hi(v.x); o[2] += w * bf_lo(v.y); o[3] += w * bf_hi(v.y);
    o[4] += w * bf_lo(v.z); o[5] += w * bf_hi(v.z); o[6] += w * bf_lo(v.w); o[7] += w * bf_hi(v.w);
}

__device__ __forceinline__ void peer_phase(const Frame& F, ArgsP Ap, int l, int nrows, char* lds) {
    unsigned char* ws = Ap->ws;
    const unsigned* TK = (const unsigned*)(ws + WS_P);
    const bf16* Bx = (const bf16*)(ws + WS_AB);
    const bf16* Ut = (const bf16*)(ws + WS_U) + (size_t)l * PEXP * DM;
    const bf16* Vt = (const bf16*)(ws + WS_V) + (size_t)l * PEXP * DM;
    const float* MOD = (const float*)(ws + WS_MOD);
    const int lane = F.lane;
    int* s_idx = (int*)(lds + F.wave * 2048); float* s_g = (float*)(lds + F.wave * 2048 + 512); int* s_sub = (int*)(lds + F.wave * 2048 + 1024);
    for (int r = F.gw; r < nrows; r += F.ngw) {
        const bool lat = r < NLAT; const int smp = lat ? (r >> 12) : 8;
        {
            const int h = lane & 7;
            const u32x4* t0 = (const u32x4*)(TK + ((size_t)r * 16 + 2 * h) * 16); const u32x4* t1 = t0 + 4;
            unsigned k0[16], k1[16];
#pragma unroll
            for (int q = 0; q < 4; ++q) { const u32x4 a = t0[q], b = t1[q]; k0[4 * q] = a.x; k0[4 * q + 1] = a.y; k0[4 * q + 2] = a.z; k0[4 * q + 3] = a.w; k1[4 * q] = b.x; k1[4 * q + 1] = b.y; k1[4 * q + 2] = b.z; k1[4 * q + 3] = b.w; }
            float f0[16], f1[16];
#pragma unroll
            for (int i = 0; i < 16; ++i) { f0[i] = key2f(k0[i] & ~127u); f1[i] = key2f(k1[i] & ~127u); }
            if (lane < 8) {
#pragma unroll
                for (int i = 0; i < 16; ++i) { s_sub[h * 32 + i] = 127 - (int)(k0[i] & 127u); s_sub[h * 32 + 16 + i] = 127 - (int)(k1[i] & 127u); }
            }
            unsigned top[16];
#pragma unroll
            for (int a = 0; a < 16; ++a) {
                unsigned c[16];
#pragma unroll
                for (int b = 0; b < 16; ++b) c[b] = (f2key(f0[a] + f1[b]) & ~255u) | (unsigned)(255 - (a * 16 + b));
                if (a == 0) {
#pragma unroll
                    for (int i = 0; i < 16; ++i) top[i] = c[i];
                } else merge16_desc(top, c);
            }
            asm volatile("s_waitcnt lgkmcnt(0)" ::: "memory");
            float cv[16]; float den = 0.f;
            const float m = key2f(top[0] & ~255u);
#pragma unroll
            for (int i = 0; i < 16; ++i) { cv[i] = __expf(key2f(top[i] & ~255u) - m); den += cv[i]; }
            const float rden = 1.f / den;
            if (lane < 8) {
#pragma unroll
                for (int i = 0; i < 16; ++i) { const int flat = 255 - (int)(top[i] & 255u); const int i1 = s_sub[h * 32 + (flat >> 4)], i2 = s_sub[h * 32 + 16 + (flat & 15)];
                    s_idx[h * 16 + i] = i1 * PNK + i2; s_g[h * 16 + i] = cv[i] * rden; }
            }
            asm volatile("s_waitcnt lgkmcnt(0)" ::: "memory");
        }
        const bf16* xr = Bx + (size_t)r * DM;
        const u32x4 x0 = *(const u32x4*)(xr + 8 * lane), x1 = *(const u32x4*)(xr + 512 + 8 * lane);
#pragma unroll 1
        for (int e0 = 0; e0 < 128; e0 += 8) {
            u32x4 ua[8], ub[8];
#pragma unroll
            for (int j = 0; j < 8; ++j) { const int idx = __builtin_amdgcn_readfirstlane(s_idx[e0 + j]); const bf16* up = Ut + (size_t)idx * DM;
                ua[j] = *(const u32x4*)(up + 8 * lane); ub[j] = *(const u32x4*)(up + 512 + 8 * lane); }
            float v[8];
#pragma unroll
            for (int j = 0; j < 8; ++j) v[j] = dot16(ua[j], ub[j], x0, x1);
            float t4[4], t2[2], t1;
            { const bool up_ = (lane & 32) != 0;
#pragma unroll
              for (int j = 0; j < 4; ++j) { const float keep = up_ ? v[j + 4] : v[j], send = up_ ? v[j] : v[j + 4]; t4[j] = keep + __shfl_xor(send, 32); } }
            { const bool up_ = (lane & 16) != 0;
#pragma unroll
              for (int j = 0; j < 2; ++j) { const float keep = up_ ? t4[j + 2] : t4[j], send = up_ ? t4[j] : t4[j + 2]; t2[j] = keep + __shfl_xor(send, 16); } }
            { const bool up_ = (lane & 8) != 0; const float keep = up_ ? t2[1] : t2[0], send = up_ ? t2[0] : t2[1]; t1 = keep + __shfl_xor(send, 8); }
            t1 += __shfl_xor(t1, 4); t1 += __shfl_xor(t1, 2); t1 += __shfl_xor(t1, 1);
            if ((lane & 7) == 0) { const int j = lane >> 3; const float a = t1; const float ge = 0.5f * a * (1.f + erff(a * 0.70710678118654752f)); s_g[e0 + j] = s_g[e0 + j] * ge; }
        }
        asm volatile("s_waitcnt lgkmcnt(0)" ::: "memory");
        float oa[8], ob[8];
#pragma unroll
        for (int i = 0; i < 8; ++i) { oa[i] = 0.f; ob[i] = 0.f; }
#pragma unroll 1
        for (int e0 = 0; e0 < 128; e0 += 8) {
            u32x4 va[8], vb[8]; float w[8];
#pragma unroll
            for (int j = 0; j < 8; ++j) { const int idx = __builtin_amdgcn_readfirstlane(s_idx[e0 + j]); const bf16* vp = Vt + (size_t)idx * DM;
                va[j] = *(const u32x4*)(vp + 8 * lane); vb[j] = *(const u32x4*)(vp + 512 + 8 * lane); w[j] = s_g[e0 + j]; }
#pragma unroll
            for (int j = 0; j < 8; ++j) { fma8(oa, va[j], w[j]); fma8(ob, vb[j], w[j]); }
        }
        float* hr = lat ? (Ap->out + (size_t)r * DM) : ((float*)(ws + WS_HCTX) + (size_t)(r - NLAT) * DM);
        const float* g2 = MOD + ((size_t)l * 9 + smp) * 6144 + 5 * DM;
#pragma unroll
        for (int half = 0; half < 2; ++half) { const int c = half * 512 + 8 * lane; const float* o = half ? ob : oa;
            const f32x4 ga = *(const f32x4*)(g2 + c), gb = *(const f32x4*)(g2 + c + 4); f32x4 ha = *(const f32x4*)(hr + c), hb = *(const f32x4*)(hr + c + 4);
            ha += ga * (f32x4){o[0], o[1], o[2], o[3]}; hb += gb * (f32x4){o[4], o[5], o[6], o[7]};
            *(f32x4*)(hr + c) = ha; *(f32x4*)(hr + c + 4) = hb; }
    }
}
constexpr int PH_PER_LAYER = 11, N_PHASES = 1 + DEPTH * PH_PER_LAYER;
#ifndef MK_ONE_LAUNCH
#define MK_ONE_LAUNCH 0
#endif
#ifndef MK_MASK
#define MK_MASK 0xFFF
#endif
#define PON(s) (((MK_MASK) >> (s)) & 1)

__global__ void __launch_bounds__(512, 2) mk_fwd(Args args_unused) {
    extern __shared__ __attribute__((aligned(16))) unsigned char lds[];
    LAS unsigned char* lds3 = (LAS unsigned char*)lds;
    ArgsP args0 = (ArgsP)__builtin_amdgcn_kernarg_segment_ptr();
    const int ph_lo = args0->ph_lo, ph_hi = args0->ph_hi;
    const int wave_s = __builtin_amdgcn_readfirstlane((int)threadIdx.x >> 6);
#pragma unroll 1
    for (int ph = ph_lo; ph < ph_hi; ++ph) {
        int zv = 0; asm volatile("" : "+v"(zv));
        ArgsP args = args0; asm volatile("" : "+s"(args));
        Frame F;
        F.zv = zv; F.lane = (int)__builtin_amdgcn_mbcnt_hi(~0u, __builtin_amdgcn_mbcnt_lo(~0u, 0u)) + zv; F.wave = wave_s; F.tid = wave_s * 64 + F.lane;
        { int bx = blockIdx.x, gd = gridDim.x; asm volatile("" : "+s"(bx), "+s"(gd)); F.bid = bx; F.G = gd; F.vcu = (gd % 8 == 0) ? (bx % 8) * (gd / 8) + bx / 8 : bx; }
        F.gw = F.bid * 8 + F.wave; F.ngw = F.G * 8;
        unsigned char* ws = args->ws;
        int njobs = 0, jkind = 0;
        pg8::Gemm gj[2]; pg8::EpiStore ej[2];
        int l = 0, mrows = NROWS;
        if (ph == 0) { if (PON(11)) p0_prologue(F, args, lds3); }
        else {
            const int q = ph - 1, s = q % PH_PER_LAYER; l = q / PH_PER_LAYER;
            mrows = (l == DEPTH - 1) ? NLAT : NROWS;
            switch (s) {
            case 0: if (PON(0)) norm_mod_phase(F, args, l, 0, NROWS); break;
            case 1: if (PON(1)) { njobs = 1;
                gj[0] = pg8::Gemm{(const bf16*)(ws + WS_AB), (const bf16*)(ws + WS_WIN) + (size_t)l * DINP * DM, NROWS, DINP, DM};
                ej[0] = pg8::EpiStore{0, (bf16*)(ws + WS_P), DIN, DIN, nullptr}; } break;
            case 2: if (PON(2)) e2_phase(F, args, l, NROWS); break;
            case 3: if (PON(3)) { njobs = 2;
                gj[0] = pg8::Gemm{(const bf16*)(ws + WS_AB), (const bf16*)(ws + WS_WUQ) + (size_t)l * 768 * QRANK, NROWS, 768, QRANK};
                ej[0] = pg8::EpiStore{0, (bf16*)(ws + WS_QM), 768, 768, nullptr};
                gj[1] = pg8::Gemm{(const bf16*)(ws + WS_AB) + (size_t)NROWS * QRANK, (const bf16*)(ws + WS_WUKV) + (size_t)l * 1024 * KVRANK, NROWS, 1024, KVRANK};
                ej[1] = pg8::EpiStore{1, (bf16*)(ws + WS_KM), 768, 1024, (bf16*)(ws + WS_VM)}; } break;
            case 4: if (PON(4)) e3_phase(F, args, l, NROWS); break;
            case 5: if (PON(5)) attn_phase(F, args, l, (char*)lds); break;
            case 6: if (PON(6)) { njobs = 1; jkind = 1;
                gj[0] = pg8::Gemm{(const bf16*)(ws + WS_AB), (const bf16*)(ws + WS_WOUT) + (size_t)l * DM * DM, mrows, DM, DM}; } break;
            case 7: if (PON(7)) norm_mod_phase(F, args, l, 1, mrows); break;
            case 8: if (PON(8)) { njobs = 1;
                gj[0] = pg8::Gemm{(const bf16*)(ws + WS_AB), (const bf16*)(ws + WS_PWQ) + (size_t)l * 2048 * DM, mrows, 2048, DM};
                ej[0] = pg8::EpiStore{0, (bf16*)(ws + WS_X5), 2048, 2048, nullptr}; } break;
            case 9: if (PON(9)) topk_phase(F, args, l, mrows); break;
            default: if (PON(10)) peer_phase(F, args, l, mrows, (char*)lds); break;
            }
        }
        if (njobs > 0) {
            if (jkind == 0) {
#pragma unroll 1
                for (int j = 0; j < njobs; ++j) { __syncthreads();
                    const pg8::Gemm g = (j == 0) ? gj[0] : gj[1]; const pg8::EpiStore E = (j == 0) ? ej[0] : ej[1];
                    pg8::StaticOrder S; S.init(g.M, g.N, F.G, F.bid);
                    pg8::gemm_phase<pg8::EpiStore, pg8::StaticOrder, true, true>(lds3, g, S, E, F.tid); }
            } else { __syncthreads();
                const pg8::Gemm g = gj[0];
                pg8::StaticOrder S; S.init(g.M, g.N, F.G, F.bid);
                pg8::EpiResid E{(l == 0) ? args->in[0] : args->out, args->in[2], args->out, (float*)(ws + WS_HCTX), (const float*)(ws + WS_MOD) + (size_t)l * 9 * 6144 + 2 * DM, NLAT};
                pg8::gemm_phase<pg8::EpiResid, pg8::StaticOrder, true, true>(lds3, g, S, E, F.tid); }
        }
#if MK_ONE_LAUNCH
        if (ph + 1 < ph_hi) cg::this_grid().sync();
#endif
    }
}

extern "C" void kernel_launch(void* const* d_in, const int* in_sizes, int n_in, void* d_out, int out_size, void* d_ws, size_t ws_size, hipStream_t stream) {
    static int grid = 0;
    if (grid == 0) {
        if (n_in != 23 || in_sizes[0] != NLAT * DM || out_size != NLAT * DM || ws_size < WS_END) {
            fprintf(stderr, "kernel_launch: unexpected shapes: n_in %d in0 %d out %d ws %zu (need %zu)\n", n_in, n_in > 0 ? in_sizes[0] : -1, out_size, ws_size, (size_t)WS_END); grid = -1; return; }
        int dev = 0, cus = 0, per_cu = 0;
        if (hipGetDevice(&dev) != hipSuccess || hipDeviceGetAttribute(&cus, hipDeviceAttributeMultiprocessorCount, dev) != hipSuccess) { fprintf(stderr, "kernel_launch: device query failed\n"); grid = -1; return; }
        if (hipFuncSetAttribute((const void*)mk_fwd, hipFuncAttributeMaxDynamicSharedMemorySize, LDS_BYTES) != hipSuccess) { fprintf(stderr, "kernel_launch: hipFuncSetAttribute failed\n"); grid = -1; return; }
        if (hipOccupancyMaxActiveBlocksPerMultiprocessor(&per_cu, (const void*)mk_fwd, 512, LDS_BYTES) != hipSuccess || per_cu < 1) { fprintf(stderr, "kernel_launch: occupancy query says %d\n", per_cu); per_cu = 1; }
        (void)hipGetLastError();
        grid = cus;
    }
    if (grid < 0) return;
    Args a{};
    for (int i = 0; i < 23; ++i) a.in[i] = (const float*)d_in[i];
    a.out = (float*)d_out; a.ws = (unsigned char*)d_ws;
#if MK_ONE_LAUNCH
    a.ph_lo = 0; a.ph_hi = N_PHASES;
    void* kargs[] = {&a};
    hipError_t e = hipLaunchCooperativeKernel((const void*)mk_fwd, dim3(grid), dim3(512), kargs, LDS_BYTES, stream);
    if (e != hipSuccess) fprintf(stderr, "kernel_launch: cooperative launch failed: %s (grid %d)\n", hipGetErrorString(e), grid);
#else
    for (int p = 0; p < N_PHASES; ++p) {
        a.ph_lo = p; a.ph_hi = p + 1;
        hipLaunchKernelGGL(mk_fwd, dim3(grid), dim3(512), LDS_BYTES, stream, a);
    }
    const hipError_t le = hipPeekAtLastError();
    if (le != hipSuccess) fprintf(stderr, "kernel_launch: launch failed: %s\n", hipGetErrorName(le));
#endif
}
```

```cpp
#define MK_ONE_LAUNCH 1
#define DBG_PRECISE_TOPK 0
#define DBG_NAIVE_ATTN 0
#define DBG_PRECISE_PEER 0
#define DBG_NAIVE_GEMM 0
#define DBG_ASCALE 1.0f
#define DBG_PSCALE 1.0f
#include <hip/hip_runtime.h>
#include <hip/hip_cooperative_groups.h>
#include <cstdio>
#include <cstdint>
#include <cmath>
namespace cg = cooperative_groups;
namespace pg8 {
#define PG8_LAS __attribute__((address_space(3)))
typedef unsigned short bf16_t;
typedef short bf16x8 __attribute__((ext_vector_type(8)));
typedef float f32x4 __attribute__((ext_vector_type(4)));
typedef unsigned u32x4 __attribute__((ext_vector_type(4)));
constexpr int BM = 256, BK = 64, HALF = 128, HTB = HALF * BK * 2  , STAGE_BYTES = 8 * HTB, NXCD = 8, WGM = 8;

__host__ __device__ __forceinline__ int lds_byte(int r, int c) { const int st = (r >> 4) * 2 + (c >> 5), rr = r & 15, cc = c & 31, ob = rr * 64 + cc * 2; return st * 1024 + (ob ^ (((ob >> 9) & 1) << 5)); }
__host__ __device__ __forceinline__ void stage_rc(int b, int& R, int& C) { const int st = b / 1024, sb = b % 1024, swz = sb ^ (((sb >> 9) & 1) << 5); R = (st >> 1) * 16 + swz / 64; C = (st & 1) * 32 + (swz % 64) / 2; }
__host__ __device__ __forceinline__ int perm32(int rho) { const int n = rho >> 4, i = rho & 15; return 8 * (i >> 2) + 4 * n + (i & 3); }

struct Unit { int pm, pn; };
struct Gemm { const bf16_t* A; const bf16_t* Bt; int M, N, K; };

struct StaticOrder {
    int nM, nN, nwg, G, c;
    __host__ __device__ void init(int M, int N, int G_, int c_) { nM = M / BM; nN = N / BM; nwg = nM * nN; G = G_; c = c_; }
    __host__ __device__ bool next(int i, Unit& u) const {
        const long L = (long)i * G + c; if (L >= nwg) return false;
        int wgid = (int)L; { const int q = nwg / NXCD, r = nwg % NXCD, xcd = wgid % NXCD, off = wgid / NXCD; wgid = (xcd < r ? xcd * (q + 1) : r * (q + 1) + (xcd - r) * q) + off; }
        const int nig = WGM * nN, gid = wgid / nig, fm = gid * WGM, gsz = (nM - fm) < WGM ? (nM - fm) : WGM;
        u.pm = fm + ((wgid % nig) % gsz); u.pn = (wgid % nig) / gsz; return true;
    }
    __device__ __forceinline__ void a_ready(const Unit&) const {}
    __device__ __forceinline__ void done(const Unit&) const {}
};

__device__ __forceinline__ unsigned cvt_pk_bf16(float lo, float hi) { unsigned r; asm volatile("v_cvt_pk_bf16_f32 %0, %1, %2" : "=v"(r) : "v"(lo), "v"(hi)); return r; }
typedef float f32x2 __attribute__((ext_vector_type(2)));
typedef unsigned u32x2 __attribute__((ext_vector_type(2)));
#ifndef DBG_ASCALE
#define DBG_ASCALE 1.0f
#endif
#ifndef DBG_PSCALE
#define DBG_PSCALE 1.0f
#endif
struct EpiStore {
    static constexpr bool PERM = true, AFTER_DRAIN = false;
    int mode; bf16_t* O; int ldc; int ncols; bf16_t* VM;
    __device__ __forceinline__ void operator()(const f32x4 (&acc)[2][2][4][2], const Unit& u, int wr, int wc, int fr, int fq) const {
        const int row0 = u.pm * BM + wr * 64 + fr;
        bf16_t* base; int rstride, hstride; bool on0, on1;
        if (mode == 0) { const int col0 = u.pn * BM + wc * 32 + 8 * fq; base = O + (size_t)row0 * ldc + col0; rstride = ldc; hstride = HALF; on0 = col0 < ncols; on1 = col0 + HALF < ncols; }
        else {
            const int j = wc * 32 + 8 * fq; const bool isk = wc < 2;
            base = isk ? (O + (size_t)row0 * 768 + (2 * u.pn) * 96 + j) : (VM + (size_t)row0 * 512 + (2 * u.pn) * 64 + (j - 64));
            rstride = isk ? 768 : 512; hstride = isk ? 96 : 64; on0 = true; on1 = true; }
#pragma unroll
        for (int ai = 0; ai < 2; ++ai)
#pragma unroll
            for (int m = 0; m < 4; ++m) { bf16_t* rowp = base + (size_t)(ai * HALF + m * 16) * rstride;
#pragma unroll
                for (int bj = 0; bj < 2; ++bj) {
                    if (bj == 0 ? on0 : on1) { const f32x4 v0 = acc[ai][bj][m][0], v1 = acc[ai][bj][m][1]; u32x4 w;
                        w.x = cvt_pk_bf16(v0[0], v0[1]); w.y = cvt_pk_bf16(v0[2], v0[3]); w.z = cvt_pk_bf16(v1[0], v1[1]); w.w = cvt_pk_bf16(v1[2], v1[3]);
                        *(u32x4*)(rowp + bj * hstride) = w; } } }
    }
};
struct EpiResid {
    static constexpr bool PERM = false, AFTER_DRAIN = false;
    const float* hin_lat; const float* hin_ctx; float* hout_lat; float* hout_ctx; const float* gate; int nlat;
    __device__ __forceinline__ void operator()(const f32x4 (&acc)[2][2][4][2], const Unit& u, int wr, int wc, int fr, int fq) const {
        const int rowt = u.pm * BM; const bool lat = rowt < nlat; const int sample = lat ? (rowt >> 12) : 8;
        const float* src = lat ? hin_lat + (size_t)rowt * 1024 : hin_ctx + (size_t)(rowt - nlat) * 1024;
        float* dst = lat ? hout_lat + (size_t)rowt * 1024 : hout_ctx + (size_t)(rowt - nlat) * 1024;
        const float* g = gate + (size_t)sample * 6144;
        const int col0 = u.pn * BM + wc * 32 + 4 * fq;
#pragma unroll
        for (int bj = 0; bj < 2; ++bj)
#pragma unroll
            for (int n = 0; n < 2; ++n) { const int c = col0 + bj * HALF + n * 16; const f32x4 gv = *(const f32x4*)(g + c);
#pragma unroll
                for (int ai = 0; ai < 2; ++ai)
#pragma unroll
                    for (int m = 0; m < 4; ++m) { const size_t off = (size_t)(ai * HALF + wr * 64 + m * 16 + fr) * 1024 + c;
                        const f32x4 hv = *(const f32x4*)(src + off); *(f32x4*)(dst + off) = hv + gv * acc[ai][bj][m][n] * (float)(DBG_ASCALE); } }
    }
};
template <class Epi, class Sched, bool ALIGN_EPI = false, bool SP2 = false>
__device__ __forceinline__ void gemm_phase(PG8_LAS unsigned char* lds, const Gemm g, const Sched& S, const Epi& E, const int tid_in) {
    const int tid = tid_in, wid = __builtin_amdgcn_readfirstlane(tid >> 6), lane = tid & 63, wr = wid >> 2, wc = wid & 3, fr = lane & 15, fq = lane >> 4;
    const int K = g.K, nt = K / BK;
    unsigned voffA[2], voffB[2];
#pragma unroll
    for (int i = 0; i < 2; ++i) { int R, C; stage_rc(tid * 16 + i * 8192, R, C); const int Rb = Epi::PERM ? ((R & ~31) + perm32(R & 31)) : R;
        voffA[i] = (unsigned)(R * K + C) * 2u; voffB[i] = (unsigned)(Rb * K + C) * 2u; }
    const size_t kstep = (size_t)(BK * 2);
    const size_t hstep = (size_t)HALF * K * 2;
    const size_t tstep = 2 * hstep;
    const unsigned ldsw = (unsigned)wid * 1024u;
    const int aoff = lds_byte(wr * 64 + fr, fq * 8), boff = lds_byte(wc * 32 + fr, fq * 8);
#define PG8_SA(b, h) (((b) * 2 + (h)) * HTB)
#define PG8_SB(b, h) ((4 + (b) * 2 + (h)) * HTB)
#define PG8_STAGE(bufoff, gbase, voff) do { _Pragma("unroll") for (int _i = 0; _i < 2; ++_i) \
        __builtin_amdgcn_global_load_lds((const unsigned*)((const char*)(gbase) + (voff)[_i]), (PG8_LAS unsigned*)(lds + (bufoff) + ldsw + _i * 8192), 16, 0, 0); } while (0)
#define PG8_LDA(dst, b, h) do { _Pragma("unroll") for (int m = 0; m < 4; ++m) _Pragma("unroll") for (int k = 0; k < 2; ++k) dst[m][k] = *(const PG8_LAS bf16x8*)(lds + PG8_SA(b, h) + aoff + m * 2048 + k * 1024); } while (0)
#define PG8_LDB(dst, b, h) do { _Pragma("unroll") for (int n = 0; n < 2; ++n) _Pragma("unroll") for (int k = 0; k < 2; ++k) dst[n][k] = *(const PG8_LAS bf16x8*)(lds + PG8_SB(b, h) + boff + n * 2048 + k * 1024); } while (0)
#define PG8_MMA(ai, bj, At, Bt) do { __builtin_amdgcn_s_setprio(1); _Pragma("unroll") for (int m = 0; m < 4; ++m) _Pragma("unroll") for (int n = 0; n < 2; ++n) _Pragma("unroll") for (int k = 0; k < 2; ++k) \
        acc[ai][bj][m][n] = __builtin_amdgcn_mfma_f32_16x16x32_bf16(Bt[n][k], At[m][k], acc[ai][bj][m][n], 0, 0, 0); __builtin_amdgcn_s_setprio(0); } while (0)
#define PG8_WAIT_V(n) asm volatile("s_waitcnt vmcnt(" #n ")" ::: "memory")
#define PG8_WAIT_L(n) asm volatile("s_waitcnt lgkmcnt(" #n ")" ::: "memory")
#define PG8_BAR __builtin_amdgcn_s_barrier()
#define PG8_SCHED __builtin_amdgcn_sched_barrier(0)
    Unit cur, nxt; int ui = 0;
    if (!S.next(0, cur)) return;
    f32x4 acc[2][2][4][2];
#pragma unroll
    for (int a = 0; a < 2; ++a)
#pragma unroll
        for (int b = 0; b < 2; ++b)
#pragma unroll
            for (int m = 0; m < 4; ++m)
#pragma unroll
                for (int n = 0; n < 2; ++n) acc[a][b][m][n] = (f32x4){0.f, 0.f, 0.f, 0.f};
    bf16x8 At[4][2], B0[2][2], B1[2][2];
    const char* cA = (const char*)g.A + (size_t)cur.pm * tstep; const char* cB = (const char*)g.Bt + (size_t)cur.pn * tstep;
    S.a_ready(cur);
    if constexpr (SP2) {
        PG8_STAGE(PG8_SB(0, 0), cB, voffB); PG8_STAGE(PG8_SB(0, 1), cB + hstep, voffB); PG8_STAGE(PG8_SA(0, 0), cA, voffA); PG8_STAGE(PG8_SA(0, 1), cA + hstep, voffA);
        if (wr == 1) PG8_BAR;
        PG8_WAIT_V(2); PG8_BAR;
        PG8_STAGE(PG8_SB(1, 0), cB + kstep, voffB); PG8_STAGE(PG8_SA(1, 0), cA + kstep, voffA); PG8_STAGE(PG8_SB(1, 1), cB + hstep + kstep, voffB);
        PG8_WAIT_V(6); PG8_BAR;
    } else {
        PG8_STAGE(PG8_SB(0, 0), cB, voffB); PG8_STAGE(PG8_SA(0, 0), cA, voffA); PG8_STAGE(PG8_SB(0, 1), cB + hstep, voffB); PG8_STAGE(PG8_SA(0, 1), cA + hstep, voffA);
        if (wr == 1) PG8_BAR;
        PG8_WAIT_V(4); PG8_BAR;
        PG8_STAGE(PG8_SB(1, 0), cB + kstep, voffB); PG8_STAGE(PG8_SA(1, 0), cA + kstep, voffA); PG8_STAGE(PG8_SB(1, 1), cB + hstep + kstep, voffB);
        PG8_WAIT_V(6); PG8_BAR;
    }
    for (;;) {
        const bool has_next = S.next(ui + 1, nxt);
        const char* nA = has_next ? (const char*)g.A + (size_t)nxt.pm * tstep : cA; const char* nB = has_next ? (const char*)g.Bt + (size_t)nxt.pn * tstep : cB;
        _Pragma("unroll 1") for (int t = 0; t < nt; t += 2) {
            const bool last = (t == nt - 2);
            const char* a1 = cA + (size_t)(t + 1) * kstep;
            const char* a2 = last ? nA : cA + (size_t)(t + 2) * kstep; const char* b2 = last ? nB : cB + (size_t)(t + 2) * kstep;
            const char* a3 = a2 + kstep; const char* b3 = b2 + kstep;
            if (last && has_next) S.a_ready(nxt);
            if constexpr (SP2) {
            PG8_LDB(B0, 0, 0); PG8_LDB(B1, 0, 1); PG8_SCHED; PG8_LDA(At, 0, 0); PG8_STAGE(PG8_SA(1, 1), a1 + hstep, voffA);
            PG8_WAIT_V(8); PG8_WAIT_L(0); PG8_BAR; PG8_MMA(0, 0, At, B0); PG8_MMA(0, 1, At, B1); PG8_BAR; PG8_SCHED;
            PG8_LDA(At, 0, 1); PG8_STAGE(PG8_SB(0, 0), b2, voffB); PG8_STAGE(PG8_SB(0, 1), b2 + hstep, voffB); PG8_STAGE(PG8_SA(0, 0), a2, voffA);
            PG8_WAIT_V(8); PG8_WAIT_L(0); PG8_BAR; PG8_MMA(1, 0, At, B0); PG8_MMA(1, 1, At, B1); PG8_BAR; PG8_SCHED;
            PG8_LDB(B0, 1, 0); PG8_LDB(B1, 1, 1); PG8_SCHED; PG8_LDA(At, 1, 0); PG8_STAGE(PG8_SA(0, 1), a2 + hstep, voffA);
            PG8_WAIT_V(8); PG8_WAIT_L(0); PG8_BAR; PG8_MMA(0, 0, At, B0); PG8_MMA(0, 1, At, B1); PG8_BAR; PG8_SCHED;
            PG8_LDA(At, 1, 1); PG8_STAGE(PG8_SB(1, 0), b3, voffB); PG8_STAGE(PG8_SB(1, 1), b3 + hstep, voffB); PG8_STAGE(PG8_SA(1, 0), a3, voffA);
            PG8_WAIT_V(8); PG8_WAIT_L(0); PG8_BAR; PG8_MMA(1, 0, At, B0); PG8_MMA(1, 1, At, B1); PG8_BAR; PG8_SCHED;
            } else {
            PG8_LDB(B0, 0, 0); PG8_SCHED; PG8_LDA(At, 0, 0); PG8_STAGE(PG8_SA(1, 1), a1 + hstep, voffA);
            PG8_WAIT_L(8); PG8_BAR; PG8_WAIT_L(0); PG8_MMA(0, 0, At, B0); PG8_BAR; PG8_SCHED;
            PG8_LDB(B1, 0, 1); PG8_STAGE(PG8_SB(0, 0), b2, voffB);
            PG8_BAR; PG8_WAIT_L(0); PG8_MMA(0, 1, At, B1); PG8_BAR;
            PG8_LDA(At, 0, 1); PG8_STAGE(PG8_SA(0, 0), a2, voffA);
            PG8_BAR; PG8_WAIT_L(0); PG8_MMA(1, 0, At, B0); PG8_BAR; PG8_SCHED;
            PG8_STAGE(PG8_SB(0, 1), b2 + hstep, voffB);
            PG8_WAIT_V(6); PG8_BAR; PG8_MMA(1, 1, At, B1); PG8_BAR;
            PG8_LDB(B0, 1, 0); PG8_SCHED; PG8_LDA(At, 1, 0); PG8_STAGE(PG8_SA(0, 1), a2 + hstep, voffA);
            PG8_WAIT_L(8); PG8_BAR; PG8_WAIT_L(0); PG8_MMA(0, 0, At, B0); PG8_BAR; PG8_SCHED;
            PG8_LDB(B1, 1, 1); PG8_STAGE(PG8_SB(1, 0), b3, voffB);
            PG8_BAR; PG8_WAIT_L(0); PG8_MMA(0, 1, At, B1); PG8_BAR;
            PG8_LDA(At, 1, 1); PG8_STAGE(PG8_SA(1, 0), a3, voffA);
            PG8_BAR; PG8_WAIT_L(0); PG8_MMA(1, 0, At, B0); PG8_BAR; PG8_SCHED;
            PG8_STAGE(PG8_SB(1, 1), b3 + hstep, voffB);
            PG8_WAIT_V(6); PG8_BAR; PG8_MMA(1, 1, At, B1); PG8_BAR;
            }
        }
        if constexpr (ALIGN_EPI) { if (wr == 0) PG8_BAR; }
        if constexpr (!Epi::AFTER_DRAIN) { E(acc, cur, wr, wc, fr, fq); S.done(cur); }
        if (!has_next) break;
#pragma unroll
        for (int a = 0; a < 2; ++a)
#pragma unroll
            for (int b = 0; b < 2; ++b)
#pragma unroll
                for (int m = 0; m < 4; ++m)
#pragma unroll
                    for (int n = 0; n < 2; ++n) acc[a][b][m][n] = (f32x4){0.f, 0.f, 0.f, 0.f};
        cur = nxt; cA = nA; cB = nB; ++ui;
        if constexpr (ALIGN_EPI) { if (wr == 1) PG8_BAR; }
    }
    PG8_WAIT_V(0);
    if constexpr (!ALIGN_EPI) { if (wr == 0) PG8_BAR; }
    PG8_BAR;
    if constexpr (Epi::AFTER_DRAIN) { E.fused(acc, cur, wr, wc, fr, fq, lds, wid, lane); S.done(cur); }
#undef PG8_SA
#undef PG8_SB
#undef PG8_STAGE
#undef PG8_LDA
#undef PG8_LDB
#undef PG8_MMA
#undef PG8_WAIT_V
#undef PG8_WAIT_L
#undef PG8_BAR
#undef PG8_SCHED
}
}
constexpr int DM = 1024, NB = 8, SEQ = 4096, CTXL = 256, DEPTH = 2;
constexpr int NLAT = NB * SEQ, NCTX = NB * CTXL, NROWS = NLAT + NCTX;
constexpr int DIN = 1440, DINP = 1536, QRANK = 384, KVRANK = 256;
constexpr int PH = 8, PNK = 128, PDH = 128, PTOPK = 16, PEXP = PNK * PNK;
constexpr float EPS = 1e-6f;
constexpr float LOG2E = 1.4426950408889634f;
constexpr float C_MLA = 0.10206207261596577f * LOG2E;
constexpr float C_SWA = 0.125f * LOG2E;

typedef unsigned short bf16;
typedef short bf16x8 __attribute__((ext_vector_type(8)));
typedef short s16x4 __attribute__((ext_vector_type(4)));
typedef float f32x4 __attribute__((ext_vector_type(4)));
typedef float f32x16 __attribute__((ext_vector_type(16)));
typedef unsigned u32x4 __attribute__((ext_vector_type(4)));
typedef unsigned u32x2v __attribute__((ext_vector_type(2)));
#define LAS __attribute__((address_space(3)))

constexpr size_t MiB = 1u << 20;
constexpr size_t WS_CTL = 0, CTL_ZERO_BYTES = 64 * 1024;
constexpr size_t WS_MOD = 1 * MiB;
constexpr size_t WS_RTS = WS_MOD + 512 * 1024;
constexpr size_t WS_RTM = WS_RTS + 64 * 16 * 2 * 4;
constexpr size_t WS_WIN = 2 * MiB;
constexpr size_t WS_WUQ = WS_WIN + 2ull * DINP * DM * 2;
constexpr size_t WS_WUKV = WS_WUQ + 2ull * 768 * QRANK * 2;
constexpr size_t WS_WOUT = WS_WUKV + 2ull * 1024 * KVRANK * 2;
constexpr size_t WS_PWQ = WS_WOUT + 2ull * 1024 * 1024 * 2;
constexpr size_t WS_PKEY = WS_PWQ + 2ull * 2048 * 1024 * 2;
constexpr size_t WS_HCTX = WS_PKEY + 2ull * 8 * 2 * 128 * 128 * 2;
constexpr size_t WS_U = 32 * MiB;
constexpr size_t WS_V = WS_U + 64 * MiB;
constexpr size_t WS_AB = WS_V + 64 * MiB;
constexpr size_t WS_P = WS_AB + (size_t)NROWS * 1024 * 2;
constexpr size_t WS_X5 = WS_P + (size_t)NROWS * DIN * 2;
constexpr size_t WS_QM = WS_X5, WS_KM = WS_QM + (size_t)NROWS * 768 * 2, WS_VM = WS_KM + (size_t)NROWS * 768 * 2, WS_QS = WS_VM + (size_t)NROWS * 512 * 2,
                 WS_KS = WS_QS + (size_t)NROWS * 512 * 2, WS_END = WS_KS + (size_t)NROWS * 128 * 2;
static_assert(WS_HCTX + (size_t)NCTX * 1024 * 4 <= WS_U, "ws map (weights)");
static_assert(WS_END <= 512 * MiB, "ws map");
static_assert((size_t)NROWS * 2048 * 2 <= WS_END - WS_X5, "QP overlay");
static_assert((size_t)NROWS * 1024 <= (size_t)NROWS * DIN * 2, "TK overlay");

constexpr int LDS_BYTES = 135168;

__constant__ float ROPE_INV[24] = {1.0f, 0.5623413324356079f, 0.3162277638912201f, 0.17782793939113617f, 0.10000000149011612f, 0.05623413249850273f, 0.03162277489900589f, 0.017782794311642647f, 0.009999999776482582f, 0.005623413249850273f, 0.003162277629598975f, 0.0017782794311642647f, 0.0010000000474974513f, 0.000562341301701963f, 0.0003162277571391314f, 0.00017782794020604342f, 1.0f, 0.3162277638912201f, 0.10000000149011612f, 0.03162277489900589f, 0.009999999776482582f, 0.003162277629598975f, 0.0010000000474974513f, 0.0003162277571391314f};
struct Args {
    const float* in[23]; float* out; unsigned char* ws; int ph_lo, ph_hi; unsigned char prog[48];
};
typedef const __attribute__((address_space(4))) Args* ArgsP;

struct Frame {
    int tid, lane, wave, G, bid, vcu, gw, ngw, zv;
};

__device__ __forceinline__ float bf_lo(unsigned w) { return __uint_as_float(w << 16); }
__device__ __forceinline__ float bf_hi(unsigned w) { return __uint_as_float(w & 0xffff0000u); }
__device__ __forceinline__ unsigned pk2(float lo, float hi) { return pg8::cvt_pk_bf16(lo, hi); }
__device__ __forceinline__ float wave_sum(float v) {
#pragma unroll
    for (int o = 1; o < 64; o <<= 1) v += __shfl_xor(v, o);
    return v;
}
__device__ __forceinline__ void unpack8(const u32x4 w, float (&x)[8]) {
    x[0] = bf_lo(w.x); x[1] = bf_hi(w.x); x[2] = bf_lo(w.y); x[3] = bf_hi(w.y); x[4] = bf_lo(w.z); x[5] = bf_hi(w.z); x[6] = bf_lo(w.w); x[7] = bf_hi(w.w);
}
__device__ __forceinline__ u32x4 pack8(const float (&x)[8]) {
    u32x4 w; w.x = pk2(x[0], x[1]); w.y = pk2(x[2], x[3]); w.z = pk2(x[4], x[5]); w.w = pk2(x[6], x[7]); return w;
}

__device__ __forceinline__ void p0_transpose_item(const float* W, int K, int N, bf16* WT, LAS float* scr, int item, int lane) {
    const int nblk = N / 32, kb = item / nblk, nb = item % nblk, k0 = 64 * kb, n0 = 32 * nb;
#pragma unroll 8
    for (int i = 0; i < 32; ++i) { const int kk = 2 * i + (lane >> 5); scr[kk * 33 + (lane & 31)] = W[(size_t)(k0 + kk) * N + n0 + (lane & 31)]; }
    asm volatile("s_waitcnt lgkmcnt(0)" ::: "memory");
    const int c = lane & 7;
#pragma unroll
    for (int j = 0; j < 4; ++j) { const int n = (lane >> 3) + 8 * j; const LAS float* s = scr + (8 * c) * 33 + n;
        u32x4 o; o.x = pk2(s[0 * 33], s[1 * 33]); o.y = pk2(s[2 * 33], s[3 * 33]); o.z = pk2(s[4 * 33], s[5 * 33]); o.w = pk2(s[6 * 33], s[7 * 33]);
        *(u32x4*)(WT + (size_t)(n0 + n) * K + k0 + 8 * c) = o; }
    asm volatile("s_waitcnt lgkmcnt(0)" ::: "memory");
}

__device__ __forceinline__ void p0_prologue(const Frame& F, ArgsP Ap, LAS unsigned char* lds) {
    unsigned char* ws = Ap->ws;
    const float* c_in = Ap->in[1]; const float* cctx_in = Ap->in[3]; const float* ada_w = Ap->in[4]; const float* ada_b = Ap->in[5];
    for (int task = F.bid; task < 48; task += F.G) {
        const int l = task / 24, cc = task % 24;
        LAS float* sl = (LAS float*)lds;
        LAS float* red = (LAS float*)(lds + 9 * 1024 * 4);
        __syncthreads();
        for (int i = F.tid; i < 9 * 1024; i += 512) { const int s = i >> 10, k = i & 1023; const float x = (s < 8) ? c_in[s * 1024 + k] : cctx_in[k]; sl[i] = x / (1.f + __expf(-x)); }
        __syncthreads();
        const int c0 = cc * 256 + F.lane * 4; const int kbase = F.wave * 128;
        f32x4 acc[9];
#pragma unroll
        for (int s = 0; s < 9; ++s) acc[s] = (f32x4){0.f, 0.f, 0.f, 0.f};
        const float* wp = ada_w + ((size_t)l * 1024 + kbase) * 6144 + c0;
#pragma unroll 4
        for (int kk = 0; kk < 128; ++kk) { const f32x4 w = *(const f32x4*)(wp + (size_t)kk * 6144);
#pragma unroll
            for (int s = 0; s < 9; ++s) acc[s] += w * sl[s * 1024 + kbase + kk]; }
#pragma unroll
        for (int s = 0; s < 9; ++s) *(LAS f32x4*)(red + (F.wave * 9 + s) * 256 + F.lane * 4) = acc[s];
        __syncthreads();
        float* MOD = (float*)(ws + WS_MOD);
        for (int i = F.tid; i < 9 * 256; i += 512) { const int s = i >> 8, ci = i & 255; float v = ada_b[l * 6144 + cc * 256 + ci];
#pragma unroll
            for (int w = 0; w < 8; ++w) v += red[(w * 9 + s) * 256 + ci];
            MOD[((size_t)l * 9 + s) * 6144 + cc * 256 + ci] = v; }
        __syncthreads();
    }
    __syncthreads();
    if (F.bid == F.G - 1) {
        float* rts = (float*)(ws + WS_RTS); float* rtm = (float*)(ws + WS_RTM);
        for (int i = F.tid; i < 64 * 24; i += 512) {
            const int pos = i / 24, k = i % 24; const float a = (float)pos * ROPE_INV[k];
            const float rev = a * 0.15915494309189535f;
            const float cs = __builtin_amdgcn_cosf(rev), sn = __builtin_amdgcn_sinf(rev);
            if (k < 16) { rts[(pos * 16 + k) * 2] = cs; rts[(pos * 16 + k) * 2 + 1] = sn; } else { rtm[(pos * 8 + (k - 16)) * 2] = cs; rtm[(pos * 8 + (k - 16)) * 2 + 1] = sn; }
        }
    }
    LAS float* scr = (LAS float*)(lds + F.wave * 16384);
    constexpr int I_WIN = (DM / 64) * (DIN / 32), I_WUQ = (QRANK / 64) * (768 / 32), I_WUKV = (KVRANK / 64) * (1024 / 32), I_WOUT = (DM / 64) * (DM / 32), I_PWQ = (DM / 64) * (2048 / 32);
    constexpr int I_L = I_WIN + I_WUQ + I_WUKV + I_WOUT + I_PWQ;
    for (int it = F.gw; it < 2 * I_L; it += F.ngw) {
        const int l = it / I_L; int r = it % I_L;
        if (r < I_WIN) { p0_transpose_item(Ap->in[8] + (size_t)l * DM * DIN, DM, DIN, (bf16*)(ws + WS_WIN) + (size_t)l * DINP * DM, scr, r, F.lane); continue; } r -= I_WIN;
        if (r < I_WUQ) { p0_transpose_item(Ap->in[10] + (size_t)l * QRANK * 768, QRANK, 768, (bf16*)(ws + WS_WUQ) + (size_t)l * 768 * QRANK, scr, r, F.lane); continue; } r -= I_WUQ;
        if (r < I_WUKV) { p0_transpose_item(Ap->in[12] + (size_t)l * KVRANK * 1024, KVRANK, 1024, (bf16*)(ws + WS_WUKV) + (size_t)l * 1024 * KVRANK, scr, r, F.lane); continue; } r -= I_WUKV;
        if (r < I_WOUT) { p0_transpose_item(Ap->in[18] + (size_t)l * DM * DM, DM, DM, (bf16*)(ws + WS_WOUT) + (size_t)l * DM * DM, scr, r, F.lane); continue; } r -= I_WOUT;
        p0_transpose_item(Ap->in[19] + (size_t)l * DM * 2048, DM, 2048, (bf16*)(ws + WS_PWQ) + (size_t)l * 2048 * DM, scr, r, F.lane);
    }
    { const size_t gt = (size_t)F.bid * 512 + F.tid, nt = (size_t)F.G * 512;
      for (size_t i = gt; i < 2ull * 96 * DM / 8; i += nt) { const size_t l = i / (96 * DM / 8), e = i % (96 * DM / 8);
          *(u32x4*)((bf16*)(ws + WS_WIN) + l * DINP * DM + (size_t)DIN * DM + e * 8) = (u32x4){(unsigned)F.zv, (unsigned)F.zv, (unsigned)F.zv, (unsigned)F.zv}; }
      const size_t NKEY8 = 2ull * 8 * 2 * 128 * 128 / 8, NU8 = 2ull * PEXP * DM / 8;
      for (size_t i = gt; i < NKEY8 + 2 * NU8; i += nt) {
          const float* src; bf16* dst; size_t j;
          if (i < NKEY8) { src = Ap->in[20]; dst = (bf16*)(ws + WS_PKEY); j = i; }
          else if (i < NKEY8 + NU8) { src = Ap->in[21]; dst = (bf16*)(ws + WS_U); j = i - NKEY8; }
          else { src = Ap->in[22]; dst = (bf16*)(ws + WS_V); j = i - NKEY8 - NU8; }
          const f32x4 a = *(const f32x4*)(src + j * 8), b = *(const f32x4*)(src + j * 8 + 4);
          u32x4 o; o.x = pk2(a[0], a[1]); o.y = pk2(a[2], a[3]); o.z = pk2(b[0], b[1]); o.w = pk2(b[2], b[3]);
          size_t dj = j * 8;
          if (i >= NKEY8 + NU8) { const size_t fl = j * 8, lay = fl / ((size_t)PEXP * DM), rem = fl % ((size_t)PEXP * DM), e = rem >> 10, d = rem & 1023;
              dj = lay * (size_t)PEXP * DM + ((d >> 6) * (size_t)PEXP + e) * 64 + (d & 63); }
          *(u32x4*)(dst + dj) = o; }
    }
}

#ifndef DBG_PRECISE_TOPK
#define DBG_PRECISE_TOPK 0
#endif
__device__ __forceinline__ void norm_mod_phase(const Frame& F, ArgsP Ap, int l, int which, int nrows) {
    unsigned char* ws = Ap->ws;
    const float* MOD = (const float*)(ws + WS_MOD);
    const float* gn = Ap->in[which ? 7 : 6] + l * DM;
    bf16* AB = (bf16*)(ws + WS_AB);
    const bool from_input = (which == 0 && l == 0);
    for (int r = F.gw; r < nrows; r += F.ngw) {
        const bool lat = r < NLAT;
        const float* hr = lat ? ((from_input ? Ap->in[0] : Ap->out) + (size_t)r * DM) : ((from_input ? Ap->in[2] : (const float*)(ws + WS_HCTX)) + (size_t)(r - NLAT) * DM);
        const int s = lat ? (r >> 12) : 8;
        const float* mp = MOD + ((size_t)l * 9 + s) * 6144 + (which ? 3 * DM : 0);
        f32x4 v[4]; float ss = 0.f;
#pragma unroll
        for (int j = 0; j < 4; ++j) { v[j] = *(const f32x4*)(hr + 256 * j + 4 * F.lane); ss += (v[j][0] * v[j][0] + v[j][1] * v[j][1]) + (v[j][2] * v[j][2] + v[j][3] * v[j][3]); }
        ss = wave_sum(ss);
        const float rinv = rsqrtf(ss * (1.f / DM) + EPS);
#pragma unroll
        for (int j = 0; j < 4; ++j) { const int c = 256 * j + 4 * F.lane;
            const f32x4 g = *(const f32x4*)(gn + c), sh = *(const f32x4*)(mp + c), sc = *(const f32x4*)(mp + DM + c);
            const f32x4 y = v[j] * rinv * g; const f32x4 a = y * (sc + 1.f) + sh;
            u32x2v o; o.x = pk2(a[0], a[1]); o.y = pk2(a[2], a[3]);
            *(u32x2v*)(AB + (size_t)r * DM + c) = o;
#if DBG_PRECISE_TOPK
            if (which) *(f32x4*)((float*)(ws + WS_X5) + (size_t)r * DM + c) = a;
#endif
            }
    }
}

__device__ __forceinline__ void e2_phase(const Frame& F, ArgsP Ap, int l, int nrows) {
    unsigned char* ws = Ap->ws;
    const bf16* P = (const bf16*)(ws + WS_P);
    bf16* QAN = (bf16*)(ws + WS_AB); bf16* KVAN = QAN + (size_t)NROWS * QRANK;
    bf16* QS = (bf16*)(ws + WS_QS); bf16* KS = (bf16*)(ws + WS_KS);
    const float* qa_g = Ap->in[9] + l * QRANK; const float* kva_g = Ap->in[11] + l * KVRANK;
    const float* sqn_g = Ap->in[15] + l * 64; const float* skn_g = Ap->in[16] + l * 64;
    const float* rts = (const float*)(ws + WS_RTS);
    const int lane = F.lane;
    for (int r = F.gw; r < nrows; r += F.ngw) {
        const bf16* pr = P + (size_t)r * DIN;
        const bool lat = r < NLAT; const int pos = r & (SEQ - 1), rp = pos >> 6, cp = pos & 63;
        u32x4 wqa = (u32x4){0u, 0u, 0u, 0u}, wkva = (u32x4){0u, 0u, 0u, 0u}, wsk = (u32x4){0u, 0u, 0u, 0u};
        if (lane < 48) wqa = *(const u32x4*)(pr + 8 * lane);
        const u32x4 wsq = *(const u32x4*)(pr + QRANK + 8 * lane);
        if (lane < 32) wkva = *(const u32x4*)(pr + 896 + 8 * lane);
        if (lane < 16) wsk = *(const u32x4*)(pr + 1184 + 8 * lane);
        float x[8];
        { unpack8(wqa, x); float ss = 0.f;
#pragma unroll
          for (int e = 0; e < 8; ++e) ss += x[e] * x[e];
          ss = wave_sum(ss); const float rinv = rsqrtf(ss * (1.f / QRANK) + EPS);
          if (lane < 48) { float y[8];
#pragma unroll
              for (int e = 0; e < 8; ++e) y[e] = x[e] * rinv * qa_g[8 * lane + e];
              *(u32x4*)(QAN + (size_t)r * QRANK + 8 * lane) = pack8(y); } }
        { unpack8(wkva, x); float ss = 0.f;
#pragma unroll
          for (int e = 0; e < 8; ++e) ss += x[e] * x[e];
          ss = wave_sum(ss); const float rinv = rsqrtf(ss * (1.f / KVRANK) + EPS);
          if (lane < 32) { float y[8];
#pragma unroll
              for (int e = 0; e < 8; ++e) y[e] = x[e] * rinv * kva_g[8 * lane + e];
              *(u32x4*)(KVAN + (size_t)r * KVRANK + 8 * lane) = pack8(y); } }
        const int ch = lane & 7;
        const float* tab = rts + (size_t)((ch < 4) ? rp : cp) * 32 + (ch & 1) * 16;
#pragma unroll
        for (int which = 0; which < 2; ++which) {
            unpack8(which ? wsk : wsq, x); float ss = 0.f;
#pragma unroll
            for (int e = 0; e < 8; ++e) ss += x[e] * x[e];
            ss += __shfl_xor(ss, 1); ss += __shfl_xor(ss, 2); ss += __shfl_xor(ss, 4);
            const float rinv = rsqrtf(ss * (1.f / 64.f) + EPS);
            const float* gg = which ? skn_g : sqn_g;
            float y[8], o[8];
#pragma unroll
            for (int e = 0; e < 8; ++e) y[e] = x[e] * rinv * gg[8 * ch + e];
#pragma unroll
            for (int e = 0; e < 8; ++e) { const float py = __shfl_xor(y[e], 2);
                if (lat) { const float cs = tab[2 * e], sn = tab[2 * e + 1]; o[e] = (ch & 2) ? (y[e] * cs + py * sn) : (y[e] * cs - py * sn); } else o[e] = y[e]; }
            if (which == 0) {
#pragma unroll
                for (int e = 0; e < 8; ++e) o[e] *= C_SWA;
                *(u32x4*)(QS + (size_t)r * 512 + 8 * lane) = pack8(o);
            } else if (lane < 16) *(u32x4*)(KS + (size_t)r * 128 + 8 * lane) = pack8(o);
        }
    }
}

__device__ __forceinline__ void e3_phase(const Frame& F, ArgsP Ap, int l, int nrows) {
    unsigned char* ws = Ap->ws;
    const bf16* P = (const bf16*)(ws + WS_P);
    bf16* QM = (bf16*)(ws + WS_QM); bf16* KM = (bf16*)(ws + WS_KM);
    const float* qn_g = Ap->in[13] + l * 96; const float* kn_g = Ap->in[14] + l * 96;
    const float* rtm = (const float*)(ws + WS_RTM);
    const int lane = F.lane, hl = lane / 12, ch = lane % 12, gbase = hl * 12;
    for (int r = F.gw; r < nrows; r += F.ngw) {
        const bool lat = r < NLAT; const int pos = r & (SEQ - 1), rp = pos >> 6, cp = pos & 63;
        const float* tab = rtm + (size_t)((ch < 10) ? rp : cp) * 16;
#pragma unroll
        for (int pass = 0; pass < 2; ++pass) {
            const int head = pass * 5 + hl; const bool valid = (lane < 60) && (head < 8);
#pragma unroll
            for (int which = 0; which < 2; ++which) {
                u32x4 w = (u32x4){0u, 0u, 0u, 0u};
                bf16* dstp = (which ? KM : QM) + (size_t)r * 768 + head * 96 + ch * 8;
                if (valid) { if (which == 1 && ch >= 8) w = *(const u32x4*)(P + (size_t)r * DIN + 1152 + (ch - 8) * 8); else w = *(const u32x4*)dstp; }
                float x[8]; unpack8(w, x); float ss = 0.f;
#pragma unroll
                for (int e = 0; e < 8; ++e) ss += x[e] * x[e];
                float tot = 0.f;
#pragma unroll
                for (int i = 0; i < 12; ++i) tot += __shfl(ss, (gbase + i) & 63);
                const float rinv = rsqrtf(tot * (1.f / 96.f) + EPS);
                const float* gg = which ? kn_g : qn_g;
                float y[8], o[8];
#pragma unroll
                for (int e = 0; e < 8; ++e) y[e] = x[e] * rinv * gg[8 * ch + e];
#pragma unroll
                for (int e = 0; e < 8; ++e) { const float py = __shfl_xor(y[e], 1);
                    if (lat && ch >= 8) { const float cs = tab[2 * e], sn = tab[2 * e + 1]; o[e] = (ch & 1) ? (y[e] * cs + py * sn) : (y[e] * cs - py * sn); } else o[e] = y[e]; }
                if (which == 0) {
#pragma unroll
                    for (int e = 0; e < 8; ++e) o[e] *= C_MLA;
                }
                if (valid) *(u32x4*)dstp = pack8(o);
            }
        }
    }
}
namespace att {
constexpr int SHM_V = 64 * 64 * 2, SHM_K = 64 * 256, LDS_ATT = 2 * SHM_V + 2 * SHM_K + 8 * 64 * 4;
#define KSWZ(row, colB) ((row) * 256 + ((colB) ^ (((row) & 7) << 4)))
#define SBAR() __builtin_amdgcn_sched_barrier(0)
__device__ __forceinline__ int crow(int r, int hi) { return (r & 3) + 8 * (r >> 2) + 4 * hi; }
__device__ __forceinline__ int v_st(int k, int c) { const int kk = (k & ~0xC) | ((k & 4) << 1) | ((k & 8) >> 1); return ((kk >> 3) * 2 + (c >> 5)) * 512 + ((kk & 7) * 32 + (c & 31)) * 2; }
__device__ __forceinline__ int v_rd_base(int lane) { return ((lane & 3) << 3) | (((lane >> 2) & 3) << 6) | (((lane >> 4) & 1) << 5) | (((lane >> 5) & 1) << 8); }
constexpr int v_rd_off(int d0, int ks, int half) { return d0 * 512 + ks * 2048 + half * 1024; }
template <int OFF> __device__ __forceinline__ s16x4 tr_read(int vb) {
    s16x4 r; asm volatile("ds_read_b64_tr_b16 %0, %1 offset:%2" : "=&v"(r) : "v"(vb), "i"(OFF) : "memory"); return r;
}
template <int D0> __device__ __forceinline__ void pv_one(f32x16& od, int vb, bf16x8 pa0, bf16x8 pa1, bf16x8 pa2, bf16x8 pa3) {
    const s16x4 l0 = tr_read<v_rd_off(D0, 0, 0)>(vb), h0 = tr_read<v_rd_off(D0, 0, 1)>(vb), l1 = tr_read<v_rd_off(D0, 1, 0)>(vb), h1 = tr_read<v_rd_off(D0, 1, 1)>(vb);
    const s16x4 l2 = tr_read<v_rd_off(D0, 2, 0)>(vb), h2 = tr_read<v_rd_off(D0, 2, 1)>(vb), l3 = tr_read<v_rd_off(D0, 3, 0)>(vb), h3 = tr_read<v_rd_off(D0, 3, 1)>(vb);
    asm volatile("s_waitcnt lgkmcnt(0)" ::: "memory"); SBAR();
#define PK(L, H) (bf16x8){L[0], L[1], L[2], L[3], H[0], H[1], H[2], H[3]}
    od = __builtin_amdgcn_mfma_f32_32x32x16_bf16(pa0, PK(l0, h0), od, 0, 0, 0);
    od = __builtin_amdgcn_mfma_f32_32x32x16_bf16(pa1, PK(l1, h1), od, 0, 0, 0);
    od = __builtin_amdgcn_mfma_f32_32x32x16_bf16(pa2, PK(l2, h2), od, 0, 0, 0);
    od = __builtin_amdgcn_mfma_f32_32x32x16_bf16(pa3, PK(l3, h3), od, 0, 0, 0);
#undef PK
}
__device__ __forceinline__ void pv2(f32x16* o, int vb, bf16x8 pa0, bf16x8 pa1, bf16x8 pa2, bf16x8 pa3) {
    pv_one<0>(o[0], vb, pa0, pa1, pa2, pa3); pv_one<1>(o[1], vb, pa0, pa1, pa2, pa3);
}
template <int ND0> __device__ __forceinline__ void qkt(f32x16& p0, f32x16& p1, const char* Ks, const bf16x8* qr, int r32, int hi) {
    p0 = f32x16{}; p1 = f32x16{};
#pragma unroll
    for (int d0 = 0; d0 < ND0; ++d0) { const int cb = (d0 * 16 + hi * 8) * 2;
        const bf16x8 b0 = *reinterpret_cast<const bf16x8*>(Ks + KSWZ(r32, cb));
        const bf16x8 b1 = *reinterpret_cast<const bf16x8*>(Ks + KSWZ(32 + r32, cb));
        p0 = __builtin_amdgcn_mfma_f32_32x32x16_bf16(b0, qr[d0], p0, 0, 0, 0);
        p1 = __builtin_amdgcn_mfma_f32_32x32x16_bf16(b1, qr[d0], p1, 0, 0, 0); }
}
__device__ __forceinline__ void wmask(f32x16& p0, f32x16& p1, int kp0, int qp, int hi) {
#pragma unroll
    for (int r = 0; r < 16; ++r) { const int d0 = kp0 + crow(r, hi) - qp; const int d1 = d0 + 32;
        if (d0 > 128 || d0 < -128) p0[r] = -INFINITY; if (d1 > 128 || d1 < -128) p1[r] = -INFINITY; }
}
__device__ __forceinline__ void smpack(f32x16& p0, f32x16& p1, float& l_reg, bf16x8& pa0, bf16x8& pa1, bf16x8& pa2, bf16x8& pa3) {
#pragma unroll
    for (int r = 0; r < 16; ++r) p0[r] = __builtin_amdgcn_exp2f(p0[r]);
#pragma unroll
    for (int r = 0; r < 16; ++r) p1[r] = __builtin_amdgcn_exp2f(p1[r]);
    float ps = 0.f;
#pragma unroll
    for (int r = 0; r < 16; ++r) ps += p0[r];
#pragma unroll
    for (int r = 0; r < 16; ++r) ps += p1[r];
    l_reg += ps;
#define PK4(P, BASE, OUT) do { unsigned a0 = pk2(P[BASE + 0], P[BASE + 1]), a1 = pk2(P[BASE + 2], P[BASE + 3]);   \
    unsigned b0 = pk2(P[BASE + 4], P[BASE + 5]), b1 = pk2(P[BASE + 6], P[BASE + 7]);                              \
    auto r0 = __builtin_amdgcn_permlane32_swap(a0, b0, false, false); auto r1 = __builtin_amdgcn_permlane32_swap(a1, b1, false, false); \
    u32x4 w = {r0[0], r1[0], r0[1], r1[1]}; OUT = *reinterpret_cast<bf16x8*>(&w); } while (0)
    PK4(p0, 0, pa0); PK4(p0, 8, pa1); PK4(p1, 0, pa2); PK4(p1, 8, pa3);
#undef PK4
}

struct Unit {
    const bf16* Q; int ldq;
    const bf16* K; int ldk;
    const bf16* V; int ldv;
    bf16* O;
    int qrow0;
    int ctx_row0;
    int lat_row0;
    int nt;
    int qpos0;
    int kpos0;
    int masked;
    float l_init;
};

template <int DQK, bool MASKED>
__device__ __forceinline__ void attn_unit(const Unit& U, char* lds, const int tid) {
    constexpr int ND0 = DQK / 16, NCH = DQK / 8;
    const int wid = tid >> 6, lane = tid & 63, r32 = lane & 31, hi = lane >> 5;
    char* V_lds = lds; char* K_lds = lds + 2 * SHM_V;
    float* wsf = (float*)(lds + 2 * SHM_V + 2 * SHM_K) + wid * 64;
    float l_reg = (hi == 0) ? U.l_init : 0.f; f32x16 o[2] = {}; bf16x8 qr[ND0];
    const bf16* Qw = U.Q + (size_t)(U.qrow0 + wid * 32 + r32) * U.ldq + hi * 8;
#pragma unroll
    for (int d0 = 0; d0 < ND0; ++d0) qr[d0] = *reinterpret_cast<const bf16x8*>(Qw + d0 * 16);
    const int vk = tid >> 3, vc = (tid & 7) * 8, vst = v_st(vk, vc);
    const int k0r = tid / NCH, k0c = tid % NCH;
    const bool k1on = (NCH == 12) && (tid < 256);
    const int k1i = k1on ? (tid + 512) : tid, k1r = k1i / NCH, k1c = k1i % NCH;
    const int vb0 = (int)(uintptr_t)V_lds + v_rd_base(lane);
    struct Slot { bf16x8 v, k0, k1; } s0;
    auto tile_row = [&](int t) -> int { return (t < 4) ? (U.ctx_row0 + 64 * t) : (U.lat_row0 + 64 * (t - 4)); };
#define SLOAD(S, t) do { const int kr_ = tile_row(t); \
        S.v = *reinterpret_cast<const bf16x8*>(U.V + (size_t)(kr_ + vk) * U.ldv + vc); \
        S.k0 = *reinterpret_cast<const bf16x8*>(U.K + (size_t)(kr_ + k0r) * U.ldk + k0c * 8); \
        if (NCH == 12) S.k1 = *reinterpret_cast<const bf16x8*>(U.K + (size_t)(kr_ + k1r) * U.ldk + k1c * 8); } while (0)
#define SWRITE(b, S) do { *reinterpret_cast<bf16x8*>(V_lds + (b) * SHM_V + vst) = S.v; \
        *reinterpret_cast<bf16x8*>(K_lds + (b) * SHM_K + KSWZ(k0r, k0c * 16)) = S.k0; \
        if (NCH == 12) { if (k1on) *reinterpret_cast<bf16x8*>(K_lds + (b) * SHM_K + KSWZ(k1r, k1c * 16)) = S.k1; } } while (0)
#define MASK(P0, P1, t) do { if (MASKED && (t) >= 4) wmask(P0, P1, U.kpos0 + 64 * ((t) - 4), U.qpos0 + wid * 32 + r32, hi); } while (0)
    f32x16 pA0, pA1, pB0, pB1; bf16x8 pa0, pa1, pa2, pa3; const int NT = U.nt;
    __syncthreads();
    SLOAD(s0, 0); SWRITE(0, s0); __syncthreads();
    qkt<ND0>(pA0, pA1, K_lds, qr, r32, hi); MASK(pA0, pA1, 0);
    SLOAD(s0, 1);
    SWRITE(1, s0); __syncthreads();
    for (int j = 1; j + 1 < NT; j += 2) {
        SBAR(); qkt<ND0>(pB0, pB1, K_lds + SHM_K, qr, r32, hi); MASK(pB0, pB1, j);
        smpack(pA0, pA1, l_reg, pa0, pa1, pa2, pa3); SBAR();
        SLOAD(s0, j + 1); SBAR();
        pv2(o, vb0, pa0, pa1, pa2, pa3);
        __syncthreads(); SWRITE(0, s0); __syncthreads();
        SBAR(); qkt<ND0>(pA0, pA1, K_lds, qr, r32, hi); MASK(pA0, pA1, j + 1);
        smpack(pB0, pB1, l_reg, pa0, pa1, pa2, pa3); SBAR();
        SLOAD(s0, j + 2); SBAR();
        pv2(o, vb0 + SHM_V, pa0, pa1, pa2, pa3);
        __syncthreads(); SWRITE(1, s0); __syncthreads();
    }
    SBAR(); qkt<ND0>(pB0, pB1, K_lds + SHM_K, qr, r32, hi); MASK(pB0, pB1, NT - 1);
    smpack(pA0, pA1, l_reg, pa0, pa1, pa2, pa3); SBAR();
    pv2(o, vb0, pa0, pa1, pa2, pa3);
    smpack(pB0, pB1, l_reg, pa0, pa1, pa2, pa3); SBAR();
    pv2(o, vb0 + SHM_V, pa0, pa1, pa2, pa3);
    { auto rr = __builtin_amdgcn_permlane32_swap(__float_as_uint(l_reg), __float_as_uint(l_reg), false, false);
      l_reg = __uint_as_float(rr[0]) + __uint_as_float(rr[1]); }
    if (hi == 0) wsf[r32] = l_reg;
    asm volatile("s_waitcnt lgkmcnt(0)" ::: "memory");
    float rli[16];
#pragma unroll
    for (int r = 0; r < 16; ++r) rli[r] = 1.f / wsf[crow(r, hi)];
    bf16* Ow = U.O + (size_t)(U.qrow0 + wid * 32) * 1024;
#pragma unroll
    for (int r = 0; r < 16; ++r) { const int orow = crow(r, hi);
#pragma unroll
        for (int d0 = 0; d0 < 2; ++d0) { const unsigned w = pk2(o[d0][r] * rli[r], 0.f); Ow[(size_t)orow * 1024 + d0 * 32 + r32] = (bf16)(w & 0xffffu); } }
#undef SLOAD
#undef SWRITE
#undef MASK
}
#undef KSWZ
}

__device__ __forceinline__ void attn_phase(const Frame& F, ArgsP Ap, int l, char* lds) {
    unsigned char* ws = Ap->ws;
    const bf16* QM = (const bf16*)(ws + WS_QM); const bf16* KM = (const bf16*)(ws + WS_KM); const bf16* VM = (const bf16*)(ws + WS_VM);
    const bf16* QS = (const bf16*)(ws + WS_QS); const bf16* KS = (const bf16*)(ws + WS_KS); const bf16* VS = (const bf16*)(ws + WS_P) + 1312;
    bf16* OB = (bf16*)(ws + WS_AB);
    const float* sink = Ap->in[17] + l * 8;
    const int nunits = (l == 0) ? 1024 + 64 : 1024;
    for (int u = F.vcu; u < nunits; u += F.G) {
        const bool isl = u < 1024;
        const int i = u >> 8, c = u & 31, b = isl ? ((u & 255) >> 5) : ((u - 1024) >> 3), h = isl ? (2 * i + (c >> 4)) : (u & 7), qb = c & 15;
        att::Unit U; U.Q = QM + h * 96; U.ldq = 768; U.K = KM + h * 96; U.ldk = 768; U.V = VM + h * 64; U.ldv = 512; U.O = OB + h * 64;
        U.qrow0 = isl ? (b * SEQ + qb * 256) : (NLAT + b * CTXL); U.ctx_row0 = NLAT + b * CTXL; U.lat_row0 = b * SEQ; U.nt = isl ? (4 + SEQ / 64) : 4; U.qpos0 = 0; U.kpos0 = 0; U.masked = 0; U.l_init = 0.f;
        att::attn_unit<96, false>(U, lds, F.tid);
    }
    for (int u = F.vcu; u < nunits; u += F.G) {
        const bool isl = u < 1024;
        const int i = u >> 8, c = u & 31, b = isl ? ((u & 255) >> 5) : ((u - 1024) >> 3), h = isl ? (2 * i + (c >> 4)) : (u & 7), qb = c & 15, g = h >> 2;
        const int q0 = qb * 256; int k_lo = q0 - 128; if (k_lo < 0) k_lo = 0; int k_hi = q0 + 256 + 128; if (k_hi > SEQ) k_hi = SEQ;
        att::Unit U; U.Q = QS + h * 64; U.ldq = 512; U.K = KS + g * 64; U.ldk = 128; U.V = VS + g * 64; U.ldv = DIN; U.O = OB + 512 + h * 64;
        U.qrow0 = isl ? (b * SEQ + q0) : (NLAT + b * CTXL); U.ctx_row0 = NLAT + b * CTXL; U.lat_row0 = b * SEQ + k_lo; U.nt = isl ? (4 + (k_hi - k_lo) / 64) : 4; U.qpos0 = q0; U.kpos0 = k_lo; U.masked = 1;
        U.l_init = __builtin_amdgcn_exp2f(sink[h] * LOG2E);
        att::attn_unit<64, true>(U, lds, F.tid);
    }
}

#ifndef DBG_NAIVE_ATTN
#define DBG_NAIVE_ATTN 0
#endif
#if DBG_NAIVE_ATTN
__device__ __forceinline__ void attn_naive_phase(const Frame& F, ArgsP Ap, int l) {
    unsigned char* ws = Ap->ws;
    const bf16* QM = (const bf16*)(ws + WS_QM); const bf16* KM = (const bf16*)(ws + WS_KM); const bf16* VM = (const bf16*)(ws + WS_VM);
    const bf16* QS = (const bf16*)(ws + WS_QS); const bf16* KS = (const bf16*)(ws + WS_KS); const bf16* VS = (const bf16*)(ws + WS_P) + 1312;
    bf16* OB = (bf16*)(ws + WS_AB);
    const float* sink = Ap->in[17] + l * 8;
    const int nrg = ((l == 0) ? NROWS : NLAT) / 64;
    for (int u = F.gw; u < nrg * 8; u += F.ngw) {
        const int h = __builtin_amdgcn_readfirstlane(u & 7), rg = __builtin_amdgcn_readfirstlane(u >> 3), row = rg * 64 + F.lane;
        const bool lat = rg * 64 < NLAT; const int b = lat ? (rg * 64) >> 12 : (rg * 64 - NLAT) >> 8;
        {
            float q[96], o[64]; float lsum = 0.f;
#pragma unroll
            for (int d = 0; d < 96; d += 2) { const unsigned w = *(const unsigned*)(QM + (size_t)row * 768 + h * 96 + d); q[d] = bf_lo(w); q[d + 1] = bf_hi(w); }
#pragma unroll
            for (int d = 0; d < 64; ++d) o[d] = 0.f;
            const int nk = lat ? (CTXL + SEQ) : CTXL;
#pragma unroll 1
            for (int j = 0; j < nk; ++j) { const int kr = (j < CTXL) ? (NLAT + b * CTXL + j) : (b * SEQ + j - CTXL);
                const bf16* kp = KM + (size_t)kr * 768 + h * 96; const bf16* vp = VM + (size_t)kr * 512 + h * 64; float s = 0.f;
#pragma unroll
                for (int d = 0; d < 96; d += 2) { const unsigned w = *(const unsigned*)(kp + d); s = fmaf(q[d], bf_lo(w), s); s = fmaf(q[d + 1], bf_hi(w), s); }
                const float p = exp2f(s); lsum += p;
#pragma unroll
                for (int d = 0; d < 64; d += 2) { const unsigned w = *(const unsigned*)(vp + d); o[d] = fmaf(p, bf_lo(w), o[d]); o[d + 1] = fmaf(p, bf_hi(w), o[d + 1]); } }
            const float rl = 1.f / lsum;
#pragma unroll
            for (int d = 0; d < 64; d += 2) *(unsigned*)(OB + (size_t)row * 1024 + h * 64 + d) = pk2(o[d] * rl, o[d + 1] * rl);
        }
        {
            const int g = h >> 2; const int pos0 = (rg * 64) & (SEQ - 1), pos = pos0 + F.lane;
            float q[64], o[64]; float lsum = exp2f(sink[h] * LOG2E);
#pragma unroll
            for (int d = 0; d < 64; d += 2) { const unsigned w = *(const unsigned*)(QS + (size_t)row * 512 + h * 64 + d); q[d] = bf_lo(w); q[d + 1] = bf_hi(w); }
#pragma unroll
            for (int d = 0; d < 64; ++d) o[d] = 0.f;
            int jlo = pos0 - 128; if (jlo < 0) jlo = 0; int jhi = pos0 + 63 + 128; if (jhi > SEQ - 1) jhi = SEQ - 1;
            const int nk = lat ? (CTXL + (jhi - jlo + 1)) : CTXL;
#pragma unroll 1
            for (int j = 0; j < nk; ++j) { const bool isc = j < CTXL; const int kpos = jlo + j - CTXL; const int kr = isc ? (NLAT + b * CTXL + j) : (b * SEQ + kpos);
                const bf16* kp = KS + (size_t)kr * 128 + g * 64; const bf16* vp = VS + (size_t)kr * DIN + g * 64; float s = 0.f;
#pragma unroll
                for (int d = 0; d < 64; d += 2) { const unsigned w = *(const unsigned*)(kp + d); s = fmaf(q[d], bf_lo(w), s); s = fmaf(q[d + 1], bf_hi(w), s); }
                float p = exp2f(s); if (!isc) { const int dd = kpos - pos; if (dd > 128 || dd < -128) p = 0.f; } lsum += p;
#pragma unroll
                for (int d = 0; d < 64; d += 2) { const unsigned w = *(const unsigned*)(vp + d); o[d] = fmaf(p, bf_lo(w), o[d]); o[d + 1] = fmaf(p, bf_hi(w), o[d + 1]); } }
            const float rl = 1.f / lsum;
#pragma unroll
            for (int d = 0; d < 64; d += 2) *(unsigned*)(OB + (size_t)row * 1024 + 512 + h * 64 + d) = pk2(o[d] * rl, o[d + 1] * rl);
        }
    }
}
#endif
__device__ __forceinline__ unsigned f2key(float f) { const unsigned u = __float_as_uint(f); return (u & 0x80000000u) ? ~u : (u | 0x80000000u); }
__device__ __forceinline__ float key2f(unsigned k) { const unsigned u = (k & 0x80000000u) ? (k & 0x7fffffffu) : ~k; return __uint_as_float(u); }
#define CE_DESC(a, b) do { const unsigned _hi = max(a, b), _lo = min(a, b); a = _hi; b = _lo; } while (0)
__device__ __forceinline__ void sort16_desc(unsigned (&a)[16]) {
#pragma unroll
    for (int k = 2; k <= 16; k <<= 1)
#pragma unroll
        for (int j = k >> 1; j > 0; j >>= 1)
#pragma unroll
            for (int i = 0; i < 16; ++i) { const int p = i ^ j;
                if (p > i) { if ((i & k) == 0) { CE_DESC(a[i], a[p]); } else { CE_DESC(a[p], a[i]); } } }
}
__device__ __forceinline__ void merge16_desc(unsigned (&t)[16], const unsigned (&c)[16]) {
#pragma unroll
    for (int i = 0; i < 16; ++i) t[i] = max(t[i], c[15 - i]);
#pragma unroll
    for (int j = 8; j > 0; j >>= 1)
#pragma unroll
        for (int i = 0; i < 16; ++i) { const int p = i ^ j; if (p > i) CE_DESC(t[i], t[p]); }
}
__device__ __forceinline__ void merge16_partner(unsigned (&t)[16]) {
    unsigned oth[16];
#pragma unroll
    for (int i = 0; i < 16; ++i) oth[i] = (unsigned)__shfl_xor((int)t[i], 32);
    merge16_desc(t, oth);
}

constexpr size_t WS_IDX = WS_P;
constexpr size_t WS_GW = WS_P + (size_t)NROWS * 128 * 2;
constexpr size_t WS_W2 = WS_GW + (size_t)NROWS * 128 * 4;
static_assert(WS_W2 + (size_t)NROWS * 128 * 4 <= WS_X5, "peer lists inside the P region");

__device__ __forceinline__ void topkc_phase(const Frame& F, ArgsP Ap, int l, int nrows, char* lds) {
    unsigned char* ws = Ap->ws;
    const bf16* QP = (const bf16*)(ws + WS_X5);
    const bf16* PK = (const bf16*)(ws + WS_PKEY) + (size_t)l * 16 * 128 * 128;
    unsigned short* IDX = (unsigned short*)(ws + WS_IDX); float* GW = (float*)(ws + WS_GW);
    char* Kl = lds;
    unsigned char* sub = (unsigned char*)(lds + 65536) + F.wave * 1024;
    const int lane = F.lane, r32 = lane & 31, hi = lane >> 5;
    const int nunits = (nrows / 256) * 8;
    for (int u = F.bid; u < nunits; u += F.G) {
        const int h = u & 7, rb = u >> 3;
        __syncthreads();
#pragma unroll
        for (int i = 0; i < 8; ++i) { const int ci = F.tid + 512 * i, krow = ci >> 4, ch = ci & 15;
            const u32x4 v = *(const u32x4*)(PK + ((size_t)(2 * h) * 128 + krow) * 128 + ch * 8);
            *(u32x4*)(Kl + krow * 256 + ((ch * 16) ^ ((krow & 7) << 4))) = v; }
        __syncthreads();
        const int row = rb * 256 + F.wave * 32 + r32;
        const unsigned hi4 = (unsigned)hi << 2, hi7 = (unsigned)hi << 7;
        unsigned t0[16], t1[16];
#pragma unroll
        for (int p = 0; p < 2; ++p) {
            const bf16* qrow = QP + (size_t)row * 2048 + (2 * h + p) * 128 + hi * 8;
            bf16x8 bq[8];
#pragma unroll
            for (int s = 0; s < 8; ++s) bq[s] = *reinterpret_cast<const bf16x8*>(qrow + s * 16);
            unsigned top[16];
#pragma unroll
            for (int blk = 0; blk < 4; ++blk) {
                f32x16 acc = f32x16{};
                const char* kb = Kl + (p * 128 + blk * 32 + r32) * 256;
#pragma unroll
                for (int s = 0; s < 8; ++s) { const bf16x8 ka = *reinterpret_cast<const bf16x8*>(kb + (((s * 16 + hi * 8) * 2) ^ ((r32 & 7) << 4)));
                    acc = __builtin_amdgcn_mfma_f32_32x32x16_bf16(ka, bq[s], acc, 0, 0, 0); }
                unsigned c[16];
#pragma unroll
                for (int r = 0; r < 16; ++r) c[r] = ((f2key(acc[r]) & ~127u) | (unsigned)(127 - (blk * 32 + (r & 3) + 8 * (r >> 2)))) ^ hi4;
                sort16_desc(c);
                if (blk == 0) {
#pragma unroll
                    for (int i = 0; i < 16; ++i) top[i] = c[i];
                } else merge16_desc(top, c);
                __builtin_amdgcn_sched_barrier(0);
            }
            merge16_partner(top);
#pragma unroll
            for (int i = 0; i < 16; ++i) { if (p == 0) t0[i] = top[i]; else t1[i] = top[i]; }
        }
        if (hi == 0) { unsigned* sw = (unsigned*)(sub + r32 * 32);
#pragma unroll
            for (int q = 0; q < 4; ++q) {
                sw[q] = (127u - (t0[4 * q] & 127u)) | ((127u - (t0[4 * q + 1] & 127u)) << 8) | ((127u - (t0[4 * q + 2] & 127u)) << 16) | ((127u - (t0[4 * q + 3] & 127u)) << 24);
                sw[4 + q] = (127u - (t1[4 * q] & 127u)) | ((127u - (t1[4 * q + 1] & 127u)) << 8) | ((127u - (t1[4 * q + 2] & 127u)) << 16) | ((127u - (t1[4 * q + 3] & 127u)) << 24); } }
        float f1[16], fa[8];
#pragma unroll
        for (int i = 0; i < 16; ++i) f1[i] = key2f(t1[i] & ~127u);
#pragma unroll
        for (int i = 0; i < 8; ++i) fa[i] = key2f((hi ? t0[8 + i] : t0[i]) & ~127u);
        unsigned top[16];
#pragma unroll
        for (int i = 0; i < 8; ++i) {
            unsigned c[16];
#pragma unroll
            for (int b = 0; b < 16; ++b) c[b] = ((f2key(fa[i] + f1[b]) & ~255u) | (unsigned)(255 - (16 * i + b))) ^ hi7;
            if (i == 0) {
#pragma unroll
                for (int k = 0; k < 16; ++k) top[k] = c[k];
            } else merge16_desc(top, c);
            __builtin_amdgcn_sched_barrier(0);
        }
        merge16_partner(top);
        asm volatile("s_waitcnt lgkmcnt(0)" ::: "memory");
        float cv[16]; float den = 0.f; const float m = key2f(top[0] & ~255u);
#pragma unroll
        for (int i = 0; i < 16; ++i) { cv[i] = __expf(key2f(top[i] & ~255u) - m); den += cv[i]; }
        const float rden = 1.f / den;
        if (hi == 0) {
            unsigned iw[8];
#pragma unroll
            for (int i = 0; i < 16; i += 2) {
                const int fl0 = 255 - (int)(top[i] & 255u), fl1 = 255 - (int)(top[i + 1] & 255u);
                const unsigned e0 = (unsigned)sub[r32 * 32 + (fl0 >> 4)] * PNK + (unsigned)sub[r32 * 32 + 16 + (fl0 & 15)];
                const unsigned e1 = (unsigned)sub[r32 * 32 + (fl1 >> 4)] * PNK + (unsigned)sub[r32 * 32 + 16 + (fl1 & 15)];
                iw[i >> 1] = e0 | (e1 << 16); }
            u32x4* ip = (u32x4*)(IDX + (size_t)row * 128 + h * 16); ip[0] = (u32x4){iw[0], iw[1], iw[2], iw[3]}; ip[1] = (u32x4){iw[4], iw[5], iw[6], iw[7]};
            f32x4* gp = (f32x4*)(GW + (size_t)row * 128 + h * 16);
#pragma unroll
            for (int q = 0; q < 4; ++q) gp[q] = (f32x4){cv[4 * q] * rden, cv[4 * q + 1] * rden, cv[4 * q + 2] * rden, cv[4 * q + 3] * rden};
        }
    }
}

typedef __bf16 bf16x2_t __attribute__((ext_vector_type(2)));
typedef float f32x2v __attribute__((ext_vector_type(2)));
__device__ __forceinline__ float dot2(unsigned w, unsigned x, float acc) { return __builtin_amdgcn_fdot2_f32_bf16(__builtin_bit_cast(bf16x2_t, w), __builtin_bit_cast(bf16x2_t, x), acc, false); }
__device__ __forceinline__ float dot16(const u32x4 a0, const u32x4 a1, const u32x4 x0, const u32x4 x1) {
    float s0 = dot2(a0.x, x0.x, 0.f), s1 = dot2(a0.y, x0.y, 0.f), s2 = dot2(a0.z, x0.z, 0.f), s3 = dot2(a0.w, x0.w, 0.f);
    s0 = dot2(a1.x, x1.x, s0); s1 = dot2(a1.y, x1.y, s1); s2 = dot2(a1.z, x1.z, s2); s3 = dot2(a1.w, x1.w, s3);
    return (s0 + s1) + (s2 + s3);
}
__device__ __forceinline__ void fma8(float (&o)[8], const u32x4 v, float w) {
    o[0] += w * bf_lo(v.x); o[1] += w * bf_hi(v.x); o[2] += w * bf_lo(v.y); o[3] += w * bf_hi(v.y);
    o[4] += w * bf_lo(v.z); o[5] += w * bf_hi(v.z); o[6] += w * bf_lo(v.w); o[7] += w * bf_hi(v.w);
}

__device__ __forceinline__ void pu_phase(const Frame& F, ArgsP Ap, int l, int nrows, char* lds) {
    unsigned char* ws = Ap->ws;
    const unsigned short* IDX = (const unsigned short*)(ws + WS_IDX); const float* GW = (const float*)(ws + WS_GW); float* W2 = (float*)(ws + WS_W2);
    const bf16* Bx = (const bf16*)(ws + WS_AB);
    const bf16* Ut = (const bf16*)(ws + WS_U) + (size_t)l * PEXP * DM;
    const int lane = F.lane;
    int* l_slot = (int*)(lds + F.wave * 2048); int* l_idx = l_slot + 128; float* l_g = (float*)(l_idx + 128);
    const bool xs = (F.G % 8) == 0;
    const int wv = xs ? ((F.bid >> 3) * 8 + F.wave) : F.gw, nwv = xs ? (F.G >> 3) * 8 : F.ngw, npass = xs ? 2 : 16;
    const unsigned long long lt = (1ull << lane) - 1ull;
    for (int pass = 0; pass < npass; ++pass) {
        const int c = xs ? ((F.bid & 7) + 8 * pass) : pass;
        for (int t = wv; t < nrows; t += nwv) {
            const unsigned iw = *(const unsigned*)(IDX + (size_t)t * 128 + 2 * lane); const int i0 = (int)(iw & 0xffffu), i1 = (int)(iw >> 16);
            const f32x2v gg = *(const f32x2v*)(GW + (size_t)t * 128 + 2 * lane);
            const bool m0 = (i0 >> 10) == c, m1 = (i1 >> 10) == c;
            const unsigned long long b0 = __ballot(m0), b1 = __ballot(m1);
            const int n = __popcll(b0) + __popcll(b1);
            if (n == 0) continue;
            const int r0 = __popcll(b0 & lt) + __popcll(b1 & lt);
            if (m0) { l_slot[r0] = 2 * lane; l_idx[r0] = i0; l_g[r0] = gg.x; }
            if (m1) { const int r1 = r0 + (m0 ? 1 : 0); l_slot[r1] = 2 * lane + 1; l_idx[r1] = i1; l_g[r1] = gg.y; }
            const bf16* xr = Bx + (size_t)t * DM;
            const u32x4 x0 = *(const u32x4*)(xr + 8 * lane), x1 = *(const u32x4*)(xr + 512 + 8 * lane);
            asm volatile("s_waitcnt lgkmcnt(0)" ::: "memory");
#pragma unroll 1
            for (int k0 = 0; k0 < n; k0 += 4) {
                float v[4];
                u32x4 ua[4], ub[4];
#pragma unroll
                for (int j = 0; j < 4; ++j) { const int kk = (k0 + j < n) ? (k0 + j) : (n - 1); const int e = __builtin_amdgcn_readfirstlane(l_idx[kk]); const bf16* up = Ut + (size_t)e * DM;
                    ua[j] = *(const u32x4*)(up + 8 * lane); ub[j] = *(const u32x4*)(up + 512 + 8 * lane); }
#pragma unroll
                for (int j = 0; j < 4; ++j) v[j] = dot16(ua[j], ub[j], x0, x1);
                float t2[2], t1;
                { const bool up_ = (lane & 32) != 0;
#pragma unroll
                  for (int j = 0; j < 2; ++j) { const float keep = up_ ? v[j + 2] : v[j], send = up_ ? v[j] : v[j + 2]; t2[j] = keep + __shfl_xor(send, 32); } }
                { const bool up_ = (lane & 16) != 0; const float keep = up_ ? t2[1] : t2[0], send = up_ ? t2[0] : t2[1]; t1 = keep + __shfl_xor(send, 16); }
                t1 += __shfl_xor(t1, 8); t1 += __shfl_xor(t1, 4); t1 += __shfl_xor(t1, 2); t1 += __shfl_xor(t1, 1);
                const int j = lane >> 4;
                if ((lane & 15) == 0 && k0 + j < n) { const float a = t1; const float ge = 0.5f * a * (1.f + erff(a * 0.70710678118654752f)); W2[(size_t)t * 128 + l_slot[k0 + j]] = l_g[k0 + j] * ge; }
            }
        }
    }
}

__device__ __forceinline__ void pv_phase(const Frame& F, ArgsP Ap, int l, int nrows, const bool dry) {
    unsigned char* ws = Ap->ws;
    const unsigned short* IDX = (const unsigned short*)(ws + WS_IDX); const float* GW = (const float*)(ws + WS_W2);
    const bf16* Vt = (const bf16*)(ws + WS_V) + (size_t)l * PEXP * DM;
    const float* MOD = (const float*)(ws + WS_MOD);
    const int lane = F.lane, sub = lane >> 3, dch = lane & 7;
    const bool xs = (F.G % 8) == 0;
    const int wv = xs ? ((F.bid >> 3) * 8 + F.wave) : F.gw, nwv = xs ? (F.G >> 3) * 8 : F.ngw, npass = xs ? 2 : 16;
    for (int pass = 0; pass < npass; ++pass) {
        const int s = xs ? ((F.bid & 7) + 8 * pass) : pass;
        const bf16* vbase = Vt + (size_t)s * PEXP * 64 + dch * 8;
        for (int t = wv; t < nrows; t += nwv) {
            const u32x4 ia = *(const u32x4*)(IDX + (size_t)t * 128 + 16 * sub), ib = *(const u32x4*)(IDX + (size_t)t * 128 + 16 * sub + 8);
            const f32x4* wp = (const f32x4*)(GW + (size_t)t * 128 + 16 * sub);
            const f32x4 w0 = wp[0], w1 = wp[1], w2 = wp[2], w3 = wp[3];
            const unsigned iw[8] = {ia.x, ia.y, ia.z, ia.w, ib.x, ib.y, ib.z, ib.w};
            const float wv_[16] = {w0[0], w0[1], w0[2], w0[3], w1[0], w1[1], w1[2], w1[3], w2[0], w2[1], w2[2], w2[3], w3[0], w3[1], w3[2], w3[3]};
            u32x4 va[16];
#pragma unroll
            for (int it = 0; it < 16; ++it) { const unsigned e = (it & 1) ? (iw[it >> 1] >> 16) : (iw[it >> 1] & 0xffffu); va[it] = *(const u32x4*)(vbase + (size_t)e * 64); }
            float o[8];
#pragma unroll
            for (int i = 0; i < 8; ++i) o[i] = 0.f;
#pragma unroll
            for (int it = 0; it < 16; ++it) fma8(o, va[it], wv_[it]);
#pragma unroll
            for (int i = 0; i < 8; ++i) { o[i] += __shfl_xor(o[i], 8); o[i] += __shfl_xor(o[i], 16); o[i] += __shfl_xor(o[i], 32); }
            if (sub == 0 && !dry) {
                const bool lat = t < NLAT; const int smp = lat ? (t >> 12) : 8;
                float* hr = (lat ? (Ap->out + (size_t)t * DM) : ((float*)(ws + WS_HCTX) + (size_t)(t - NLAT) * DM)) + s * 64 + dch * 8;
                const float* g2 = MOD + ((size_t)l * 9 + smp) * 6144 + 5 * DM + s * 64 + dch * 8;
                const f32x4 ga = *(const f32x4*)g2, gb = *(const f32x4*)(g2 + 4); f32x4 ha = *(const f32x4*)hr, hb = *(const f32x4*)(hr + 4);
                ha += ga * (f32x4){o[0], o[1], o[2], o[3]}; hb += gb * (f32x4){o[4], o[5], o[6], o[7]};
                *(f32x4*)hr = ha; *(f32x4*)(hr + 4) = hb;
            }
        }
    }
}
constexpr int PH_PER_LAYER = 12, N_PHASES = 1 + DEPTH * PH_PER_LAYER;
#ifndef MK_ONE_LAUNCH
#define MK_ONE_LAUNCH 0
#endif
#ifndef MK_MASK
#define MK_MASK 0x1FFF
#endif
#define PON(s) (((MK_MASK) >> (s)) & 1)

#ifndef DBG_NAIVE_GEMM
#define DBG_NAIVE_GEMM 0
#endif
#if DBG_NAIVE_GEMM
__device__ __forceinline__ void naive_gemm(const Frame& F, const pg8::Gemm g, int kind, const pg8::EpiStore es, const pg8::EpiResid er) {
    const int ncg = g.N / 64; const int nunits = g.M * ncg;
    for (int u = F.gw; u < nunits; u += F.ngw) {
        const int row = __builtin_amdgcn_readfirstlane(u / ncg), col = (u % ncg) * 64 + F.lane;
        const bf16* ar = g.A + (size_t)row * g.K; const bf16* br = g.Bt + (size_t)col * g.K; float acc = 0.f;
#pragma unroll 1
        for (int k = 0; k < g.K; k += 8) { const u32x4 a = *(const u32x4*)(ar + k), b = *(const u32x4*)(br + k); float x[8], y[8]; unpack8(a, x); unpack8(b, y);
#pragma unroll
            for (int e = 0; e < 8; ++e) acc = fmaf(x[e], y[e], acc); }
        if (kind == 0) { if (col < es.ncols) es.O[(size_t)row * es.ldc + col] = (bf16)(pk2(acc, 0.f) & 0xffffu); }
        else if (kind == 1) { const int head = col >> 7, j = col & 127; bf16* d = (j < 64) ? (es.O + (size_t)row * 768 + head * 96 + j) : (es.VM + (size_t)row * 512 + head * 64 + (j - 64)); *d = (bf16)(pk2(acc, 0.f) & 0xffffu); }
        else { const bool lat = row < er.nlat; const int sample = lat ? (row >> 12) : 8;
            const float* src = lat ? er.hin_lat + (size_t)row * 1024 : er.hin_ctx + (size_t)(row - er.nlat) * 1024; float* dst = lat ? er.hout_lat + (size_t)row * 1024 : er.hout_ctx + (size_t)(row - er.nlat) * 1024;
            dst[col] = src[col] + er.gate[(size_t)sample * 6144 + col] * acc; }
    }
}
#endif

__global__ void __launch_bounds__(512, 2) mk_fwd(Args args_unused) {
    extern __shared__ __attribute__((aligned(16))) unsigned char lds[];
    LAS unsigned char* lds3 = (LAS unsigned char*)lds;
    ArgsP args0 = (ArgsP)__builtin_amdgcn_kernarg_segment_ptr();
    const int ph_lo = args0->ph_lo, ph_hi = args0->ph_hi;
    const int wave_s = __builtin_amdgcn_readfirstlane((int)threadIdx.x >> 6);
#pragma unroll 1
    for (int pi = ph_lo; pi < ph_hi; ++pi) {
        int zv = 0; asm volatile("" : "+v"(zv));
        ArgsP args = args0; asm volatile("" : "+s"(args));
        Frame F;
        F.zv = zv; F.lane = (int)__builtin_amdgcn_mbcnt_hi(~0u, __builtin_amdgcn_mbcnt_lo(~0u, 0u)) + zv; F.wave = wave_s; F.tid = wave_s * 64 + F.lane;
        { int bx = blockIdx.x, gd = gridDim.x; asm volatile("" : "+s"(bx), "+s"(gd)); F.bid = bx; F.G = gd; F.vcu = (gd % 8 == 0) ? (bx % 8) * (gd / 8) + bx / 8 : bx; }
        F.gw = F.bid * 8 + F.wave; F.ngw = F.G * 8;
        unsigned char* ws = args->ws;
        const int phraw = args->prog[pi], ph = phraw & 63; const bool dry = (phraw & 64) != 0;
        int njobs = 0, jkind = 0;
        pg8::Gemm gj[2]; pg8::EpiStore ej[2];
        int l = 0, mrows = NROWS;
        if (ph == 0) { if (PON(12)) p0_prologue(F, args, lds3); }
        else {
            const int q = ph - 1, s = q % PH_PER_LAYER; l = q / PH_PER_LAYER;
            mrows = (l == DEPTH - 1) ? NLAT : NROWS;
            switch (s) {
            case 0: if (PON(0)) norm_mod_phase(F, args, l, 0, NROWS); break;
            case 1: if (PON(1)) { njobs = 1;
                gj[0] = pg8::Gemm{(const bf16*)(ws + WS_AB), (const bf16*)(ws + WS_WIN) + (size_t)l * DINP * DM, NROWS, DINP, DM};
                ej[0] = pg8::EpiStore{0, (bf16*)(ws + WS_P), DIN, DIN, nullptr}; } break;
            case 2: if (PON(2)) e2_phase(F, args, l, NROWS); break;
            case 3: if (PON(3)) { njobs = 2;
                gj[0] = pg8::Gemm{(const bf16*)(ws + WS_AB), (const bf16*)(ws + WS_WUQ) + (size_t)l * 768 * QRANK, NROWS, 768, QRANK};
                ej[0] = pg8::EpiStore{0, (bf16*)(ws + WS_QM), 768, 768, nullptr};
                gj[1] = pg8::Gemm{(const bf16*)(ws + WS_AB) + (size_t)NROWS * QRANK, (const bf16*)(ws + WS_WUKV) + (size_t)l * 1024 * KVRANK, NROWS, 1024, KVRANK};
                ej[1] = pg8::EpiStore{1, (bf16*)(ws + WS_KM), 768, 1024, (bf16*)(ws + WS_VM)}; } break;
            case 4: if (PON(4)) e3_phase(F, args, l, NROWS); break;
            case 5: if (PON(5)) {
#if DBG_NAIVE_ATTN
                attn_naive_phase(F, args, l);
#else
                attn_phase(F, args, l, (char*)lds);
#endif
                } break;
            case 6: if (PON(6)) { njobs = 1; jkind = 1;
                gj[0] = pg8::Gemm{(const bf16*)(ws + WS_AB), (const bf16*)(ws + WS_WOUT) + (size_t)l * DM * DM, mrows, DM, DM}; } break;
            case 7: if (PON(7)) norm_mod_phase(F, args, l, 1, mrows); break;
            case 8: if (PON(8)) { njobs = 1;
                gj[0] = pg8::Gemm{(const bf16*)(ws + WS_AB), (const bf16*)(ws + WS_PWQ) + (size_t)l * 2048 * DM, mrows, 2048, DM};
                ej[0] = pg8::EpiStore{0, (bf16*)(ws + WS_X5), 2048, 2048, nullptr}; } break;
            case 9: if (PON(9)) topkc_phase(F, args, l, mrows, (char*)lds); break;
            case 10: if (PON(10)) pu_phase(F, args, l, mrows, (char*)lds); break;
            default: if (PON(11)) pv_phase(F, args, l, mrows, dry); break;
            }
        }
        if (njobs > 0) {
#if DBG_NAIVE_GEMM
            { const pg8::EpiResid ER{(l == 0) ? args->in[0] : args->out, args->in[2], args->out, (float*)(ws + WS_HCTX), (const float*)(ws + WS_MOD) + (size_t)l * 9 * 6144 + 2 * DM, NLAT};
              _Pragma("unroll 1") for (int j = 0; j < njobs; ++j) { const pg8::Gemm g = (j == 0) ? gj[0] : gj[1]; const pg8::EpiStore E = (j == 0) ? ej[0] : ej[1]; naive_gemm(F, g, jkind ? 2 : E.mode, E, ER); } }
#else
            if (jkind == 0) {
#pragma unroll 1
                for (int j = 0; j < njobs; ++j) { __syncthreads();
                    const pg8::Gemm g = (j == 0) ? gj[0] : gj[1]; const pg8::EpiStore E = (j == 0) ? ej[0] : ej[1];
                    pg8::StaticOrder S; S.init(g.M, g.N, F.G, F.bid);
                    pg8::gemm_phase<pg8::EpiStore, pg8::StaticOrder, true, true>(lds3, g, S, E, F.tid); }
            } else { __syncthreads();
                const pg8::Gemm g = gj[0];
                pg8::StaticOrder S; S.init(g.M, g.N, F.G, F.bid);
                pg8::EpiResid E{(l == 0) ? args->in[0] : args->out, args->in[2], args->out, (float*)(ws + WS_HCTX), (const float*)(ws + WS_MOD) + (size_t)l * 9 * 6144 + 2 * DM, NLAT};
                pg8::gemm_phase<pg8::EpiResid, pg8::StaticOrder, true, true>(lds3, g, S, E, F.tid); }
#endif
        }
#if MK_ONE_LAUNCH
        if (pi + 1 < ph_hi) cg::this_grid().sync();
#endif
    }
}

extern "C" void kernel_launch(void* const* d_in, const int* in_sizes, int n_in, void* d_out, int out_size, void* d_ws, size_t ws_size, hipStream_t stream) {
    static int grid = 0;
    if (grid == 0) {
        if (n_in != 23 || in_sizes[0] != NLAT * DM || out_size != NLAT * DM || ws_size < WS_END) {
            fprintf(stderr, "kernel_launch: unexpected shapes: n_in %d in0 %d out %d ws %zu (need %zu)\n", n_in, n_in > 0 ? in_sizes[0] : -1, out_size, ws_size, (size_t)WS_END); grid = -1; return; }
        int dev = 0, cus = 0, per_cu = 0;
        if (hipGetDevice(&dev) != hipSuccess || hipDeviceGetAttribute(&cus, hipDeviceAttributeMultiprocessorCount, dev) != hipSuccess) { fprintf(stderr, "kernel_launch: device query failed\n"); grid = -1; return; }
        if (hipFuncSetAttribute((const void*)mk_fwd, hipFuncAttributeMaxDynamicSharedMemorySize, LDS_BYTES) != hipSuccess) { fprintf(stderr, "kernel_launch: hipFuncSetAttribute failed\n"); grid = -1; return; }
        if (hipOccupancyMaxActiveBlocksPerMultiprocessor(&per_cu, (const void*)mk_fwd, 512, LDS_BYTES) != hipSuccess || per_cu < 1) { fprintf(stderr, "kernel_launch: occupancy query says %d\n", per_cu); per_cu = 1; }
        (void)hipGetLastError();
        grid = cus;
    }
    if (grid < 0) return;
    Args a{};
    for (int i = 0; i < 23; ++i) a.in[i] = (const float*)d_in[i];
    a.out = (float*)d_out; a.ws = (unsigned char*)d_ws;
    int np = 0;
#ifdef MK_PROG
    { static const int pr[] = {MK_PROG}; for (int i = 0; i < (int)(sizeof(pr) / sizeof(pr[0])); ++i) a.prog[np++] = (unsigned char)pr[i]; }
#else
    for (int p = 0; p < N_PHASES; ++p) a.prog[np++] = (unsigned char)p;
#endif
#if MK_ONE_LAUNCH
    a.ph_lo = 0; a.ph_hi = np;
    void* kargs[] = {&a};
    hipError_t e = hipLaunchCooperativeKernel((const void*)mk_fwd, dim3(grid), dim3(512), kargs, LDS_BYTES, stream);
    if (e != hipSuccess) fprintf(stderr, "kernel_launch: cooperative launch failed: %s (grid %d)\n", hipGetErrorString(e), grid);
#else
    for (int p = 0; p < np; ++p) {
        a.ph_lo = p; a.ph_hi = p + 1;
        hipLaunchKernelGGL(mk_fwd, dim3(grid), dim3(512), LDS_BYTES, stream, a);
    }
    const hipError_t le = hipPeekAtLastError();
    if (le != hipSuccess) fprintf(stderr, "kernel_launch: launch failed: %s\n", hipGetErrorName(le));
#endif
}
```

```cpp
#define MK_ONE_LAUNCH 2
#define DBG_PRECISE_TOPK 0
#define DBG_NAIVE_ATTN 0
#define DBG_PRECISE_PEER 0
#define DBG_NAIVE_GEMM 0
#define DBG_ASCALE 1.0f
#define DBG_PSCALE 1.0f
#include <hip/hip_runtime.h>
#include <hip/hip_cooperative_groups.h>
#include <cstdio>
#include <cstdint>
#include <cmath>
namespace cg = cooperative_groups;
namespace pg8 {
#define PG8_LAS __attribute__((address_space(3)))
typedef unsigned short bf16_t;
typedef short bf16x8 __attribute__((ext_vector_type(8)));
typedef float f32x4 __attribute__((ext_vector_type(4)));
typedef unsigned u32x4 __attribute__((ext_vector_type(4)));
constexpr int BM = 256, BK = 64, HALF = 128, HTB = HALF * BK * 2  , STAGE_BYTES = 8 * HTB, NXCD = 8, WGM = 8;

__host__ __device__ __forceinline__ int lds_byte(int r, int c) { const int st = (r >> 4) * 2 + (c >> 5), rr = r & 15, cc = c & 31, ob = rr * 64 + cc * 2; return st * 1024 + (ob ^ (((ob >> 9) & 1) << 5)); }
__host__ __device__ __forceinline__ void stage_rc(int b, int& R, int& C) { const int st = b / 1024, sb = b % 1024, swz = sb ^ (((sb >> 9) & 1) << 5); R = (st >> 1) * 16 + swz / 64; C = (st & 1) * 32 + (swz % 64) / 2; }
__host__ __device__ __forceinline__ int perm32(int rho) { const int n = rho >> 4, i = rho & 15; return 8 * (i >> 2) + 4 * n + (i & 3); }

struct Unit { int pm, pn; };
struct Gemm { const bf16_t* A; const bf16_t* Bt; int M, N, K; };

struct StaticOrder {
    int nM, nN, nwg, G, c;
    __host__ __device__ void init(int M, int N, int G_, int c_) { nM = M / BM; nN = N / BM; nwg = nM * nN; G = G_; c = c_; }
    __host__ __device__ bool next(int i, Unit& u) const {
        const long L = (long)i * G + c; if (L >= nwg) return false;
        int wgid = (int)L; { const int q = nwg / NXCD, r = nwg % NXCD, xcd = wgid % NXCD, off = wgid / NXCD; wgid = (xcd < r ? xcd * (q + 1) : r * (q + 1) + (xcd - r) * q) + off; }
        const int nig = WGM * nN, gid = wgid / nig, fm = gid * WGM, gsz = (nM - fm) < WGM ? (nM - fm) : WGM;
        u.pm = fm + ((wgid % nig) % gsz); u.pn = (wgid % nig) / gsz; return true;
    }
    __device__ __forceinline__ void a_ready(const Unit&) const {}
    __device__ __forceinline__ void done(const Unit&) const {}
};

__device__ __forceinline__ unsigned cvt_pk_bf16(float lo, float hi) { unsigned r; asm volatile("v_cvt_pk_bf16_f32 %0, %1, %2" : "=v"(r) : "v"(lo), "v"(hi)); return r; }
typedef float f32x2 __attribute__((ext_vector_type(2)));
typedef unsigned u32x2 __attribute__((ext_vector_type(2)));
#ifndef DBG_ASCALE
#define DBG_ASCALE 1.0f
#endif
#ifndef DBG_PSCALE
#define DBG_PSCALE 1.0f
#endif
struct EpiStore {
    static constexpr bool PERM = true, AFTER_DRAIN = false;
    int mode; bf16_t* O; int ldc; int ncols; bf16_t* VM;
    __device__ __forceinline__ void operator()(const f32x4 (&acc)[2][2][4][2], const Unit& u, int wr, int wc, int fr, int fq) const {
        const int row0 = u.pm * BM + wr * 64 + fr;
        bf16_t* base; int rstride, hstride; bool on0, on1;
        if (mode == 0) { const int col0 = u.pn * BM + wc * 32 + 8 * fq; base = O + (size_t)row0 * ldc + col0; rstride = ldc; hstride = HALF; on0 = col0 < ncols; on1 = col0 + HALF < ncols; }
        else {
            const int j = wc * 32 + 8 * fq; const bool isk = wc < 2;
            base = isk ? (O + (size_t)row0 * 768 + (2 * u.pn) * 96 + j) : (VM + (size_t)row0 * 512 + (2 * u.pn) * 64 + (j - 64));
            rstride = isk ? 768 : 512; hstride = isk ? 96 : 64; on0 = true; on1 = true; }
#pragma unroll
        for (int ai = 0; ai < 2; ++ai)
#pragma unroll
            for (int m = 0; m < 4; ++m) { bf16_t* rowp = base + (size_t)(ai * HALF + m * 16) * rstride;
#pragma unroll
                for (int bj = 0; bj < 2; ++bj) {
                    if (bj == 0 ? on0 : on1) { const f32x4 v0 = acc[ai][bj][m][0], v1 = acc[ai][bj][m][1]; u32x4 w;
                        w.x = cvt_pk_bf16(v0[0], v0[1]); w.y = cvt_pk_bf16(v0[2], v0[3]); w.z = cvt_pk_bf16(v1[0], v1[1]); w.w = cvt_pk_bf16(v1[2], v1[3]);
                        *(u32x4*)(rowp + bj * hstride) = w; } } }
    }
};
struct EpiResid {
    static constexpr bool PERM = false, AFTER_DRAIN = false;
    const float* hin_lat; const float* hin_ctx; float* hout_lat; float* hout_ctx; const float* gate; int nlat;
    __device__ __forceinline__ void operator()(const f32x4 (&acc)[2][2][4][2], const Unit& u, int wr, int wc, int fr, int fq) const {
        const int rowt = u.pm * BM; const bool lat = rowt < nlat; const int sample = lat ? (rowt >> 12) : 8;
        const float* src = lat ? hin_lat + (size_t)rowt * 1024 : hin_ctx + (size_t)(rowt - nlat) * 1024;
        float* dst = lat ? hout_lat + (size_t)rowt * 1024 : hout_ctx + (size_t)(rowt - nlat) * 1024;
        const float* g = gate + (size_t)sample * 6144;
        const int col0 = u.pn * BM + wc * 32 + 4 * fq;
#pragma unroll
        for (int bj = 0; bj < 2; ++bj)
#pragma unroll
            for (int n = 0; n < 2; ++n) { const int c = col0 + bj * HALF + n * 16; const f32x4 gv = *(const f32x4*)(g + c);
#pragma unroll
                for (int ai = 0; ai < 2; ++ai)
#pragma unroll
                    for (int m = 0; m < 4; ++m) { const size_t off = (size_t)(ai * HALF + wr * 64 + m * 16 + fr) * 1024 + c;
                        const f32x4 hv = *(const f32x4*)(src + off); *(f32x4*)(dst + off) = hv + gv * acc[ai][bj][m][n] * (float)(DBG_ASCALE); } }
    }
};
template <class Epi, class Sched, bool ALIGN_EPI = false, bool SP2 = false>
__device__ __forceinline__ void gemm_phase(PG8_LAS unsigned char* lds, const Gemm g, const Sched& S, const Epi& E, const int tid_in) {
    const int tid = tid_in, wid = __builtin_amdgcn_readfirstlane(tid >> 6), lane = tid & 63, wr = wid >> 2, wc = wid & 3, fr = lane & 15, fq = lane >> 4;
    const int K = g.K, nt = K / BK;
    unsigned voffA[2], voffB[2];
#pragma unroll
    for (int i = 0; i < 2; ++i) { int R, C; stage_rc(tid * 16 + i * 8192, R, C); const int Rb = Epi::PERM ? ((R & ~31) + perm32(R & 31)) : R;
        voffA[i] = (unsigned)(R * K + C) * 2u; voffB[i] = (unsigned)(Rb * K + C) * 2u; }
    const size_t kstep = (size_t)(BK * 2);
    const size_t hstep = (size_t)HALF * K * 2;
    const size_t tstep = 2 * hstep;
    const unsigned ldsw = (unsigned)wid * 1024u;
    const int aoff = lds_byte(wr * 64 + fr, fq * 8), boff = lds_byte(wc * 32 + fr, fq * 8);
#define PG8_SA(b, h) (((b) * 2 + (h)) * HTB)
#define PG8_SB(b, h) ((4 + (b) * 2 + (h)) * HTB)
#define PG8_STAGE(bufoff, gbase, voff) do { _Pragma("unroll") for (int _i = 0; _i < 2; ++_i) \
        __builtin_amdgcn_global_load_lds((const unsigned*)((const char*)(gbase) + (voff)[_i]), (PG8_LAS unsigned*)(lds + (bufoff) + ldsw + _i * 8192), 16, 0, 0); } while (0)
#define PG8_LDA(dst, b, h) do { _Pragma("unroll") for (int m = 0; m < 4; ++m) _Pragma("unroll") for (int k = 0; k < 2; ++k) dst[m][k] = *(const PG8_LAS bf16x8*)(lds + PG8_SA(b, h) + aoff + m * 2048 + k * 1024); } while (0)
#define PG8_LDB(dst, b, h) do { _Pragma("unroll") for (int n = 0; n < 2; ++n) _Pragma("unroll") for (int k = 0; k < 2; ++k) dst[n][k] = *(const PG8_LAS bf16x8*)(lds + PG8_SB(b, h) + boff + n * 2048 + k * 1024); } while (0)
#define PG8_MMA(ai, bj, At, Bt) do { __builtin_amdgcn_s_setprio(1); _Pragma("unroll") for (int m = 0; m < 4; ++m) _Pragma("unroll") for (int n = 0; n < 2; ++n) _Pragma("unroll") for (int k = 0; k < 2; ++k) \
        acc[ai][bj][m][n] = __builtin_amdgcn_mfma_f32_16x16x32_bf16(Bt[n][k], At[m][k], acc[ai][bj][m][n], 0, 0, 0); __builtin_amdgcn_s_setprio(0); } while (0)
#define PG8_WAIT_V(n) asm volatile("s_waitcnt vmcnt(" #n ")" ::: "memory")
#define PG8_WAIT_L(n) asm volatile("s_waitcnt lgkmcnt(" #n ")" ::: "memory")
#define PG8_BAR __builtin_amdgcn_s_barrier()
#define PG8_SCHED __builtin_amdgcn_sched_barrier(0)
    Unit cur, nxt; int ui = 0;
    if (!S.next(0, cur)) return;
    f32x4 acc[2][2][4][2];
#pragma unroll
    for (int a = 0; a < 2; ++a)
#pragma unroll
        for (int b = 0; b < 2; ++b)
#pragma unroll
            for (int m = 0; m < 4; ++m)
#pragma unroll
                for (int n = 0; n < 2; ++n) acc[a][b][m][n] = (f32x4){0.f, 0.f, 0.f, 0.f};
    bf16x8 At[4][2], B0[2][2], B1[2][2];
    const char* cA = (const char*)g.A + (size_t)cur.pm * tstep; const char* cB = (const char*)g.Bt + (size_t)cur.pn * tstep;
    S.a_ready(cur);
    if constexpr (SP2) {
        PG8_STAGE(PG8_SB(0, 0), cB, voffB); PG8_STAGE(PG8_SB(0, 1), cB + hstep, voffB); PG8_STAGE(PG8_SA(0, 0), cA, voffA); PG8_STAGE(PG8_SA(0, 1), cA + hstep, voffA);
        if (wr == 1) PG8_BAR;
        PG8_WAIT_V(2); PG8_BAR;
        PG8_STAGE(PG8_SB(1, 0), cB + kstep, voffB); PG8_STAGE(PG8_SA(1, 0), cA + kstep, voffA); PG8_STAGE(PG8_SB(1, 1), cB + hstep + kstep, voffB);
        PG8_WAIT_V(6); PG8_BAR;
    } else {
        PG8_STAGE(PG8_SB(0, 0), cB, voffB); PG8_STAGE(PG8_SA(0, 0), cA, voffA); PG8_STAGE(PG8_SB(0, 1), cB + hstep, voffB); PG8_STAGE(PG8_SA(0, 1), cA + hstep, voffA);
        if (wr == 1) PG8_BAR;
        PG8_WAIT_V(4); PG8_BAR;
        PG8_STAGE(PG8_SB(1, 0), cB + kstep, voffB); PG8_STAGE(PG8_SA(1, 0), cA + kstep, voffA); PG8_STAGE(PG8_SB(1, 1), cB + hstep + kstep, voffB);
        PG8_WAIT_V(6); PG8_BAR;
    }
    for (;;) {
        const bool has_next = S.next(ui + 1, nxt);
        const char* nA = has_next ? (const char*)g.A + (size_t)nxt.pm * tstep : cA; const char* nB = has_next ? (const char*)g.Bt + (size_t)nxt.pn * tstep : cB;
        _Pragma("unroll 1") for (int t = 0; t < nt; t += 2) {
            const bool last = (t == nt - 2);
            const char* a1 = cA + (size_t)(t + 1) * kstep;
            const char* a2 = last ? nA : cA + (size_t)(t + 2) * kstep; const char* b2 = last ? nB : cB + (size_t)(t + 2) * kstep;
            const char* a3 = a2 + kstep; const char* b3 = b2 + kstep;
            if (last && has_next) S.a_ready(nxt);
            if constexpr (SP2) {
            PG8_LDB(B0, 0, 0); PG8_LDB(B1, 0, 1); PG8_SCHED; PG8_LDA(At, 0, 0); PG8_STAGE(PG8_SA(1, 1), a1 + hstep, voffA);
            PG8_WAIT_V(8); PG8_WAIT_L(0); PG8_BAR; PG8_MMA(0, 0, At, B0); PG8_MMA(0, 1, At, B1); PG8_BAR; PG8_SCHED;
            PG8_LDA(At, 0, 1); PG8_STAGE(PG8_SB(0, 0), b2, voffB); PG8_STAGE(PG8_SB(0, 1), b2 + hstep, voffB); PG8_STAGE(PG8_SA(0, 0), a2, voffA);
            PG8_WAIT_V(8); PG8_WAIT_L(0); PG8_BAR; PG8_MMA(1, 0, At, B0); PG8_MMA(1, 1, At, B1); PG8_BAR; PG8_SCHED;
            PG8_LDB(B0, 1, 0); PG8_LDB(B1, 1, 1); PG8_SCHED; PG8_LDA(At, 1, 0); PG8_STAGE(PG8_SA(0, 1), a2 + hstep, voffA);
            PG8_WAIT_V(8); PG8_WAIT_L(0); PG8_BAR; PG8_MMA(0, 0, At, B0); PG8_MMA(0, 1, At, B1); PG8_BAR; PG8_SCHED;
            PG8_LDA(At, 1, 1); PG8_STAGE(PG8_SB(1, 0), b3, voffB); PG8_STAGE(PG8_SB(1, 1), b3 + hstep, voffB); PG8_STAGE(PG8_SA(1, 0), a3, voffA);
            PG8_WAIT_V(8); PG8_WAIT_L(0); PG8_BAR; PG8_MMA(1, 0, At, B0); PG8_MMA(1, 1, At, B1); PG8_BAR; PG8_SCHED;
            } else {
            PG8_LDB(B0, 0, 0); PG8_SCHED; PG8_LDA(At, 0, 0); PG8_STAGE(PG8_SA(1, 1), a1 + hstep, voffA);
            PG8_WAIT_L(8); PG8_BAR; PG8_WAIT_L(0); PG8_MMA(0, 0, At, B0); PG8_BAR; PG8_SCHED;
            PG8_LDB(B1, 0, 1); PG8_STAGE(PG8_SB(0, 0), b2, voffB);
            PG8_BAR; PG8_WAIT_L(0); PG8_MMA(0, 1, At, B1); PG8_BAR;
            PG8_LDA(At, 0, 1); PG8_STAGE(PG8_SA(0, 0), a2, voffA);
            PG8_BAR; PG8_WAIT_L(0); PG8_MMA(1, 0, At, B0); PG8_BAR; PG8_SCHED;
            PG8_STAGE(PG8_SB(0, 1), b2 + hstep, voffB);
            PG8_WAIT_V(6); PG8_BAR; PG8_MMA(1, 1, At, B1); PG8_BAR;
            PG8_LDB(B0, 1, 0); PG8_SCHED; PG8_LDA(At, 1, 0); PG8_STAGE(PG8_SA(0, 1), a2 + hstep, voffA);
            PG8_WAIT_L(8); PG8_BAR; PG8_WAIT_L(0); PG8_MMA(0, 0, At, B0); PG8_BAR; PG8_SCHED;
            PG8_LDB(B1, 1, 1); PG8_STAGE(PG8_SB(1, 0), b3, voffB);
            PG8_BAR; PG8_WAIT_L(0); PG8_MMA(0, 1, At, B1); PG8_BAR;
            PG8_LDA(At, 1, 1); PG8_STAGE(PG8_SA(1, 0), a3, voffA);
            PG8_BAR; PG8_WAIT_L(0); PG8_MMA(1, 0, At, B0); PG8_BAR; PG8_SCHED;
            PG8_STAGE(PG8_SB(1, 1), b3 + hstep, voffB);
            PG8_WAIT_V(6); PG8_BAR; PG8_MMA(1, 1, At, B1); PG8_BAR;
            }
        }
        if constexpr (ALIGN_EPI) { if (wr == 0) PG8_BAR; }
        if constexpr (!Epi::AFTER_DRAIN) { E(acc, cur, wr, wc, fr, fq); S.done(cur); }
        if (!has_next) break;
#pragma unroll
        for (int a = 0; a < 2; ++a)
#pragma unroll
            for (int b = 0; b < 2; ++b)
#pragma unroll
                for (int m = 0; m < 4; ++m)
#pragma unroll
                    for (int n = 0; n < 2; ++n) acc[a][b][m][n] = (f32x4){0.f, 0.f, 0.f, 0.f};
        cur = nxt; cA = nA; cB = nB; ++ui;
        if constexpr (ALIGN_EPI) { if (wr == 1) PG8_BAR; }
    }
    PG8_WAIT_V(0);
    if constexpr (!ALIGN_EPI) { if (wr == 0) PG8_BAR; }
    PG8_BAR;
    if constexpr (Epi::AFTER_DRAIN) { E.fused(acc, cur, wr, wc, fr, fq, lds, wid, lane); S.done(cur); }
#undef PG8_SA
#undef PG8_SB
#undef PG8_STAGE
#undef PG8_LDA
#undef PG8_LDB
#undef PG8_MMA
#undef PG8_WAIT_V
#undef PG8_WAIT_L
#undef PG8_BAR
#undef PG8_SCHED
}
}
constexpr int DM = 1024, NB = 8, SEQ = 4096, CTXL = 256, DEPTH = 2;
constexpr int NLAT = NB * SEQ, NCTX = NB * CTXL, NROWS = NLAT + NCTX;
constexpr int DIN = 1440, DINP = 1536, QRANK = 384, KVRANK = 256;
constexpr int PH = 8, PNK = 128, PDH = 128, PTOPK = 16, PEXP = PNK * PNK;
constexpr float EPS = 1e-6f;
constexpr float LOG2E = 1.4426950408889634f;
constexpr float C_MLA = 0.10206207261596577f * LOG2E;
constexpr float C_SWA = 0.125f * LOG2E;

typedef unsigned short bf16;
typedef short bf16x8 __attribute__((ext_vector_type(8)));
typedef short s16x4 __attribute__((ext_vector_type(4)));
typedef float f32x4 __attribute__((ext_vector_type(4)));
typedef float f32x16 __attribute__((ext_vector_type(16)));
typedef unsigned u32x4 __attribute__((ext_vector_type(4)));
typedef unsigned u32x2v __attribute__((ext_vector_type(2)));
#define LAS __attribute__((address_space(3)))

constexpr size_t MiB = 1u << 20;
constexpr size_t WS_CTL = 0, CTL_ZERO_BYTES = 64 * 1024;
constexpr size_t WS_MOD = 1 * MiB;
constexpr size_t WS_RTS = WS_MOD + 512 * 1024;
constexpr size_t WS_RTM = WS_RTS + 64 * 16 * 2 * 4;
constexpr size_t WS_WIN = 2 * MiB;
constexpr size_t WS_WUQ = WS_WIN + 2ull * DINP * DM * 2;
constexpr size_t WS_WUKV = WS_WUQ + 2ull * 768 * QRANK * 2;
constexpr size_t WS_WOUT = WS_WUKV + 2ull * 1024 * KVRANK * 2;
constexpr size_t WS_PWQ = WS_WOUT + 2ull * 1024 * 1024 * 2;
constexpr size_t WS_PKEY = WS_PWQ + 2ull * 2048 * 1024 * 2;
constexpr size_t WS_HCTX = WS_PKEY + 2ull * 8 * 2 * 128 * 128 * 2;
constexpr size_t WS_U = 32 * MiB;
constexpr size_t WS_V = WS_U + 64 * MiB;
constexpr size_t WS_AB = WS_V + 64 * MiB;
constexpr size_t WS_P = WS_AB + (size_t)NROWS * 1024 * 2;
constexpr size_t WS_X5 = WS_P + (size_t)NROWS * DIN * 2;
constexpr size_t WS_QM = WS_X5, WS_KM = WS_QM + (size_t)NROWS * 768 * 2, WS_VM = WS_KM + (size_t)NROWS * 768 * 2, WS_QS = WS_VM + (size_t)NROWS * 512 * 2,
                 WS_KS = WS_QS + (size_t)NROWS * 512 * 2, WS_END = WS_KS + (size_t)NROWS * 128 * 2;
static_assert(WS_HCTX + (size_t)NCTX * 1024 * 4 <= WS_U, "ws map (weights)");
static_assert(WS_END <= 512 * MiB, "ws map");
static_assert((size_t)NROWS * 2048 * 2 <= WS_END - WS_X5, "QP overlay");
static_assert((size_t)NROWS * 1024 <= (size_t)NROWS * DIN * 2, "TK overlay");

constexpr int LDS_BYTES = 135168;

__constant__ float ROPE_INV[24] = {1.0f, 0.5623413324356079f, 0.3162277638912201f, 0.17782793939113617f, 0.10000000149011612f, 0.05623413249850273f, 0.03162277489900589f, 0.017782794311642647f, 0.009999999776482582f, 0.005623413249850273f, 0.003162277629598975f, 0.0017782794311642647f, 0.0010000000474974513f, 0.000562341301701963f, 0.0003162277571391314f, 0.00017782794020604342f, 1.0f, 0.3162277638912201f, 0.10000000149011612f, 0.03162277489900589f, 0.009999999776482582f, 0.003162277629598975f, 0.0010000000474974513f, 0.0003162277571391314f};
struct Args {
    const float* in[23]; float* out; unsigned char* ws; int ph_lo, ph_hi; unsigned char prog[48];
};
typedef const __attribute__((address_space(4))) Args* ArgsP;

struct Frame {
    int tid, lane, wave, G, bid, vcu, gw, ngw, zv;
};

__device__ __forceinline__ float bf_lo(unsigned w) { return __uint_as_float(w << 16); }
__device__ __forceinline__ float bf_hi(unsigned w) { return __uint_as_float(w & 0xffff0000u); }
__device__ __forceinline__ unsigned pk2(float lo, float hi) { return pg8::cvt_pk_bf16(lo, hi); }
__device__ __forceinline__ float wave_sum(float v) {
#pragma unroll
    for (int o = 1; o < 64; o <<= 1) v += __shfl_xor(v, o);
    return v;
}
__device__ __forceinline__ void unpack8(const u32x4 w, float (&x)[8]) {
    x[0] = bf_lo(w.x); x[1] = bf_hi(w.x); x[2] = bf_lo(w.y); x[3] = bf_hi(w.y); x[4] = bf_lo(w.z); x[5] = bf_hi(w.z); x[6] = bf_lo(w.w); x[7] = bf_hi(w.w);
}
__device__ __forceinline__ u32x4 pack8(const float (&x)[8]) {
    u32x4 w; w.x = pk2(x[0], x[1]); w.y = pk2(x[2], x[3]); w.z = pk2(x[4], x[5]); w.w = pk2(x[6], x[7]); return w;
}

__device__ __forceinline__ void p0_transpose_item(const float* W, int K, int N, bf16* WT, LAS float* scr, int item, int lane) {
    const int nblk = N / 32, kb = item / nblk, nb = item % nblk, k0 = 64 * kb, n0 = 32 * nb;
#pragma unroll 8
    for (int i = 0; i < 32; ++i) { const int kk = 2 * i + (lane >> 5); scr[kk * 33 + (lane & 31)] = W[(size_t)(k0 + kk) * N + n0 + (lane & 31)]; }
    asm volatile("s_waitcnt lgkmcnt(0)" ::: "memory");
    const int c = lane & 7;
#pragma unroll
    for (int j = 0; j < 4; ++j) { const int n = (lane >> 3) + 8 * j; const LAS float* s = scr + (8 * c) * 33 + n;
        u32x4 o; o.x = pk2(s[0 * 33], s[1 * 33]); o.y = pk2(s[2 * 33], s[3 * 33]); o.z = pk2(s[4 * 33], s[5 * 33]); o.w = pk2(s[6 * 33], s[7 * 33]);
        *(u32x4*)(WT + (size_t)(n0 + n) * K + k0 + 8 * c) = o; }
    asm volatile("s_waitcnt lgkmcnt(0)" ::: "memory");
}

__device__ __forceinline__ void p0_prologue(const Frame& F, ArgsP Ap, LAS unsigned char* lds) {
    unsigned char* ws = Ap->ws;
    const float* c_in = Ap->in[1]; const float* cctx_in = Ap->in[3]; const float* ada_w = Ap->in[4]; const float* ada_b = Ap->in[5];
    for (int task = F.bid; task < 48; task += F.G) {
        const int l = task / 24, cc = task % 24;
        LAS float* sl = (LAS float*)lds;
        LAS float* red = (LAS float*)(lds + 9 * 1024 * 4);
        __syncthreads();
        for (int i = F.tid; i < 9 * 1024; i += 512) { const int s = i >> 10, k = i & 1023; const float x = (s < 8) ? c_in[s * 1024 + k] : cctx_in[k]; sl[i] = x / (1.f + __expf(-x)); }
        __syncthreads();
        const int c0 = cc * 256 + F.lane * 4; const int kbase = F.wave * 128;
        f32x4 acc[9];
#pragma unroll
        for (int s = 0; s < 9; ++s) acc[s] = (f32x4){0.f, 0.f, 0.f, 0.f};
        const float* wp = ada_w + ((size_t)l * 1024 + kbase) * 6144 + c0;
#pragma unroll 4
        for (int kk = 0; kk < 128; ++kk) { const f32x4 w = *(const f32x4*)(wp + (size_t)kk * 6144);
#pragma unroll
            for (int s = 0; s < 9; ++s) acc[s] += w * sl[s * 1024 + kbase + kk]; }
#pragma unroll
        for (int s = 0; s < 9; ++s) *(LAS f32x4*)(red + (F.wave * 9 + s) * 256 + F.lane * 4) = acc[s];
        __syncthreads();
        float* MOD = (float*)(ws + WS_MOD);
        for (int i = F.tid; i < 9 * 256; i += 512) { const int s = i >> 8, ci = i & 255; float v = ada_b[l * 6144 + cc * 256 + ci];
#pragma unroll
            for (int w = 0; w < 8; ++w) v += red[(w * 9 + s) * 256 + ci];
            MOD[((size_t)l * 9 + s) * 6144 + cc * 256 + ci] = v; }
        __syncthreads();
    }
    __syncthreads();
    if (F.bid == F.G - 1) {
        float* rts = (float*)(ws + WS_RTS); float* rtm = (float*)(ws + WS_RTM);
        for (int i = F.tid; i < 64 * 24; i += 512) {
            const int pos = i / 24, k = i % 24; const float a = (float)pos * ROPE_INV[k];
            const float rev = a * 0.15915494309189535f;
            const float cs = __builtin_amdgcn_cosf(rev), sn = __builtin_amdgcn_sinf(rev);
            if (k < 16) { rts[(pos * 16 + k) * 2] = cs; rts[(pos * 16 + k) * 2 + 1] = sn; } else { rtm[(pos * 8 + (k - 16)) * 2] = cs; rtm[(pos * 8 + (k - 16)) * 2 + 1] = sn; }
        }
    }
    LAS float* scr = (LAS float*)(lds + F.wave * 16384);
    constexpr int I_WIN = (DM / 64) * (DIN / 32), I_WUQ = (QRANK / 64) * (768 / 32), I_WUKV = (KVRANK / 64) * (1024 / 32), I_WOUT = (DM / 64) * (DM / 32), I_PWQ = (DM / 64) * (2048 / 32);
    constexpr int I_L = I_WIN + I_WUQ + I_WUKV + I_WOUT + I_PWQ;
    for (int it = F.gw; it < 2 * I_L; it += F.ngw) {
        const int l = it / I_L; int r = it % I_L;
        if (r < I_WIN) { p0_transpose_item(Ap->in[8] + (size_t)l * DM * DIN, DM, DIN, (bf16*)(ws + WS_WIN) + (size_t)l * DINP * DM, scr, r, F.lane); continue; } r -= I_WIN;
        if (r < I_WUQ) { p0_transpose_item(Ap->in[10] + (size_t)l * QRANK * 768, QRANK, 768, (bf16*)(ws + WS_WUQ) + (size_t)l * 768 * QRANK, scr, r, F.lane); continue; } r -= I_WUQ;
        if (r < I_WUKV) { p0_transpose_item(Ap->in[12] + (size_t)l * KVRANK * 1024, KVRANK, 1024, (bf16*)(ws + WS_WUKV) + (size_t)l * 1024 * KVRANK, scr, r, F.lane); continue; } r -= I_WUKV;
        if (r < I_WOUT) { p0_transpose_item(Ap->in[18] + (size_t)l * DM * DM, DM, DM, (bf16*)(ws + WS_WOUT) + (size_t)l * DM * DM, scr, r, F.lane); continue; } r -= I_WOUT;
        p0_transpose_item(Ap->in[19] + (size_t)l * DM * 2048, DM, 2048, (bf16*)(ws + WS_PWQ) + (size_t)l * 2048 * DM, scr, r, F.lane);
    }
    { const size_t gt = (size_t)F.bid * 512 + F.tid, nt = (size_t)F.G * 512;
      for (size_t i = gt; i < 2ull * 96 * DM / 8; i += nt) { const size_t l = i / (96 * DM / 8), e = i % (96 * DM / 8);
          *(u32x4*)((bf16*)(ws + WS_WIN) + l * DINP * DM + (size_t)DIN * DM + e * 8) = (u32x4){(unsigned)F.zv, (unsigned)F.zv, (unsigned)F.zv, (unsigned)F.zv}; }
      const size_t NKEY8 = 2ull * 8 * 2 * 128 * 128 / 8, NU8 = 2ull * PEXP * DM / 8;
      for (size_t i = gt; i < NKEY8 + 2 * NU8; i += nt) {
          const float* src; bf16* dst; size_t j;
          if (i < NKEY8) { src = Ap->in[20]; dst = (bf16*)(ws + WS_PKEY); j = i; }
          else if (i < NKEY8 + NU8) { src = Ap->in[21]; dst = (bf16*)(ws + WS_U); j = i - NKEY8; }
          else { src = Ap->in[22]; dst = (bf16*)(ws + WS_V); j = i - NKEY8 - NU8; }
          const f32x4 a = *(const f32x4*)(src + j * 8), b = *(const f32x4*)(src + j * 8 + 4);
          u32x4 o; o.x = pk2(a[0], a[1]); o.y = pk2(a[2], a[3]); o.z = pk2(b[0], b[1]); o.w = pk2(b[2], b[3]);
          size_t dj = j * 8;
          if (i >= NKEY8 + NU8) { const size_t fl = j * 8, lay = fl / ((size_t)PEXP * DM), rem = fl % ((size_t)PEXP * DM), e = rem >> 10, d = rem & 1023;
              dj = lay * (size_t)PEXP * DM + ((d >> 6) * (size_t)PEXP + e) * 64 + (d & 63); }
          *(u32x4*)(dst + dj) = o; }
    }
}

#ifndef DBG_PRECISE_TOPK
#define DBG_PRECISE_TOPK 0
#endif
__device__ __forceinline__ void norm_mod_phase(const Frame& F, ArgsP Ap, int l, int which, int nrows) {
    unsigned char* ws = Ap->ws;
    const float* MOD = (const float*)(ws + WS_MOD);
    const float* gn = Ap->in[which ? 7 : 6] + l * DM;
    bf16* AB = (bf16*)(ws + WS_AB);
    const bool from_input = (which == 0 && l == 0);
    for (int r = F.gw; r < nrows; r += F.ngw) {
        const bool lat = r < NLAT;
        const float* hr = lat ? ((from_input ? Ap->in[0] : Ap->out) + (size_t)r * DM) : ((from_input ? Ap->in[2] : (const float*)(ws + WS_HCTX)) + (size_t)(r - NLAT) * DM);
        const int s = lat ? (r >> 12) : 8;
        const float* mp = MOD + ((size_t)l * 9 + s) * 6144 + (which ? 3 * DM : 0);
        f32x4 v[4]; float ss = 0.f;
#pragma unroll
        for (int j = 0; j < 4; ++j) { v[j] = *(const f32x4*)(hr + 256 * j + 4 * F.lane); ss += (v[j][0] * v[j][0] + v[j][1] * v[j][1]) + (v[j][2] * v[j][2] + v[j][3] * v[j][3]); }
        ss = wave_sum(ss);
        const float rinv = rsqrtf(ss * (1.f / DM) + EPS);
#pragma unroll
        for (int j = 0; j < 4; ++j) { const int c = 256 * j + 4 * F.lane;
            const f32x4 g = *(const f32x4*)(gn + c), sh = *(const f32x4*)(mp + c), sc = *(const f32x4*)(mp + DM + c);
            const f32x4 y = v[j] * rinv * g; const f32x4 a = y * (sc + 1.f) + sh;
            u32x2v o; o.x = pk2(a[0], a[1]); o.y = pk2(a[2], a[3]);
            *(u32x2v*)(AB + (size_t)r * DM + c) = o;
#if DBG_PRECISE_TOPK
            if (which) *(f32x4*)((float*)(ws + WS_X5) + (size_t)r * DM + c) = a;
#endif
            }
    }
}

__device__ __forceinline__ void e2_phase(const Frame& F, ArgsP Ap, int l, int nrows) {
    unsigned char* ws = Ap->ws;
    const bf16* P = (const bf16*)(ws + WS_P);
    bf16* QAN = (bf16*)(ws + WS_AB); bf16* KVAN = QAN + (size_t)NROWS * QRANK;
    bf16* QS = (bf16*)(ws + WS_QS); bf16* KS = (bf16*)(ws + WS_KS);
    const float* qa_g = Ap->in[9] + l * QRANK; const float* kva_g = Ap->in[11] + l * KVRANK;
    const float* sqn_g = Ap->in[15] + l * 64; const float* skn_g = Ap->in[16] + l * 64;
    const float* rts = (const float*)(ws + WS_RTS);
    const int lane = F.lane;
    for (int r = F.gw; r < nrows; r += F.ngw) {
        const bf16* pr = P + (size_t)r * DIN;
        const bool lat = r < NLAT; const int pos = r & (SEQ - 1), rp = pos >> 6, cp = pos & 63;
        u32x4 wqa = (u32x4){0u, 0u, 0u, 0u}, wkva = (u32x4){0u, 0u, 0u, 0u}, wsk = (u32x4){0u, 0u, 0u, 0u};
        if (lane < 48) wqa = *(const u32x4*)(pr + 8 * lane);
        const u32x4 wsq = *(const u32x4*)(pr + QRANK + 8 * lane);
        if (lane < 32) wkva = *(const u32x4*)(pr + 896 + 8 * lane);
        if (lane < 16) wsk = *(const u32x4*)(pr + 1184 + 8 * lane);
        float x[8];
        { unpack8(wqa, x); float ss = 0.f;
#pragma unroll
          for (int e = 0; e < 8; ++e) ss += x[e] * x[e];
          ss = wave_sum(ss); const float rinv = rsqrtf(ss * (1.f / QRANK) + EPS);
          if (lane < 48) { float y[8];
#pragma unroll
              for (int e = 0; e < 8; ++e) y[e] = x[e] * rinv * qa_g[8 * lane + e];
              *(u32x4*)(QAN + (size_t)r * QRANK + 8 * lane) = pack8(y); } }
        { unpack8(wkva, x); float ss = 0.f;
#pragma unroll
          for (int e = 0; e < 8; ++e) ss += x[e] * x[e];
          ss = wave_sum(ss); const float rinv = rsqrtf(ss * (1.f / KVRANK) + EPS);
          if (lane < 32) { float y[8];
#pragma unroll
              for (int e = 0; e < 8; ++e) y[e] = x[e] * rinv * kva_g[8 * lane + e];
              *(u32x4*)(KVAN + (size_t)r * KVRANK + 8 * lane) = pack8(y); } }
        const int ch = lane & 7;
        const float* tab = rts + (size_t)((ch < 4) ? rp : cp) * 32 + (ch & 1) * 16;
#pragma unroll
        for (int which = 0; which < 2; ++which) {
            unpack8(which ? wsk : wsq, x); float ss = 0.f;
#pragma unroll
            for (int e = 0; e < 8; ++e) ss += x[e] * x[e];
            ss += __shfl_xor(ss, 1); ss += __shfl_xor(ss, 2); ss += __shfl_xor(ss, 4);
            const float rinv = rsqrtf(ss * (1.f / 64.f) + EPS);
            const float* gg = which ? skn_g : sqn_g;
            float y[8], o[8];
#pragma unroll
            for (int e = 0; e < 8; ++e) y[e] = x[e] * rinv * gg[8 * ch + e];
#pragma unroll
            for (int e = 0; e < 8; ++e) { const float py = __shfl_xor(y[e], 2);
                if (lat) { const float cs = tab[2 * e], sn = tab[2 * e + 1]; o[e] = (ch & 2) ? (y[e] * cs + py * sn) : (y[e] * cs - py * sn); } else o[e] = y[e]; }
            if (which == 0) {
#pragma unroll
                for (int e = 0; e < 8; ++e) o[e] *= C_SWA;
                *(u32x4*)(QS + (size_t)r * 512 + 8 * lane) = pack8(o);
            } else if (lane < 16) *(u32x4*)(KS + (size_t)r * 128 + 8 * lane) = pack8(o);
        }
    }
}

__device__ __forceinline__ void e3_phase(const Frame& F, ArgsP Ap, int l, int nrows) {
    unsigned char* ws = Ap->ws;
    const bf16* P = (const bf16*)(ws + WS_P);
    bf16* QM = (bf16*)(ws + WS_QM); bf16* KM = (bf16*)(ws + WS_KM);
    const float* qn_g = Ap->in[13] + l * 96; const float* kn_g = Ap->in[14] + l * 96;
    const float* rtm = (const float*)(ws + WS_RTM);
    const int lane = F.lane, hl = lane / 12, ch = lane % 12, gbase = hl * 12;
    for (int r = F.gw; r < nrows; r += F.ngw) {
        const bool lat = r < NLAT; const int pos = r & (SEQ - 1), rp = pos >> 6, cp = pos & 63;
        const float* tab = rtm + (size_t)((ch < 10) ? rp : cp) * 16;
#pragma unroll
        for (int pass = 0; pass < 2; ++pass) {
            const int head = pass * 5 + hl; const bool valid = (lane < 60) && (head < 8);
#pragma unroll
            for (int which = 0; which < 2; ++which) {
                u32x4 w = (u32x4){0u, 0u, 0u, 0u};
                bf16* dstp = (which ? KM : QM) + (size_t)r * 768 + head * 96 + ch * 8;
                if (valid) { if (which == 1 && ch >= 8) w = *(const u32x4*)(P + (size_t)r * DIN + 1152 + (ch - 8) * 8); else w = *(const u32x4*)dstp; }
                float x[8]; unpack8(w, x); float ss = 0.f;
#pragma unroll
                for (int e = 0; e < 8; ++e) ss += x[e] * x[e];
                float tot = 0.f;
#pragma unroll
                for (int i = 0; i < 12; ++i) tot += __shfl(ss, (gbase + i) & 63);
                const float rinv = rsqrtf(tot * (1.f / 96.f) + EPS);
                const float* gg = which ? kn_g : qn_g;
                float y[8], o[8];
#pragma unroll
                for (int e = 0; e < 8; ++e) y[e] = x[e] * rinv * gg[8 * ch + e];
#pragma unroll
                for (int e = 0; e < 8; ++e) { const float py = __shfl_xor(y[e], 1);
                    if (lat && ch >= 8) { const float cs = tab[2 * e], sn = tab[2 * e + 1]; o[e] = (ch & 1) ? (y[e] * cs + py * sn) : (y[e] * cs - py * sn); } else o[e] = y[e]; }
                if (which == 0) {
#pragma unroll
                    for (int e = 0; e < 8; ++e) o[e] *= C_MLA;
                }
                if (valid) *(u32x4*)dstp = pack8(o);
            }
        }
    }
}
#define XB_TMO      128
#define XB_XCNT(j)  (256  + 64 * (j))
#define XB_XSUB(j)  (1280 + 64 * (j))
#define XB_XGEN(j)  (2304 + 64 * (j))
#define XB_TOP      3328
#define XB_TOPGEN   3392
#define XCD_BAR_WORDS 3456
#define XB_SPIN_CAP (1u << 18)

__device__ __forceinline__ unsigned xb_ld(unsigned* p)              { return __hip_atomic_load(p, __ATOMIC_RELAXED, __HIP_MEMORY_SCOPE_AGENT); }
__device__ __forceinline__ unsigned xb_add(unsigned* p, unsigned v) { return __hip_atomic_fetch_add(p, v, __ATOMIC_RELAXED, __HIP_MEMORY_SCOPE_AGENT); }
__device__ __forceinline__ unsigned xb_xcc_id() { return (unsigned)__builtin_amdgcn_s_getreg((3 << 11) | 20) & 0xFu; }
#define XB_SPIN(cond, bar) do { unsigned _sp = 0; while (cond) { __builtin_amdgcn_s_sleep(1); \
    if ((++_sp & 255u) == 0u) { if (xb_ld(&(bar)[XB_TMO])) break; if (_sp > XB_SPIN_CAP) { atomicAdd(&(bar)[XB_TMO], 1u); break; } } } } while (0)

struct XcdBarrier {
    unsigned* bar; unsigned x;
    volatile LAS unsigned* st;
};

__device__ __forceinline__ XcdBarrier xcd_barrier_post(unsigned* bar, volatile LAS unsigned* st, const bool t0) {
    XcdBarrier b; b.bar = bar; b.x = xb_xcc_id(); b.st = st;
    if (t0) (void)xb_add(&bar[XB_XCNT(b.x)], 1u);
    return b;
}
__device__ __forceinline__ void xcd_barrier_complete(unsigned* bar, unsigned x, unsigned& nloc, unsigned& nx) {
    const unsigned G = gridDim.x * gridDim.y * gridDim.z;
    unsigned sum, cnt, mine, sp = 0u;
    for (;;) {
        sum = 0u; cnt = 0u; mine = 0u;
#pragma unroll
        for (unsigned j = 0; j < 16; ++j) { const unsigned c = xb_ld(&bar[XB_XCNT(j)]); sum += c; cnt += (c > 0u) ? 1u : 0u; mine = (j == x) ? c : mine; }
        if (sum == G) break;
        __builtin_amdgcn_s_sleep(1);
        if ((++sp & 255u) == 0u) { if (xb_ld(&bar[XB_TMO])) break; if (sp > XB_SPIN_CAP) { atomicAdd(&bar[XB_TMO], 1u); break; } }
    }
    nloc = mine > 0u ? mine : 1u; nx = cnt > 0u ? cnt : 1u;
}

__device__ __forceinline__ void xcd_barrier(const XcdBarrier& b, const bool t0) {
    asm volatile("s_waitcnt vmcnt(0)" ::: "memory");
    __syncthreads();
    if (t0) {
        unsigned* bar = b.bar;
        __builtin_amdgcn_s_waitcnt(0);
        unsigned nloc = b.st[0], nx = b.st[1];
        if (nloc == 0u) { xcd_barrier_complete(bar, b.x, nloc, nx); b.st[0] = nloc; b.st[1] = nx; }
        const unsigned old = xb_add(&bar[XB_XSUB(b.x)], 1u);
        const unsigned gen = old / nloc;
        if (old + 1u == (gen + 1u) * nloc) {
            __builtin_amdgcn_fence(__ATOMIC_RELEASE, "agent");
            asm volatile("s_waitcnt vmcnt(0)" ::: "memory");
            const unsigned og = xb_add(&bar[XB_TOP], 1u);
            const unsigned tg = og / nx;
            if (og + 1u == (tg + 1u) * nx) xb_add(&bar[XB_TOPGEN], 1u);
            else XB_SPIN(xb_ld(&bar[XB_TOPGEN]) == tg, bar);
            __builtin_amdgcn_fence(__ATOMIC_ACQUIRE, "agent");
            xb_add(&bar[XB_XGEN(b.x)], 1u);
            asm volatile("s_waitcnt vmcnt(0)" ::: "memory");
        } else {
            XB_SPIN(xb_ld(&bar[XB_XGEN(b.x)]) == gen, bar);
            __builtin_amdgcn_fence(__ATOMIC_ACQUIRE, "agent");
            asm volatile("s_waitcnt vmcnt(0)" ::: "memory");
        }
    }
    __syncthreads();
}
namespace att {
constexpr int SHM_V = 64 * 64 * 2, SHM_K = 64 * 256, LDS_ATT = 2 * SHM_V + 2 * SHM_K + 8 * 64 * 4;
#define KSWZ(row, colB) ((row) * 256 + ((colB) ^ (((row) & 7) << 4)))
#define SBAR() __builtin_amdgcn_sched_barrier(0)
__device__ __forceinline__ int crow(int r, int hi) { return (r & 3) + 8 * (r >> 2) + 4 * hi; }
__device__ __forceinline__ int v_st(int k, int c) { const int kk = (k & ~0xC) | ((k & 4) << 1) | ((k & 8) >> 1); return ((kk >> 3) * 2 + (c >> 5)) * 512 + ((kk & 7) * 32 + (c & 31)) * 2; }
__device__ __forceinline__ int v_rd_base(int lane) { return ((lane & 3) << 3) | (((lane >> 2) & 3) << 6) | (((lane >> 4) & 1) << 5) | (((lane >> 5) & 1) << 8); }
constexpr int v_rd_off(int d0, int ks, int half) { return d0 * 512 + ks * 2048 + half * 1024; }
template <int OFF> __device__ __forceinline__ s16x4 tr_read(int vb) {
    s16x4 r; asm volatile("ds_read_b64_tr_b16 %0, %1 offset:%2" : "=&v"(r) : "v"(vb), "i"(OFF) : "memory"); return r;
}
template <int D0> __device__ __forceinline__ void pv_one(f32x16& od, int vb, bf16x8 pa0, bf16x8 pa1, bf16x8 pa2, bf16x8 pa3) {
    const s16x4 l0 = tr_read<v_rd_off(D0, 0, 0)>(vb), h0 = tr_read<v_rd_off(D0, 0, 1)>(vb), l1 = tr_read<v_rd_off(D0, 1, 0)>(vb), h1 = tr_read<v_rd_off(D0, 1, 1)>(vb);
    const s16x4 l2 = tr_read<v_rd_off(D0, 2, 0)>(vb), h2 = tr_read<v_rd_off(D0, 2, 1)>(vb), l3 = tr_read<v_rd_off(D0, 3, 0)>(vb), h3 = tr_read<v_rd_off(D0, 3, 1)>(vb);
    asm volatile("s_waitcnt lgkmcnt(0)" ::: "memory"); SBAR();
#define PK(L, H) (bf16x8){L[0], L[1], L[2], L[3], H[0], H[1], H[2], H[3]}
    od = __builtin_amdgcn_mfma_f32_32x32x16_bf16(pa0, PK(l0, h0), od, 0, 0, 0);
    od = __builtin_amdgcn_mfma_f32_32x32x16_bf16(pa1, PK(l1, h1), od, 0, 0, 0);
    od = __builtin_amdgcn_mfma_f32_32x32x16_bf16(pa2, PK(l2, h2), od, 0, 0, 0);
    od = __builtin_amdgcn_mfma_f32_32x32x16_bf16(pa3, PK(l3, h3), od, 0, 0, 0);
#undef PK
}
__device__ __forceinline__ void pv2(f32x16* o, int vb, bf16x8 pa0, bf16x8 pa1, bf16x8 pa2, bf16x8 pa3) {
    pv_one<0>(o[0], vb, pa0, pa1, pa2, pa3); pv_one<1>(o[1], vb, pa0, pa1, pa2, pa3);
}
template <int ND0> __device__ __forceinline__ void qkt(f32x16& p0, f32x16& p1, const char* Ks, const bf16x8* qr, int r32, int hi) {
    p0 = f32x16{}; p1 = f32x16{};
#pragma unroll
    for (int d0 = 0; d0 < ND0; ++d0) { const int cb = (d0 * 16 + hi * 8) * 2;
        const bf16x8 b0 = *reinterpret_cast<const bf16x8*>(Ks + KSWZ(r32, cb));
        const bf16x8 b1 = *reinterpret_cast<const bf16x8*>(Ks + KSWZ(32 + r32, cb));
        p0 = __builtin_amdgcn_mfma_f32_32x32x16_bf16(b0, qr[d0], p0, 0, 0, 0);
        p1 = __builtin_amdgcn_mfma_f32_32x32x16_bf16(b1, qr[d0], p1, 0, 0, 0); }
}
__device__ __forceinline__ void wmask(f32x16& p0, f32x16& p1, int kp0, int qp, int hi) {
#pragma unroll
    for (int r = 0; r < 16; ++r) { const int d0 = kp0 + crow(r, hi) - qp; const int d1 = d0 + 32;
        if (d0 > 128 || d0 < -128) p0[r] = -INFINITY; if (d1 > 128 || d1 < -128) p1[r] = -INFINITY; }
}
__device__ __forceinline__ void smpack(f32x16& p0, f32x16& p1, float& l_reg, bf16x8& pa0, bf16x8& pa1, bf16x8& pa2, bf16x8& pa3) {
#pragma unroll
    for (int r = 0; r < 16; ++r) p0[r] = __builtin_amdgcn_exp2f(p0[r]);
#pragma unroll
    for (int r = 0; r < 16; ++r) p1[r] = __builtin_amdgcn_exp2f(p1[r]);
    float ps = 0.f;
#pragma unroll
    for (int r = 0; r < 16; ++r) ps += p0[r];
#pragma unroll
    for (int r = 0; r < 16; ++r) ps += p1[r];
    l_reg += ps;
#define PK4(P, BASE, OUT) do { unsigned a0 = pk2(P[BASE + 0], P[BASE + 1]), a1 = pk2(P[BASE + 2], P[BASE + 3]);   \
    unsigned b0 = pk2(P[BASE + 4], P[BASE + 5]), b1 = pk2(P[BASE + 6], P[BASE + 7]);                              \
    auto r0 = __builtin_amdgcn_permlane32_swap(a0, b0, false, false); auto r1 = __builtin_amdgcn_permlane32_swap(a1, b1, false, false); \
    u32x4 w = {r0[0], r1[0], r0[1], r1[1]}; OUT = *reinterpret_cast<bf16x8*>(&w); } while (0)
    PK4(p0, 0, pa0); PK4(p0, 8, pa1); PK4(p1, 0, pa2); PK4(p1, 8, pa3);
#undef PK4
}

struct Unit {
    const bf16* Q; int ldq;
    const bf16* K; int ldk;
    const bf16* V; int ldv;
    bf16* O;
    int qrow0;
    int ctx_row0;
    int lat_row0;
    int nt;
    int qpos0;
    int kpos0;
    int masked;
    float l_init;
};

template <int DQK, bool MASKED>
__device__ __forceinline__ void attn_unit(const Unit& U, char* lds, const int tid) {
    constexpr int ND0 = DQK / 16, NCH = DQK / 8;
    const int wid = tid >> 6, lane = tid & 63, r32 = lane & 31, hi = lane >> 5;
    char* V_lds = lds; char* K_lds = lds + 2 * SHM_V;
    float* wsf = (float*)(lds + 2 * SHM_V + 2 * SHM_K) + wid * 64;
    float l_reg = (hi == 0) ? U.l_init : 0.f; f32x16 o[2] = {}; bf16x8 qr[ND0];
    const bf16* Qw = U.Q + (size_t)(U.qrow0 + wid * 32 + r32) * U.ldq + hi * 8;
#pragma unroll
    for (int d0 = 0; d0 < ND0; ++d0) qr[d0] = *reinterpret_cast<const bf16x8*>(Qw + d0 * 16);
    const int vk = tid >> 3, vc = (tid & 7) * 8, vst = v_st(vk, vc);
    const int k0r = tid / NCH, k0c = tid % NCH;
    const bool k1on = (NCH == 12) && (tid < 256);
    const int k1i = k1on ? (tid + 512) : tid, k1r = k1i / NCH, k1c = k1i % NCH;
    const int vb0 = (int)(uintptr_t)V_lds + v_rd_base(lane);
    struct Slot { bf16x8 v, k0, k1; } s0;
    auto tile_row = [&](int t) -> int { return (t < 4) ? (U.ctx_row0 + 64 * t) : (U.lat_row0 + 64 * (t - 4)); };
#define SLOAD(S, t) do { const int kr_ = tile_row(t); \
        S.v = *reinterpret_cast<const bf16x8*>(U.V + (size_t)(kr_ + vk) * U.ldv + vc); \
        S.k0 = *reinterpret_cast<const bf16x8*>(U.K + (size_t)(kr_ + k0r) * U.ldk + k0c * 8); \
        if (NCH == 12) S.k1 = *reinterpret_cast<const bf16x8*>(U.K + (size_t)(kr_ + k1r) * U.ldk + k1c * 8); } while (0)
#define SWRITE(b, S) do { *reinterpret_cast<bf16x8*>(V_lds + (b) * SHM_V + vst) = S.v; \
        *reinterpret_cast<bf16x8*>(K_lds + (b) * SHM_K + KSWZ(k0r, k0c * 16)) = S.k0; \
        if (NCH == 12) { if (k1on) *reinterpret_cast<bf16x8*>(K_lds + (b) * SHM_K + KSWZ(k1r, k1c * 16)) = S.k1; } } while (0)
#define MASK(P0, P1, t) do { if (MASKED && (t) >= 4) wmask(P0, P1, U.kpos0 + 64 * ((t) - 4), U.qpos0 + wid * 32 + r32, hi); } while (0)
    f32x16 pA0, pA1, pB0, pB1; bf16x8 pa0, pa1, pa2, pa3; const int NT = U.nt;
    __syncthreads();
    SLOAD(s0, 0); SWRITE(0, s0); __syncthreads();
    qkt<ND0>(pA0, pA1, K_lds, qr, r32, hi); MASK(pA0, pA1, 0);
    SLOAD(s0, 1);
    SWRITE(1, s0); __syncthreads();
    for (int j = 1; j + 1 < NT; j += 2) {
        SBAR(); qkt<ND0>(pB0, pB1, K_lds + SHM_K, qr, r32, hi); MASK(pB0, pB1, j);
        smpack(pA0, pA1, l_reg, pa0, pa1, pa2, pa3); SBAR();
        SLOAD(s0, j + 1); SBAR();
        pv2(o, vb0, pa0, pa1, pa2, pa3);
        __syncthreads(); SWRITE(0, s0); __syncthreads();
        SBAR(); qkt<ND0>(pA0, pA1, K_lds, qr, r32, hi); MASK(pA0, pA1, j + 1);
        smpack(pB0, pB1, l_reg, pa0, pa1, pa2, pa3); SBAR();
        SLOAD(s0, j + 2); SBAR();
        pv2(o, vb0 + SHM_V, pa0, pa1, pa2, pa3);
        __syncthreads(); SWRITE(1, s0); __syncthreads();
    }
    SBAR(); qkt<ND0>(pB0, pB1, K_lds + SHM_K, qr, r32, hi); MASK(pB0, pB1, NT - 1);
    smpack(pA0, pA1, l_reg, pa0, pa1, pa2, pa3); SBAR();
    pv2(o, vb0, pa0, pa1, pa2, pa3);
    smpack(pB0, pB1, l_reg, pa0, pa1, pa2, pa3); SBAR();
    pv2(o, vb0 + SHM_V, pa0, pa1, pa2, pa3);
    { auto rr = __builtin_amdgcn_permlane32_swap(__float_as_uint(l_reg), __float_as_uint(l_reg), false, false);
      l_reg = __uint_as_float(rr[0]) + __uint_as_float(rr[1]); }
    if (hi == 0) wsf[r32] = l_reg;
    asm volatile("s_waitcnt lgkmcnt(0)" ::: "memory");
    float rli[16];
#pragma unroll
    for (int r = 0; r < 16; ++r) rli[r] = 1.f / wsf[crow(r, hi)];
    bf16* Ow = U.O + (size_t)(U.qrow0 + wid * 32) * 1024;
#pragma unroll
    for (int r = 0; r < 16; ++r) { const int orow = crow(r, hi);
#pragma unroll
        for (int d0 = 0; d0 < 2; ++d0) { const unsigned w = pk2(o[d0][r] * rli[r], 0.f); Ow[(size_t)orow * 1024 + d0 * 32 + r32] = (bf16)(w & 0xffffu); } }
#undef SLOAD
#undef SWRITE
#undef MASK
}
#undef KSWZ
}

__device__ __forceinline__ void attn_phase(const Frame& F, ArgsP Ap, int l, char* lds) {
    unsigned char* ws = Ap->ws;
    const bf16* QM = (const bf16*)(ws + WS_QM); const bf16* KM = (const bf16*)(ws + WS_KM); const bf16* VM = (const bf16*)(ws + WS_VM);
    const bf16* QS = (const bf16*)(ws + WS_QS); const bf16* KS = (const bf16*)(ws + WS_KS); const bf16* VS = (const bf16*)(ws + WS_P) + 1312;
    bf16* OB = (bf16*)(ws + WS_AB);
    const float* sink = Ap->in[17] + l * 8;
    const int nunits = (l == 0) ? 1024 + 64 : 1024;
    for (int u = F.vcu; u < nunits; u += F.G) {
        const bool isl = u < 1024;
        const int i = u >> 8, c = u & 31, b = isl ? ((u & 255) >> 5) : ((u - 1024) >> 3), h = isl ? (2 * i + (c >> 4)) : (u & 7), qb = c & 15;
        att::Unit U; U.Q = QM + h * 96; U.ldq = 768; U.K = KM + h * 96; U.ldk = 768; U.V = VM + h * 64; U.ldv = 512; U.O = OB + h * 64;
        U.qrow0 = isl ? (b * SEQ + qb * 256) : (NLAT + b * CTXL); U.ctx_row0 = NLAT + b * CTXL; U.lat_row0 = b * SEQ; U.nt = isl ? (4 + SEQ / 64) : 4; U.qpos0 = 0; U.kpos0 = 0; U.masked = 0; U.l_init = 0.f;
        att::attn_unit<96, false>(U, lds, F.tid);
    }
    for (int u = F.vcu; u < nunits; u += F.G) {
        const bool isl = u < 1024;
        const int i = u >> 8, c = u & 31, b = isl ? ((u & 255) >> 5) : ((u - 1024) >> 3), h = isl ? (2 * i + (c >> 4)) : (u & 7), qb = c & 15, g = h >> 2;
        const int q0 = qb * 256; int k_lo = q0 - 128; if (k_lo < 0) k_lo = 0; int k_hi = q0 + 256 + 128; if (k_hi > SEQ) k_hi = SEQ;
        att::Unit U; U.Q = QS + h * 64; U.ldq = 512; U.K = KS + g * 64; U.ldk = 128; U.V = VS + g * 64; U.ldv = DIN; U.O = OB + 512 + h * 64;
        U.qrow0 = isl ? (b * SEQ + q0) : (NLAT + b * CTXL); U.ctx_row0 = NLAT + b * CTXL; U.lat_row0 = b * SEQ + k_lo; U.nt = isl ? (4 + (k_hi - k_lo) / 64) : 4; U.qpos0 = q0; U.kpos0 = k_lo; U.masked = 1;
        U.l_init = __builtin_amdgcn_exp2f(sink[h] * LOG2E);
        att::attn_unit<64, true>(U, lds, F.tid);
    }
}

#ifndef DBG_NAIVE_ATTN
#define DBG_NAIVE_ATTN 0
#endif
#if DBG_NAIVE_ATTN
__device__ __forceinline__ void attn_naive_phase(const Frame& F, ArgsP Ap, int l) {
    unsigned char* ws = Ap->ws;
    const bf16* QM = (const bf16*)(ws + WS_QM); const bf16* KM = (const bf16*)(ws + WS_KM); const bf16* VM = (const bf16*)(ws + WS_VM);
    const bf16* QS = (const bf16*)(ws + WS_QS); const bf16* KS = (const bf16*)(ws + WS_KS); const bf16* VS = (const bf16*)(ws + WS_P) + 1312;
    bf16* OB = (bf16*)(ws + WS_AB);
    const float* sink = Ap->in[17] + l * 8;
    const int nrg = ((l == 0) ? NROWS : NLAT) / 64;
    for (int u = F.gw; u < nrg * 8; u += F.ngw) {
        const int h = __builtin_amdgcn_readfirstlane(u & 7), rg = __builtin_amdgcn_readfirstlane(u >> 3), row = rg * 64 + F.lane;
        const bool lat = rg * 64 < NLAT; const int b = lat ? (rg * 64) >> 12 : (rg * 64 - NLAT) >> 8;
        {
            float q[96], o[64]; float lsum = 0.f;
#pragma unroll
            for (int d = 0; d < 96; d += 2) { const unsigned w = *(const unsigned*)(QM + (size_t)row * 768 + h * 96 + d); q[d] = bf_lo(w); q[d + 1] = bf_hi(w); }
#pragma unroll
            for (int d = 0; d < 64; ++d) o[d] = 0.f;
            const int nk = lat ? (CTXL + SEQ) : CTXL;
#pragma unroll 1
            for (int j = 0; j < nk; ++j) { const int kr = (j < CTXL) ? (NLAT + b * CTXL + j) : (b * SEQ + j - CTXL);
                const bf16* kp = KM + (size_t)kr * 768 + h * 96; const bf16* vp = VM + (size_t)kr * 512 + h * 64; float s = 0.f;
#pragma unroll
                for (int d = 0; d < 96; d += 2) { const unsigned w = *(const unsigned*)(kp + d); s = fmaf(q[d], bf_lo(w), s); s = fmaf(q[d + 1], bf_hi(w), s); }
                const float p = exp2f(s); lsum += p;
#pragma unroll
                for (int d = 0; d < 64; d += 2) { const unsigned w = *(const unsigned*)(vp + d); o[d] = fmaf(p, bf_lo(w), o[d]); o[d + 1] = fmaf(p, bf_hi(w), o[d + 1]); } }
            const float rl = 1.f / lsum;
#pragma unroll
            for (int d = 0; d < 64; d += 2) *(unsigned*)(OB + (size_t)row * 1024 + h * 64 + d) = pk2(o[d] * rl, o[d + 1] * rl);
        }
        {
            const int g = h >> 2; const int pos0 = (rg * 64) & (SEQ - 1), pos = pos0 + F.lane;
            float q[64], o[64]; float lsum = exp2f(sink[h] * LOG2E);
#pragma unroll
            for (int d = 0; d < 64; d += 2) { const unsigned w = *(const unsigned*)(QS + (size_t)row * 512 + h * 64 + d); q[d] = bf_lo(w); q[d + 1] = bf_hi(w); }
#pragma unroll
            for (int d = 0; d < 64; ++d) o[d] = 0.f;
            int jlo = pos0 - 128; if (jlo < 0) jlo = 0; int jhi = pos0 + 63 + 128; if (jhi > SEQ - 1) jhi = SEQ - 1;
            const int nk = lat ? (CTXL + (jhi - jlo + 1)) : CTXL;
#pragma unroll 1
            for (int j = 0; j < nk; ++j) { const bool isc = j < CTXL; const int kpos = jlo + j - CTXL; const int kr = isc ? (NLAT + b * CTXL + j) : (b * SEQ + kpos);
                const bf16* kp = KS + (size_t)kr * 128 + g * 64; const bf16* vp = VS + (size_t)kr * DIN + g * 64; float s = 0.f;
#pragma unroll
                for (int d = 0; d < 64; d += 2) { const unsigned w = *(const unsigned*)(kp + d); s = fmaf(q[d], bf_lo(w), s); s = fmaf(q[d + 1], bf_hi(w), s); }
                float p = exp2f(s); if (!isc) { const int dd = kpos - pos; if (dd > 128 || dd < -128) p = 0.f; } lsum += p;
#pragma unroll
                for (int d = 0; d < 64; d += 2) { const unsigned w = *(const unsigned*)(vp + d); o[d] = fmaf(p, bf_lo(w), o[d]); o[d + 1] = fmaf(p, bf_hi(w), o[d + 1]); } }
            const float rl = 1.f / lsum;
#pragma unroll
            for (int d = 0; d < 64; d += 2) *(unsigned*)(OB + (size_t)row * 1024 + 512 + h * 64 + d) = pk2(o[d] * rl, o[d + 1] * rl);
        }
    }
}
#endif
__device__ __forceinline__ unsigned f2key(float f) { const unsigned u = __float_as_uint(f); return (u & 0x80000000u) ? ~u : (u | 0x80000000u); }
__device__ __forceinline__ float key2f(unsigned k) { const unsigned u = (k & 0x80000000u) ? (k & 0x7fffffffu) : ~k; return __uint_as_float(u); }
#define CE_DESC(a, b) do { const unsigned _hi = max(a, b), _lo = min(a, b); a = _hi; b = _lo; } while (0)
__device__ __forceinline__ void sort16_desc(unsigned (&a)[16]) {
#pragma unroll
    for (int k = 2; k <= 16; k <<= 1)
#pragma unroll
        for (int j = k >> 1; j > 0; j >>= 1)
#pragma unroll
            for (int i = 0; i < 16; ++i) { const int p = i ^ j;
                if (p > i) { if ((i & k) == 0) { CE_DESC(a[i], a[p]); } else { CE_DESC(a[p], a[i]); } } }
}
__device__ __forceinline__ void merge16_desc(unsigned (&t)[16], const unsigned (&c)[16]) {
#pragma unroll
    for (int i = 0; i < 16; ++i) t[i] = max(t[i], c[15 - i]);
#pragma unroll
    for (int j = 8; j > 0; j >>= 1)
#pragma unroll
        for (int i = 0; i < 16; ++i) { const int p = i ^ j; if (p > i) CE_DESC(t[i], t[p]); }
}
__device__ __forceinline__ void merge16_partner(unsigned (&t)[16]) {
    unsigned oth[16];
#pragma unroll
    for (int i = 0; i < 16; ++i) oth[i] = (unsigned)__shfl_xor((int)t[i], 32);
    merge16_desc(t, oth);
}

constexpr size_t WS_IDX = WS_P;
constexpr size_t WS_GW = WS_P + (size_t)NROWS * 128 * 2;
constexpr size_t WS_W2 = WS_GW + (size_t)NROWS * 128 * 4;
static_assert(WS_W2 + (size_t)NROWS * 128 * 4 <= WS_X5, "peer lists inside the P region");

__device__ __forceinline__ void topkc_phase(const Frame& F, ArgsP Ap, int l, int nrows, char* lds) {
    unsigned char* ws = Ap->ws;
    const bf16* QP = (const bf16*)(ws + WS_X5);
    const bf16* PK = (const bf16*)(ws + WS_PKEY) + (size_t)l * 16 * 128 * 128;
    unsigned short* IDX = (unsigned short*)(ws + WS_IDX); float* GW = (float*)(ws + WS_GW);
    char* Kl = lds;
    unsigned char* sub = (unsigned char*)(lds + 65536) + F.wave * 1024;
    const int lane = F.lane, r32 = lane & 31, hi = lane >> 5;
    const int nunits = (nrows / 256) * 8;
    for (int u = F.bid; u < nunits; u += F.G) {
        const int h = u & 7, rb = u >> 3;
        __syncthreads();
#pragma unroll
        for (int i = 0; i < 8; ++i) { const int ci = F.tid + 512 * i, krow = ci >> 4, ch = ci & 15;
            const u32x4 v = *(const u32x4*)(PK + ((size_t)(2 * h) * 128 + krow) * 128 + ch * 8);
            *(u32x4*)(Kl + krow * 256 + ((ch * 16) ^ ((krow & 7) << 4))) = v; }
        __syncthreads();
        const int row = rb * 256 + F.wave * 32 + r32;
        const unsigned hi4 = (unsigned)hi << 2, hi7 = (unsigned)hi << 7;
        unsigned t0[16], t1[16];
#pragma unroll
        for (int p = 0; p < 2; ++p) {
            const bf16* qrow = QP + (size_t)row * 2048 + (2 * h + p) * 128 + hi * 8;
            bf16x8 bq[8];
#pragma unroll
            for (int s = 0; s < 8; ++s) bq[s] = *reinterpret_cast<const bf16x8*>(qrow + s * 16);
            unsigned top[16];
#pragma unroll
            for (int blk = 0; blk < 4; ++blk) {
                f32x16 acc = f32x16{};
                const char* kb = Kl + (p * 128 + blk * 32 + r32) * 256;
#pragma unroll
                for (int s = 0; s < 8; ++s) { const bf16x8 ka = *reinterpret_cast<const bf16x8*>(kb + (((s * 16 + hi * 8) * 2) ^ ((r32 & 7) << 4)));
                    acc = __builtin_amdgcn_mfma_f32_32x32x16_bf16(ka, bq[s], acc, 0, 0, 0); }
                unsigned c[16];
#pragma unroll
                for (int r = 0; r < 16; ++r) c[r] = ((f2key(acc[r]) & ~127u) | (unsigned)(127 - (blk * 32 + (r & 3) + 8 * (r >> 2)))) ^ hi4;
                sort16_desc(c);
                if (blk == 0) {
#pragma unroll
                    for (int i = 0; i < 16; ++i) top[i] = c[i];
                } else merge16_desc(top, c);
                __builtin_amdgcn_sched_barrier(0);
            }
            merge16_partner(top);
#pragma unroll
            for (int i = 0; i < 16; ++i) { if (p == 0) t0[i] = top[i]; else t1[i] = top[i]; }
        }
        if (hi == 0) { unsigned* sw = (unsigned*)(sub + r32 * 32);
#pragma unroll
            for (int q = 0; q < 4; ++q) {
                sw[q] = (127u - (t0[4 * q] & 127u)) | ((127u - (t0[4 * q + 1] & 127u)) << 8) | ((127u - (t0[4 * q + 2] & 127u)) << 16) | ((127u - (t0[4 * q + 3] & 127u)) << 24);
                sw[4 + q] = (127u - (t1[4 * q] & 127u)) | ((127u - (t1[4 * q + 1] & 127u)) << 8) | ((127u - (t1[4 * q + 2] & 127u)) << 16) | ((127u - (t1[4 * q + 3] & 127u)) << 24); } }
        float f1[16], fa[8];
#pragma unroll
        for (int i = 0; i < 16; ++i) f1[i] = key2f(t1[i] & ~127u);
#pragma unroll
        for (int i = 0; i < 8; ++i) fa[i] = key2f((hi ? t0[8 + i] : t0[i]) & ~127u);
        unsigned top[16];
#pragma unroll
        for (int i = 0; i < 8; ++i) {
            unsigned c[16];
#pragma unroll
            for (int b = 0; b < 16; ++b) c[b] = ((f2key(fa[i] + f1[b]) & ~255u) | (unsigned)(255 - (16 * i + b))) ^ hi7;
            if (i == 0) {
#pragma unroll
                for (int k = 0; k < 16; ++k) top[k] = c[k];
            } else merge16_desc(top, c);
            __builtin_amdgcn_sched_barrier(0);
        }
        merge16_partner(top);
        asm volatile("s_waitcnt lgkmcnt(0)" ::: "memory");
        float cv[16]; float den = 0.f; const float m = key2f(top[0] & ~255u);
#pragma unroll
        for (int i = 0; i < 16; ++i) { cv[i] = __expf(key2f(top[i] & ~255u) - m); den += cv[i]; }
        const float rden = 1.f / den;
        if (hi == 0) {
            unsigned iw[8];
#pragma unroll
            for (int i = 0; i < 16; i += 2) {
                const int fl0 = 255 - (int)(top[i] & 255u), fl1 = 255 - (int)(top[i + 1] & 255u);
                const unsigned e0 = (unsigned)sub[r32 * 32 + (fl0 >> 4)] * PNK + (unsigned)sub[r32 * 32 + 16 + (fl0 & 15)];
                const unsigned e1 = (unsigned)sub[r32 * 32 + (fl1 >> 4)] * PNK + (unsigned)sub[r32 * 32 + 16 + (fl1 & 15)];
                iw[i >> 1] = e0 | (e1 << 16); }
            u32x4* ip = (u32x4*)(IDX + (size_t)row * 128 + h * 16); ip[0] = (u32x4){iw[0], iw[1], iw[2], iw[3]}; ip[1] = (u32x4){iw[4], iw[5], iw[6], iw[7]};
            f32x4* gp = (f32x4*)(GW + (size_t)row * 128 + h * 16);
#pragma unroll
            for (int q = 0; q < 4; ++q) gp[q] = (f32x4){cv[4 * q] * rden, cv[4 * q + 1] * rden, cv[4 * q + 2] * rden, cv[4 * q + 3] * rden};
        }
    }
}

typedef __bf16 bf16x2_t __attribute__((ext_vector_type(2)));
typedef float f32x2v __attribute__((ext_vector_type(2)));
__device__ __forceinline__ float dot2(unsigned w, unsigned x, float acc) { return __builtin_amdgcn_fdot2_f32_bf16(__builtin_bit_cast(bf16x2_t, w), __builtin_bit_cast(bf16x2_t, x), acc, false); }
__device__ __forceinline__ float dot16(const u32x4 a0, const u32x4 a1, const u32x4 x0, const u32x4 x1) {
    float s0 = dot2(a0.x, x0.x, 0.f), s1 = dot2(a0.y, x0.y, 0.f), s2 = dot2(a0.z, x0.z, 0.f), s3 = dot2(a0.w, x0.w, 0.f);
    s0 = dot2(a1.x, x1.x, s0); s1 = dot2(a1.y, x1.y, s1); s2 = dot2(a1.z, x1.z, s2); s3 = dot2(a1.w, x1.w, s3);
    return (s0 + s1) + (s2 + s3);
}
__device__ __forceinline__ void fma8(float (&o)[8], const u32x4 v, float w) {
    o[0] += w * bf_lo(v.x); o[1] += w * bf_hi(v.x); o[2] += w * bf_lo(v.y); o[3] += w * bf_hi(v.y);
    o[4] += w * bf_lo(v.z); o[5] += w * bf_hi(v.z); o[6] += w * bf_lo(v.w); o[7] += w * bf_hi(v.w);
}

__device__ __forceinline__ void pu_phase(const Frame& F, ArgsP Ap, int l, int nrows, char* lds) {
    unsigned char* ws = Ap->ws;
    const unsigned short* IDX = (const unsigned short*)(ws + WS_IDX); const float* GW = (const float*)(ws + WS_GW); float* W2 = (float*)(ws + WS_W2);
    const bf16* Bx = (const bf16*)(ws + WS_AB);
    const bf16* Ut = (const bf16*)(ws + WS_U) + (size_t)l * PEXP * DM;
    const int lane = F.lane;
    int* l_slot = (int*)(lds + F.wave * 2048); int* l_idx = l_slot + 128; float* l_g = (float*)(l_idx + 128);
    const bool xs = (F.G % 8) == 0;
    const int wv = xs ? ((F.bid >> 3) * 8 + F.wave) : F.gw, nwv = xs ? (F.G >> 3) * 8 : F.ngw, npass = xs ? 2 : 16;
    const unsigned long long lt = (1ull << lane) - 1ull;
    for (int pass = 0; pass < npass; ++pass) {
        const int c = xs ? ((F.bid & 7) + 8 * pass) : pass;
        for (int t = wv; t < nrows; t += nwv) {
            const unsigned iw = *(const unsigned*)(IDX + (size_t)t * 128 + 2 * lane); const int i0 = (int)(iw & 0xffffu), i1 = (int)(iw >> 16);
            const f32x2v gg = *(const f32x2v*)(GW + (size_t)t * 128 + 2 * lane);
            const bool m0 = (i0 >> 10) == c, m1 = (i1 >> 10) == c;
            const unsigned long long b0 = __ballot(m0), b1 = __ballot(m1);
            const int n = __popcll(b0) + __popcll(b1);
            if (n == 0) continue;
            const int r0 = __popcll(b0 & lt) + __popcll(b1 & lt);
            if (m0) { l_slot[r0] = 2 * lane; l_idx[r0] = i0; l_g[r0] = gg.x; }
            if (m1) { const int r1 = r0 + (m0 ? 1 : 0); l_slot[r1] = 2 * lane + 1; l_idx[r1] = i1; l_g[r1] = gg.y; }
            const bf16* xr = Bx + (size_t)t * DM;
            const u32x4 x0 = *(const u32x4*)(xr + 8 * lane), x1 = *(const u32x4*)(xr + 512 + 8 * lane);
            asm volatile("s_waitcnt lgkmcnt(0)" ::: "memory");
#pragma unroll 1
            for (int k0 = 0; k0 < n; k0 += 4) {
                float v[4];
                u32x4 ua[4], ub[4];
#pragma unroll
                for (int j = 0; j < 4; ++j) { const int kk = (k0 + j < n) ? (k0 + j) : (n - 1); const int e = __builtin_amdgcn_readfirstlane(l_idx[kk]); const bf16* up = Ut + (size_t)e * DM;
                    ua[j] = *(const u32x4*)(up + 8 * lane); ub[j] = *(const u32x4*)(up + 512 + 8 * lane); }
#pragma unroll
                for (int j = 0; j < 4; ++j) v[j] = dot16(ua[j], ub[j], x0, x1);
                float t2[2], t1;
                { const bool up_ = (lane & 32) != 0;
#pragma unroll
                  for (int j = 0; j < 2; ++j) { const float keep = up_ ? v[j + 2] : v[j], send = up_ ? v[j] : v[j + 2]; t2[j] = keep + __shfl_xor(send, 32); } }
                { const bool up_ = (lane & 16) != 0; const float keep = up_ ? t2[1] : t2[0], send = up_ ? t2[0] : t2[1]; t1 = keep + __shfl_xor(send, 16); }
                t1 += __shfl_xor(t1, 8); t1 += __shfl_xor(t1, 4); t1 += __shfl_xor(t1, 2); t1 += __shfl_xor(t1, 1);
                const int j = lane >> 4;
                if ((lane & 15) == 0 && k0 + j < n) { const float a = t1; const float ge = 0.5f * a * (1.f + erff(a * 0.70710678118654752f)); W2[(size_t)t * 128 + l_slot[k0 + j]] = l_g[k0 + j] * ge; }
            }
        }
    }
}

__device__ __forceinline__ void pv_phase(const Frame& F, ArgsP Ap, int l, int nrows, const bool dry) {
    unsigned char* ws = Ap->ws;
    const unsigned short* IDX = (const unsigned short*)(ws + WS_IDX); const float* GW = (const float*)(ws + WS_W2);
    const bf16* Vt = (const bf16*)(ws + WS_V) + (size_t)l * PEXP * DM;
    const float* MOD = (const float*)(ws + WS_MOD);
    const int lane = F.lane, sub = lane >> 3, dch = lane & 7;
    const bool xs = (F.G % 8) == 0;
    const int wv = xs ? ((F.bid >> 3) * 8 + F.wave) : F.gw, nwv = xs ? (F.G >> 3) * 8 : F.ngw, npass = xs ? 2 : 16;
    for (int pass = 0; pass < npass; ++pass) {
        const int s = xs ? ((F.bid & 7) + 8 * pass) : pass;
        const bf16* vbase = Vt + (size_t)s * PEXP * 64 + dch * 8;
        for (int t = wv; t < nrows; t += nwv) {
            const u32x4 ia = *(const u32x4*)(IDX + (size_t)t * 128 + 16 * sub), ib = *(const u32x4*)(IDX + (size_t)t * 128 + 16 * sub + 8);
            const f32x4* wp = (const f32x4*)(GW + (size_t)t * 128 + 16 * sub);
            const f32x4 w0 = wp[0], w1 = wp[1], w2 = wp[2], w3 = wp[3];
            const unsigned iw[8] = {ia.x, ia.y, ia.z, ia.w, ib.x, ib.y, ib.z, ib.w};
            const float wv_[16] = {w0[0], w0[1], w0[2], w0[3], w1[0], w1[1], w1[2], w1[3], w2[0], w2[1], w2[2], w2[3], w3[0], w3[1], w3[2], w3[3]};
            u32x4 va[16];
#pragma unroll
            for (int it = 0; it < 16; ++it) { const unsigned e = (it & 1) ? (iw[it >> 1] >> 16) : (iw[it >> 1] & 0xffffu); va[it] = *(const u32x4*)(vbase + (size_t)e * 64); }
            float o[8];
#pragma unroll
            for (int i = 0; i < 8; ++i) o[i] = 0.f;
#pragma unroll
            for (int it = 0; it < 16; ++it) fma8(o, va[it], wv_[it]);
#pragma unroll
            for (int i = 0; i < 8; ++i) { o[i] += __shfl_xor(o[i], 8); o[i] += __shfl_xor(o[i], 16); o[i] += __shfl_xor(o[i], 32); }
            if (sub == 0 && !dry) {
                const bool lat = t < NLAT; const int smp = lat ? (t >> 12) : 8;
                float* hr = (lat ? (Ap->out + (size_t)t * DM) : ((float*)(ws + WS_HCTX) + (size_t)(t - NLAT) * DM)) + s * 64 + dch * 8;
                const float* g2 = MOD + ((size_t)l * 9 + smp) * 6144 + 5 * DM + s * 64 + dch * 8;
                const f32x4 ga = *(const f32x4*)g2, gb = *(const f32x4*)(g2 + 4); f32x4 ha = *(const f32x4*)hr, hb = *(const f32x4*)(hr + 4);
                ha += ga * (f32x4){o[0], o[1], o[2], o[3]}; hb += gb * (f32x4){o[4], o[5], o[6], o[7]};
                *(f32x4*)hr = ha; *(f32x4*)(hr + 4) = hb;
            }
        }
    }
}
constexpr int PH_PER_LAYER = 12, N_PHASES = 1 + DEPTH * PH_PER_LAYER;
#ifndef MK_ONE_LAUNCH
#define MK_ONE_LAUNCH 0
#endif
#ifndef MK_MASK
#define MK_MASK 0x1FFF
#endif
#define PON(s) (((MK_MASK) >> (s)) & 1)

#ifndef DBG_NAIVE_GEMM
#define DBG_NAIVE_GEMM 0
#endif
#if DBG_NAIVE_GEMM
__device__ __forceinline__ void naive_gemm(const Frame& F, const pg8::Gemm g, int kind, const pg8::EpiStore es, const pg8::EpiResid er) {
    const int ncg = g.N / 64; const int nunits = g.M * ncg;
    for (int u = F.gw; u < nunits; u += F.ngw) {
        const int row = __builtin_amdgcn_readfirstlane(u / ncg), col = (u % ncg) * 64 + F.lane;
        const bf16* ar = g.A + (size_t)row * g.K; const bf16* br = g.Bt + (size_t)col * g.K; float acc = 0.f;
#pragma unroll 1
        for (int k = 0; k < g.K; k += 8) { const u32x4 a = *(const u32x4*)(ar + k), b = *(const u32x4*)(br + k); float x[8], y[8]; unpack8(a, x); unpack8(b, y);
#pragma unroll
            for (int e = 0; e < 8; ++e) acc = fmaf(x[e], y[e], acc); }
        if (kind == 0) { if (col < es.ncols) es.O[(size_t)row * es.ldc + col] = (bf16)(pk2(acc, 0.f) & 0xffffu); }
        else if (kind == 1) { const int head = col >> 7, j = col & 127; bf16* d = (j < 64) ? (es.O + (size_t)row * 768 + head * 96 + j) : (es.VM + (size_t)row * 512 + head * 64 + (j - 64)); *d = (bf16)(pk2(acc, 0.f) & 0xffffu); }
        else { const bool lat = row < er.nlat; const int sample = lat ? (row >> 12) : 8;
            const float* src = lat ? er.hin_lat + (size_t)row * 1024 : er.hin_ctx + (size_t)(row - er.nlat) * 1024; float* dst = lat ? er.hout_lat + (size_t)row * 1024 : er.hout_ctx + (size_t)(row - er.nlat) * 1024;
            dst[col] = src[col] + er.gate[(size_t)sample * 6144 + col] * acc; }
    }
}
#endif

__global__ void __launch_bounds__(512, 2) mk_fwd(Args args_unused) {
    extern __shared__ __attribute__((aligned(16))) unsigned char lds[];
    LAS unsigned char* lds3 = (LAS unsigned char*)lds;
    ArgsP args0 = (ArgsP)__builtin_amdgcn_kernarg_segment_ptr();
    const int ph_lo = args0->ph_lo, ph_hi = args0->ph_hi;
    const int wave_s = __builtin_amdgcn_readfirstlane((int)threadIdx.x >> 6);
#if MK_ONE_LAUNCH == 2
    {
        volatile LAS unsigned* st = (volatile LAS unsigned*)(lds3 + LDS_BYTES - 64);
        if (threadIdx.x < 2) st[threadIdx.x] = 0u;
        __syncthreads();
        (void)xcd_barrier_post((unsigned*)(args0->ws + WS_CTL), st, threadIdx.x == 0);
    }
#endif
#pragma unroll 1
    for (int pi = ph_lo; pi < ph_hi; ++pi) {
        int zv = 0; asm volatile("" : "+v"(zv));
        ArgsP args = args0; asm volatile("" : "+s"(args));
        Frame F;
        F.zv = zv; F.lane = (int)__builtin_amdgcn_mbcnt_hi(~0u, __builtin_amdgcn_mbcnt_lo(~0u, 0u)) + zv; F.wave = wave_s; F.tid = wave_s * 64 + F.lane;
        { int bx = blockIdx.x, gd = gridDim.x; asm volatile("" : "+s"(bx), "+s"(gd)); F.bid = bx; F.G = gd; F.vcu = (gd % 8 == 0) ? (bx % 8) * (gd / 8) + bx / 8 : bx; }
        F.gw = F.bid * 8 + F.wave; F.ngw = F.G * 8;
        unsigned char* ws = args->ws;
        const int phraw = args->prog[pi], ph = phraw & 63; const bool dry = (phraw & 64) != 0;
        int njobs = 0, jkind = 0;
        pg8::Gemm gj[2]; pg8::EpiStore ej[2];
        int l = 0, mrows = NROWS;
        if (ph == 0) { if (PON(12)) p0_prologue(F, args, lds3); }
        else {
            const int q = ph - 1, s = q % PH_PER_LAYER; l = q / PH_PER_LAYER;
            mrows = (l == DEPTH - 1) ? NLAT : NROWS;
            switch (s) {
            case 0: if (PON(0)) norm_mod_phase(F, args, l, 0, NROWS); break;
            case 1: if (PON(1)) { njobs = 1;
                gj[0] = pg8::Gemm{(const bf16*)(ws + WS_AB), (const bf16*)(ws + WS_WIN) + (size_t)l * DINP * DM, NROWS, DINP, DM};
                ej[0] = pg8::EpiStore{0, (bf16*)(ws + WS_P), DIN, DIN, nullptr}; } break;
            case 2: if (PON(2)) e2_phase(F, args, l, NROWS); break;
            case 3: if (PON(3)) { njobs = 2;
                gj[0] = pg8::Gemm{(const bf16*)(ws + WS_AB), (const bf16*)(ws + WS_WUQ) + (size_t)l * 768 * QRANK, NROWS, 768, QRANK};
                ej[0] = pg8::EpiStore{0, (bf16*)(ws + WS_QM), 768, 768, nullptr};
                gj[1] = pg8::Gemm{(const bf16*)(ws + WS_AB) + (size_t)NROWS * QRANK, (const bf16*)(ws + WS_WUKV) + (size_t)l * 1024 * KVRANK, NROWS, 1024, KVRANK};
                ej[1] = pg8::EpiStore{1, (bf16*)(ws + WS_KM), 768, 1024, (bf16*)(ws + WS_VM)}; } break;
            case 4: if (PON(4)) e3_phase(F, args, l, NROWS); break;
            case 5: if (PON(5)) {
#if DBG_NAIVE_ATTN
                attn_naive_phase(F, args, l);
#else
                attn_phase(F, args, l, (char*)lds);
#endif
                } break;
            case 6: if (PON(6)) { njobs = 1; jkind = 1;
                gj[0] = pg8::Gemm{(const bf16*)(ws + WS_AB), (const bf16*)(ws + WS_WOUT) + (size_t)l * DM * DM, mrows, DM, DM}; } break;
            case 7: if (PON(7)) norm_mod_phase(F, args, l, 1, mrows); break;
            case 8: if (PON(8)) { njobs = 1;
                gj[0] = pg8::Gemm{(const bf16*)(ws + WS_AB), (const bf16*)(ws + WS_PWQ) + (size_t)l * 2048 * DM, mrows, 2048, DM};
                ej[0] = pg8::EpiStore{0, (bf16*)(ws + WS_X5), 2048, 2048, nullptr}; } break;
            case 9: if (PON(9)) topkc_phase(F, args, l, mrows, (char*)lds); break;
            case 10: if (PON(10)) pu_phase(F, args, l, mrows, (char*)lds); break;
            default: if (PON(11)) pv_phase(F, args, l, mrows, dry); break;
            }
        }
        if (njobs > 0) {
#if DBG_NAIVE_GEMM
            { const pg8::EpiResid ER{(l == 0) ? args->in[0] : args->out, args->in[2], args->out, (float*)(ws + WS_HCTX), (const float*)(ws + WS_MOD) + (size_t)l * 9 * 6144 + 2 * DM, NLAT};
              _Pragma("unroll 1") for (int j = 0; j < njobs; ++j) { const pg8::Gemm g = (j == 0) ? gj[0] : gj[1]; const pg8::EpiStore E = (j == 0) ? ej[0] : ej[1]; naive_gemm(F, g, jkind ? 2 : E.mode, E, ER); } }
#else
            if (jkind == 0) {
#pragma unroll 1
                for (int j = 0; j < njobs; ++j) { __syncthreads();
                    const pg8::Gemm g = (j == 0) ? gj[0] : gj[1]; const pg8::EpiStore E = (j == 0) ? ej[0] : ej[1];
                    pg8::StaticOrder S; S.init(g.M, g.N, F.G, F.bid);
                    pg8::gemm_phase<pg8::EpiStore, pg8::StaticOrder, true, true>(lds3, g, S, E, F.tid); }
            } else { __syncthreads();
                const pg8::Gemm g = gj[0];
                pg8::StaticOrder S; S.init(g.M, g.N, F.G, F.bid);
                pg8::EpiResid E{(l == 0) ? args->in[0] : args->out, args->in[2], args->out, (float*)(ws + WS_HCTX), (const float*)(ws + WS_MOD) + (size_t)l * 9 * 6144 + 2 * DM, NLAT};
                pg8::gemm_phase<pg8::EpiResid, pg8::StaticOrder, true, true>(lds3, g, S, E, F.tid); }
#endif
        }
#if MK_ONE_LAUNCH == 1
        if (pi + 1 < ph_hi) cg::this_grid().sync();
#elif MK_ONE_LAUNCH == 2
        if (pi + 1 < ph_hi) { XcdBarrier xb; xb.bar = (unsigned*)(ws + WS_CTL); xb.x = xb_xcc_id(); xb.st = (volatile LAS unsigned*)(lds3 + LDS_BYTES - 64); xcd_barrier(xb, F.tid == 0); }
#endif
    }
}

extern "C" void kernel_launch(void* const* d_in, const int* in_sizes, int n_in, void* d_out, int out_size, void* d_ws, size_t ws_size, hipStream_t stream) {
    static int grid = 0;
    if (grid == 0) {
        if (n_in != 23 || in_sizes[0] != NLAT * DM || out_size != NLAT * DM || ws_size < WS_END) {
            fprintf(stderr, "kernel_launch: unexpected shapes: n_in %d in0 %d out %d ws %zu (need %zu)\n", n_in, n_in > 0 ? in_sizes[0] : -1, out_size, ws_size, (size_t)WS_END); grid = -1; return; }
        int dev = 0, cus = 0, per_cu = 0;
        if (hipGetDevice(&dev) != hipSuccess || hipDeviceGetAttribute(&cus, hipDeviceAttributeMultiprocessorCount, dev) != hipSuccess) { fprintf(stderr, "kernel_launch: device query failed\n"); grid = -1; return; }
        if (hipFuncSetAttribute((const void*)mk_fwd, hipFuncAttributeMaxDynamicSharedMemorySize, LDS_BYTES) != hipSuccess) { fprintf(stderr, "kernel_launch: hipFuncSetAttribute failed\n"); grid = -1; return; }
        if (hipOccupancyMaxActiveBlocksPerMultiprocessor(&per_cu, (const void*)mk_fwd, 512, LDS_BYTES) != hipSuccess || per_cu < 1) { fprintf(stderr, "kernel_launch: occupancy query says %d\n", per_cu); per_cu = 1; }
        (void)hipGetLastError();
        grid = cus;
    }
    if (grid < 0) return;
    Args a{};
    for (int i = 0; i < 23; ++i) a.in[i] = (const float*)d_in[i];
    a.out = (float*)d_out; a.ws = (unsigned char*)d_ws;
    int np = 0;
#ifdef MK_PROG
    { static const int pr[] = {MK_PROG}; for (int i = 0; i < (int)(sizeof(pr) / sizeof(pr[0])); ++i) a.prog[np++] = (unsigned char)pr[i]; }
#else
    for (int p = 0; p < N_PHASES; ++p) a.prog[np++] = (unsigned char)p;
#endif
#if MK_ONE_LAUNCH == 2
    a.ph_lo = 0; a.ph_hi = np;
    if (hipMemsetAsync((char*)d_ws + WS_CTL, 0, CTL_ZERO_BYTES, stream) != hipSuccess) { fprintf(stderr, "kernel_launch: hipMemsetAsync of the barrier words failed\n"); return; }
    hipLaunchKernelGGL(mk_fwd, dim3(grid), dim3(512), LDS_BYTES, stream, a);
    { const hipError_t le = hipPeekAtLastError(); if (le != hipSuccess) fprintf(stderr, "kernel_launch: launch failed: %s\n", hipGetErrorName(le)); }
#elif MK_ONE_LAUNCH == 1
    a.ph_lo = 0; a.ph_hi = np;
    void* kargs[] = {&a};
    hipError_t e = hipLaunchCooperativeKernel((const void*)mk_fwd, dim3(grid), dim3(512), kargs, LDS_BYTES, stream);
    if (e != hipSuccess) fprintf(stderr, "kernel_launch: cooperative launch failed: %s (grid %d)\n", hipGetErrorString(e), grid);
#else
    for (int p = 0; p < np; ++p) {
        a.ph_lo = p; a.ph_hi = p + 1;
        hipLaunchKernelGGL(mk_fwd, dim3(grid), dim3(512), LDS_BYTES, stream, a);
    }
    const hipError_t le = hipPeekAtLastError();
    if (le != hipSuccess) fprintf(stderr, "kernel_launch: launch failed: %s\n", hipGetErrorName(le));
#endif
}
```

```cpp
#define MK_ONE_LAUNCH 2
#define DBG_PRECISE_TOPK 0
#define DBG_NAIVE_ATTN 0
#define DBG_PRECISE_PEER 0
#define DBG_NAIVE_GEMM 0
#define DBG_ASCALE 1.0f
#define DBG_PSCALE 1.0f
#include <hip/hip_runtime.h>
#include <hip/hip_cooperative_groups.h>
#include <cstdio>
#include <cstdint>
#include <cmath>
namespace cg = cooperative_groups;
namespace pg8 {
#define PG8_LAS __attribute__((address_space(3)))
typedef unsigned short bf16_t;
typedef short bf16x8 __attribute__((ext_vector_type(8)));
typedef float f32x4 __attribute__((ext_vector_type(4)));
typedef unsigned u32x4 __attribute__((ext_vector_type(4)));
constexpr int BM = 256, BK = 64, HALF = 128, HTB = HALF * BK * 2  , STAGE_BYTES = 8 * HTB, NXCD = 8, WGM = 8;

__host__ __device__ __forceinline__ int lds_byte(int r, int c) { const int st = (r >> 4) * 2 + (c >> 5), rr = r & 15, cc = c & 31, ob = rr * 64 + cc * 2; return st * 1024 + (ob ^ (((ob >> 9) & 1) << 5)); }
__host__ __device__ __forceinline__ void stage_rc(int b, int& R, int& C) { const int st = b / 1024, sb = b % 1024, swz = sb ^ (((sb >> 9) & 1) << 5); R = (st >> 1) * 16 + swz / 64; C = (st & 1) * 32 + (swz % 64) / 2; }
__host__ __device__ __forceinline__ int perm32(int rho) { const int n = rho >> 4, i = rho & 15; return 8 * (i >> 2) + 4 * n + (i & 3); }

struct Unit { int pm, pn; };
struct Gemm { const bf16_t* A; const bf16_t* Bt; int M, N, K; };

struct StaticOrder {
    int nM, nN, nwg, G, c;
    __host__ __device__ void init(int M, int N, int G_, int c_) { nM = M / BM; nN = N / BM; nwg = nM * nN; G = G_; c = c_; }
    __host__ __device__ bool next(int i, Unit& u) const {
        const long L = (long)i * G + c; if (L >= nwg) return false;
        int wgid = (int)L; { const int q = nwg / NXCD, r = nwg % NXCD, xcd = wgid % NXCD, off = wgid / NXCD; wgid = (xcd < r ? xcd * (q + 1) : r * (q + 1) + (xcd - r) * q) + off; }
        const int nig = WGM * nN, gid = wgid / nig, fm = gid * WGM, gsz = (nM - fm) < WGM ? (nM - fm) : WGM;
        u.pm = fm + ((wgid % nig) % gsz); u.pn = (wgid % nig) / gsz; return true;
    }
    __device__ __forceinline__ void a_ready(const Unit&) const {}
    __device__ __forceinline__ void done(const Unit&) const {}
};

__device__ __forceinline__ unsigned cvt_pk_bf16(float lo, float hi) { unsigned r; asm volatile("v_cvt_pk_bf16_f32 %0, %1, %2" : "=v"(r) : "v"(lo), "v"(hi)); return r; }
typedef float f32x2 __attribute__((ext_vector_type(2)));
typedef unsigned u32x2 __attribute__((ext_vector_type(2)));
#ifndef DBG_ASCALE
#define DBG_ASCALE 1.0f
#endif
#ifndef DBG_PSCALE
#define DBG_PSCALE 1.0f
#endif
struct EpiStore {
    static constexpr bool PERM = true, AFTER_DRAIN = false;
    int mode; bf16_t* O; int ldc; int ncols; bf16_t* VM;
    __device__ __forceinline__ void operator()(const f32x4 (&acc)[2][2][4][2], const Unit& u, int wr, int wc, int fr, int fq) const {
        const int row0 = u.pm * BM + wr * 64 + fr;
        bf16_t* base; int rstride, hstride; bool on0, on1;
        if (mode == 0) { const int col0 = u.pn * BM + wc * 32 + 8 * fq; base = O + (size_t)row0 * ldc + col0; rstride = ldc; hstride = HALF; on0 = col0 < ncols; on1 = col0 + HALF < ncols; }
        else {
            const int j = wc * 32 + 8 * fq; const bool isk = wc < 2;
            base = isk ? (O + (size_t)row0 * 768 + (2 * u.pn) * 96 + j) : (VM + (size_t)row0 * 512 + (2 * u.pn) * 64 + (j - 64));
            rstride = isk ? 768 : 512; hstride = isk ? 96 : 64; on0 = true; on1 = true; }
#pragma unroll
        for (int ai = 0; ai < 2; ++ai)
#pragma unroll
            for (int m = 0; m < 4; ++m) { bf16_t* rowp = base + (size_t)(ai * HALF + m * 16) * rstride;
#pragma unroll
                for (int bj = 0; bj < 2; ++bj) {
                    if (bj == 0 ? on0 : on1) { const f32x4 v0 = acc[ai][bj][m][0], v1 = acc[ai][bj][m][1]; u32x4 w;
                        w.x = cvt_pk_bf16(v0[0], v0[1]); w.y = cvt_pk_bf16(v0[2], v0[3]); w.z = cvt_pk_bf16(v1[0], v1[1]); w.w = cvt_pk_bf16(v1[2], v1[3]);
                        *(u32x4*)(rowp + bj * hstride) = w; } } }
    }
};
struct EpiResid {
    static constexpr bool PERM = false, AFTER_DRAIN = false;
    const float* hin_lat; const float* hin_ctx; float* hout_lat; float* hout_ctx; const float* gate; int nlat;
    __device__ __forceinline__ void operator()(const f32x4 (&acc)[2][2][4][2], const Unit& u, int wr, int wc, int fr, int fq) const {
        const int rowt = u.pm * BM; const bool lat = rowt < nlat; const int sample = lat ? (rowt >> 12) : 8;
        const float* src = lat ? hin_lat + (size_t)rowt * 1024 : hin_ctx + (size_t)(rowt - nlat) * 1024;
        float* dst = lat ? hout_lat + (size_t)rowt * 1024 : hout_ctx + (size_t)(rowt - nlat) * 1024;
        const float* g = gate + (size_t)sample * 6144;
        const int col0 = u.pn * BM + wc * 32 + 4 * fq;
#pragma unroll
        for (int bj = 0; bj < 2; ++bj)
#pragma unroll
            for (int n = 0; n < 2; ++n) { const int c = col0 + bj * HALF + n * 16; const f32x4 gv = *(const f32x4*)(g + c);
#pragma unroll
                for (int ai = 0; ai < 2; ++ai)
#pragma unroll
                    for (int m = 0; m < 4; ++m) { const size_t off = (size_t)(ai * HALF + wr * 64 + m * 16 + fr) * 1024 + c;
                        const f32x4 hv = *(const f32x4*)(src + off); *(f32x4*)(dst + off) = hv + gv * acc[ai][bj][m][n] * (float)(DBG_ASCALE); } }
    }
};
template <class Epi, class Sched, bool ALIGN_EPI = false, bool SP2 = false>
__device__ __forceinline__ void gemm_phase(PG8_LAS unsigned char* lds, const Gemm g, const Sched& S, const Epi& E, const int tid_in) {
    const int tid = tid_in, wid = __builtin_amdgcn_readfirstlane(tid >> 6), lane = tid & 63, wr = wid >> 2, wc = wid & 3, fr = lane & 15, fq = lane >> 4;
    const int K = g.K, nt = K / BK;
    unsigned voffA[2], voffB[2];
#pragma unroll
    for (int i = 0; i < 2; ++i) { int R, C; stage_rc(tid * 16 + i * 8192, R, C); const int Rb = Epi::PERM ? ((R & ~31) + perm32(R & 31)) : R;
        voffA[i] = (unsigned)(R * K + C) * 2u; voffB[i] = (unsigned)(Rb * K + C) * 2u; }
    const size_t kstep = (size_t)(BK * 2);
    const size_t hstep = (size_t)HALF * K * 2;
    const size_t tstep = 2 * hstep;
    const unsigned ldsw = (unsigned)wid * 1024u;
    const int aoff = lds_byte(wr * 64 + fr, fq * 8), boff = lds_byte(wc * 32 + fr, fq * 8);
#define PG8_SA(b, h) (((b) * 2 + (h)) * HTB)
#define PG8_SB(b, h) ((4 + (b) * 2 + (h)) * HTB)
#define PG8_STAGE(bufoff, gbase, voff) do { _Pragma("unroll") for (int _i = 0; _i < 2; ++_i) \
        __builtin_amdgcn_global_load_lds((const unsigned*)((const char*)(gbase) + (voff)[_i]), (PG8_LAS unsigned*)(lds + (bufoff) + ldsw + _i * 8192), 16, 0, 0); } while (0)
#define PG8_LDA(dst, b, h) do { _Pragma("unroll") for (int m = 0; m < 4; ++m) _Pragma("unroll") for (int k = 0; k < 2; ++k) dst[m][k] = *(const PG8_LAS bf16x8*)(lds + PG8_SA(b, h) + aoff + m * 2048 + k * 1024); } while (0)
#define PG8_LDB(dst, b, h) do { _Pragma("unroll") for (int n = 0; n < 2; ++n) _Pragma("unroll") for (int k = 0; k < 2; ++k) dst[n][k] = *(const PG8_LAS bf16x8*)(lds + PG8_SB(b, h) + boff + n * 2048 + k * 1024); } while (0)
#define PG8_MMA(ai, bj, At, Bt) do { __builtin_amdgcn_s_setprio(1); _Pragma("unroll") for (int m = 0; m < 4; ++m) _Pragma("unroll") for (int n = 0; n < 2; ++n) _Pragma("unroll") for (int k = 0; k < 2; ++k) \
        acc[ai][bj][m][n] = __builtin_amdgcn_mfma_f32_16x16x32_bf16(Bt[n][k], At[m][k], acc[ai][bj][m][n], 0, 0, 0); __builtin_amdgcn_s_setprio(0); } while (0)
#define PG8_WAIT_V(n) asm volatile("s_waitcnt vmcnt(" #n ")" ::: "memory")
#define PG8_WAIT_L(n) asm volatile("s_waitcnt lgkmcnt(" #n ")" ::: "memory")
#define PG8_BAR __builtin_amdgcn_s_barrier()
#define PG8_SCHED __builtin_amdgcn_sched_barrier(0)
    Unit cur, nxt; int ui = 0;
    if (!S.next(0, cur)) return;
    f32x4 acc[2][2][4][2];
#pragma unroll
    for (int a = 0; a < 2; ++a)
#pragma unroll
        for (int b = 0; b < 2; ++b)
#pragma unroll
            for (int m = 0; m < 4; ++m)
#pragma unroll
                for (int n = 0; n < 2; ++n) acc[a][b][m][n] = (f32x4){0.f, 0.f, 0.f, 0.f};
    bf16x8 At[4][2], B0[2][2], B1[2][2];
    const char* cA = (const char*)g.A + (size_t)cur.pm * tstep; const char* cB = (const char*)g.Bt + (size_t)cur.pn * tstep;
    S.a_ready(cur);
    if constexpr (SP2) {
        PG8_STAGE(PG8_SB(0, 0), cB, voffB); PG8_STAGE(PG8_SB(0, 1), cB + hstep, voffB); PG8_STAGE(PG8_SA(0, 0), cA, voffA); PG8_STAGE(PG8_SA(0, 1), cA + hstep, voffA);
        if (wr == 1) PG8_BAR;
        PG8_WAIT_V(2); PG8_BAR;
        PG8_STAGE(PG8_SB(1, 0), cB + kstep, voffB); PG8_STAGE(PG8_SA(1, 0), cA + kstep, voffA); PG8_STAGE(PG8_SB(1, 1), cB + hstep + kstep, voffB);
        PG8_WAIT_V(6); PG8_BAR;
    } else {
        PG8_STAGE(PG8_SB(0, 0), cB, voffB); PG8_STAGE(PG8_SA(0, 0), cA, voffA); PG8_STAGE(PG8_SB(0, 1), cB + hstep, voffB); PG8_STAGE(PG8_SA(0, 1), cA + hstep, voffA);
        if (wr == 1) PG8_BAR;
        PG8_WAIT_V(4); PG8_BAR;
        PG8_STAGE(PG8_SB(1, 0), cB + kstep, voffB); PG8_STAGE(PG8_SA(1, 0), cA + kstep, voffA); PG8_STAGE(PG8_SB(1, 1), cB + hstep + kstep, voffB);
        PG8_WAIT_V(6); PG8_BAR;
    }
    for (;;) {
        const bool has_next = S.next(ui + 1, nxt);
        const char* nA = has_next ? (const char*)g.A + (size_t)nxt.pm * tstep : cA; const char* nB = has_next ? (const char*)g.Bt + (size_t)nxt.pn * tstep : cB;
        _Pragma("unroll 1") for (int t = 0; t < nt; t += 2) {
            const bool last = (t == nt - 2);
            const char* a1 = cA + (size_t)(t + 1) * kstep;
            const char* a2 = last ? nA : cA + (size_t)(t + 2) * kstep; const char* b2 = last ? nB : cB + (size_t)(t + 2) * kstep;
            const char* a3 = a2 + kstep; const char* b3 = b2 + kstep;
            if (last && has_next) S.a_ready(nxt);
            if constexpr (SP2) {
            PG8_LDB(B0, 0, 0); PG8_LDB(B1, 0, 1); PG8_SCHED; PG8_LDA(At, 0, 0); PG8_STAGE(PG8_SA(1, 1), a1 + hstep, voffA);
            PG8_WAIT_V(8); PG8_WAIT_L(0); PG8_BAR; PG8_MMA(0, 0, At, B0); PG8_MMA(0, 1, At, B1); PG8_BAR; PG8_SCHED;
            PG8_LDA(At, 0, 1); PG8_STAGE(PG8_SB(0, 0), b2, voffB); PG8_STAGE(PG8_SB(0, 1), b2 + hstep, voffB); PG8_STAGE(PG8_SA(0, 0), a2, voffA);
            PG8_WAIT_V(8); PG8_WAIT_L(0); PG8_BAR; PG8_MMA(1, 0, At, B0); PG8_MMA(1, 1, At, B1); PG8_BAR; PG8_SCHED;
            PG8_LDB(B0, 1, 0); PG8_LDB(B1, 1, 1); PG8_SCHED; PG8_LDA(At, 1, 0); PG8_STAGE(PG8_SA(0, 1), a2 + hstep, voffA);
            PG8_WAIT_V(8); PG8_WAIT_L(0); PG8_BAR; PG8_MMA(0, 0, At, B0); PG8_MMA(0, 1, At, B1); PG8_BAR; PG8_SCHED;
            PG8_LDA(At, 1, 1); PG8_STAGE(PG8_SB(1, 0), b3, voffB); PG8_STAGE(PG8_SB(1, 1), b3 + hstep, voffB); PG8_STAGE(PG8_SA(1, 0), a3, voffA);
            PG8_WAIT_V(8); PG8_WAIT_L(0); PG8_BAR; PG8_MMA(1, 0, At, B0); PG8_MMA(1, 1, At, B1); PG8_BAR; PG8_SCHED;
            } else {
            PG8_LDB(B0, 0, 0); PG8_SCHED; PG8_LDA(At, 0, 0); PG8_STAGE(PG8_SA(1, 1), a1 + hstep, voffA);
            PG8_WAIT_L(8); PG8_BAR; PG8_WAIT_L(0); PG8_MMA(0, 0, At, B0); PG8_BAR; PG8_SCHED;
            PG8_LDB(B1, 0, 1); PG8_STAGE(PG8_SB(0, 0), b2, voffB);
            PG8_BAR; PG8_WAIT_L(0); PG8_MMA(0, 1, At, B1); PG8_BAR;
            PG8_LDA(At, 0, 1); PG8_STAGE(PG8_SA(0, 0), a2, voffA);
            PG8_BAR; PG8_WAIT_L(0); PG8_MMA(1, 0, At, B0); PG8_BAR; PG8_SCHED;
            PG8_STAGE(PG8_SB(0, 1), b2 + hstep, voffB);
            PG8_WAIT_V(6); PG8_BAR; PG8_MMA(1, 1, At, B1); PG8_BAR;
            PG8_LDB(B0, 1, 0); PG8_SCHED; PG8_LDA(At, 1, 0); PG8_STAGE(PG8_SA(0, 1), a2 + hstep, voffA);
            PG8_WAIT_L(8); PG8_BAR; PG8_WAIT_L(0); PG8_MMA(0, 0, At, B0); PG8_BAR; PG8_SCHED;
            PG8_LDB(B1, 1, 1); PG8_STAGE(PG8_SB(1, 0), b3, voffB);
            PG8_BAR; PG8_WAIT_L(0); PG8_MMA(0, 1, At, B1); PG8_BAR;
            PG8_LDA(At, 1, 1); PG8_STAGE(PG8_SA(1, 0), a3, voffA);
            PG8_BAR; PG8_WAIT_L(0); PG8_MMA(1, 0, At, B0); PG8_BAR; PG8_SCHED;
            PG8_STAGE(PG8_SB(1, 1), b3 + hstep, voffB);
            PG8_WAIT_V(6); PG8_BAR; PG8_MMA(1, 1, At, B1); PG8_BAR;
            }
        }
        if constexpr (ALIGN_EPI) { if (wr == 0) PG8_BAR; }
        if constexpr (!Epi::AFTER_DRAIN) { E(acc, cur, wr, wc, fr, fq); S.done(cur); }
        if (!has_next) break;
#pragma unroll
        for (int a = 0; a < 2; ++a)
#pragma unroll
            for (int b = 0; b < 2; ++b)
#pragma unroll
                for (int m = 0; m < 4; ++m)
#pragma unroll
                    for (int n = 0; n < 2; ++n) acc[a][b][m][n] = (f32x4){0.f, 0.f, 0.f, 0.f};
        cur = nxt; cA = nA; cB = nB; ++ui;
        if constexpr (ALIGN_EPI) { if (wr == 1) PG8_BAR; }
    }
    PG8_WAIT_V(0);
    if constexpr (!ALIGN_EPI) { if (wr == 0) PG8_BAR; }
    PG8_BAR;
    if constexpr (Epi::AFTER_DRAIN) { E.fused(acc, cur, wr, wc, fr, fq, lds, wid, lane); S.done(cur); }
#undef PG8_SA
#undef PG8_SB
#undef PG8_STAGE
#undef PG8_LDA
#undef PG8_LDB
#undef PG8_MMA
#undef PG8_WAIT_V
#undef PG8_WAIT_L
#undef PG8_BAR
#undef PG8_SCHED
}
}
constexpr int DM = 1024, NB = 8, SEQ = 4096, CTXL = 256, DEPTH = 2;
constexpr int NLAT = NB * SEQ, NCTX = NB * CTXL, NROWS = NLAT + NCTX;
constexpr int DIN = 1440, DINP = 1536, QRANK = 384, KVRANK = 256;
constexpr int PH = 8, PNK = 128, PDH = 128, PTOPK = 16, PEXP = PNK * PNK;
constexpr float EPS = 1e-6f;
constexpr float LOG2E = 1.4426950408889634f;
constexpr float C_MLA = 0.10206207261596577f * LOG2E;
constexpr float C_SWA = 0.125f * LOG2E;

typedef unsigned short bf16;
typedef short bf16x8 __attribute__((ext_vector_type(8)));
typedef short s16x4 __attribute__((ext_vector_type(4)));
typedef float f32x4 __attribute__((ext_vector_type(4)));
typedef float f32x16 __attribute__((ext_vector_type(16)));
typedef unsigned u32x4 __attribute__((ext_vector_type(4)));
typedef unsigned u32x2v __attribute__((ext_vector_type(2)));
#define LAS __attribute__((address_space(3)))

constexpr size_t MiB = 1u << 20;
constexpr size_t WS_CTL = 0, CTL_ZERO_BYTES = 64 * 1024;
constexpr size_t WS_MOD = 1 * MiB;
constexpr size_t WS_RTS = WS_MOD + 512 * 1024;
constexpr size_t WS_RTM = WS_RTS + 64 * 16 * 2 * 4;
constexpr size_t WS_WIN = 2 * MiB;
constexpr size_t WS_WUQ = WS_WIN + 2ull * DINP * DM * 2;
constexpr size_t WS_WUKV = WS_WUQ + 2ull * 768 * QRANK * 2;
constexpr size_t WS_WOUT = WS_WUKV + 2ull * 1024 * KVRANK * 2;
constexpr size_t WS_PWQ = WS_WOUT + 2ull * 1024 * 1024 * 2;
constexpr size_t WS_PKEY = WS_PWQ + 2ull * 2048 * 1024 * 2;
constexpr size_t WS_HCTX = WS_PKEY + 2ull * 8 * 2 * 128 * 128 * 2;
constexpr size_t WS_U = 32 * MiB;
constexpr size_t WS_V = WS_U + 64 * MiB;
constexpr size_t WS_AB = WS_V + 64 * MiB;
constexpr size_t WS_P = WS_AB + (size_t)NROWS * 1024 * 2;
constexpr size_t WS_X5 = WS_P + (size_t)NROWS * DIN * 2;
constexpr size_t WS_QM = WS_X5, WS_KM = WS_QM + (size_t)NROWS * 768 * 2, WS_VM = WS_KM + (size_t)NROWS * 768 * 2, WS_QS = WS_VM + (size_t)NROWS * 512 * 2,
                 WS_KS = WS_QS + (size_t)NROWS * 512 * 2, WS_END = WS_KS + (size_t)NROWS * 128 * 2;
static_assert(WS_HCTX + (size_t)NCTX * 1024 * 4 <= WS_U, "ws map (weights)");
static_assert(WS_END <= 512 * MiB, "ws map");
static_assert((size_t)NROWS * 2048 * 2 <= WS_END - WS_X5, "QP overlay");
static_assert((size_t)NROWS * 1024 <= (size_t)NROWS * DIN * 2, "TK overlay");

constexpr int LDS_BYTES = 135168;

__constant__ float ROPE_INV[24] = {1.0f, 0.5623413324356079f, 0.3162277638912201f, 0.17782793939113617f, 0.10000000149011612f, 0.05623413249850273f, 0.03162277489900589f, 0.017782794311642647f, 0.009999999776482582f, 0.005623413249850273f, 0.003162277629598975f, 0.0017782794311642647f, 0.0010000000474974513f, 0.000562341301701963f, 0.0003162277571391314f, 0.00017782794020604342f, 1.0f, 0.3162277638912201f, 0.10000000149011612f, 0.03162277489900589f, 0.009999999776482582f, 0.003162277629598975f, 0.0010000000474974513f, 0.0003162277571391314f};
struct Args {
    const float* in[23]; float* out; unsigned char* ws; int ph_lo, ph_hi; unsigned char prog[48];
};
typedef const __attribute__((address_space(4))) Args* ArgsP;

struct Frame {
    int tid, lane, wave, G, bid, vcu, gw, ngw, zv;
};

__device__ __forceinline__ float bf_lo(unsigned w) { return __uint_as_float(w << 16); }
__device__ __forceinline__ float bf_hi(unsigned w) { return __uint_as_float(w & 0xffff0000u); }
__device__ __forceinline__ unsigned pk2(float lo, float hi) { return pg8::cvt_pk_bf16(lo, hi); }
__device__ __forceinline__ float wave_sum(float v) {
#pragma unroll
    for (int o = 1; o < 64; o <<= 1) v += __shfl_xor(v, o);
    return v;
}
__device__ __forceinline__ void unpack8(const u32x4 w, float (&x)[8]) {
    x[0] = bf_lo(w.x); x[1] = bf_hi(w.x); x[2] = bf_lo(w.y); x[3] = bf_hi(w.y); x[4] = bf_lo(w.z); x[5] = bf_hi(w.z); x[6] = bf_lo(w.w); x[7] = bf_hi(w.w);
}
__device__ __forceinline__ u32x4 pack8(const float (&x)[8]) {
    u32x4 w; w.x = pk2(x[0], x[1]); w.y = pk2(x[2], x[3]); w.z = pk2(x[4], x[5]); w.w = pk2(x[6], x[7]); return w;
}

__device__ __forceinline__ void p0_transpose_item(const float* W, int K, int N, bf16* WT, LAS float* scr, int item, int lane) {
    const int nblk = N / 32, kb = item / nblk, nb = item % nblk, k0 = 64 * kb, n0 = 32 * nb;
#pragma unroll 8
    for (int i = 0; i < 32; ++i) { const int kk = 2 * i + (lane >> 5); scr[kk * 33 + (lane & 31)] = W[(size_t)(k0 + kk) * N + n0 + (lane & 31)]; }
    asm volatile("s_waitcnt lgkmcnt(0)" ::: "memory");
    const int c = lane & 7;
#pragma unroll
    for (int j = 0; j < 4; ++j) { const int n = (lane >> 3) + 8 * j; const LAS float* s = scr + (8 * c) * 33 + n;
        u32x4 o; o.x = pk2(s[0 * 33], s[1 * 33]); o.y = pk2(s[2 * 33], s[3 * 33]); o.z = pk2(s[4 * 33], s[5 * 33]); o.w = pk2(s[6 * 33], s[7 * 33]);
        *(u32x4*)(WT + (size_t)(n0 + n) * K + k0 + 8 * c) = o; }
    asm volatile("s_waitcnt lgkmcnt(0)" ::: "memory");
}

__device__ __forceinline__ void p0_prologue(const Frame& F, ArgsP Ap, LAS unsigned char* lds) {
    unsigned char* ws = Ap->ws;
    const float* c_in = Ap->in[1]; const float* cctx_in = Ap->in[3]; const float* ada_w = Ap->in[4]; const float* ada_b = Ap->in[5];
    for (int task = F.bid; task < 48; task += F.G) {
        const int l = task / 24, cc = task % 24;
        LAS float* sl = (LAS float*)lds;
        LAS float* red = (LAS float*)(lds + 9 * 1024 * 4);
        __syncthreads();
        for (int i = F.tid; i < 9 * 1024; i += 512) { const int s = i >> 10, k = i & 1023; const float x = (s < 8) ? c_in[s * 1024 + k] : cctx_in[k]; sl[i] = x / (1.f + __expf(-x)); }
        __syncthreads();
        const int c0 = cc * 256 + F.lane * 4; const int kbase = F.wave * 128;
        f32x4 acc[9];
#pragma unroll
        for (int s = 0; s < 9; ++s) acc[s] = (f32x4){0.f, 0.f, 0.f, 0.f};
        const float* wp = ada_w + ((size_t)l * 1024 + kbase) * 6144 + c0;
#pragma unroll 4
        for (int kk = 0; kk < 128; ++kk) { const f32x4 w = *(const f32x4*)(wp + (size_t)kk * 6144);
#pragma unroll
            for (int s = 0; s < 9; ++s) acc[s] += w * sl[s * 1024 + kbase + kk]; }
#pragma unroll
        for (int s = 0; s < 9; ++s) *(LAS f32x4*)(red + (F.wave * 9 + s) * 256 + F.lane * 4) = acc[s];
        __syncthreads();
        float* MOD = (float*)(ws + WS_MOD);
        for (int i = F.tid; i < 9 * 256; i += 512) { const int s = i >> 8, ci = i & 255; float v = ada_b[l * 6144 + cc * 256 + ci];
#pragma unroll
            for (int w = 0; w < 8; ++w) v += red[(w * 9 + s) * 256 + ci];
            MOD[((size_t)l * 9 + s) * 6144 + cc * 256 + ci] = v; }
        __syncthreads();
    }
    __syncthreads();
    if (F.bid == F.G - 1) {
        float* rts = (float*)(ws + WS_RTS); float* rtm = (float*)(ws + WS_RTM);
        for (int i = F.tid; i < 64 * 24; i += 512) {
            const int pos = i / 24, k = i % 24; const float a = (float)pos * ROPE_INV[k];
            const float rev = a * 0.15915494309189535f;
            const float cs = __builtin_amdgcn_cosf(rev), sn = __builtin_amdgcn_sinf(rev);
            if (k < 16) { rts[(pos * 16 + k) * 2] = cs; rts[(pos * 16 + k) * 2 + 1] = sn; } else { rtm[(pos * 8 + (k - 16)) * 2] = cs; rtm[(pos * 8 + (k - 16)) * 2 + 1] = sn; }
        }
    }
    LAS float* scr = (LAS float*)(lds + F.wave * 16384);
    constexpr int I_WIN = (DM / 64) * (DIN / 32), I_WUQ = (QRANK / 64) * (768 / 32), I_WUKV = (KVRANK / 64) * (1024 / 32), I_WOUT = (DM / 64) * (DM / 32), I_PWQ = (DM / 64) * (2048 / 32);
    constexpr int I_L = I_WIN + I_WUQ + I_WUKV + I_WOUT + I_PWQ;
    for (int it = F.gw; it < 2 * I_L; it += F.ngw) {
        const int l = it / I_L; int r = it % I_L;
        if (r < I_WIN) { p0_transpose_item(Ap->in[8] + (size_t)l * DM * DIN, DM, DIN, (bf16*)(ws + WS_WIN) + (size_t)l * DINP * DM, scr, r, F.lane); continue; } r -= I_WIN;
        if (r < I_WUQ) { p0_transpose_item(Ap->in[10] + (size_t)l * QRANK * 768, QRANK, 768, (bf16*)(ws + WS_WUQ) + (size_t)l * 768 * QRANK, scr, r, F.lane); continue; } r -= I_WUQ;
        if (r < I_WUKV) { p0_transpose_item(Ap->in[12] + (size_t)l * KVRANK * 1024, KVRANK, 1024, (bf16*)(ws + WS_WUKV) + (size_t)l * 1024 * KVRANK, scr, r, F.lane); continue; } r -= I_WUKV;
        if (r < I_WOUT) { p0_transpose_item(Ap->in[18] + (size_t)l * DM * DM, DM, DM, (bf16*)(ws + WS_WOUT) + (size_t)l * DM * DM, scr, r, F.lane); continue; } r -= I_WOUT;
        p0_transpose_item(Ap->in[19] + (size_t)l * DM * 2048, DM, 2048, (bf16*)(ws + WS_PWQ) + (size_t)l * 2048 * DM, scr, r, F.lane);
    }
    { const size_t gt = (size_t)F.bid * 512 + F.tid, nt = (size_t)F.G * 512;
      for (size_t i = gt; i < 2ull * 96 * DM / 8; i += nt) { const size_t l = i / (96 * DM / 8), e = i % (96 * DM / 8);
          *(u32x4*)((bf16*)(ws + WS_WIN) + l * DINP * DM + (size_t)DIN * DM + e * 8) = (u32x4){(unsigned)F.zv, (unsigned)F.zv, (unsigned)F.zv, (unsigned)F.zv}; }
      const size_t NKEY8 = 2ull * 8 * 2 * 128 * 128 / 8, NU8 = 2ull * PEXP * DM / 8;
      for (size_t i = gt; i < NKEY8 + 2 * NU8; i += nt) {
          const float* src; bf16* dst; size_t j;
          if (i < NKEY8) { src = Ap->in[20]; dst = (bf16*)(ws + WS_PKEY); j = i; }
          else if (i < NKEY8 + NU8) { src = Ap->in[21]; dst = (bf16*)(ws + WS_U); j = i - NKEY8; }
          else { src = Ap->in[22]; dst = (bf16*)(ws + WS_V); j = i - NKEY8 - NU8; }
          const f32x4 a = *(const f32x4*)(src + j * 8), b = *(const f32x4*)(src + j * 8 + 4);
          u32x4 o; o.x = pk2(a[0], a[1]); o.y = pk2(a[2], a[3]); o.z = pk2(b[0], b[1]); o.w = pk2(b[2], b[3]);
          size_t dj = j * 8;
          if (i >= NKEY8 + NU8) { const size_t fl = j * 8, lay = fl / ((size_t)PEXP * DM), rem = fl % ((size_t)PEXP * DM), e = rem >> 10, d = rem & 1023;
              dj = lay * (size_t)PEXP * DM + ((d >> 6) * (size_t)PEXP + e) * 64 + (d & 63); }
          *(u32x4*)(dst + dj) = o; }
    }
}

#ifndef DBG_PRECISE_TOPK
#define DBG_PRECISE_TOPK 0
#endif
__device__ __forceinline__ void norm_mod_phase(const Frame& F, ArgsP Ap, int l, int which, int nrows) {
    unsigned char* ws = Ap->ws;
    const float* MOD = (const float*)(ws + WS_MOD);
    const float* gn = Ap->in[which ? 7 : 6] + l * DM;
    bf16* AB = (bf16*)(ws + WS_AB);
    const bool from_input = (which == 0 && l == 0);
    for (int r = F.gw; r < nrows; r += F.ngw) {
        const bool lat = r < NLAT;
        const float* hr = lat ? ((from_input ? Ap->in[0] : Ap->out) + (size_t)r * DM) : ((from_input ? Ap->in[2] : (const float*)(ws + WS_HCTX)) + (size_t)(r - NLAT) * DM);
        const int s = lat ? (r >> 12) : 8;
        const float* mp = MOD + ((size_t)l * 9 + s) * 6144 + (which ? 3 * DM : 0);
        f32x4 v[4]; float ss = 0.f;
#pragma unroll
        for (int j = 0; j < 4; ++j) { v[j] = *(const f32x4*)(hr + 256 * j + 4 * F.lane); ss += (v[j][0] * v[j][0] + v[j][1] * v[j][1]) + (v[j][2] * v[j][2] + v[j][3] * v[j][3]); }
        ss = wave_sum(ss);
        const float rinv = rsqrtf(ss * (1.f / DM) + EPS);
#pragma unroll
        for (int j = 0; j < 4; ++j) { const int c = 256 * j + 4 * F.lane;
            const f32x4 g = *(const f32x4*)(gn + c), sh = *(const f32x4*)(mp + c), sc = *(const f32x4*)(mp + DM + c);
            const f32x4 y = v[j] * rinv * g; const f32x4 a = y * (sc + 1.f) + sh;
            u32x2v o; o.x = pk2(a[0], a[1]); o.y = pk2(a[2], a[3]);
            *(u32x2v*)(AB + (size_t)r * DM + c) = o;
#if DBG_PRECISE_TOPK
            if (which) *(f32x4*)((float*)(ws + WS_X5) + (size_t)r * DM + c) = a;
#endif
            }
    }
}

__device__ __forceinline__ void e2_phase(const Frame& F, ArgsP Ap, int l, int nrows) {
    unsigned char* ws = Ap->ws;
    const bf16* P = (const bf16*)(ws + WS_P);
    bf16* QAN = (bf16*)(ws + WS_AB); bf16* KVAN = QAN + (size_t)NROWS * QRANK;
    bf16* QS = (bf16*)(ws + WS_QS); bf16* KS = (bf16*)(ws + WS_KS);
    const float* qa_g = Ap->in[9] + l * QRANK; const float* kva_g = Ap->in[11] + l * KVRANK;
    const float* sqn_g = Ap->in[15] + l * 64; const float* skn_g = Ap->in[16] + l * 64;
    const float* rts = (const float*)(ws + WS_RTS);
    const int lane = F.lane;
    for (int r = F.gw; r < nrows; r += F.ngw) {
        const bf16* pr = P + (size_t)r * DIN;
        const bool lat = r < NLAT; const int pos = r & (SEQ - 1), rp = pos >> 6, cp = pos & 63;
        u32x4 wqa = (u32x4){0u, 0u, 0u, 0u}, wkva = (u32x4){0u, 0u, 0u, 0u}, wsk = (u32x4){0u, 0u, 0u, 0u};
        if (lane < 48) wqa = *(const u32x4*)(pr + 8 * lane);
        const u32x4 wsq = *(const u32x4*)(pr + QRANK + 8 * lane);
        if (lane < 32) wkva = *(const u32x4*)(pr + 896 + 8 * lane);
        if (lane < 16) wsk = *(const u32x4*)(pr + 1184 + 8 * lane);
        float x[8];
        { unpack8(wqa, x); float ss = 0.f;
#pragma unroll
          for (int e = 0; e < 8; ++e) ss += x[e] * x[e];
          ss = wave_sum(ss); const float rinv = rsqrtf(ss * (1.f / QRANK) + EPS);
          if (lane < 48) { float y[8];
#pragma unroll
              for (int e = 0; e < 8; ++e) y[e] = x[e] * rinv * qa_g[8 * lane + e];
              *(u32x4*)(QAN + (size_t)r * QRANK + 8 * lane) = pack8(y); } }
        { unpack8(wkva, x); float ss = 0.f;
#pragma unroll
          for (int e = 0; e < 8; ++e) ss += x[e] * x[e];
          ss = wave_sum(ss); const float rinv = rsqrtf(ss * (1.f / KVRANK) + EPS);
          if (lane < 32) { float y[8];
#pragma unroll
              for (int e = 0; e < 8; ++e) y[e] = x[e] * rinv * kva_g[8 * lane + e];
              *(u32x4*)(KVAN + (size_t)r * KVRANK + 8 * lane) = pack8(y); } }
        const int ch = lane & 7;
        const float* tab = rts + (size_t)((ch < 4) ? rp : cp) * 32 + (ch & 1) * 16;
#pragma unroll
        for (int which = 0; which < 2; ++which) {
            unpack8(which ? wsk : wsq, x); float ss = 0.f;
#pragma unroll
            for (int e = 0; e < 8; ++e) ss += x[e] * x[e];
            ss += __shfl_xor(ss, 1); ss += __shfl_xor(ss, 2); ss += __shfl_xor(ss, 4);
            const float rinv = rsqrtf(ss * (1.f / 64.f) + EPS);
            const float* gg = which ? skn_g : sqn_g;
            float y[8], o[8];
#pragma unroll
            for (int e = 0; e < 8; ++e) y[e] = x[e] * rinv * gg[8 * ch + e];
#pragma unroll
            for (int e = 0; e < 8; ++e) { const float py = __shfl_xor(y[e], 2);
                if (lat) { const float cs = tab[2 * e], sn = tab[2 * e + 1]; o[e] = (ch & 2) ? (y[e] * cs + py * sn) : (y[e] * cs - py * sn); } else o[e] = y[e]; }
            if (which == 0) {
#pragma unroll
                for (int e = 0; e < 8; ++e) o[e] *= C_SWA;
                *(u32x4*)(QS + (size_t)r * 512 + 8 * lane) = pack8(o);
            } else if (lane < 16) *(u32x4*)(KS + (size_t)r * 128 + 8 * lane) = pack8(o);
        }
    }
}

__device__ __forceinline__ void e3_phase(const Frame& F, ArgsP Ap, int l, int nrows) {
    unsigned char* ws = Ap->ws;
    const bf16* P = (const bf16*)(ws + WS_P);
    bf16* QM = (bf16*)(ws + WS_QM); bf16* KM = (bf16*)(ws + WS_KM);
    const float* qn_g = Ap->in[13] + l * 96; const float* kn_g = Ap->in[14] + l * 96;
    const float* rtm = (const float*)(ws + WS_RTM);
    const int lane = F.lane, hl = lane / 12, ch = lane % 12, gbase = hl * 12;
    for (int r = F.gw; r < nrows; r += F.ngw) {
        const bool lat = r < NLAT; const int pos = r & (SEQ - 1), rp = pos >> 6, cp = pos & 63;
        const float* tab = rtm + (size_t)((ch < 10) ? rp : cp) * 16;
#pragma unroll
        for (int pass = 0; pass < 2; ++pass) {
            const int head = pass * 5 + hl; const bool valid = (lane < 60) && (head < 8);
#pragma unroll
            for (int which = 0; which < 2; ++which) {
                u32x4 w = (u32x4){0u, 0u, 0u, 0u};
                bf16* dstp = (which ? KM : QM) + (size_t)r * 768 + head * 96 + ch * 8;
                if (valid) { if (which == 1 && ch >= 8) w = *(const u32x4*)(P + (size_t)r * DIN + 1152 + (ch - 8) * 8); else w = *(const u32x4*)dstp; }
                float x[8]; unpack8(w, x); float ss = 0.f;
#pragma unroll
                for (int e = 0; e < 8; ++e) ss += x[e] * x[e];
                float tot = 0.f;
#pragma unroll
                for (int i = 0; i < 12; ++i) tot += __shfl(ss, (gbase + i) & 63);
                const float rinv = rsqrtf(tot * (1.f / 96.f) + EPS);
                const float* gg = which ? kn_g : qn_g;
                float y[8], o[8];
#pragma unroll
                for (int e = 0; e < 8; ++e) y[e] = x[e] * rinv * gg[8 * ch + e];
#pragma unroll
                for (int e = 0; e < 8; ++e) { const float py = __shfl_xor(y[e], 1);
                    if (lat && ch >= 8) { const float cs = tab[2 * e], sn = tab[2 * e + 1]; o[e] = (ch & 1) ? (y[e] * cs + py * sn) : (y[e] * cs - py * sn); } else o[e] = y[e]; }
                if (which == 0) {
#pragma unroll
                    for (int e = 0; e < 8; ++e) o[e] *= C_MLA;
                }
                if (valid) *(u32x4*)dstp = pack8(o);
            }
        }
    }
}
#define XB_TMO      128
#define XB_XCNT(j)  (256  + 64 * (j))
#define XB_XSUB(j)  (1280 + 64 * (j))
#define XB_XGEN(j)  (2304 + 64 * (j))
#define XB_TOP      3328
#define XB_TOPGEN   3392
#define XCD_BAR_WORDS 3456
#define XB_SPIN_CAP (1u << 18)

__device__ __forceinline__ unsigned xb_ld(unsigned* p)              { return __hip_atomic_load(p, __ATOMIC_RELAXED, __HIP_MEMORY_SCOPE_AGENT); }
__device__ __forceinline__ unsigned xb_add(unsigned* p, unsigned v) { return __hip_atomic_fetch_add(p, v, __ATOMIC_RELAXED, __HIP_MEMORY_SCOPE_AGENT); }
__device__ __forceinline__ unsigned xb_xcc_id() { return (unsigned)__builtin_amdgcn_s_getreg((3 << 11) | 20) & 0xFu; }
#define XB_SPIN(cond, bar) do { unsigned _sp = 0; while (cond) { __builtin_amdgcn_s_sleep(1); \
    if ((++_sp & 255u) == 0u) { if (xb_ld(&(bar)[XB_TMO])) break; if (_sp > XB_SPIN_CAP) { atomicAdd(&(bar)[XB_TMO], 1u); break; } } } } while (0)

struct XcdBarrier {
    unsigned* bar; unsigned x;
    volatile LAS unsigned* st;
};

__device__ __forceinline__ XcdBarrier xcd_barrier_post(unsigned* bar, volatile LAS unsigned* st, const bool t0) {
    XcdBarrier b; b.bar = bar; b.x = xb_xcc_id(); b.st = st;
    if (t0) (void)xb_add(&bar[XB_XCNT(b.x)], 1u);
    return b;
}
__device__ __forceinline__ void xcd_barrier_complete(unsigned* bar, unsigned x, unsigned& nloc, unsigned& nx) {
    const unsigned G = gridDim.x * gridDim.y * gridDim.z;
    unsigned sum, cnt, mine, sp = 0u;
    for (;;) {
        sum = 0u; cnt = 0u; mine = 0u;
#pragma unroll
        for (unsigned j = 0; j < 16; ++j) { const unsigned c = xb_ld(&bar[XB_XCNT(j)]); sum += c; cnt += (c > 0u) ? 1u : 0u; mine = (j == x) ? c : mine; }
        if (sum == G) break;
        __builtin_amdgcn_s_sleep(1);
        if ((++sp & 255u) == 0u) { if (xb_ld(&bar[XB_TMO])) break; if (sp > XB_SPIN_CAP) { atomicAdd(&bar[XB_TMO], 1u); break; } }
    }
    nloc = mine > 0u ? mine : 1u; nx = cnt > 0u ? cnt : 1u;
}

__device__ __forceinline__ void xcd_barrier(const XcdBarrier& b, const bool t0) {
    asm volatile("s_waitcnt vmcnt(0)" ::: "memory");
    __syncthreads();
    if (t0) {
        unsigned* bar = b.bar;
        __builtin_amdgcn_s_waitcnt(0);
        unsigned nloc = b.st[0], nx = b.st[1];
        if (nloc == 0u) { xcd_barrier_complete(bar, b.x, nloc, nx); b.st[0] = nloc; b.st[1] = nx; }
        const unsigned old = xb_add(&bar[XB_XSUB(b.x)], 1u);
        const unsigned gen = old / nloc;
        if (old + 1u == (gen + 1u) * nloc) {
            __builtin_amdgcn_fence(__ATOMIC_RELEASE, "agent");
            asm volatile("s_waitcnt vmcnt(0)" ::: "memory");
            const unsigned og = xb_add(&bar[XB_TOP], 1u);
            const unsigned tg = og / nx;
            if (og + 1u == (tg + 1u) * nx) xb_add(&bar[XB_TOPGEN], 1u);
            else XB_SPIN(xb_ld(&bar[XB_TOPGEN]) == tg, bar);
            __builtin_amdgcn_fence(__ATOMIC_ACQUIRE, "agent");
            xb_add(&bar[XB_XGEN(b.x)], 1u);
            asm volatile("s_waitcnt vmcnt(0)" ::: "memory");
        } else {
            XB_SPIN(xb_ld(&bar[XB_XGEN(b.x)]) == gen, bar);
            __builtin_amdgcn_fence(__ATOMIC_ACQUIRE, "agent");
            asm volatile("s_waitcnt vmcnt(0)" ::: "memory");
        }
    }
    __syncthreads();
}
namespace att {
constexpr int SHM_V = 64 * 64 * 2, SHM_K = 64 * 256, LDS_ATT = 2 * SHM_V + 2 * SHM_K + 8 * 64 * 4;
#define KSWZ(row, colB) ((row) * 256 + ((colB) ^ (((row) & 7) << 4)))
#define SBAR() __builtin_amdgcn_sched_barrier(0)
__device__ __forceinline__ int crow(int r, int hi) { return (r & 3) + 8 * (r >> 2) + 4 * hi; }
__device__ __forceinline__ int v_st(int k, int c) { const int kk = (k & ~0xC) | ((k & 4) << 1) | ((k & 8) >> 1); return ((kk >> 3) * 2 + (c >> 5)) * 512 + ((kk & 7) * 32 + (c & 31)) * 2; }
__device__ __forceinline__ int v_rd_base(int lane) { return ((lane & 3) << 3) | (((lane >> 2) & 3) << 6) | (((lane >> 4) & 1) << 5) | (((lane >> 5) & 1) << 8); }
constexpr int v_rd_off(int d0, int ks, int half) { return d0 * 512 + ks * 2048 + half * 1024; }
template <int OFF> __device__ __forceinline__ s16x4 tr_read(int vb) {
    s16x4 r; asm volatile("ds_read_b64_tr_b16 %0, %1 offset:%2" : "=&v"(r) : "v"(vb), "i"(OFF) : "memory"); return r;
}
template <int D0> __device__ __forceinline__ void pv_one(f32x16& od, int vb, bf16x8 pa0, bf16x8 pa1, bf16x8 pa2, bf16x8 pa3) {
    const s16x4 l0 = tr_read<v_rd_off(D0, 0, 0)>(vb), h0 = tr_read<v_rd_off(D0, 0, 1)>(vb), l1 = tr_read<v_rd_off(D0, 1, 0)>(vb), h1 = tr_read<v_rd_off(D0, 1, 1)>(vb);
    const s16x4 l2 = tr_read<v_rd_off(D0, 2, 0)>(vb), h2 = tr_read<v_rd_off(D0, 2, 1)>(vb), l3 = tr_read<v_rd_off(D0, 3, 0)>(vb), h3 = tr_read<v_rd_off(D0, 3, 1)>(vb);
    asm volatile("s_waitcnt lgkmcnt(0)" ::: "memory"); SBAR();
#define PK(L, H) (bf16x8){L[0], L[1], L[2], L[3], H[0], H[1], H[2], H[3]}
    od = __builtin_amdgcn_mfma_f32_32x32x16_bf16(pa0, PK(l0, h0), od, 0, 0, 0);
    od = __builtin_amdgcn_mfma_f32_32x32x16_bf16(pa1, PK(l1, h1), od, 0, 0, 0);
    od = __builtin_amdgcn_mfma_f32_32x32x16_bf16(pa2, PK(l2, h2), od, 0, 0, 0);
    od = __builtin_amdgcn_mfma_f32_32x32x16_bf16(pa3, PK(l3, h3), od, 0, 0, 0);
#undef PK
}
__device__ __forceinline__ void pv2(f32x16* o, int vb, bf16x8 pa0, bf16x8 pa1, bf16x8 pa2, bf16x8 pa3) {
    pv_one<0>(o[0], vb, pa0, pa1, pa2, pa3); pv_one<1>(o[1], vb, pa0, pa1, pa2, pa3);
}
template <int ND0> __device__ __forceinline__ void qkt(f32x16& p0, f32x16& p1, const char* Ks, const bf16x8* qr, int r32, int hi) {
    p0 = f32x16{}; p1 = f32x16{};
#pragma unroll
    for (int d0 = 0; d0 < ND0; ++d0) { const int cb = (d0 * 16 + hi * 8) * 2;
        const bf16x8 b0 = *reinterpret_cast<const bf16x8*>(Ks + KSWZ(r32, cb));
        const bf16x8 b1 = *reinterpret_cast<const bf16x8*>(Ks + KSWZ(32 + r32, cb));
        p0 = __builtin_amdgcn_mfma_f32_32x32x16_bf16(b0, qr[d0], p0, 0, 0, 0);
        p1 = __builtin_amdgcn_mfma_f32_32x32x16_bf16(b1, qr[d0], p1, 0, 0, 0); }
}
__device__ __forceinline__ void wmask(f32x16& p0, f32x16& p1, int kp0, int qp, int hi) {
#pragma unroll
    for (int r = 0; r < 16; ++r) { const int d0 = kp0 + crow(r, hi) - qp; const int d1 = d0 + 32;
        if (d0 > 128 || d0 < -128) p0[r] = -INFINITY; if (d1 > 128 || d1 < -128) p1[r] = -INFINITY; }
}
__device__ __forceinline__ void smpack(f32x16& p0, f32x16& p1, float& l_reg, bf16x8& pa0, bf16x8& pa1, bf16x8& pa2, bf16x8& pa3) {
#pragma unroll
    for (int r = 0; r < 16; ++r) p0[r] = __builtin_amdgcn_exp2f(p0[r]);
#pragma unroll
    for (int r = 0; r < 16; ++r) p1[r] = __builtin_amdgcn_exp2f(p1[r]);
    float ps = 0.f;
#pragma unroll
    for (int r = 0; r < 16; ++r) ps += p0[r];
#pragma unroll
    for (int r = 0; r < 16; ++r) ps += p1[r];
    l_reg += ps;
#define PK4(P, BASE, OUT) do { unsigned a0 = pk2(P[BASE + 0], P[BASE + 1]), a1 = pk2(P[BASE + 2], P[BASE + 3]);   \
    unsigned b0 = pk2(P[BASE + 4], P[BASE + 5]), b1 = pk2(P[BASE + 6], P[BASE + 7]);                              \
    auto r0 = __builtin_amdgcn_permlane32_swap(a0, b0, false, false); auto r1 = __builtin_amdgcn_permlane32_swap(a1, b1, false, false); \
    u32x4 w = {r0[0], r1[0], r0[1], r1[1]}; OUT = *reinterpret_cast<bf16x8*>(&w); } while (0)
    PK4(p0, 0, pa0); PK4(p0, 8, pa1); PK4(p1, 0, pa2); PK4(p1, 8, pa3);
#undef PK4
}

struct Unit {
    const bf16* Q; int ldq;
    const bf16* K; int ldk;
    const bf16* V; int ldv;
    bf16* O;
    int qrow0;
    int ctx_row0;
    int lat_row0;
    int nt;
    int qpos0;
    int kpos0;
    int masked;
    float l_init;
};

template <int DQK, bool MASKED>
__device__ __forceinline__ void attn_unit(const Unit& U, char* lds, const int tid) {
    constexpr int ND0 = DQK / 16, NCH = DQK / 8;
    const int wid = tid >> 6, lane = tid & 63, r32 = lane & 31, hi = lane >> 5;
    char* V_lds = lds; char* K_lds = lds + 2 * SHM_V;
    float* wsf = (float*)(lds + 2 * SHM_V + 2 * SHM_K) + wid * 64;
    float l_reg = (hi == 0) ? U.l_init : 0.f; f32x16 o[2] = {}; bf16x8 qr[ND0];
    const bf16* Qw = U.Q + (size_t)(U.qrow0 + wid * 32 + r32) * U.ldq + hi * 8;
#pragma unroll
    for (int d0 = 0; d0 < ND0; ++d0) qr[d0] = *reinterpret_cast<const bf16x8*>(Qw + d0 * 16);
    const int vk = tid >> 3, vc = (tid & 7) * 8, vst = v_st(vk, vc);
    const int k0r = tid / NCH, k0c = tid % NCH;
    const bool k1on = (NCH == 12) && (tid < 256);
    const int k1i = k1on ? (tid + 512) : tid, k1r = k1i / NCH, k1c = k1i % NCH;
    const int vb0 = (int)(uintptr_t)V_lds + v_rd_base(lane);
    struct Slot { bf16x8 v, k0, k1; } s0;
    auto tile_row = [&](int t) -> int { return (t < 4) ? (U.ctx_row0 + 64 * t) : (U.lat_row0 + 64 * (t - 4)); };
#define SLOAD(S, t) do { const int kr_ = tile_row(t); \
        S.v = *reinterpret_cast<const bf16x8*>(U.V + (size_t)(kr_ + vk) * U.ldv + vc); \
        S.k0 = *reinterpret_cast<const bf16x8*>(U.K + (size_t)(kr_ + k0r) * U.ldk + k0c * 8); \
        if (NCH == 12) S.k1 = *reinterpret_cast<const bf16x8*>(U.K + (size_t)(kr_ + k1r) * U.ldk + k1c * 8); } while (0)
#define SWRITE(b, S) do { *reinterpret_cast<bf16x8*>(V_lds + (b) * SHM_V + vst) = S.v; \
        *reinterpret_cast<bf16x8*>(K_lds + (b) * SHM_K + KSWZ(k0r, k0c * 16)) = S.k0; \
        if (NCH == 12) { if (k1on) *reinterpret_cast<bf16x8*>(K_lds + (b) * SHM_K + KSWZ(k1r, k1c * 16)) = S.k1; } } while (0)
#define MASK(P0, P1, t) do { if (MASKED && (t) >= 4) wmask(P0, P1, U.kpos0 + 64 * ((t) - 4), U.qpos0 + wid * 32 + r32, hi); } while (0)
    f32x16 pA0, pA1, pB0, pB1; bf16x8 pa0, pa1, pa2, pa3; const int NT = U.nt;
    __syncthreads();
    SLOAD(s0, 0); SWRITE(0, s0); __syncthreads();
    qkt<ND0>(pA0, pA1, K_lds, qr, r32, hi); MASK(pA0, pA1, 0);
    SLOAD(s0, 1);
    SWRITE(1, s0); __syncthreads();
    for (int j = 1; j + 1 < NT; j += 2) {
        SBAR(); qkt<ND0>(pB0, pB1, K_lds + SHM_K, qr, r32, hi); MASK(pB0, pB1, j);
        smpack(pA0, pA1, l_reg, pa0, pa1, pa2, pa3); SBAR();
        SLOAD(s0, j + 1); SBAR();
        pv2(o, vb0, pa0, pa1, pa2, pa3);
        __syncthreads(); SWRITE(0, s0); __syncthreads();
        SBAR(); qkt<ND0>(pA0, pA1, K_lds, qr, r32, hi); MASK(pA0, pA1, j + 1);
        smpack(pB0, pB1, l_reg, pa0, pa1, pa2, pa3); SBAR();
        SLOAD(s0, j + 2); SBAR();
        pv2(o, vb0 + SHM_V, pa0, pa1, pa2, pa3);
        __syncthreads(); SWRITE(1, s0); __syncthreads();
    }
    SBAR(); qkt<ND0>(pB0, pB1, K_lds + SHM_K, qr, r32, hi); MASK(pB0, pB1, NT - 1);
    smpack(pA0, pA1, l_reg, pa0, pa1, pa2, pa3); SBAR();
    pv2(o, vb0, pa0, pa1, pa2, pa3);
    smpack(pB0, pB1, l_reg, pa0, pa1, pa2, pa3); SBAR();
    pv2(o, vb0 + SHM_V, pa0, pa1, pa2, pa3);
    { auto rr = __builtin_amdgcn_permlane32_swap(__float_as_uint(l_reg), __float_as_uint(l_reg), false, false);
      l_reg = __uint_as_float(rr[0]) + __uint_as_float(rr[1]); }
    if (hi == 0) wsf[r32] = l_reg;
    asm volatile("s_waitcnt lgkmcnt(0)" ::: "memory");
    float rli[16];
#pragma unroll
    for (int r = 0; r < 16; ++r) rli[r] = 1.f / wsf[crow(r, hi)];
    bf16* Ow = U.O + (size_t)(U.qrow0 + wid * 32) * 1024;
#pragma unroll
    for (int r = 0; r < 16; ++r) { const int orow = crow(r, hi);
#pragma unroll
        for (int d0 = 0; d0 < 2; ++d0) { const unsigned w = pk2(o[d0][r] * rli[r], 0.f); Ow[(size_t)orow * 1024 + d0 * 32 + r32] = (bf16)(w & 0xffffu); } }
#undef SLOAD
#undef SWRITE
#undef MASK
}
#undef KSWZ
}

__device__ __forceinline__ void attn_phase(const Frame& F, ArgsP Ap, int l, char* lds) {
    unsigned char* ws = Ap->ws;
    const bf16* QM = (const bf16*)(ws + WS_QM); const bf16* KM = (const bf16*)(ws + WS_KM); const bf16* VM = (const bf16*)(ws + WS_VM);
    const bf16* QS = (const bf16*)(ws + WS_QS); const bf16* KS = (const bf16*)(ws + WS_KS); const bf16* VS = (const bf16*)(ws + WS_P) + 1312;
    bf16* OB = (bf16*)(ws + WS_AB);
    const float* sink = Ap->in[17] + l * 8;
    const int nunits = (l == 0) ? 1024 + 64 : 1024;
    for (int u = F.vcu; u < nunits; u += F.G) {
        const bool isl = u < 1024;
        const int i = u >> 8, c = u & 31, b = isl ? ((u & 255) >> 5) : ((u - 1024) >> 3), h = isl ? (2 * i + (c >> 4)) : (u & 7), qb = c & 15;
        att::Unit U; U.Q = QM + h * 96; U.ldq = 768; U.K = KM + h * 96; U.ldk = 768; U.V = VM + h * 64; U.ldv = 512; U.O = OB + h * 64;
        U.qrow0 = isl ? (b * SEQ + qb * 256) : (NLAT + b * CTXL); U.ctx_row0 = NLAT + b * CTXL; U.lat_row0 = b * SEQ; U.nt = isl ? (4 + SEQ / 64) : 4; U.qpos0 = 0; U.kpos0 = 0; U.masked = 0; U.l_init = 0.f;
        att::attn_unit<96, false>(U, lds, F.tid);
    }
    for (int u = F.vcu; u < nunits; u += F.G) {
        const bool isl = u < 1024;
        const int i = u >> 8, c = u & 31, b = isl ? ((u & 255) >> 5) : ((u - 1024) >> 3), h = isl ? (2 * i + (c >> 4)) : (u & 7), qb = c & 15, g = h >> 2;
        const int q0 = qb * 256; int k_lo = q0 - 128; if (k_lo < 0) k_lo = 0; int k_hi = q0 + 256 + 128; if (k_hi > SEQ) k_hi = SEQ;
        att::Unit U; U.Q = QS + h * 64; U.ldq = 512; U.K = KS + g * 64; U.ldk = 128; U.V = VS + g * 64; U.ldv = DIN; U.O = OB + 512 + h * 64;
        U.qrow0 = isl ? (b * SEQ + q0) : (NLAT + b * CTXL); U.ctx_row0 = NLAT + b * CTXL; U.lat_row0 = b * SEQ + k_lo; U.nt = isl ? (4 + (k_hi - k_lo) / 64) : 4; U.qpos0 = q0; U.kpos0 = k_lo; U.masked = 1;
        U.l_init = __builtin_amdgcn_exp2f(sink[h] * LOG2E);
        att::attn_unit<64, true>(U, lds, F.tid);
    }
}

#ifndef DBG_NAIVE_ATTN
#define DBG_NAIVE_ATTN 0
#endif
#if DBG_NAIVE_ATTN
__device__ __forceinline__ void attn_naive_phase(const Frame& F, ArgsP Ap, int l) {
    unsigned char* ws = Ap->ws;
    const bf16* QM = (const bf16*)(ws + WS_QM); const bf16* KM = (const bf16*)(ws + WS_KM); const bf16* VM = (const bf16*)(ws + WS_VM);
    const bf16* QS = (const bf16*)(ws + WS_QS); const bf16* KS = (const bf16*)(ws + WS_KS); const bf16* VS = (const bf16*)(ws + WS_P) + 1312;
    bf16* OB = (bf16*)(ws + WS_AB);
    const float* sink = Ap->in[17] + l * 8;
    const int nrg = ((l == 0) ? NROWS : NLAT) / 64;
    for (int u = F.gw; u < nrg * 8; u += F.ngw) {
        const int h = __builtin_amdgcn_readfirstlane(u & 7), rg = __builtin_amdgcn_readfirstlane(u >> 3), row = rg * 64 + F.lane;
        const bool lat = rg * 64 < NLAT; const int b = lat ? (rg * 64) >> 12 : (rg * 64 - NLAT) >> 8;
        {
            float q[96], o[64]; float lsum = 0.f;
#pragma unroll
            for (int d = 0; d < 96; d += 2) { const unsigned w = *(const unsigned*)(QM + (size_t)row * 768 + h * 96 + d); q[d] = bf_lo(w); q[d + 1] = bf_hi(w); }
#pragma unroll
            for (int d = 0; d < 64; ++d) o[d] = 0.f;
            const int nk = lat ? (CTXL + SEQ) : CTXL;
#pragma unroll 1
            for (int j = 0; j < nk; ++j) { const int kr = (j < CTXL) ? (NLAT + b * CTXL + j) : (b * SEQ + j - CTXL);
                const bf16* kp = KM + (size_t)kr * 768 + h * 96; const bf16* vp = VM + (size_t)kr * 512 + h * 64; float s = 0.f;
#pragma unroll
                for (int d = 0; d < 96; d += 2) { const unsigned w = *(const unsigned*)(kp + d); s = fmaf(q[d], bf_lo(w), s); s = fmaf(q[d + 1], bf_hi(w), s); }
                const float p = exp2f(s); lsum += p;
#pragma unroll
                for (int d = 0; d < 64; d += 2) { const unsigned w = *(const unsigned*)(vp + d); o[d] = fmaf(p, bf_lo(w), o[d]); o[d + 1] = fmaf(p, bf_hi(w), o[d + 1]); } }
            const float rl = 1.f / lsum;
#pragma unroll
            for (int d = 0; d < 64; d += 2) *(unsigned*)(OB + (size_t)row * 1024 + h * 64 + d) = pk2(o[d] * rl, o[d + 1] * rl);
        }
        {
            const int g = h >> 2; const int pos0 = (rg * 64) & (SEQ - 1), pos = pos0 + F.lane;
            float q[64], o[64]; float lsum = exp2f(sink[h] * LOG2E);
#pragma unroll
            for (int d = 0; d < 64; d += 2) { const unsigned w = *(const unsigned*)(QS + (size_t)row * 512 + h * 64 + d); q[d] = bf_lo(w); q[d + 1] = bf_hi(w); }
#pragma unroll
            for (int d = 0; d < 64; ++d) o[d] = 0.f;
            int jlo = pos0 - 128; if (jlo < 0) jlo = 0; int jhi = pos0 + 63 + 128; if (jhi > SEQ - 1) jhi = SEQ - 1;
            const int nk = lat ? (CTXL + (jhi - jlo + 1)) : CTXL;
#pragma unroll 1
            for (int j = 0; j < nk; ++j) { const bool isc = j < CTXL; const int kpos = jlo + j - CTXL; const int kr = isc ? (NLAT + b * CTXL + j) : (b * SEQ + kpos);
                const bf16* kp = KS + (size_t)kr * 128 + g * 64; const bf16* vp = VS + (size_t)kr * DIN + g * 64; float s = 0.f;
#pragma unroll
                for (int d = 0; d < 64; d += 2) { const unsigned w = *(const unsigned*)(kp + d); s = fmaf(q[d], bf_lo(w), s); s = fmaf(q[d + 1], bf_hi(w), s); }
                float p = exp2f(s); if (!isc) { const int dd = kpos - pos; if (dd > 128 || dd < -128) p = 0.f; } lsum += p;
#pragma unroll
                for (int d = 0; d < 64; d += 2) { const unsigned w = *(const unsigned*)(vp + d); o[d] = fmaf(p, bf_lo(w), o[d]); o[d + 1] = fmaf(p, bf_hi(w), o[d + 1]); } }
            const float rl = 1.f / lsum;
#pragma unroll
            for (int d = 0; d < 64; d += 2) *(unsigned*)(OB + (size_t)row * 1024 + 512 + h * 64 + d) = pk2(o[d] * rl, o[d + 1] * rl);
        }
    }
}
#endif
__device__ __forceinline__ unsigned f2key(float f) { const unsigned u = __float_as_uint(f); return (u & 0x80000000u) ? ~u : (u | 0x80000000u); }
__device__ __forceinline__ float key2f(unsigned k) { const unsigned u = (k & 0x80000000u) ? (k & 0x7fffffffu) : ~k; return __uint_as_float(u); }
#define CE_DESC(a, b) do { const unsigned _hi = max(a, b), _lo = min(a, b); a = _hi; b = _lo; } while (0)
__device__ __forceinline__ void sort16_desc(unsigned (&a)[16]) {
#pragma unroll
    for (int k = 2; k <= 16; k <<= 1)
#pragma unroll
        for (int j = k >> 1; j > 0; j >>= 1)
#pragma unroll
            for (int i = 0; i < 16; ++i) { const int p = i ^ j;
                if (p > i) { if ((i & k) == 0) { CE_DESC(a[i], a[p]); } else { CE_DESC(a[p], a[i]); } } }
}
__device__ __forceinline__ void merge16_desc(unsigned (&t)[16], const unsigned (&c)[16]) {
#pragma unroll
    for (int i = 0; i < 16; ++i) t[i] = max(t[i], c[15 - i]);
#pragma unroll
    for (int j = 8; j > 0; j >>= 1)
#pragma unroll
        for (int i = 0; i < 16; ++i) { const int p = i ^ j; if (p > i) CE_DESC(t[i], t[p]); }
}
__device__ __forceinline__ void merge16_partner(unsigned (&t)[16]) {
    unsigned oth[16];
#pragma unroll
    for (int i = 0; i < 16; ++i) oth[i] = (unsigned)__shfl_xor((int)t[i], 32);
    merge16_desc(t, oth);
}

constexpr size_t WS_IDX = WS_P;
constexpr size_t WS_GW = WS_P + (size_t)NROWS * 128 * 2;
constexpr size_t WS_W2 = WS_GW + (size_t)NROWS * 128 * 4;
static_assert(WS_W2 + (size_t)NROWS * 128 * 4 <= WS_X5, "peer lists inside the P region");

__device__ __forceinline__ void topkc_phase(const Frame& F, ArgsP Ap, int l, int nrows, char* lds) {
    unsigned char* ws = Ap->ws;
    const bf16* QP = (const bf16*)(ws + WS_X5);
    const bf16* PK = (const bf16*)(ws + WS_PKEY) + (size_t)l * 16 * 128 * 128;
    unsigned short* IDX = (unsigned short*)(ws + WS_IDX); float* GW = (float*)(ws + WS_GW);
    char* Kl = lds;
    unsigned char* sub = (unsigned char*)(lds + 65536) + F.wave * 1024;
    const int lane = F.lane, r32 = lane & 31, hi = lane >> 5;
    const int nunits = (nrows / 256) * 8;
    for (int u = F.bid; u < nunits; u += F.G) {
        const int h = u & 7, rb = u >> 3;
        __syncthreads();
#pragma unroll
        for (int i = 0; i < 8; ++i) { const int ci = F.tid + 512 * i, krow = ci >> 4, ch = ci & 15;
            const u32x4 v = *(const u32x4*)(PK + ((size_t)(2 * h) * 128 + krow) * 128 + ch * 8);
            *(u32x4*)(Kl + krow * 256 + ((ch * 16) ^ ((krow & 7) << 4))) = v; }
        __syncthreads();
        const int row = rb * 256 + F.wave * 32 + r32;
        const unsigned hi4 = (unsigned)hi << 2, hi7 = (unsigned)hi << 7;
        unsigned t0[16], t1[16];
#pragma unroll
        for (int p = 0; p < 2; ++p) {
            const bf16* qrow = QP + (size_t)row * 2048 + (2 * h + p) * 128 + hi * 8;
            bf16x8 bq[8];
#pragma unroll
            for (int s = 0; s < 8; ++s) bq[s] = *reinterpret_cast<const bf16x8*>(qrow + s * 16);
            unsigned top[16];
#pragma unroll
            for (int blk = 0; blk < 4; ++blk) {
                f32x16 acc = f32x16{};
                const char* kb = Kl + (p * 128 + blk * 32 + r32) * 256;
#pragma unroll
                for (int s = 0; s < 8; ++s) { const bf16x8 ka = *reinterpret_cast<const bf16x8*>(kb + (((s * 16 + hi * 8) * 2) ^ ((r32 & 7) << 4)));
                    acc = __builtin_amdgcn_mfma_f32_32x32x16_bf16(ka, bq[s], acc, 0, 0, 0); }
                unsigned c[16];
#pragma unroll
                for (int r = 0; r < 16; ++r) c[r] = ((f2key(acc[r]) & ~127u) | (unsigned)(127 - (blk * 32 + (r & 3) + 8 * (r >> 2)))) ^ hi4;
                sort16_desc(c);
                if (blk == 0) {
#pragma unroll
                    for (int i = 0; i < 16; ++i) top[i] = c[i];
                } else merge16_desc(top, c);
                __builtin_amdgcn_sched_barrier(0);
            }
            merge16_partner(top);
#pragma unroll
            for (int i = 0; i < 16; ++i) { if (p == 0) t0[i] = top[i]; else t1[i] = top[i]; }
        }
        if (hi == 0) { unsigned* sw = (unsigned*)(sub + r32 * 32);
#pragma unroll
            for (int q = 0; q < 4; ++q) {
                sw[q] = (127u - (t0[4 * q] & 127u)) | ((127u - (t0[4 * q + 1] & 127u)) << 8) | ((127u - (t0[4 * q + 2] & 127u)) << 16) | ((127u - (t0[4 * q + 3] & 127u)) << 24);
                sw[4 + q] = (127u - (t1[4 * q] & 127u)) | ((127u - (t1[4 * q + 1] & 127u)) << 8) | ((127u - (t1[4 * q + 2] & 127u)) << 16) | ((127u - (t1[4 * q + 3] & 127u)) << 24); } }
        float f1[16], fa[8];
#pragma unroll
        for (int i = 0; i < 16; ++i) f1[i] = key2f(t1[i] & ~127u);
#pragma unroll
        for (int i = 0; i < 8; ++i) fa[i] = key2f((hi ? t0[8 + i] : t0[i]) & ~127u);
        unsigned top[16];
#pragma unroll
        for (int i = 0; i < 8; ++i) {
            unsigned c[16];
#pragma unroll
            for (int b = 0; b < 16; ++b) c[b] = ((f2key(fa[i] + f1[b]) & ~255u) | (unsigned)(255 - (16 * i + b))) ^ hi7;
            if (i == 0) {
#pragma unroll
                for (int k = 0; k < 16; ++k) top[k] = c[k];
            } else merge16_desc(top, c);
            __builtin_amdgcn_sched_barrier(0);
        }
        merge16_partner(top);
        asm volatile("s_waitcnt lgkmcnt(0)" ::: "memory");
        float cv[16]; float den = 0.f; const float m = key2f(top[0] & ~255u);
#pragma unroll
        for (int i = 0; i < 16; ++i) { cv[i] = __expf(key2f(top[i] & ~255u) - m); den += cv[i]; }
        const float rden = 1.f / den;
        if (hi == 0) {
            unsigned iw[8];
#pragma unroll
            for (int i = 0; i < 16; i += 2) {
                const int fl0 = 255 - (int)(top[i] & 255u), fl1 = 255 - (int)(top[i + 1] & 255u);
                const unsigned e0 = (unsigned)sub[r32 * 32 + (fl0 >> 4)] * PNK + (unsigned)sub[r32 * 32 + 16 + (fl0 & 15)];
                const unsigned e1 = (unsigned)sub[r32 * 32 + (fl1 >> 4)] * PNK + (unsigned)sub[r32 * 32 + 16 + (fl1 & 15)];
                iw[i >> 1] = e0 | (e1 << 16); }
            u32x4* ip = (u32x4*)(IDX + (size_t)row * 128 + h * 16); ip[0] = (u32x4){iw[0], iw[1], iw[2], iw[3]}; ip[1] = (u32x4){iw[4], iw[5], iw[6], iw[7]};
            f32x4* gp = (f32x4*)(GW + (size_t)row * 128 + h * 16);
#pragma unroll
            for (int q = 0; q < 4; ++q) gp[q] = (f32x4){cv[4 * q] * rden, cv[4 * q + 1] * rden, cv[4 * q + 2] * rden, cv[4 * q + 3] * rden};
        }
    }
}

typedef __bf16 bf16x2_t __attribute__((ext_vector_type(2)));
typedef float f32x2v __attribute__((ext_vector_type(2)));
__device__ __forceinline__ float dot2(unsigned w, unsigned x, float acc) { return __builtin_amdgcn_fdot2_f32_bf16(__builtin_bit_cast(bf16x2_t, w), __builtin_bit_cast(bf16x2_t, x), acc, false); }
__device__ __forceinline__ float dot16(const u32x4 a0, const u32x4 a1, const u32x4 x0, const u32x4 x1) {
    float s0 = dot2(a0.x, x0.x, 0.f), s1 = dot2(a0.y, x0.y, 0.f), s2 = dot2(a0.z, x0.z, 0.f), s3 = dot2(a0.w, x0.w, 0.f);
    s0 = dot2(a1.x, x1.x, s0); s1 = dot2(a1.y, x1.y, s1); s2 = dot2(a1.z, x1.z, s2); s3 = dot2(a1.w, x1.w, s3);
    return (s0 + s1) + (s2 + s3);
}
__device__ __forceinline__ void fma8(float (&o)[8], const u32x4 v, float w) {
    o[0] += w * bf_lo(v.x); o[1] += w * bf_hi(v.x); o[2] += w * bf_lo(v.y); o[3] += w * bf_hi(v.y);
    o[4] += w * bf_lo(v.z); o[5] += w * bf_hi(v.z); o[6] += w * bf_lo(v.w); o[7] += w * bf_hi(v.w);
}

#define DPP_ADD(v, CTRL) ((v) + __builtin_bit_cast(float, __builtin_amdgcn_update_dpp(0, __builtin_bit_cast(int, (v)), (CTRL), 0xF, 0xF, true)))
__device__ __forceinline__ float dpp_sum8(float v) { v = DPP_ADD(v, 0xB1); v = DPP_ADD(v, 0x4E); v = DPP_ADD(v, 0x141); return v; }
__device__ __forceinline__ float dpp_sum16(float v) { v = dpp_sum8(v); v = DPP_ADD(v, 0x140); return v; }
__device__ __forceinline__ float sum_b345(float v) {
    v = DPP_ADD(v, 0x128);
    { unsigned a = __builtin_bit_cast(unsigned, v), b = a; asm volatile("s_nop 1\n\tv_permlane16_swap_b32 %0, %1" : "+v"(a), "+v"(b)); v = __builtin_bit_cast(float, a) + __builtin_bit_cast(float, b); }
    { unsigned a = __builtin_bit_cast(unsigned, v), b = a; asm volatile("s_nop 1\n\tv_permlane32_swap_b32 %0, %1" : "+v"(a), "+v"(b)); v = __builtin_bit_cast(float, a) + __builtin_bit_cast(float, b); }
    return v;
}
__device__ __forceinline__ float gelu_as(float v) {
    const float av = fabsf(v), t = __builtin_amdgcn_rcpf(av * 0.2316418882f + 1.0f);
    float q = t * 0.5307027145f + (-0.7265760135f); q = q * t + 0.7107068705f; q = q * t + (-0.142248368f); q = q * t + 0.127414796f; q = q * t;
    const float e = __builtin_amdgcn_exp2f((v * v) * (-0.72134752044f)); const float m = v * (q * e);
    return v < 0.f ? m : v - m;
}
__device__ __forceinline__ void pu_phase(const Frame& F, ArgsP Ap, int l, int nrows, char* lds, const int pvar) {
    unsigned char* ws = Ap->ws;
    const unsigned short* IDX = (const unsigned short*)(ws + WS_IDX); const float* GW = (const float*)(ws + WS_GW); bf16* W2 = (bf16*)(ws + (pvar ? WS_W2 + (size_t)NROWS * 128 * 2 : WS_W2));
    const bf16* Bx = (const bf16*)(ws + WS_AB);
    const char* Ut = (const char*)((const bf16*)(ws + WS_U) + (size_t)l * PEXP * DM);
    const int lane = F.lane, grp = lane >> 4, li = lane & 15;
    int* l_slot = (int*)(lds + F.wave * 2048); int* l_idx = l_slot + 128; float* l_g = (float*)(l_idx + 128);
    const bool xs = (F.G % 8) == 0;
    const int wv = xs ? ((F.bid >> 3) * 8 + F.wave) : F.gw, nwv = xs ? (F.G >> 3) * 8 : F.ngw, npass = xs ? 2 : 16;
    const unsigned long long lt = (1ull << lane) - 1ull;
    const unsigned lo2 = (unsigned)lane * 4u, li16 = (unsigned)li * 16u;
    for (int pass = 0; pass < npass; ++pass) {
        const int c = xs ? ((F.bid & 7) + 8 * pass) : pass;
        unsigned iw = 0u, iwn = 0u; f32x2v gg = {0.f, 0.f}, ggn = {0.f, 0.f}; u32x4 xv[8], xn[8];
#define PU_LOAD(IW, GG, X, t_) do { IW = *(const unsigned*)((const char*)(IDX + (size_t)(t_) * 128) + lo2); GG = *(const f32x2v*)((const char*)(GW + (size_t)(t_) * 128) + 2 * lo2); \
        const char* xr_ = (const char*)(Bx + (size_t)(t_) * DM); _Pragma("unroll") for (int s = 0; s < 8; ++s) X[s] = *(const u32x4*)(xr_ + s * 256 + li16); } while (0)
        int t = wv;
        if (t < nrows) PU_LOAD(iw, gg, xv, t);
        for (; t < nrows; t += nwv) {
            const int i0 = (int)(iw & 0xffffu), i1 = (int)(iw >> 16); const bool m0 = (i0 >> 10) == c, m1 = (i1 >> 10) == c;
            const unsigned long long b0 = __ballot(m0), b1 = __ballot(m1); const int n = __popcll(b0) + __popcll(b1); const int r0 = __popcll(b0 & lt) + __popcll(b1 & lt);
            if (m0) { l_slot[r0] = 2 * lane; l_idx[r0] = i0; l_g[r0] = gg.x; }
            if (m1) { const int r1 = r0 + (m0 ? 1 : 0); l_slot[r1] = 2 * lane + 1; l_idx[r1] = i1; l_g[r1] = gg.y; }
            if (t + nwv < nrows) PU_LOAD(iwn, ggn, xn, t + nwv);
            asm volatile("s_waitcnt lgkmcnt(0)" ::: "memory");
#pragma unroll 1
            for (int k0 = 0; k0 < n; k0 += 8) {
                const int kA = (k0 + grp < n) ? (k0 + grp) : (n - 1), kB = (k0 + 4 + grp < n) ? (k0 + 4 + grp) : (n - 1);
                const unsigned eA = (pvar == 1) ? ((unsigned)c << 10) : (unsigned)l_idx[kA], eB = (pvar == 1) ? ((unsigned)c << 10) : (unsigned)l_idx[kB];
                const char* uA = Ut + (eA * 2048u + li16); const char* uB = Ut + (eB * 2048u + li16);
                u32x4 ra[8], rb[8];
#pragma unroll
                for (int s = 0; s < 8; ++s) ra[s] = *(const u32x4*)(uA + s * 256);
#pragma unroll
                for (int s = 0; s < 8; ++s) rb[s] = *(const u32x4*)(uB + s * 256);
                float dA0 = 0.f, dA1 = 0.f, dB0 = 0.f, dB1 = 0.f;
#pragma unroll
                for (int s = 0; s < 8; ++s) { dA0 = dot2(ra[s].x, xv[s].x, dA0); dA1 = dot2(ra[s].y, xv[s].y, dA1); dA0 = dot2(ra[s].z, xv[s].z, dA0); dA1 = dot2(ra[s].w, xv[s].w, dA1); }
#pragma unroll
                for (int s = 0; s < 8; ++s) { dB0 = dot2(rb[s].x, xv[s].x, dB0); dB1 = dot2(rb[s].y, xv[s].y, dB1); dB0 = dot2(rb[s].z, xv[s].z, dB0); dB1 = dot2(rb[s].w, xv[s].w, dB1); }
                const float aA = dpp_sum16(dA0 + dA1), aB = dpp_sum16(dB0 + dB1);
                if (li == 0) {
                    if (k0 + grp < n) W2[(size_t)t * 128 + l_slot[kA]] = (bf16)(pk2(l_g[kA] * gelu_as(aA), 0.f) & 0xffffu);
                    if (k0 + 4 + grp < n) W2[(size_t)t * 128 + l_slot[kB]] = (bf16)(pk2(l_g[kB] * gelu_as(aB), 0.f) & 0xffffu);
                }
            }
            iw = iwn; gg = ggn;
#pragma unroll
            for (int s = 0; s < 8; ++s) xv[s] = xn[s];
        }
#undef PU_LOAD
    }
}

__device__ __forceinline__ void pv_phase(const Frame& F, ArgsP Ap, int l, int nrows, const bool dry, char* lds) {
    unsigned char* ws = Ap->ws;
    const unsigned short* IDX = (const unsigned short*)(ws + WS_IDX); const bf16* W2 = (const bf16*)(ws + WS_W2);
    const bf16* Vt = (const bf16*)(ws + WS_V) + (size_t)l * PEXP * DM;
    const float* MOD = (const float*)(ws + WS_MOD) + (size_t)l * 9 * 6144 + 5 * DM;
    float* hlat = Ap->out; float* hctx = (float*)(ws + WS_HCTX);
    float* g2l = (float*)lds;
    const int lane = F.lane, sub = lane >> 3, dch = lane & 7;
    const bool xs = (F.G % 8) == 0;
    const int wv = xs ? ((F.bid >> 3) * 8 + F.wave) : F.gw, nwv = xs ? (F.G >> 3) * 8 : F.ngw, npass = xs ? 2 : 16;
    for (int pass = 0; pass < npass; ++pass) {
        const int s = xs ? ((F.bid & 7) + 8 * pass) : pass;
        const char* vslice = (const char*)(Vt + (size_t)s * PEXP * 64);
        const unsigned dchb = (unsigned)dch * 16u, coffb = (unsigned)(s * 64 + dch * 8) * 4u, subo = (unsigned)sub * 32u;
        __syncthreads();
        for (int i = F.tid; i < 9 * 64; i += 512) g2l[i] = MOD[(size_t)(i >> 6) * 6144 + s * 64 + (i & 63)];
        __syncthreads();
        u32x4 ia0, ib0, ia1, ib1, rA[8], rB[8], wA, wB; f32x4 ha, hb; float o_[8];
#define PV_IDX(IA, IB, t_) do { const char* ib_ = (const char*)(IDX + (size_t)(t_) * 128); IA = *(const u32x4*)(ib_ + subo); IB = *(const u32x4*)(ib_ + subo + 16u); } while (0)
#define PV_ROWS8(R, I) do { const unsigned iw_[4] = {I.x, I.y, I.z, I.w}; \
            _Pragma("unroll") for (int it = 0; it < 8; ++it) { const unsigned e_ = (it & 1) ? (iw_[it >> 1] >> 16) : (iw_[it >> 1] & 0xffffu); R[it] = *(const u32x4*)(vslice + (e_ * 128u + dchb)); } } while (0)
#define PV_ROWSA(IA, t_) do { PV_ROWS8(rA, IA); wA = *(const u32x4*)((const char*)(W2 + (size_t)(t_) * 128) + subo); } while (0)
#define PV_ROWSB(IB, t_) do { PV_ROWS8(rB, IB); wB = *(const u32x4*)((const char*)(W2 + (size_t)(t_) * 128) + subo + 16u); \
            { const char* hr_ = (const char*)(((t_) < NLAT) ? (hlat + (size_t)(t_) * DM) : (hctx + (size_t)((t_) - NLAT) * DM));     \
              ha = *(const f32x4*)(hr_ + coffb); hb = *(const f32x4*)(hr_ + coffb + 16u); } } while (0)
#define PV_SUM8(R, W) do { const unsigned ww_[4] = {W.x, W.y, W.z, W.w}; _Pragma("unroll") for (int it = 0; it < 8; ++it) fma8(o_, R[it], (it & 1) ? bf_hi(ww_[it >> 1]) : bf_lo(ww_[it >> 1])); } while (0)
#define PV_FINA() do { _Pragma("unroll") for (int i = 0; i < 8; ++i) o_[i] = 0.f; PV_SUM8(rA, wA); } while (0)
#define PV_FINB(t_) do { PV_SUM8(rB, wB); \
            _Pragma("unroll") for (int i = 0; i < 8; ++i) o_[i] = sum_b345(o_[i]); \
            { const bool lat_ = (t_) < NLAT; float* hr_ = (float*)((char*)(lat_ ? (hlat + (size_t)(t_) * DM) : (hctx + (size_t)((t_) - NLAT) * DM)) + coffb); \
                const float* g2_ = g2l + (lat_ ? ((t_) >> 12) : 8) * 64 + dch * 8; const f32x4 ga_ = *(const f32x4*)g2_, gb_ = *(const f32x4*)(g2_ + 4); \
                  \
                *(f32x4*)hr_ = ha + ga_ * (f32x4){o_[0], o_[1], o_[2], o_[3]}; *(f32x4*)(hr_ + 4) = hb + gb_ * (f32x4){o_[4], o_[5], o_[6], o_[7]}; } } while (0)
        int t = wv;
        if (t < nrows) { PV_IDX(ia0, ib0, t); PV_ROWSA(ia0, t); }
        for (; t + 2 * nwv < nrows; t += 2 * nwv) {
            PV_IDX(ia1, ib1, t + nwv);     PV_ROWSB(ib0, t);       PV_FINA(); PV_ROWSA(ia1, t + nwv);     PV_FINB(t);
            PV_IDX(ia0, ib0, t + 2 * nwv); PV_ROWSB(ib1, t + nwv); PV_FINA(); PV_ROWSA(ia0, t + 2 * nwv); PV_FINB(t + nwv);
        }
        for (; t < nrows; t += 2 * nwv) {
            const int t1 = t + nwv;
            if (t1 < nrows) PV_IDX(ia1, ib1, t1);
            PV_ROWSB(ib0, t); PV_FINA();
            if (t1 < nrows) PV_ROWSA(ia1, t1);
            PV_FINB(t);
            if (t1 < nrows) { PV_ROWSB(ib1, t1); PV_FINA(); PV_FINB(t1); }
        }
#undef PV_IDX
#undef PV_ROWS8
#undef PV_ROWSA
#undef PV_ROWSB
#undef PV_SUM8
#undef PV_FINA
#undef PV_FINB
    }
}
constexpr int PH_PER_LAYER = 12, N_PHASES = 1 + DEPTH * PH_PER_LAYER;
#ifndef MK_ONE_LAUNCH
#define MK_ONE_LAUNCH 0
#endif
#ifndef MK_MASK
#define MK_MASK 0x1FFF
#endif
#define PON(s) (((MK_MASK) >> (s)) & 1)

#ifndef DBG_NAIVE_GEMM
#define DBG_NAIVE_GEMM 0
#endif
#if DBG_NAIVE_GEMM
__device__ __forceinline__ void naive_gemm(const Frame& F, const pg8::Gemm g, int kind, const pg8::EpiStore es, const pg8::EpiResid er) {
    const int ncg = g.N / 64; const int nunits = g.M * ncg;
    for (int u = F.gw; u < nunits; u += F.ngw) {
        const int row = __builtin_amdgcn_readfirstlane(u / ncg), col = (u % ncg) * 64 + F.lane;
        const bf16* ar = g.A + (size_t)row * g.K; const bf16* br = g.Bt + (size_t)col * g.K; float acc = 0.f;
#pragma unroll 1
        for (int k = 0; k < g.K; k += 8) { const u32x4 a = *(const u32x4*)(ar + k), b = *(const u32x4*)(br + k); float x[8], y[8]; unpack8(a, x); unpack8(b, y);
#pragma unroll
            for (int e = 0; e < 8; ++e) acc = fmaf(x[e], y[e], acc); }
        if (kind == 0) { if (col < es.ncols) es.O[(size_t)row * es.ldc + col] = (bf16)(pk2(acc, 0.f) & 0xffffu); }
        else if (kind == 1) { const int head = col >> 7, j = col & 127; bf16* d = (j < 64) ? (es.O + (size_t)row * 768 + head * 96 + j) : (es.VM + (size_t)row * 512 + head * 64 + (j - 64)); *d = (bf16)(pk2(acc, 0.f) & 0xffffu); }
        else { const bool lat = row < er.nlat; const int sample = lat ? (row >> 12) : 8;
            const float* src = lat ? er.hin_lat + (size_t)row * 1024 : er.hin_ctx + (size_t)(row - er.nlat) * 1024; float* dst = lat ? er.hout_lat + (size_t)row * 1024 : er.hout_ctx + (size_t)(row - er.nlat) * 1024;
            dst[col] = src[col] + er.gate[(size_t)sample * 6144 + col] * acc; }
    }
}
#endif

__global__ void __launch_bounds__(512, 2) mk_fwd(Args args_unused) {
    extern __shared__ __attribute__((aligned(16))) unsigned char lds[];
    LAS unsigned char* lds3 = (LAS unsigned char*)lds;
    ArgsP args0 = (ArgsP)__builtin_amdgcn_kernarg_segment_ptr();
    const int ph_lo = args0->ph_lo, ph_hi = args0->ph_hi;
    const int wave_s = __builtin_amdgcn_readfirstlane((int)threadIdx.x >> 6);
#if MK_ONE_LAUNCH == 2
    {
        volatile LAS unsigned* st = (volatile LAS unsigned*)(lds3 + LDS_BYTES - 64);
        if (threadIdx.x < 2) st[threadIdx.x] = 0u;
        __syncthreads();
        (void)xcd_barrier_post((unsigned*)(args0->ws + WS_CTL), st, threadIdx.x == 0);
    }
#endif
#pragma unroll 1
    for (int pi = ph_lo; pi < ph_hi; ++pi) {
        int zv = 0; asm volatile("" : "+v"(zv));
        ArgsP args = args0; asm volatile("" : "+s"(args));
        Frame F;
        F.zv = zv; F.lane = (int)__builtin_amdgcn_mbcnt_hi(~0u, __builtin_amdgcn_mbcnt_lo(~0u, 0u)) + zv; F.wave = wave_s; F.tid = wave_s * 64 + F.lane;
        { int bx = blockIdx.x, gd = gridDim.x; asm volatile("" : "+s"(bx), "+s"(gd)); F.bid = bx; F.G = gd; F.vcu = (gd % 8 == 0) ? (bx % 8) * (gd / 8) + bx / 8 : bx; }
        F.gw = F.bid * 8 + F.wave; F.ngw = F.G * 8;
        unsigned char* ws = args->ws;
        const int phraw = args->prog[pi], ph = phraw & 63, pvar = phraw >> 6;
        int njobs = 0, jkind = 0;
        pg8::Gemm gj[2]; pg8::EpiStore ej[2];
        int l = 0, mrows = NROWS;
        if (ph == 0) { if (PON(12)) p0_prologue(F, args, lds3); }
        else {
            const int q = ph - 1, s = q % PH_PER_LAYER; l = q / PH_PER_LAYER;
            mrows = (l == DEPTH - 1) ? NLAT : NROWS;
            switch (s) {
            case 0: if (PON(0)) norm_mod_phase(F, args, l, 0, NROWS); break;
            case 1: if (PON(1)) { njobs = 1;
                gj[0] = pg8::Gemm{(const bf16*)(ws + WS_AB), (const bf16*)(ws + WS_WIN) + (size_t)l * DINP * DM, NROWS, DINP, DM};
                ej[0] = pg8::EpiStore{0, (bf16*)(ws + WS_P), DIN, DIN, nullptr}; } break;
            case 2: if (PON(2)) e2_phase(F, args, l, NROWS); break;
            case 3: if (PON(3)) { njobs = 2;
                gj[0] = pg8::Gemm{(const bf16*)(ws + WS_AB), (const bf16*)(ws + WS_WUQ) + (size_t)l * 768 * QRANK, NROWS, 768, QRANK};
                ej[0] = pg8::EpiStore{0, (bf16*)(ws + WS_QM), 768, 768, nullptr};
                gj[1] = pg8::Gemm{(const bf16*)(ws + WS_AB) + (size_t)NROWS * QRANK, (const bf16*)(ws + WS_WUKV) + (size_t)l * 1024 * KVRANK, NROWS, 1024, KVRANK};
                ej[1] = pg8::EpiStore{1, (bf16*)(ws + WS_KM), 768, 1024, (bf16*)(ws + WS_VM)}; } break;
            case 4: if (PON(4)) e3_phase(F, args, l, NROWS); break;
            case 5: if (PON(5)) {
#if DBG_NAIVE_ATTN
                attn_naive_phase(F, args, l);
#else
                attn_phase(F, args, l, (char*)lds);
#endif
                } break;
            case 6: if (PON(6)) { njobs = 1; jkind = 1;
                gj[0] = pg8::Gemm{(const bf16*)(ws + WS_AB), (const bf16*)(ws + WS_WOUT) + (size_t)l * DM * DM, mrows, DM, DM}; } break;
            case 7: if (PON(7)) norm_mod_phase(F, args, l, 1, mrows); break;
            case 8: if (PON(8)) { njobs = 1;
                gj[0] = pg8::Gemm{(const bf16*)(ws + WS_AB), (const bf16*)(ws + WS_PWQ) + (size_t)l * 2048 * DM, mrows, 2048, DM};
                ej[0] = pg8::EpiStore{0, (bf16*)(ws + WS_X5), 2048, 2048, nullptr}; } break;
            case 9: if (PON(9)) topkc_phase(F, args, l, mrows, (char*)lds); break;
            case 10: if (PON(10)) pu_phase(F, args, l, mrows, (char*)lds, pvar); break;
            default: if (PON(11)) pv_phase(F, args, l, mrows, false, (char*)lds); break;
            }
        }
        if (njobs > 0) {
#if DBG_NAIVE_GEMM
            { const pg8::EpiResid ER{(l == 0) ? args->in[0] : args->out, args->in[2], args->out, (float*)(ws + WS_HCTX), (const float*)(ws + WS_MOD) + (size_t)l * 9 * 6144 + 2 * DM, NLAT};
              _Pragma("unroll 1") for (int j = 0; j < njobs; ++j) { const pg8::Gemm g = (j == 0) ? gj[0] : gj[1]; const pg8::EpiStore E = (j == 0) ? ej[0] : ej[1]; naive_gemm(F, g, jkind ? 2 : E.mode, E, ER); } }
#else
            if (jkind == 0) {
#pragma unroll 1
                for (int j = 0; j < njobs; ++j) { __syncthreads();
                    const pg8::Gemm g = (j == 0) ? gj[0] : gj[1]; const pg8::EpiStore E = (j == 0) ? ej[0] : ej[1];
                    pg8::StaticOrder S; S.init(g.M, g.N, F.G, F.bid);
                    pg8::gemm_phase<pg8::EpiStore, pg8::StaticOrder, true, true>(lds3, g, S, E, F.tid); }
            } else { __syncthreads();
                const pg8::Gemm g = gj[0];
                pg8::StaticOrder S; S.init(g.M, g.N, F.G, F.bid);
                pg8::EpiResid E{(l == 0) ? args->in[0] : args->out, args->in[2], args->out, (float*)(ws + WS_HCTX), (const float*)(ws + WS_MOD) + (size_t)l * 9 * 6144 + 2 * DM, NLAT};
                pg8::gemm_phase<pg8::EpiResid, pg8::StaticOrder, true, true>(lds3, g, S, E, F.tid); }
#endif
        }
#if MK_ONE_LAUNCH == 1
        if (pi + 1 < ph_hi) cg::this_grid().sync();
#elif MK_ONE_LAUNCH == 2
        if (pi + 1 < ph_hi) { XcdBarrier xb; xb.bar = (unsigned*)(ws + WS_CTL); xb.x = xb_xcc_id(); xb.st = (volatile LAS unsigned*)(lds3 + LDS_BYTES - 64); xcd_barrier(xb, F.tid == 0); }
#endif
    }
}

extern "C" void kernel_launch(void* const* d_in, const int* in_sizes, int n_in, void* d_out, int out_size, void* d_ws, size_t ws_size, hipStream_t stream) {
    static int grid = 0;
    if (grid == 0) {
        if (n_in != 23 || in_sizes[0] != NLAT * DM || out_size != NLAT * DM || ws_size < WS_END) {
            fprintf(stderr, "kernel_launch: unexpected shapes: n_in %d in0 %d out %d ws %zu (need %zu)\n", n_in, n_in > 0 ? in_sizes[0] : -1, out_size, ws_size, (size_t)WS_END); grid = -1; return; }
        int dev = 0, cus = 0, per_cu = 0;
        if (hipGetDevice(&dev) != hipSuccess || hipDeviceGetAttribute(&cus, hipDeviceAttributeMultiprocessorCount, dev) != hipSuccess) { fprintf(stderr, "kernel_launch: device query failed\n"); grid = -1; return; }
        if (hipFuncSetAttribute((const void*)mk_fwd, hipFuncAttributeMaxDynamicSharedMemorySize, LDS_BYTES) != hipSuccess) { fprintf(stderr, "kernel_launch: hipFuncSetAttribute failed\n"); grid = -1; return; }
        if (hipOccupancyMaxActiveBlocksPerMultiprocessor(&per_cu, (const void*)mk_fwd, 512, LDS_BYTES) != hipSuccess || per_cu < 1) { fprintf(stderr, "kernel_launch: occupancy query says %d\n", per_cu); per_cu = 1; }
        (void)hipGetLastError();
        grid = cus;
    }
    if (grid < 0) return;
    Args a{};
    for (int i = 0; i < 23; ++i) a.in[i] = (const float*)d_in[i];
    a.out = (float*)d_out; a.ws = (unsigned char*)d_ws;
    int np = 0;
#ifdef MK_PROG
    { static const int pr[] = {MK_PROG}; for (int i = 0; i < (int)(sizeof(pr) / sizeof(pr[0])); ++i) a.prog[np++] = (unsigned char)pr[i]; }
#else
    for (int p = 0; p < N_PHASES; ++p) a.prog[np++] = (unsigned char)p;
#endif
#if MK_ONE_LAUNCH == 2
    a.ph_lo = 0; a.ph_hi = np;
    if (hipMemsetAsync((char*)d_ws + WS_CTL, 0, CTL_ZERO_BYTES, stream) != hipSuccess) { fprintf(stderr, "kernel_launch: hipMemsetAsync of the barrier words failed\n"); return; }
    hipLaunchKernelGGL(mk_fwd, dim3(grid), dim3(512), LDS_BYTES, stream, a);
    { const hipError_t le = hipPeekAtLastError(); if (le != hipSuccess) fprintf(stderr, "kernel_launch: launch failed: %s\n", hipGetErrorName(le)); }
#elif MK_ONE_LAUNCH == 1
    a.ph_lo = 0; a.ph_hi = np;
    void* kargs[] = {&a};
    hipError_t e = hipLaunchCooperativeKernel((const void*)mk_fwd, dim3(grid), dim3(512), kargs, LDS_BYTES, stream);
    if (e != hipSuccess) fprintf(stderr, "kernel_launch: cooperative launch failed: %s (grid %d)\n", hipGetErrorString(e), grid);
#else
    for (int p = 0; p < np; ++p) {
        a.ph_lo = p; a.ph_hi = p + 1;
        hipLaunchKernelGGL(mk_fwd, dim3(grid), dim3(512), LDS_BYTES, stream, a);
    }
    const hipError_t le = hipPeekAtLastError();
    if (le != hipSuccess) fprintf(stderr, "kernel_launch: launch failed: %s\n", hipGetErrorName(le));
#endif
}
```

```cpp
#define MK_ONE_LAUNCH 2
#define DBG_PRECISE_TOPK 0
#define DBG_NAIVE_ATTN 0
#define DBG_PRECISE_PEER 0
#define DBG_NAIVE_GEMM 0
#define DBG_ASCALE 1.0f
#define DBG_PSCALE 1.0f
#include <hip/hip_runtime.h>
#include <hip/hip_cooperative_groups.h>
#include <cstdio>
#include <cstdint>
#include <cmath>
namespace cg = cooperative_groups;
namespace pg8 {
#define PG8_LAS __attribute__((address_space(3)))
typedef unsigned short bf16_t;
typedef short bf16x8 __attribute__((ext_vector_type(8)));
typedef float f32x4 __attribute__((ext_vector_type(4)));
typedef unsigned u32x4 __attribute__((ext_vector_type(4)));
constexpr int BM = 256, BK = 64, HALF = 128, HTB = HALF * BK * 2  , STAGE_BYTES = 8 * HTB, NXCD = 8, WGM = 8;

__host__ __device__ __forceinline__ int lds_byte(int r, int c) { const int st = (r >> 4) * 2 + (c >> 5), rr = r & 15, cc = c & 31, ob = rr * 64 + cc * 2; return st * 1024 + (ob ^ (((ob >> 9) & 1) << 5)); }
__host__ __device__ __forceinline__ void stage_rc(int b, int& R, int& C) { const int st = b / 1024, sb = b % 1024, swz = sb ^ (((sb >> 9) & 1) << 5); R = (st >> 1) * 16 + swz / 64; C = (st & 1) * 32 + (swz % 64) / 2; }
__host__ __device__ __forceinline__ int perm32(int rho) { const int n = rho >> 4, i = rho & 15; return 8 * (i >> 2) + 4 * n + (i & 3); }

struct Unit { int pm, pn; };
struct Gemm { const bf16_t* A; const bf16_t* Bt; int M, N, K; };

struct StaticOrder {
    int nM, nN, nwg, G, c;
    __host__ __device__ void init(int M, int N, int G_, int c_) { nM = M / BM; nN = N / BM; nwg = nM * nN; G = G_; c = c_; }
    __host__ __device__ bool next(int i, Unit& u) const {
        const long L = (long)i * G + c; if (L >= nwg) return false;
        int wgid = (int)L; { const int q = nwg / NXCD, r = nwg % NXCD, xcd = wgid % NXCD, off = wgid / NXCD; wgid = (xcd < r ? xcd * (q + 1) : r * (q + 1) + (xcd - r) * q) + off; }
        const int nig = WGM * nN, gid = wgid / nig, fm = gid * WGM, gsz = (nM - fm) < WGM ? (nM - fm) : WGM;
        u.pm = fm + ((wgid % nig) % gsz); u.pn = (wgid % nig) / gsz; return true;
    }
    __device__ __forceinline__ void a_ready(const Unit&) const {}
    __device__ __forceinline__ void done(const Unit&) const {}
};

__device__ __forceinline__ unsigned cvt_pk_bf16(float lo, float hi) { unsigned r; asm volatile("v_cvt_pk_bf16_f32 %0, %1, %2" : "=v"(r) : "v"(lo), "v"(hi)); return r; }
typedef float f32x2 __attribute__((ext_vector_type(2)));
typedef unsigned u32x2 __attribute__((ext_vector_type(2)));
#ifndef DBG_ASCALE
#define DBG_ASCALE 1.0f
#endif
#ifndef DBG_PSCALE
#define DBG_PSCALE 1.0f
#endif
struct EpiStore {
    static constexpr bool PERM = true, AFTER_DRAIN = false;
    int mode; bf16_t* O; int ldc; int ncols; bf16_t* VM;
    __device__ __forceinline__ void operator()(const f32x4 (&acc)[2][2][4][2], const Unit& u, int wr, int wc, int fr, int fq) const {
        const int row0 = u.pm * BM + wr * 64 + fr;
        bf16_t* base; int rstride, hstride; bool on0, on1;
        if (mode == 0) { const int col0 = u.pn * BM + wc * 32 + 8 * fq; base = O + (size_t)row0 * ldc + col0; rstride = ldc; hstride = HALF; on0 = col0 < ncols; on1 = col0 + HALF < ncols; }
        else {
            const int j = wc * 32 + 8 * fq; const bool isk = wc < 2;
            base = isk ? (O + (size_t)row0 * 768 + (2 * u.pn) * 96 + j) : (VM + (size_t)row0 * 512 + (2 * u.pn) * 64 + (j - 64));
            rstride = isk ? 768 : 512; hstride = isk ? 96 : 64; on0 = true; on1 = true; }
#pragma unroll
        for (int ai = 0; ai < 2; ++ai)
#pragma unroll
            for (int m = 0; m < 4; ++m) { bf16_t* rowp = base + (size_t)(ai * HALF + m * 16) * rstride;
#pragma unroll
                for (int bj = 0; bj < 2; ++bj) {
                    if (bj == 0 ? on0 : on1) { const f32x4 v0 = acc[ai][bj][m][0], v1 = acc[ai][bj][m][1]; u32x4 w;
                        w.x = cvt_pk_bf16(v0[0], v0[1]); w.y = cvt_pk_bf16(v0[2], v0[3]); w.z = cvt_pk_bf16(v1[0], v1[1]); w.w = cvt_pk_bf16(v1[2], v1[3]);
                        *(u32x4*)(rowp + bj * hstride) = w; } } }
    }
};
struct EpiResid {
    static constexpr bool PERM = false, AFTER_DRAIN = false;
    const float* hin_lat; const float* hin_ctx; float* hout_lat; float* hout_ctx; const float* gate; int nlat;
    __device__ __forceinline__ void operator()(const f32x4 (&acc)[2][2][4][2], const Unit& u, int wr, int wc, int fr, int fq) const {
        const int rowt = u.pm * BM; const bool lat = rowt < nlat; const int sample = lat ? (rowt >> 12) : 8;
        const float* src = lat ? hin_lat + (size_t)rowt * 1024 : hin_ctx + (size_t)(rowt - nlat) * 1024;
        float* dst = lat ? hout_lat + (size_t)rowt * 1024 : hout_ctx + (size_t)(rowt - nlat) * 1024;
        const float* g = gate + (size_t)sample * 6144;
        const int col0 = u.pn * BM + wc * 32 + 4 * fq;
#pragma unroll
        for (int bj = 0; bj < 2; ++bj)
#pragma unroll
            for (int n = 0; n < 2; ++n) { const int c = col0 + bj * HALF + n * 16; const f32x4 gv = *(const f32x4*)(g + c);
#pragma unroll
                for (int ai = 0; ai < 2; ++ai)
#pragma unroll
                    for (int m = 0; m < 4; ++m) { const size_t off = (size_t)(ai * HALF + wr * 64 + m * 16 + fr) * 1024 + c;
                        const f32x4 hv = *(const f32x4*)(src + off); *(f32x4*)(dst + off) = hv + gv * acc[ai][bj][m][n] * (float)(DBG_ASCALE); } }
    }
};
template <class Epi, class Sched, bool ALIGN_EPI = false, bool SP2 = false>
__device__ __forceinline__ void gemm_phase(PG8_LAS unsigned char* lds, const Gemm g, const Sched& S, const Epi& E, const int tid_in) {
    const int tid = tid_in, wid = __builtin_amdgcn_readfirstlane(tid >> 6), lane = tid & 63, wr = wid >> 2, wc = wid & 3, fr = lane & 15, fq = lane >> 4;
    const int K = g.K, nt = K / BK;
    unsigned voffA[2], voffB[2];
#pragma unroll
    for (int i = 0; i < 2; ++i) { int R, C; stage_rc(tid * 16 + i * 8192, R, C); const int Rb = Epi::PERM ? ((R & ~31) + perm32(R & 31)) : R;
        voffA[i] = (unsigned)(R * K + C) * 2u; voffB[i] = (unsigned)(Rb * K + C) * 2u; }
    const size_t kstep = (size_t)(BK * 2);
    const size_t hstep = (size_t)HALF * K * 2;
    const size_t tstep = 2 * hstep;
    const unsigned ldsw = (unsigned)wid * 1024u;
    const int aoff = lds_byte(wr * 64 + fr, fq * 8), boff = lds_byte(wc * 32 + fr, fq * 8);
#define PG8_SA(b, h) (((b) * 2 + (h)) * HTB)
#define PG8_SB(b, h) ((4 + (b) * 2 + (h)) * HTB)
#define PG8_STAGE(bufoff, gbase, voff) do { _Pragma("unroll") for (int _i = 0; _i < 2; ++_i) \
        __builtin_amdgcn_global_load_lds((const unsigned*)((const char*)(gbase) + (voff)[_i]), (PG8_LAS unsigned*)(lds + (bufoff) + ldsw + _i * 8192), 16, 0, 0); } while (0)
#define PG8_LDA(dst, b, h) do { _Pragma("unroll") for (int m = 0; m < 4; ++m) _Pragma("unroll") for (int k = 0; k < 2; ++k) dst[m][k] = *(const PG8_LAS bf16x8*)(lds + PG8_SA(b, h) + aoff + m * 2048 + k * 1024); } while (0)
#define PG8_LDB(dst, b, h) do { _Pragma("unroll") for (int n = 0; n < 2; ++n) _Pragma("unroll") for (int k = 0; k < 2; ++k) dst[n][k] = *(const PG8_LAS bf16x8*)(lds + PG8_SB(b, h) + boff + n * 2048 + k * 1024); } while (0)
#define PG8_MMA(ai, bj, At, Bt) do { __builtin_amdgcn_s_setprio(1); _Pragma("unroll") for (int m = 0; m < 4; ++m) _Pragma("unroll") for (int n = 0; n < 2; ++n) _Pragma("unroll") for (int k = 0; k < 2; ++k) \
        acc[ai][bj][m][n] = __builtin_amdgcn_mfma_f32_16x16x32_bf16(Bt[n][k], At[m][k], acc[ai][bj][m][n], 0, 0, 0); __builtin_amdgcn_s_setprio(0); } while (0)
#define PG8_WAIT_V(n) asm volatile("s_waitcnt vmcnt(" #n ")" ::: "memory")
#define PG8_WAIT_L(n) asm volatile("s_waitcnt lgkmcnt(" #n ")" ::: "memory")
#define PG8_BAR __builtin_amdgcn_s_barrier()
#define PG8_SCHED __builtin_amdgcn_sched_barrier(0)
    Unit cur, nxt; int ui = 0;
    if (!S.next(0, cur)) return;
    f32x4 acc[2][2][4][2];
#pragma unroll
    for (int a = 0; a < 2; ++a)
#pragma unroll
        for (int b = 0; b < 2; ++b)
#pragma unroll
            for (int m = 0; m < 4; ++m)
#pragma unroll
                for (int n = 0; n < 2; ++n) acc[a][b][m][n] = (f32x4){0.f, 0.f, 0.f, 0.f};
    bf16x8 At[4][2], B0[2][2], B1[2][2];
    const char* cA = (const char*)g.A + (size_t)cur.pm * tstep; const char* cB = (const char*)g.Bt + (size_t)cur.pn * tstep;
    S.a_ready(cur);
    if constexpr (SP2) {
        PG8_STAGE(PG8_SB(0, 0), cB, voffB); PG8_STAGE(PG8_SB(0, 1), cB + hstep, voffB); PG8_STAGE(PG8_SA(0, 0), cA, voffA); PG8_STAGE(PG8_SA(0, 1), cA + hstep, voffA);
        if (wr == 1) PG8_BAR;
        PG8_WAIT_V(2); PG8_BAR;
        PG8_STAGE(PG8_SB(1, 0), cB + kstep, voffB); PG8_STAGE(PG8_SA(1, 0), cA + kstep, voffA); PG8_STAGE(PG8_SB(1, 1), cB + hstep + kstep, voffB);
        PG8_WAIT_V(6); PG8_BAR;
    } else {
        PG8_STAGE(PG8_SB(0, 0), cB, voffB); PG8_STAGE(PG8_SA(0, 0), cA, voffA); PG8_STAGE(PG8_SB(0, 1), cB + hstep, voffB); PG8_STAGE(PG8_SA(0, 1), cA + hstep, voffA);
        if (wr == 1) PG8_BAR;
        PG8_WAIT_V(4); PG8_BAR;
        PG8_STAGE(PG8_SB(1, 0), cB + kstep, voffB); PG8_STAGE(PG8_SA(1, 0), cA + kstep, voffA); PG8_STAGE(PG8_SB(1, 1), cB + hstep + kstep, voffB);
        PG8_WAIT_V(6); PG8_BAR;
    }
    for (;;) {
        const bool has_next = S.next(ui + 1, nxt);
        const char* nA = has_next ? (const char*)g.A + (size_t)nxt.pm * tstep : cA; const char* nB = has_next ? (const char*)g.Bt + (size_t)nxt.pn * tstep : cB;
        _Pragma("unroll 1") for (int t = 0; t < nt; t += 2) {
            const bool last = (t == nt - 2);
            const char* a1 = cA + (size_t)(t + 1) * kstep;
            const char* a2 = last ? nA : cA + (size_t)(t + 2) * kstep; const char* b2 = last ? nB : cB + (size_t)(t + 2) * kstep;
            const char* a3 = a2 + kstep; const char* b3 = b2 + kstep;
            if (last && has_next) S.a_ready(nxt);
            if constexpr (SP2) {
            PG8_LDB(B0, 0, 0); PG8_LDB(B1, 0, 1); PG8_SCHED; PG8_LDA(At, 0, 0); PG8_STAGE(PG8_SA(1, 1), a1 + hstep, voffA);
            PG8_WAIT_V(8); PG8_WAIT_L(0); PG8_BAR; PG8_MMA(0, 0, At, B0); PG8_MMA(0, 1, At, B1); PG8_BAR; PG8_SCHED;
            PG8_LDA(At, 0, 1); PG8_STAGE(PG8_SB(0, 0), b2, voffB); PG8_STAGE(PG8_SB(0, 1), b2 + hstep, voffB); PG8_STAGE(PG8_SA(0, 0), a2, voffA);
            PG8_WAIT_V(8); PG8_WAIT_L(0); PG8_BAR; PG8_MMA(1, 0, At, B0); PG8_MMA(1, 1, At, B1); PG8_BAR; PG8_SCHED;
            PG8_LDB(B0, 1, 0); PG8_LDB(B1, 1, 1); PG8_SCHED; PG8_LDA(At, 1, 0); PG8_STAGE(PG8_SA(0, 1), a2 + hstep, voffA);
            PG8_WAIT_V(8); PG8_WAIT_L(0); PG8_BAR; PG8_MMA(0, 0, At, B0); PG8_MMA(0, 1, At, B1); PG8_BAR; PG8_SCHED;
            PG8_LDA(At, 1, 1); PG8_STAGE(PG8_SB(1, 0), b3, voffB); PG8_STAGE(PG8_SB(1, 1), b3 + hstep, voffB); PG8_STAGE(PG8_SA(1, 0), a3, voffA);
            PG8_WAIT_V(8); PG8_WAIT_L(0); PG8_BAR; PG8_MMA(1, 0, At, B0); PG8_MMA(1, 1, At, B1); PG8_BAR; PG8_SCHED;
            } else {
            PG8_LDB(B0, 0, 0); PG8_SCHED; PG8_LDA(At, 0, 0); PG8_STAGE(PG8_SA(1, 1), a1 + hstep, voffA);
            PG8_WAIT_L(8); PG8_BAR; PG8_WAIT_L(0); PG8_MMA(0, 0, At, B0); PG8_BAR; PG8_SCHED;
            PG8_LDB(B1, 0, 1); PG8_STAGE(PG8_SB(0, 0), b2, voffB);
            PG8_BAR; PG8_WAIT_L(0); PG8_MMA(0, 1, At, B1); PG8_BAR;
            PG8_LDA(At, 0, 1); PG8_STAGE(PG8_SA(0, 0), a2, voffA);
            PG8_BAR; PG8_WAIT_L(0); PG8_MMA(1, 0, At, B0); PG8_BAR; PG8_SCHED;
            PG8_STAGE(PG8_SB(0, 1), b2 + hstep, voffB);
            PG8_WAIT_V(6); PG8_BAR; PG8_MMA(1, 1, At, B1); PG8_BAR;
            PG8_LDB(B0, 1, 0); PG8_SCHED; PG8_LDA(At, 1, 0); PG8_STAGE(PG8_SA(0, 1), a2 + hstep, voffA);
            PG8_WAIT_L(8); PG8_BAR; PG8_WAIT_L(0); PG8_MMA(0, 0, At, B0); PG8_BAR; PG8_SCHED;
            PG8_LDB(B1, 1, 1); PG8_STAGE(PG8_SB(1, 0), b3, voffB);
            PG8_BAR; PG8_WAIT_L(0); PG8_MMA(0, 1, At, B1); PG8_BAR;
            PG8_LDA(At, 1, 1); PG8_STAGE(PG8_SA(1, 0), a3, voffA);
            PG8_BAR; PG8_WAIT_L(0); PG8_MMA(1, 0, At, B0); PG8_BAR; PG8_SCHED;
            PG8_STAGE(PG8_SB(1, 1), b3 + hstep, voffB);
            PG8_WAIT_V(6); PG8_BAR; PG8_MMA(1, 1, At, B1); PG8_BAR;
            }
        }
        if constexpr (ALIGN_EPI) { if (wr == 0) PG8_BAR; }
        if constexpr (!Epi::AFTER_DRAIN) { E(acc, cur, wr, wc, fr, fq); S.done(cur); }
        if (!has_next) break;
#pragma unroll
        for (int a = 0; a < 2; ++a)
#pragma unroll
            for (int b = 0; b < 2; ++b)
#pragma unroll
                for (int m = 0; m < 4; ++m)
#pragma unroll
                    for (int n = 0; n < 2; ++n) acc[a][b][m][n] = (f32x4){0.f, 0.f, 0.f, 0.f};
        cur = nxt; cA = nA; cB = nB; ++ui;
        if constexpr (ALIGN_EPI) { if (wr == 1) PG8_BAR; }
    }
    PG8_WAIT_V(0);
    if constexpr (!ALIGN_EPI) { if (wr == 0) PG8_BAR; }
    PG8_BAR;
    if constexpr (Epi::AFTER_DRAIN) { E.fused(acc, cur, wr, wc, fr, fq, lds, wid, lane); S.done(cur); }
#undef PG8_SA
#undef PG8_SB
#undef PG8_STAGE
#undef PG8_LDA
#undef PG8_LDB
#undef PG8_MMA
#undef PG8_WAIT_V
#undef PG8_WAIT_L
#undef PG8_BAR
#undef PG8_SCHED
}
}
constexpr int DM = 1024, NB = 8, SEQ = 4096, CTXL = 256, DEPTH = 2;
constexpr int NLAT = NB * SEQ, NCTX = NB * CTXL, NROWS = NLAT + NCTX;
constexpr int DIN = 1440, DINP = 1536, QRANK = 384, KVRANK = 256;
constexpr int PH = 8, PNK = 128, PDH = 128, PTOPK = 16, PEXP = PNK * PNK;
constexpr float EPS = 1e-6f;
constexpr float LOG2E = 1.4426950408889634f;
constexpr float C_MLA = 0.10206207261596577f * LOG2E;
constexpr float C_SWA = 0.125f * LOG2E;

typedef unsigned short bf16;
typedef short bf16x8 __attribute__((ext_vector_type(8)));
typedef short s16x4 __attribute__((ext_vector_type(4)));
typedef float f32x4 __attribute__((ext_vector_type(4)));
typedef float f32x16 __attribute__((ext_vector_type(16)));
typedef unsigned u32x4 __attribute__((ext_vector_type(4)));
typedef unsigned u32x2v __attribute__((ext_vector_type(2)));
#define LAS __attribute__((address_space(3)))

constexpr size_t MiB = 1u << 20;
constexpr size_t WS_CTL = 0, CTL_ZERO_BYTES = 64 * 1024;
constexpr size_t WS_MOD = 1 * MiB;
constexpr size_t WS_RTS = WS_MOD + 512 * 1024;
constexpr size_t WS_RTM = WS_RTS + 64 * 16 * 2 * 4;
constexpr size_t WS_WIN = 2 * MiB;
constexpr size_t WS_WUQ = WS_WIN + 2ull * DINP * DM * 2;
constexpr size_t WS_WUKV = WS_WUQ + 2ull * 768 * QRANK * 2;
constexpr size_t WS_WOUT = WS_WUKV + 2ull * 1024 * KVRANK * 2;
constexpr size_t WS_PWQ = WS_WOUT + 2ull * 1024 * 1024 * 2;
constexpr size_t WS_PKEY = WS_PWQ + 2ull * 2048 * 1024 * 2;
constexpr size_t WS_HCTX = WS_PKEY + 2ull * 8 * 2 * 128 * 128 * 2;
constexpr size_t WS_US = WS_HCTX + (size_t)NCTX * 1024 * 4;
constexpr size_t WS_VS = WS_US + 2ull * PEXP * 4;
constexpr size_t WS_U = 32 * MiB;
constexpr size_t WS_V = WS_U + 32 * MiB;
constexpr size_t WS_F16B = WS_V + 32 * MiB;
constexpr size_t WS_AB = WS_F16B + (size_t)NROWS * 1024 * 2;
constexpr size_t WS_P = WS_AB + (size_t)NROWS * 1024 * 2;
constexpr size_t WS_X5 = WS_P + (size_t)NROWS * DIN * 2;
constexpr size_t WS_QM = WS_X5, WS_KM = WS_QM + (size_t)NROWS * 768 * 2, WS_VM = WS_KM + (size_t)NROWS * 768 * 2, WS_QS = WS_VM + (size_t)NROWS * 512 * 2,
                 WS_KS = WS_QS + (size_t)NROWS * 512 * 2, WS_END = WS_KS + (size_t)NROWS * 128 * 2;
static_assert(WS_VS + 2ull * PEXP * 4 <= WS_U, "ws map (weights)");
static_assert(WS_END <= 512 * MiB, "ws map");
static_assert((size_t)NROWS * 2048 * 2 <= WS_END - WS_X5, "QP overlay");
static_assert((size_t)NROWS * 1024 <= (size_t)NROWS * DIN * 2, "TK overlay");

constexpr int LDS_BYTES = 135168;

__constant__ float ROPE_INV[24] = {1.0f, 0.5623413324356079f, 0.3162277638912201f, 0.17782793939113617f, 0.10000000149011612f, 0.05623413249850273f, 0.03162277489900589f, 0.017782794311642647f, 0.009999999776482582f, 0.005623413249850273f, 0.003162277629598975f, 0.0017782794311642647f, 0.0010000000474974513f, 0.000562341301701963f, 0.0003162277571391314f, 0.00017782794020604342f, 1.0f, 0.3162277638912201f, 0.10000000149011612f, 0.03162277489900589f, 0.009999999776482582f, 0.003162277629598975f, 0.0010000000474974513f, 0.0003162277571391314f};
struct Args {
    const float* in[23]; float* out; unsigned char* ws; int ph_lo, ph_hi; unsigned char prog[48];
};
typedef const __attribute__((address_space(4))) Args* ArgsP;

struct Frame {
    int tid, lane, wave, G, bid, vcu, gw, ngw, zv;
};

__device__ __forceinline__ float bf_lo(unsigned w) { return __uint_as_float(w << 16); }
__device__ __forceinline__ float bf_hi(unsigned w) { return __uint_as_float(w & 0xffff0000u); }
__device__ __forceinline__ unsigned pk2(float lo, float hi) { return pg8::cvt_pk_bf16(lo, hi); }
__device__ __forceinline__ float wave_sum(float v) {
#pragma unroll
    for (int o = 1; o < 64; o <<= 1) v += __shfl_xor(v, o);
    return v;
}
__device__ __forceinline__ void unpack8(const u32x4 w, float (&x)[8]) {
    x[0] = bf_lo(w.x); x[1] = bf_hi(w.x); x[2] = bf_lo(w.y); x[3] = bf_hi(w.y); x[4] = bf_lo(w.z); x[5] = bf_hi(w.z); x[6] = bf_lo(w.w); x[7] = bf_hi(w.w);
}
__device__ __forceinline__ u32x4 pack8(const float (&x)[8]) {
    u32x4 w; w.x = pk2(x[0], x[1]); w.y = pk2(x[2], x[3]); w.z = pk2(x[4], x[5]); w.w = pk2(x[6], x[7]); return w;
}

__device__ __forceinline__ void p0_transpose_item(const float* W, int K, int N, bf16* WT, LAS float* scr, int item, int lane) {
    const int nblk = N / 32, kb = item / nblk, nb = item % nblk, k0 = 64 * kb, n0 = 32 * nb;
#pragma unroll 8
    for (int i = 0; i < 32; ++i) { const int kk = 2 * i + (lane >> 5); scr[kk * 33 + (lane & 31)] = W[(size_t)(k0 + kk) * N + n0 + (lane & 31)]; }
    asm volatile("s_waitcnt lgkmcnt(0)" ::: "memory");
    const int c = lane & 7;
#pragma unroll
    for (int j = 0; j < 4; ++j) { const int n = (lane >> 3) + 8 * j; const LAS float* s = scr + (8 * c) * 33 + n;
        u32x4 o; o.x = pk2(s[0 * 33], s[1 * 33]); o.y = pk2(s[2 * 33], s[3 * 33]); o.z = pk2(s[4 * 33], s[5 * 33]); o.w = pk2(s[6 * 33], s[7 * 33]);
        *(u32x4*)(WT + (size_t)(n0 + n) * K + k0 + 8 * c) = o; }
    asm volatile("s_waitcnt lgkmcnt(0)" ::: "memory");
}

__device__ __forceinline__ void p0_prologue(const Frame& F, ArgsP Ap, LAS unsigned char* lds) {
    unsigned char* ws = Ap->ws;
    const float* c_in = Ap->in[1]; const float* cctx_in = Ap->in[3]; const float* ada_w = Ap->in[4]; const float* ada_b = Ap->in[5];
    for (int task = F.bid; task < 48; task += F.G) {
        const int l = task / 24, cc = task % 24;
        LAS float* sl = (LAS float*)lds;
        LAS float* red = (LAS float*)(lds + 9 * 1024 * 4);
        __syncthreads();
        for (int i = F.tid; i < 9 * 1024; i += 512) { const int s = i >> 10, k = i & 1023; const float x = (s < 8) ? c_in[s * 1024 + k] : cctx_in[k]; sl[i] = x / (1.f + __expf(-x)); }
        __syncthreads();
        const int c0 = cc * 256 + F.lane * 4; const int kbase = F.wave * 128;
        f32x4 acc[9];
#pragma unroll
        for (int s = 0; s < 9; ++s) acc[s] = (f32x4){0.f, 0.f, 0.f, 0.f};
        const float* wp = ada_w + ((size_t)l * 1024 + kbase) * 6144 + c0;
#pragma unroll 4
        for (int kk = 0; kk < 128; ++kk) { const f32x4 w = *(const f32x4*)(wp + (size_t)kk * 6144);
#pragma unroll
            for (int s = 0; s < 9; ++s) acc[s] += w * sl[s * 1024 + kbase + kk]; }
#pragma unroll
        for (int s = 0; s < 9; ++s) *(LAS f32x4*)(red + (F.wave * 9 + s) * 256 + F.lane * 4) = acc[s];
        __syncthreads();
        float* MOD = (float*)(ws + WS_MOD);
        for (int i = F.tid; i < 9 * 256; i += 512) { const int s = i >> 8, ci = i & 255; float v = ada_b[l * 6144 + cc * 256 + ci];
#pragma unroll
            for (int w = 0; w < 8; ++w) v += red[(w * 9 + s) * 256 + ci];
            MOD[((size_t)l * 9 + s) * 6144 + cc * 256 + ci] = v; }
        __syncthreads();
    }
    __syncthreads();
    if (F.bid == F.G - 1) {
        float* rts = (float*)(ws + WS_RTS); float* rtm = (float*)(ws + WS_RTM);
        for (int i = F.tid; i < 64 * 24; i += 512) {
            const int pos = i / 24, k = i % 24; const float a = (float)pos * ROPE_INV[k];
            const float rev = a * 0.15915494309189535f;
            const float cs = __builtin_amdgcn_cosf(rev), sn = __builtin_amdgcn_sinf(rev);
            if (k < 16) { rts[(pos * 16 + k) * 2] = cs; rts[(pos * 16 + k) * 2 + 1] = sn; } else { rtm[(pos * 8 + (k - 16)) * 2] = cs; rtm[(pos * 8 + (k - 16)) * 2 + 1] = sn; }
        }
    }
    LAS float* scr = (LAS float*)(lds + F.wave * 16384);
    constexpr int I_WIN = (DM / 64) * (DIN / 32), I_WUQ = (QRANK / 64) * (768 / 32), I_WUKV = (KVRANK / 64) * (1024 / 32), I_WOUT = (DM / 64) * (DM / 32), I_PWQ = (DM / 64) * (2048 / 32);
    constexpr int I_L = I_WIN + I_WUQ + I_WUKV + I_WOUT + I_PWQ;
    for (int it = F.gw; it < 2 * I_L; it += F.ngw) {
        const int l = it / I_L; int r = it % I_L;
        if (r < I_WIN) { p0_transpose_item(Ap->in[8] + (size_t)l * DM * DIN, DM, DIN, (bf16*)(ws + WS_WIN) + (size_t)l * DINP * DM, scr, r, F.lane); continue; } r -= I_WIN;
        if (r < I_WUQ) { p0_transpose_item(Ap->in[10] + (size_t)l * QRANK * 768, QRANK, 768, (bf16*)(ws + WS_WUQ) + (size_t)l * 768 * QRANK, scr, r, F.lane); continue; } r -= I_WUQ;
        if (r < I_WUKV) { p0_transpose_item(Ap->in[12] + (size_t)l * KVRANK * 1024, KVRANK, 1024, (bf16*)(ws + WS_WUKV) + (size_t)l * 1024 * KVRANK, scr, r, F.lane); continue; } r -= I_WUKV;
        if (r < I_WOUT) { p0_transpose_item(Ap->in[18] + (size_t)l * DM * DM, DM, DM, (bf16*)(ws + WS_WOUT) + (size_t)l * DM * DM, scr, r, F.lane); continue; } r -= I_WOUT;
        p0_transpose_item(Ap->in[19] + (size_t)l * DM * 2048, DM, 2048, (bf16*)(ws + WS_PWQ) + (size_t)l * 2048 * DM, scr, r, F.lane);
    }
    { const size_t gt = (size_t)F.bid * 512 + F.tid, nt = (size_t)F.G * 512;
      for (size_t i = gt; i < 2ull * 96 * DM / 8; i += nt) { const size_t l = i / (96 * DM / 8), e = i % (96 * DM / 8);
          *(u32x4*)((bf16*)(ws + WS_WIN) + l * DINP * DM + (size_t)DIN * DM + e * 8) = (u32x4){(unsigned)F.zv, (unsigned)F.zv, (unsigned)F.zv, (unsigned)F.zv}; }
      const size_t NKEY8 = 2ull * 8 * 2 * 128 * 128 / 8;
      for (size_t i = gt; i < NKEY8; i += nt) {
          const float* src = Ap->in[20]; bf16* dst = (bf16*)(ws + WS_PKEY);
          const f32x4 a = *(const f32x4*)(src + i * 8), b = *(const f32x4*)(src + i * 8 + 4);
          u32x4 o; o.x = pk2(a[0], a[1]); o.y = pk2(a[2], a[3]); o.z = pk2(b[0], b[1]); o.w = pk2(b[2], b[3]);
          *(u32x4*)(dst + i * 8) = o; }
    }
    for (int rr = F.gw; rr < 2 * 2 * PEXP; rr += F.ngw) {
        const int tab = rr / (2 * PEXP), lay = (rr / PEXP) & 1, e = rr % PEXP;
        const float* src = Ap->in[21 + tab] + ((size_t)lay * PEXP + e) * DM + 16 * F.lane;
        f32x4 x[4]; float mx = 0.f;
#pragma unroll
        for (int j = 0; j < 4; ++j) { x[j] = *(const f32x4*)(src + 4 * j); mx = fmaxf(fmaxf(fmaxf(mx, fabsf(x[j][0])), fmaxf(fabsf(x[j][1]), fabsf(x[j][2]))), fabsf(x[j][3])); }
#pragma unroll
        for (int o = 1; o < 64; o <<= 1) mx = fmaxf(mx, __shfl_xor(mx, o));
        const float inv = (mx > 0.f) ? 127.f / mx : 0.f;
        unsigned w[4];
#pragma unroll
        for (int j = 0; j < 4; ++j) { const unsigned c0 = (unsigned)(128 + (int)rintf(x[j][0] * inv)), c1 = (unsigned)(128 + (int)rintf(x[j][1] * inv)), c2 = (unsigned)(128 + (int)rintf(x[j][2] * inv)), c3 = (unsigned)(128 + (int)rintf(x[j][3] * inv));
            w[j] = c0 | (c1 << 8) | (c2 << 16) | (c3 << 24); }
        unsigned char* dst = tab ? (ws + WS_V + (size_t)lay * PEXP * DM + ((size_t)(F.lane >> 3) * PEXP + e) * 128 + (F.lane & 7) * 16)
                                 : (ws + WS_U + ((size_t)lay * PEXP + e) * DM + 16 * F.lane);
        *(u32x4*)dst = (u32x4){w[0], w[1], w[2], w[3]};
        if (F.lane == 0) ((float*)(ws + (tab ? WS_VS : WS_US)))[lay * PEXP + e] = (mx > 0.f) ? mx / 127.f : 1.f;
    }
}

#ifndef DBG_PRECISE_TOPK
#define DBG_PRECISE_TOPK 0
#endif
__device__ __forceinline__ void norm_mod_phase(const Frame& F, ArgsP Ap, int l, int which, int nrows) {
    unsigned char* ws = Ap->ws;
    const float* MOD = (const float*)(ws + WS_MOD);
    const float* gn = Ap->in[which ? 7 : 6] + l * DM;
    bf16* AB = (bf16*)(ws + WS_AB);
    const bool from_input = (which == 0 && l == 0);
    for (int r = F.gw; r < nrows; r += F.ngw) {
        const bool lat = r < NLAT;
        const float* hr = lat ? ((from_input ? Ap->in[0] : Ap->out) + (size_t)r * DM) : ((from_input ? Ap->in[2] : (const float*)(ws + WS_HCTX)) + (size_t)(r - NLAT) * DM);
        const int s = lat ? (r >> 12) : 8;
        const float* mp = MOD + ((size_t)l * 9 + s) * 6144 + (which ? 3 * DM : 0);
        f32x4 v[4]; float ss = 0.f;
#pragma unroll
        for (int j = 0; j < 4; ++j) { v[j] = *(const f32x4*)(hr + 256 * j + 4 * F.lane); ss += (v[j][0] * v[j][0] + v[j][1] * v[j][1]) + (v[j][2] * v[j][2] + v[j][3] * v[j][3]); }
        ss = wave_sum(ss);
        const float rinv = rsqrtf(ss * (1.f / DM) + EPS);
#pragma unroll
        for (int j = 0; j < 4; ++j) { const int c = 256 * j + 4 * F.lane;
            const f32x4 g = *(const f32x4*)(gn + c), sh = *(const f32x4*)(mp + c), sc = *(const f32x4*)(mp + DM + c);
            const f32x4 y = v[j] * rinv * g; const f32x4 a = y * (sc + 1.f) + sh;
            u32x2v o; o.x = pk2(a[0], a[1]); o.y = pk2(a[2], a[3]);
            *(u32x2v*)(AB + (size_t)r * DM + c) = o;
            if (which) { typedef _Float16 h2_t __attribute__((ext_vector_type(2))); const h2_t p0 = {(_Float16)a[0], (_Float16)a[1]}, p1 = {(_Float16)a[2], (_Float16)a[3]};
                u32x2v oh; oh.x = __builtin_bit_cast(unsigned, p0); oh.y = __builtin_bit_cast(unsigned, p1); *(u32x2v*)((unsigned short*)(ws + WS_F16B) + (size_t)r * DM + c) = oh; }
            }
    }
}

__device__ __forceinline__ void e2_phase(const Frame& F, ArgsP Ap, int l, int nrows) {
    unsigned char* ws = Ap->ws;
    const bf16* P = (const bf16*)(ws + WS_P);
    bf16* QAN = (bf16*)(ws + WS_AB); bf16* KVAN = QAN + (size_t)NROWS * QRANK;
    bf16* QS = (bf16*)(ws + WS_QS); bf16* KS = (bf16*)(ws + WS_KS);
    const float* qa_g = Ap->in[9] + l * QRANK; const float* kva_g = Ap->in[11] + l * KVRANK;
    const float* sqn_g = Ap->in[15] + l * 64; const float* skn_g = Ap->in[16] + l * 64;
    const float* rts = (const float*)(ws + WS_RTS);
    const int lane = F.lane;
    for (int r = F.gw; r < nrows; r += F.ngw) {
        const bf16* pr = P + (size_t)r * DIN;
        const bool lat = r < NLAT; const int pos = r & (SEQ - 1), rp = pos >> 6, cp = pos & 63;
        u32x4 wqa = (u32x4){0u, 0u, 0u, 0u}, wkva = (u32x4){0u, 0u, 0u, 0u}, wsk = (u32x4){0u, 0u, 0u, 0u};
        if (lane < 48) wqa = *(const u32x4*)(pr + 8 * lane);
        const u32x4 wsq = *(const u32x4*)(pr + QRANK + 8 * lane);
        if (lane < 32) wkva = *(const u32x4*)(pr + 896 + 8 * lane);
        if (lane < 16) wsk = *(const u32x4*)(pr + 1184 + 8 * lane);
        float x[8];
        { unpack8(wqa, x); float ss = 0.f;
#pragma unroll
          for (int e = 0; e < 8; ++e) ss += x[e] * x[e];
          ss = wave_sum(ss); const float rinv = rsqrtf(ss * (1.f / QRANK) + EPS);
          if (lane < 48) { float y[8];
#pragma unroll
              for (int e = 0; e < 8; ++e) y[e] = x[e] * rinv * qa_g[8 * lane + e];
              *(u32x4*)(QAN + (size_t)r * QRANK + 8 * lane) = pack8(y); } }
        { unpack8(wkva, x); float ss = 0.f;
#pragma unroll
          for (int e = 0; e < 8; ++e) ss += x[e] * x[e];
          ss = wave_sum(ss); const float rinv = rsqrtf(ss * (1.f / KVRANK) + EPS);
          if (lane < 32) { float y[8];
#pragma unroll
              for (int e = 0; e < 8; ++e) y[e] = x[e] * rinv * kva_g[8 * lane + e];
              *(u32x4*)(KVAN + (size_t)r * KVRANK + 8 * lane) = pack8(y); } }
        const int ch = lane & 7;
        const float* tab = rts + (size_t)((ch < 4) ? rp : cp) * 32 + (ch & 1) * 16;
#pragma unroll
        for (int which = 0; which < 2; ++which) {
            unpack8(which ? wsk : wsq, x); float ss = 0.f;
#pragma unroll
            for (int e = 0; e < 8; ++e) ss += x[e] * x[e];
            ss += __shfl_xor(ss, 1); ss += __shfl_xor(ss, 2); ss += __shfl_xor(ss, 4);
            const float rinv = rsqrtf(ss * (1.f / 64.f) + EPS);
            const float* gg = which ? skn_g : sqn_g;
            float y[8], o[8];
#pragma unroll
            for (int e = 0; e < 8; ++e) y[e] = x[e] * rinv * gg[8 * ch + e];
#pragma unroll
            for (int e = 0; e < 8; ++e) { const float py = __shfl_xor(y[e], 2);
                if (lat) { const float cs = tab[2 * e], sn = tab[2 * e + 1]; o[e] = (ch & 2) ? (y[e] * cs + py * sn) : (y[e] * cs - py * sn); } else o[e] = y[e]; }
            if (which == 0) {
#pragma unroll
                for (int e = 0; e < 8; ++e) o[e] *= C_SWA;
                *(u32x4*)(QS + (size_t)r * 512 + 8 * lane) = pack8(o);
            } else if (lane < 16) *(u32x4*)(KS + (size_t)r * 128 + 8 * lane) = pack8(o);
        }
    }
}

__device__ __forceinline__ void e3_phase(const Frame& F, ArgsP Ap, int l, int nrows) {
    unsigned char* ws = Ap->ws;
    const bf16* P = (const bf16*)(ws + WS_P);
    bf16* QM = (bf16*)(ws + WS_QM); bf16* KM = (bf16*)(ws + WS_KM);
    const float* qn_g = Ap->in[13] + l * 96; const float* kn_g = Ap->in[14] + l * 96;
    const float* rtm = (const float*)(ws + WS_RTM);
    const int lane = F.lane, hl = lane / 12, ch = lane % 12, gbase = hl * 12;
    for (int r = F.gw; r < nrows; r += F.ngw) {
        const bool lat = r < NLAT; const int pos = r & (SEQ - 1), rp = pos >> 6, cp = pos & 63;
        const float* tab = rtm + (size_t)((ch < 10) ? rp : cp) * 16;
#pragma unroll
        for (int pass = 0; pass < 2; ++pass) {
            const int head = pass * 5 + hl; const bool valid = (lane < 60) && (head < 8);
#pragma unroll
            for (int which = 0; which < 2; ++which) {
                u32x4 w = (u32x4){0u, 0u, 0u, 0u};
                bf16* dstp = (which ? KM : QM) + (size_t)r * 768 + head * 96 + ch * 8;
                if (valid) { if (which == 1 && ch >= 8) w = *(const u32x4*)(P + (size_t)r * DIN + 1152 + (ch - 8) * 8); else w = *(const u32x4*)dstp; }
                float x[8]; unpack8(w, x); float ss = 0.f;
#pragma unroll
                for (int e = 0; e < 8; ++e) ss += x[e] * x[e];
                float tot = 0.f;
#pragma unroll
                for (int i = 0; i < 12; ++i) tot += __shfl(ss, (gbase + i) & 63);
                const float rinv = rsqrtf(tot * (1.f / 96.f) + EPS);
                const float* gg = which ? kn_g : qn_g;
                float y[8], o[8];
#pragma unroll
                for (int e = 0; e < 8; ++e) y[e] = x[e] * rinv * gg[8 * ch + e];
#pragma unroll
                for (int e = 0; e < 8; ++e) { const float py = __shfl_xor(y[e], 1);
                    if (lat && ch >= 8) { const float cs = tab[2 * e], sn = tab[2 * e + 1]; o[e] = (ch & 1) ? (y[e] * cs + py * sn) : (y[e] * cs - py * sn); } else o[e] = y[e]; }
                if (which == 0) {
#pragma unroll
                    for (int e = 0; e < 8; ++e) o[e] *= C_MLA;
                }
                if (valid) *(u32x4*)dstp = pack8(o);
            }
        }
    }
}
#define XB_TMO      128
#define XB_XCNT(j)  (256  + 64 * (j))
#define XB_XSUB(j)  (1280 + 64 * (j))
#define XB_XGEN(j)  (2304 + 64 * (j))
#define XB_TOP      3328
#define XB_TOPGEN   3392
#define XCD_BAR_WORDS 3456
#define XB_SPIN_CAP (1u << 18)

__device__ __forceinline__ unsigned xb_ld(unsigned* p)              { return __hip_atomic_load(p, __ATOMIC_RELAXED, __HIP_MEMORY_SCOPE_AGENT); }
__device__ __forceinline__ unsigned xb_add(unsigned* p, unsigned v) { return __hip_atomic_fetch_add(p, v, __ATOMIC_RELAXED, __HIP_MEMORY_SCOPE_AGENT); }
__device__ __forceinline__ unsigned xb_xcc_id() { return (unsigned)__builtin_amdgcn_s_getreg((3 << 11) | 20) & 0xFu; }
#define XB_SPIN(cond, bar) do { unsigned _sp = 0; while (cond) { __builtin_amdgcn_s_sleep(1); \
    if ((++_sp & 255u) == 0u) { if (xb_ld(&(bar)[XB_TMO])) break; if (_sp > XB_SPIN_CAP) { atomicAdd(&(bar)[XB_TMO], 1u); break; } } } } while (0)

struct XcdBarrier {
    unsigned* bar; unsigned x;
    volatile LAS unsigned* st;
};

__device__ __forceinline__ XcdBarrier xcd_barrier_post(unsigned* bar, volatile LAS unsigned* st, const bool t0) {
    XcdBarrier b; b.bar = bar; b.x = xb_xcc_id(); b.st = st;
    if (t0) (void)xb_add(&bar[XB_XCNT(b.x)], 1u);
    return b;
}
__device__ __forceinline__ void xcd_barrier_complete(unsigned* bar, unsigned x, unsigned& nloc, unsigned& nx) {
    const unsigned G = gridDim.x * gridDim.y * gridDim.z;
    unsigned sum, cnt, mine, sp = 0u;
    for (;;) {
        sum = 0u; cnt = 0u; mine = 0u;
#pragma unroll
        for (unsigned j = 0; j < 16; ++j) { const unsigned c = xb_ld(&bar[XB_XCNT(j)]); sum += c; cnt += (c > 0u) ? 1u : 0u; mine = (j == x) ? c : mine; }
        if (sum == G) break;
        __builtin_amdgcn_s_sleep(1);
        if ((++sp & 255u) == 0u) { if (xb_ld(&bar[XB_TMO])) break; if (sp > XB_SPIN_CAP) { atomicAdd(&bar[XB_TMO], 1u); break; } }
    }
    nloc = mine > 0u ? mine : 1u; nx = cnt > 0u ? cnt : 1u;
}

__device__ __forceinline__ void xcd_barrier(const XcdBarrier& b, const bool t0) {
    asm volatile("s_waitcnt vmcnt(0)" ::: "memory");
    __syncthreads();
    if (t0) {
        unsigned* bar = b.bar;
        __builtin_amdgcn_s_waitcnt(0);
        unsigned nloc = b.st[0], nx = b.st[1];
        if (nloc == 0u) { xcd_barrier_complete(bar, b.x, nloc, nx); b.st[0] = nloc; b.st[1] = nx; }
        const unsigned old = xb_add(&bar[XB_XSUB(b.x)], 1u);
        const unsigned gen = old / nloc;
        if (old + 1u == (gen + 1u) * nloc) {
            __builtin_amdgcn_fence(__ATOMIC_RELEASE, "agent");
            asm volatile("s_waitcnt vmcnt(0)" ::: "memory");
            const unsigned og = xb_add(&bar[XB_TOP], 1u);
            const unsigned tg = og / nx;
            if (og + 1u == (tg + 1u) * nx) xb_add(&bar[XB_TOPGEN], 1u);
            else XB_SPIN(xb_ld(&bar[XB_TOPGEN]) == tg, bar);
            __builtin_amdgcn_fence(__ATOMIC_ACQUIRE, "agent");
            xb_add(&bar[XB_XGEN(b.x)], 1u);
            asm volatile("s_waitcnt vmcnt(0)" ::: "memory");
        } else {
            XB_SPIN(xb_ld(&bar[XB_XGEN(b.x)]) == gen, bar);
            __builtin_amdgcn_fence(__ATOMIC_ACQUIRE, "agent");
            asm volatile("s_waitcnt vmcnt(0)" ::: "memory");
        }
    }
    __syncthreads();
}
namespace att {
constexpr int SHM_V = 64 * 64 * 2, SHM_K = 64 * 256, LDS_ATT = 2 * SHM_V + 2 * SHM_K + 8 * 64 * 4;
#define KSWZ(row, colB) ((row) * 256 + ((colB) ^ (((row) & 7) << 4)))
#define SBAR() __builtin_amdgcn_sched_barrier(0)
__device__ __forceinline__ int crow(int r, int hi) { return (r & 3) + 8 * (r >> 2) + 4 * hi; }
__device__ __forceinline__ int v_st(int k, int c) { const int kk = (k & ~0xC) | ((k & 4) << 1) | ((k & 8) >> 1); return ((kk >> 3) * 2 + (c >> 5)) * 512 + ((kk & 7) * 32 + (c & 31)) * 2; }
__device__ __forceinline__ int v_rd_base(int lane) { return ((lane & 3) << 3) | (((lane >> 2) & 3) << 6) | (((lane >> 4) & 1) << 5) | (((lane >> 5) & 1) << 8); }
constexpr int v_rd_off(int d0, int ks, int half) { return d0 * 512 + ks * 2048 + half * 1024; }
template <int OFF> __device__ __forceinline__ s16x4 tr_read(int vb) {
    s16x4 r; asm volatile("ds_read_b64_tr_b16 %0, %1 offset:%2" : "=&v"(r) : "v"(vb), "i"(OFF) : "memory"); return r;
}
template <int D0> __device__ __forceinline__ void pv_one(f32x16& od, int vb, bf16x8 pa0, bf16x8 pa1, bf16x8 pa2, bf16x8 pa3) {
    const s16x4 l0 = tr_read<v_rd_off(D0, 0, 0)>(vb), h0 = tr_read<v_rd_off(D0, 0, 1)>(vb), l1 = tr_read<v_rd_off(D0, 1, 0)>(vb), h1 = tr_read<v_rd_off(D0, 1, 1)>(vb);
    const s16x4 l2 = tr_read<v_rd_off(D0, 2, 0)>(vb), h2 = tr_read<v_rd_off(D0, 2, 1)>(vb), l3 = tr_read<v_rd_off(D0, 3, 0)>(vb), h3 = tr_read<v_rd_off(D0, 3, 1)>(vb);
    asm volatile("s_waitcnt lgkmcnt(0)" ::: "memory"); SBAR();
#define PK(L, H) (bf16x8){L[0], L[1], L[2], L[3], H[0], H[1], H[2], H[3]}
    od = __builtin_amdgcn_mfma_f32_32x32x16_bf16(pa0, PK(l0, h0), od, 0, 0, 0);
    od = __builtin_amdgcn_mfma_f32_32x32x16_bf16(pa1, PK(l1, h1), od, 0, 0, 0);
    od = __builtin_amdgcn_mfma_f32_32x32x16_bf16(pa2, PK(l2, h2), od, 0, 0, 0);
    od = __builtin_amdgcn_mfma_f32_32x32x16_bf16(pa3, PK(l3, h3), od, 0, 0, 0);
#undef PK
}
__device__ __forceinline__ void pv2(f32x16* o, int vb, bf16x8 pa0, bf16x8 pa1, bf16x8 pa2, bf16x8 pa3) {
    pv_one<0>(o[0], vb, pa0, pa1, pa2, pa3); pv_one<1>(o[1], vb, pa0, pa1, pa2, pa3);
}
template <int ND0> __device__ __forceinline__ void qkt(f32x16& p0, f32x16& p1, const char* Ks, const bf16x8* qr, int r32, int hi) {
    p0 = f32x16{}; p1 = f32x16{};
#pragma unroll
    for (int d0 = 0; d0 < ND0; ++d0) { const int cb = (d0 * 16 + hi * 8) * 2;
        const bf16x8 b0 = *reinterpret_cast<const bf16x8*>(Ks + KSWZ(r32, cb));
        const bf16x8 b1 = *reinterpret_cast<const bf16x8*>(Ks + KSWZ(32 + r32, cb));
        p0 = __builtin_amdgcn_mfma_f32_32x32x16_bf16(b0, qr[d0], p0, 0, 0, 0);
        p1 = __builtin_amdgcn_mfma_f32_32x32x16_bf16(b1, qr[d0], p1, 0, 0, 0); }
}
__device__ __forceinline__ void wmask(f32x16& p0, f32x16& p1, int kp0, int qp, int hi) {
#pragma unroll
    for (int r = 0; r < 16; ++r) { const int d0 = kp0 + crow(r, hi) - qp; const int d1 = d0 + 32;
        if (d0 > 128 || d0 < -128) p0[r] = -INFINITY; if (d1 > 128 || d1 < -128) p1[r] = -INFINITY; }
}
__device__ __forceinline__ void smpack(f32x16& p0, f32x16& p1, float& l_reg, bf16x8& pa0, bf16x8& pa1, bf16x8& pa2, bf16x8& pa3) {
#pragma unroll
    for (int r = 0; r < 16; ++r) p0[r] = __builtin_amdgcn_exp2f(p0[r]);
#pragma unroll
    for (int r = 0; r < 16; ++r) p1[r] = __builtin_amdgcn_exp2f(p1[r]);
    float ps = 0.f;
#pragma unroll
    for (int r = 0; r < 16; ++r) ps += p0[r];
#pragma unroll
    for (int r = 0; r < 16; ++r) ps += p1[r];
    l_reg += ps;
#define PK4(P, BASE, OUT) do { unsigned a0 = pk2(P[BASE + 0], P[BASE + 1]), a1 = pk2(P[BASE + 2], P[BASE + 3]);   \
    unsigned b0 = pk2(P[BASE + 4], P[BASE + 5]), b1 = pk2(P[BASE + 6], P[BASE + 7]);                              \
    auto r0 = __builtin_amdgcn_permlane32_swap(a0, b0, false, false); auto r1 = __builtin_amdgcn_permlane32_swap(a1, b1, false, false); \
    u32x4 w = {r0[0], r1[0], r0[1], r1[1]}; OUT = *reinterpret_cast<bf16x8*>(&w); } while (0)
    PK4(p0, 0, pa0); PK4(p0, 8, pa1); PK4(p1, 0, pa2); PK4(p1, 8, pa3);
#undef PK4
}

struct Unit {
    const bf16* Q; int ldq;
    const bf16* K; int ldk;
    const bf16* V; int ldv;
    bf16* O;
    int qrow0;
    int ctx_row0;
    int lat_row0;
    int nt;
    int qpos0;
    int kpos0;
    int masked;
    float l_init;
};

template <int DQK, bool MASKED>
__device__ __forceinline__ void attn_unit(const Unit& U, char* lds, const int tid) {
    constexpr int ND0 = DQK / 16, NCH = DQK / 8;
    const int wid = tid >> 6, lane = tid & 63, r32 = lane & 31, hi = lane >> 5;
    char* V_lds = lds; char* K_lds = lds + 2 * SHM_V;
    float* wsf = (float*)(lds + 2 * SHM_V + 2 * SHM_K) + wid * 64;
    float l_reg = (hi == 0) ? U.l_init : 0.f; f32x16 o[2] = {}; bf16x8 qr[ND0];
    const bf16* Qw = U.Q + (size_t)(U.qrow0 + wid * 32 + r32) * U.ldq + hi * 8;
#pragma unroll
    for (int d0 = 0; d0 < ND0; ++d0) qr[d0] = *reinterpret_cast<const bf16x8*>(Qw + d0 * 16);
    const int vk = tid >> 3, vc = (tid & 7) * 8, vst = v_st(vk, vc);
    const int k0r = tid / NCH, k0c = tid % NCH;
    const bool k1on = (NCH == 12) && (tid < 256);
    const int k1i = k1on ? (tid + 512) : tid, k1r = k1i / NCH, k1c = k1i % NCH;
    const int vb0 = (int)(uintptr_t)V_lds + v_rd_base(lane);
    struct Slot { bf16x8 v, k0, k1; } s0;
    auto tile_row = [&](int t) -> int { return (t < 4) ? (U.ctx_row0 + 64 * t) : (U.lat_row0 + 64 * (t - 4)); };
#define SLOAD(S, t) do { const int kr_ = tile_row(t); \
        S.v = *reinterpret_cast<const bf16x8*>(U.V + (size_t)(kr_ + vk) * U.ldv + vc); \
        S.k0 = *reinterpret_cast<const bf16x8*>(U.K + (size_t)(kr_ + k0r) * U.ldk + k0c * 8); \
        if (NCH == 12) S.k1 = *reinterpret_cast<const bf16x8*>(U.K + (size_t)(kr_ + k1r) * U.ldk + k1c * 8); } while (0)
#define SWRITE(b, S) do { *reinterpret_cast<bf16x8*>(V_lds + (b) * SHM_V + vst) = S.v; \
        *reinterpret_cast<bf16x8*>(K_lds + (b) * SHM_K + KSWZ(k0r, k0c * 16)) = S.k0; \
        if (NCH == 12) { if (k1on) *reinterpret_cast<bf16x8*>(K_lds + (b) * SHM_K + KSWZ(k1r, k1c * 16)) = S.k1; } } while (0)
#define MASK(P0, P1, t) do { if (MASKED && (t) >= 4) wmask(P0, P1, U.kpos0 + 64 * ((t) - 4), U.qpos0 + wid * 32 + r32, hi); } while (0)
    f32x16 pA0, pA1, pB0, pB1; bf16x8 pa0, pa1, pa2, pa3; const int NT = U.nt;
    __syncthreads();
    SLOAD(s0, 0); SWRITE(0, s0); __syncthreads();
    qkt<ND0>(pA0, pA1, K_lds, qr, r32, hi); MASK(pA0, pA1, 0);
    SLOAD(s0, 1);
    SWRITE(1, s0); __syncthreads();
    for (int j = 1; j + 1 < NT; j += 2) {
        SBAR(); qkt<ND0>(pB0, pB1, K_lds + SHM_K, qr, r32, hi); MASK(pB0, pB1, j);
        smpack(pA0, pA1, l_reg, pa0, pa1, pa2, pa3); SBAR();
        SLOAD(s0, j + 1); SBAR();
        pv2(o, vb0, pa0, pa1, pa2, pa3);
        __syncthreads(); SWRITE(0, s0); __syncthreads();
        SBAR(); qkt<ND0>(pA0, pA1, K_lds, qr, r32, hi); MASK(pA0, pA1, j + 1);
        smpack(pB0, pB1, l_reg, pa0, pa1, pa2, pa3); SBAR();
        SLOAD(s0, j + 2); SBAR();
        pv2(o, vb0 + SHM_V, pa0, pa1, pa2, pa3);
        __syncthreads(); SWRITE(1, s0); __syncthreads();
    }
    SBAR(); qkt<ND0>(pB0, pB1, K_lds + SHM_K, qr, r32, hi); MASK(pB0, pB1, NT - 1);
    smpack(pA0, pA1, l_reg, pa0, pa1, pa2, pa3); SBAR();
    pv2(o, vb0, pa0, pa1, pa2, pa3);
    smpack(pB0, pB1, l_reg, pa0, pa1, pa2, pa3); SBAR();
    pv2(o, vb0 + SHM_V, pa0, pa1, pa2, pa3);
    { auto rr = __builtin_amdgcn_permlane32_swap(__float_as_uint(l_reg), __float_as_uint(l_reg), false, false);
      l_reg = __uint_as_float(rr[0]) + __uint_as_float(rr[1]); }
    if (hi == 0) wsf[r32] = l_reg;
    asm volatile("s_waitcnt lgkmcnt(0)" ::: "memory");
    float rli[16];
#pragma unroll
    for (int r = 0; r < 16; ++r) rli[r] = 1.f / wsf[crow(r, hi)];
    bf16* Ow = U.O + (size_t)(U.qrow0 + wid * 32) * 1024;
#pragma unroll
    for (int r = 0; r < 16; ++r) { const int orow = crow(r, hi);
#pragma unroll
        for (int d0 = 0; d0 < 2; ++d0) { const unsigned w = pk2(o[d0][r] * rli[r], 0.f); Ow[(size_t)orow * 1024 + d0 * 32 + r32] = (bf16)(w & 0xffffu); } }
#undef SLOAD
#undef SWRITE
#undef MASK
}
#undef KSWZ
}

__device__ __forceinline__ void attn_phase(const Frame& F, ArgsP Ap, int l, char* lds) {
    unsigned char* ws = Ap->ws;
    const bf16* QM = (const bf16*)(ws + WS_QM); const bf16* KM = (const bf16*)(ws + WS_KM); const bf16* VM = (const bf16*)(ws + WS_VM);
    const bf16* QS = (const bf16*)(ws + WS_QS); const bf16* KS = (const bf16*)(ws + WS_KS); const bf16* VS = (const bf16*)(ws + WS_P) + 1312;
    bf16* OB = (bf16*)(ws + WS_AB);
    const float* sink = Ap->in[17] + l * 8;
    const int nunits = (l == 0) ? 1024 + 64 : 1024;
    for (int u = F.vcu; u < nunits; u += F.G) {
        const bool isl = u < 1024;
        const int i = u >> 8, c = u & 31, b = isl ? ((u & 255) >> 5) : ((u - 1024) >> 3), h = isl ? (2 * i + (c >> 4)) : (u & 7), qb = c & 15;
        att::Unit U; U.Q = QM + h * 96; U.ldq = 768; U.K = KM + h * 96; U.ldk = 768; U.V = VM + h * 64; U.ldv = 512; U.O = OB + h * 64;
        U.qrow0 = isl ? (b * SEQ + qb * 256) : (NLAT + b * CTXL); U.ctx_row0 = NLAT + b * CTXL; U.lat_row0 = b * SEQ; U.nt = isl ? (4 + SEQ / 64) : 4; U.qpos0 = 0; U.kpos0 = 0; U.masked = 0; U.l_init = 0.f;
        att::attn_unit<96, false>(U, lds, F.tid);
    }
    for (int u = F.vcu; u < nunits; u += F.G) {
        const bool isl = u < 1024;
        const int i = u >> 8, c = u & 31, b = isl ? ((u & 255) >> 5) : ((u - 1024) >> 3), h = isl ? (2 * i + (c >> 4)) : (u & 7), qb = c & 15, g = h >> 2;
        const int q0 = qb * 256; int k_lo = q0 - 128; if (k_lo < 0) k_lo = 0; int k_hi = q0 + 256 + 128; if (k_hi > SEQ) k_hi = SEQ;
        att::Unit U; U.Q = QS + h * 64; U.ldq = 512; U.K = KS + g * 64; U.ldk = 128; U.V = VS + g * 64; U.ldv = DIN; U.O = OB + 512 + h * 64;
        U.qrow0 = isl ? (b * SEQ + q0) : (NLAT + b * CTXL); U.ctx_row0 = NLAT + b * CTXL; U.lat_row0 = b * SEQ + k_lo; U.nt = isl ? (4 + (k_hi - k_lo) / 64) : 4; U.qpos0 = q0; U.kpos0 = k_lo; U.masked = 1;
        U.l_init = __builtin_amdgcn_exp2f(sink[h] * LOG2E);
        att::attn_unit<64, true>(U, lds, F.tid);
    }
}

#ifndef DBG_NAIVE_ATTN
#define DBG_NAIVE_ATTN 0
#endif
#if DBG_NAIVE_ATTN
__device__ __forceinline__ void attn_naive_phase(const Frame& F, ArgsP Ap, int l) {
    unsigned char* ws = Ap->ws;
    const bf16* QM = (const bf16*)(ws + WS_QM); const bf16* KM = (const bf16*)(ws + WS_KM); const bf16* VM = (const bf16*)(ws + WS_VM);
    const bf16* QS = (const bf16*)(ws + WS_QS); const bf16* KS = (const bf16*)(ws + WS_KS); const bf16* VS = (const bf16*)(ws + WS_P) + 1312;
    bf16* OB = (bf16*)(ws + WS_AB);
    const float* sink = Ap->in[17] + l * 8;
    const int nrg = ((l == 0) ? NROWS : NLAT) / 64;
    for (int u = F.gw; u < nrg * 8; u += F.ngw) {
        const int h = __builtin_amdgcn_readfirstlane(u & 7), rg = __builtin_amdgcn_readfirstlane(u >> 3), row = rg * 64 + F.lane;
        const bool lat = rg * 64 < NLAT; const int b = lat ? (rg * 64) >> 12 : (rg * 64 - NLAT) >> 8;
        {
            float q[96], o[64]; float lsum = 0.f;
#pragma unroll
            for (int d = 0; d < 96; d += 2) { const unsigned w = *(const unsigned*)(QM + (size_t)row * 768 + h * 96 + d); q[d] = bf_lo(w); q[d + 1] = bf_hi(w); }
#pragma unroll
            for (int d = 0; d < 64; ++d) o[d] = 0.f;
            const int nk = lat ? (CTXL + SEQ) : CTXL;
#pragma unroll 1
            for (int j = 0; j < nk; ++j) { const int kr = (j < CTXL) ? (NLAT + b * CTXL + j) : (b * SEQ + j - CTXL);
                const bf16* kp = KM + (size_t)kr * 768 + h * 96; const bf16* vp = VM + (size_t)kr * 512 + h * 64; float s = 0.f;
#pragma unroll
                for (int d = 0; d < 96; d += 2) { const unsigned w = *(const unsigned*)(kp + d); s = fmaf(q[d], bf_lo(w), s); s = fmaf(q[d + 1], bf_hi(w), s); }
                const float p = exp2f(s); lsum += p;
#pragma unroll
                for (int d = 0; d < 64; d += 2) { const unsigned w = *(const unsigned*)(vp + d); o[d] = fmaf(p, bf_lo(w), o[d]); o[d + 1] = fmaf(p, bf_hi(w), o[d + 1]); } }
            const float rl = 1.f / lsum;
#pragma unroll
            for (int d = 0; d < 64; d += 2) *(unsigned*)(OB + (size_t)row * 1024 + h * 64 + d) = pk2(o[d] * rl, o[d + 1] * rl);
        }
        {
            const int g = h >> 2; const int pos0 = (rg * 64) & (SEQ - 1), pos = pos0 + F.lane;
            float q[64], o[64]; float lsum = exp2f(sink[h] * LOG2E);
#pragma unroll
            for (int d = 0; d < 64; d += 2) { const unsigned w = *(const unsigned*)(QS + (size_t)row * 512 + h * 64 + d); q[d] = bf_lo(w); q[d + 1] = bf_hi(w); }
#pragma unroll
            for (int d = 0; d < 64; ++d) o[d] = 0.f;
            int jlo = pos0 - 128; if (jlo < 0) jlo = 0; int jhi = pos0 + 63 + 128; if (jhi > SEQ - 1) jhi = SEQ - 1;
            const int nk = lat ? (CTXL + (jhi - jlo + 1)) : CTXL;
#pragma unroll 1
            for (int j = 0; j < nk; ++j) { const bool isc = j < CTXL; const int kpos = jlo + j - CTXL; const int kr = isc ? (NLAT + b * CTXL + j) : (b * SEQ + kpos);
                const bf16* kp = KS + (size_t)kr * 128 + g * 64; const bf16* vp = VS + (size_t)kr * DIN + g * 64; float s = 0.f;
#pragma unroll
                for (int d = 0; d < 64; d += 2) { const unsigned w = *(const unsigned*)(kp + d); s = fmaf(q[d], bf_lo(w), s); s = fmaf(q[d + 1], bf_hi(w), s); }
                float p = exp2f(s); if (!isc) { const int dd = kpos - pos; if (dd > 128 || dd < -128) p = 0.f; } lsum += p;
#pragma unroll
                for (int d = 0; d < 64; d += 2) { const unsigned w = *(const unsigned*)(vp + d); o[d] = fmaf(p, bf_lo(w), o[d]); o[d + 1] = fmaf(p, bf_hi(w), o[d + 1]); } }
            const float rl = 1.f / lsum;
#pragma unroll
            for (int d = 0; d < 64; d += 2) *(unsigned*)(OB + (size_t)row * 1024 + 512 + h * 64 + d) = pk2(o[d] * rl, o[d + 1] * rl);
        }
    }
}
#endif
__device__ __forceinline__ unsigned f2key(float f) { const unsigned u = __float_as_uint(f); return (u & 0x80000000u) ? ~u : (u | 0x80000000u); }
__device__ __forceinline__ float key2f(unsigned k) { const unsigned u = (k & 0x80000000u) ? (k & 0x7fffffffu) : ~k; return __uint_as_float(u); }
#define CE_DESC(a, b) do { const unsigned _hi = max(a, b), _lo = min(a, b); a = _hi; b = _lo; } while (0)
__device__ __forceinline__ void sort16_desc(unsigned (&a)[16]) {
#pragma unroll
    for (int k = 2; k <= 16; k <<= 1)
#pragma unroll
        for (int j = k >> 1; j > 0; j >>= 1)
#pragma unroll
            for (int i = 0; i < 16; ++i) { const int p = i ^ j;
                if (p > i) { if ((i & k) == 0) { CE_DESC(a[i], a[p]); } else { CE_DESC(a[p], a[i]); } } }
}
__device__ __forceinline__ void merge16_desc(unsigned (&t)[16], const unsigned (&c)[16]) {
#pragma unroll
    for (int i = 0; i < 16; ++i) t[i] = max(t[i], c[15 - i]);
#pragma unroll
    for (int j = 8; j > 0; j >>= 1)
#pragma unroll
        for (int i = 0; i < 16; ++i) { const int p = i ^ j; if (p > i) CE_DESC(t[i], t[p]); }
}
__device__ __forceinline__ void merge16_partner(unsigned (&t)[16]) {
    unsigned oth[16];
#pragma unroll
    for (int i = 0; i < 16; ++i) oth[i] = (unsigned)__shfl_xor((int)t[i], 32);
    merge16_desc(t, oth);
}

constexpr size_t WS_IDX = WS_P;
constexpr size_t WS_GW = WS_P + (size_t)NROWS * 128 * 2;
constexpr size_t WS_W2 = WS_GW + (size_t)NROWS * 128 * 4;
static_assert(WS_W2 + (size_t)NROWS * 128 * 4 <= WS_X5, "peer lists inside the P region");

__device__ __forceinline__ void topkc_phase(const Frame& F, ArgsP Ap, int l, int nrows, char* lds) {
    unsigned char* ws = Ap->ws;
    const bf16* QP = (const bf16*)(ws + WS_X5);
    const bf16* PK = (const bf16*)(ws + WS_PKEY) + (size_t)l * 16 * 128 * 128;
    unsigned short* IDX = (unsigned short*)(ws + WS_IDX); float* GW = (float*)(ws + WS_GW);
    char* Kl = lds;
    unsigned char* sub = (unsigned char*)(lds + 65536) + F.wave * 1024;
    const int lane = F.lane, r32 = lane & 31, hi = lane >> 5;
    const int nunits = (nrows / 256) * 8;
    for (int u = F.bid; u < nunits; u += F.G) {
        const int h = u & 7, rb = u >> 3;
        __syncthreads();
#pragma unroll
        for (int i = 0; i < 8; ++i) { const int ci = F.tid + 512 * i, krow = ci >> 4, ch = ci & 15;
            const u32x4 v = *(const u32x4*)(PK + ((size_t)(2 * h) * 128 + krow) * 128 + ch * 8);
            *(u32x4*)(Kl + krow * 256 + ((ch * 16) ^ ((krow & 7) << 4))) = v; }
        __syncthreads();
        const int row = rb * 256 + F.wave * 32 + r32;
        const unsigned hi4 = (unsigned)hi << 2, hi7 = (unsigned)hi << 7;
        unsigned t0[16], t1[16];
#pragma unroll
        for (int p = 0; p < 2; ++p) {
            const bf16* qrow = QP + (size_t)row * 2048 + (2 * h + p) * 128 + hi * 8;
            bf16x8 bq[8];
#pragma unroll
            for (int s = 0; s < 8; ++s) bq[s] = *reinterpret_cast<const bf16x8*>(qrow + s * 16);
            unsigned top[16];
#pragma unroll
            for (int blk = 0; blk < 4; ++blk) {
                f32x16 acc = f32x16{};
                const char* kb = Kl + (p * 128 + blk * 32 + r32) * 256;
#pragma unroll
                for (int s = 0; s < 8; ++s) { const bf16x8 ka = *reinterpret_cast<const bf16x8*>(kb + (((s * 16 + hi * 8) * 2) ^ ((r32 & 7) << 4)));
                    acc = __builtin_amdgcn_mfma_f32_32x32x16_bf16(ka, bq[s], acc, 0, 0, 0); }
                unsigned c[16];
#pragma unroll
                for (int r = 0; r < 16; ++r) c[r] = ((f2key(acc[r]) & ~127u) | (unsigned)(127 - (blk * 32 + (r & 3) + 8 * (r >> 2)))) ^ hi4;
                sort16_desc(c);
                if (blk == 0) {
#pragma unroll
                    for (int i = 0; i < 16; ++i) top[i] = c[i];
                } else merge16_desc(top, c);
                __builtin_amdgcn_sched_barrier(0);
            }
            merge16_partner(top);
#pragma unroll
            for (int i = 0; i < 16; ++i) { if (p == 0) t0[i] = top[i]; else t1[i] = top[i]; }
        }
        if (hi == 0) { unsigned* sw = (unsigned*)(sub + r32 * 32);
#pragma unroll
            for (int q = 0; q < 4; ++q) {
                sw[q] = (127u - (t0[4 * q] & 127u)) | ((127u - (t0[4 * q + 1] & 127u)) << 8) | ((127u - (t0[4 * q + 2] & 127u)) << 16) | ((127u - (t0[4 * q + 3] & 127u)) << 24);
                sw[4 + q] = (127u - (t1[4 * q] & 127u)) | ((127u - (t1[4 * q + 1] & 127u)) << 8) | ((127u - (t1[4 * q + 2] & 127u)) << 16) | ((127u - (t1[4 * q + 3] & 127u)) << 24); } }
        float f1[16], fa[8];
#pragma unroll
        for (int i = 0; i < 16; ++i) f1[i] = key2f(t1[i] & ~127u);
#pragma unroll
        for (int i = 0; i < 8; ++i) fa[i] = key2f((hi ? t0[8 + i] : t0[i]) & ~127u);
        unsigned top[16];
#pragma unroll
        for (int i = 0; i < 8; ++i) {
            unsigned c[16];
#pragma unroll
            for (int b = 0; b < 16; ++b) c[b] = ((f2key(fa[i] + f1[b]) & ~255u) | (unsigned)(255 - (16 * i + b))) ^ hi7;
            if (i == 0) {
#pragma unroll
                for (int k = 0; k < 16; ++k) top[k] = c[k];
            } else merge16_desc(top, c);
            __builtin_amdgcn_sched_barrier(0);
        }
        merge16_partner(top);
        asm volatile("s_waitcnt lgkmcnt(0)" ::: "memory");
        float cv[16]; float den = 0.f; const float m = key2f(top[0] & ~255u);
#pragma unroll
        for (int i = 0; i < 16; ++i) { cv[i] = __expf(key2f(top[i] & ~255u) - m); den += cv[i]; }
        const float rden = 1.f / den;
        if (hi == 0) {
            unsigned iw[8];
#pragma unroll
            for (int i = 0; i < 16; i += 2) {
                const int fl0 = 255 - (int)(top[i] & 255u), fl1 = 255 - (int)(top[i + 1] & 255u);
                const unsigned e0 = (unsigned)sub[r32 * 32 + (fl0 >> 4)] * PNK + (unsigned)sub[r32 * 32 + 16 + (fl0 & 15)];
                const unsigned e1 = (unsigned)sub[r32 * 32 + (fl1 >> 4)] * PNK + (unsigned)sub[r32 * 32 + 16 + (fl1 & 15)];
                iw[i >> 1] = e0 | (e1 << 16); }
            u32x4* ip = (u32x4*)(IDX + (size_t)row * 128 + h * 16); ip[0] = (u32x4){iw[0], iw[1], iw[2], iw[3]}; ip[1] = (u32x4){iw[4], iw[5], iw[6], iw[7]};
            f32x4* gp = (f32x4*)(GW + (size_t)row * 128 + h * 16);
#pragma unroll
            for (int q = 0; q < 4; ++q) gp[q] = (f32x4){cv[4 * q] * rden, cv[4 * q + 1] * rden, cv[4 * q + 2] * rden, cv[4 * q + 3] * rden};
        }
    }
}

typedef __bf16 bf16x2_t __attribute__((ext_vector_type(2)));
typedef float f32x2v __attribute__((ext_vector_type(2)));
__device__ __forceinline__ float dot2(unsigned w, unsigned x, float acc) { return __builtin_amdgcn_fdot2_f32_bf16(__builtin_bit_cast(bf16x2_t, w), __builtin_bit_cast(bf16x2_t, x), acc, false); }
__device__ __forceinline__ float dot16(const u32x4 a0, const u32x4 a1, const u32x4 x0, const u32x4 x1) {
    float s0 = dot2(a0.x, x0.x, 0.f), s1 = dot2(a0.y, x0.y, 0.f), s2 = dot2(a0.z, x0.z, 0.f), s3 = dot2(a0.w, x0.w, 0.f);
    s0 = dot2(a1.x, x1.x, s0); s1 = dot2(a1.y, x1.y, s1); s2 = dot2(a1.z, x1.z, s2); s3 = dot2(a1.w, x1.w, s3);
    return (s0 + s1) + (s2 + s3);
}
__device__ __forceinline__ void fma8(float (&o)[8], const u32x4 v, float w) {
    o[0] += w * bf_lo(v.x); o[1] += w * bf_hi(v.x); o[2] += w * bf_lo(v.y); o[3] += w * bf_hi(v.y);
    o[4] += w * bf_lo(v.z); o[5] += w * bf_hi(v.z); o[6] += w * bf_lo(v.w); o[7] += w * bf_hi(v.w);
}

#define DPP_ADD(v, CTRL) ((v) + __builtin_bit_cast(float, __builtin_amdgcn_update_dpp(0, __builtin_bit_cast(int, (v)), (CTRL), 0xF, 0xF, true)))
__device__ __forceinline__ float dpp_sum8(float v) { v = DPP_ADD(v, 0xB1); v = DPP_ADD(v, 0x4E); v = DPP_ADD(v, 0x141); return v; }
__device__ __forceinline__ float dpp_sum16(float v) { v = dpp_sum8(v); v = DPP_ADD(v, 0x140); return v; }
__device__ __forceinline__ float sum_b345(float v) {
    v = DPP_ADD(v, 0x128);
    { unsigned a = __builtin_bit_cast(unsigned, v), b = a; asm volatile("s_nop 1\n\tv_permlane16_swap_b32 %0, %1" : "+v"(a), "+v"(b)); v = __builtin_bit_cast(float, a) + __builtin_bit_cast(float, b); }
    { unsigned a = __builtin_bit_cast(unsigned, v), b = a; asm volatile("s_nop 1\n\tv_permlane32_swap_b32 %0, %1" : "+v"(a), "+v"(b)); v = __builtin_bit_cast(float, a) + __builtin_bit_cast(float, b); }
    return v;
}
__device__ __forceinline__ float gelu_as(float v) {
    const float av = fabsf(v), t = __builtin_amdgcn_rcpf(av * 0.2316418882f + 1.0f);
    float q = t * 0.5307027145f + (-0.7265760135f); q = q * t + 0.7107068705f; q = q * t + (-0.142248368f); q = q * t + 0.127414796f; q = q * t;
    const float e = __builtin_amdgcn_exp2f((v * v) * (-0.72134752044f)); const float m = v * (q * e);
    return v < 0.f ? m : v - m;
}
typedef _Float16 h2_t __attribute__((ext_vector_type(2)));
__device__ __forceinline__ float dot2h(unsigned a, unsigned b, float acc) { return __builtin_amdgcn_fdot2(__builtin_bit_cast(h2_t, a), __builtin_bit_cast(h2_t, b), acc, false); }
constexpr unsigned H_ONES = 0x3C003C00u;
constexpr unsigned H_K64 = 0x64646464u;
constexpr float CODE_BIAS = 1152.f;

__device__ __forceinline__ void pu_phase(const Frame& F, ArgsP Ap, int l, int nrows, char* lds, const int pvar) {
    unsigned char* ws = Ap->ws;
    const unsigned short* IDX = (const unsigned short*)(ws + WS_IDX); const float* GW = (const float*)(ws + WS_GW);
    unsigned short* W16 = (unsigned short*)(ws + (pvar ? WS_W2 + (size_t)NROWS * 128 * 2 : WS_W2));
    const unsigned short* Bh = (const unsigned short*)(ws + WS_F16B);
    const char* Ut = (const char*)(ws + WS_U + (size_t)l * PEXP * DM);
    const float* US = (const float*)(ws + WS_US) + l * PEXP; const float* VS = (const float*)(ws + WS_VS) + l * PEXP;
    const int lane = F.lane, grp = lane >> 4, li = lane & 15;
    int* l_slot = (int*)(lds + F.wave * 2048); int* l_idx = l_slot + 128; float* l_g = (float*)(l_idx + 128);
    const bool xs = (F.G % 8) == 0;
    const int wv = xs ? ((F.bid >> 3) * 8 + F.wave) : F.gw, nwv = xs ? (F.G >> 3) * 8 : F.ngw, npass = xs ? 1 : 8;
    const unsigned long long lt = (1ull << lane) - 1ull;
    const unsigned lo2 = (unsigned)lane * 4u, li16 = (unsigned)li * 16u, li32 = (unsigned)li * 32u;
    for (int pass = 0; pass < npass; ++pass) {
        const int c = xs ? (F.bid & 7) : pass;
        unsigned iw = 0u, iwn = 0u; f32x2v gg = {0.f, 0.f}, ggn = {0.f, 0.f}; u32x4 xv[8], xn[8];
#define PU_LOAD(IW, GG, X, t_) do { IW = *(const unsigned*)((const char*)(IDX + (size_t)(t_) * 128) + lo2); GG = *(const f32x2v*)((const char*)(GW + (size_t)(t_) * 128) + 2 * lo2); \
        const char* xr_ = (const char*)(Bh + (size_t)(t_) * DM); _Pragma("unroll") for (int s = 0; s < 4; ++s) { X[2 * s] = *(const u32x4*)(xr_ + s * 512 + li32); X[2 * s + 1] = *(const u32x4*)(xr_ + s * 512 + li32 + 16u); } } while (0)
        int t = wv;
        if (t < nrows) PU_LOAD(iw, gg, xv, t);
        for (; t < nrows; t += nwv) {
            const int i0 = (int)(iw & 0xffffu), i1 = (int)(iw >> 16); const bool m0 = (i0 >> 11) == c, m1 = (i1 >> 11) == c;
            const unsigned long long b0 = __ballot(m0), b1 = __ballot(m1); const int n = __popcll(b0) + __popcll(b1); const int r0 = __popcll(b0 & lt) + __popcll(b1 & lt);
            if (m0) { l_slot[r0] = 2 * lane; l_idx[r0] = i0; l_g[r0] = gg.x; }
            if (m1) { const int r1 = r0 + (m0 ? 1 : 0); l_slot[r1] = 2 * lane + 1; l_idx[r1] = i1; l_g[r1] = gg.y; }
            if (t + nwv < nrows) PU_LOAD(iwn, ggn, xn, t + nwv);
            float bsum = 0.f;
#pragma unroll
            for (int s = 0; s < 8; ++s) { bsum = dot2h(xv[s].x, H_ONES, bsum); bsum = dot2h(xv[s].y, H_ONES, bsum); bsum = dot2h(xv[s].z, H_ONES, bsum); bsum = dot2h(xv[s].w, H_ONES, bsum); }
            asm volatile("s_waitcnt lgkmcnt(0)" ::: "memory");
#pragma unroll 1
            for (int k0 = 0; k0 < n; k0 += 8) {
                const int kA = (k0 + grp < n) ? (k0 + grp) : (n - 1), kB = (k0 + 4 + grp < n) ? (k0 + 4 + grp) : (n - 1);
                const unsigned eA = (unsigned)l_idx[kA], eB = (unsigned)l_idx[kB];
                const char* uA = Ut + (eA * 1024u + li16); const char* uB = Ut + (eB * 1024u + li16);
                u32x4 ra[4], rb[4];
#pragma unroll
                for (int s = 0; s < 4; ++s) ra[s] = *(const u32x4*)(uA + s * 256);
#pragma unroll
                for (int s = 0; s < 4; ++s) rb[s] = *(const u32x4*)(uB + s * 256);
                const float usA = US[eA], vsA = VS[eA], usB = US[eB], vsB = VS[eB];
                float dA0 = 0.f, dA1 = 0.f, dB0 = 0.f, dB1 = 0.f;
#define PU_W(acc0, acc1, w_, xa_, xb_) do { acc0 = dot2h(__builtin_amdgcn_perm(H_K64, (w_), 0x04010400u), (xa_), acc0); acc1 = dot2h(__builtin_amdgcn_perm(H_K64, (w_), 0x04030402u), (xb_), acc1); } while (0)
#pragma unroll
                for (int s = 0; s < 4; ++s) { PU_W(dA0, dA1, ra[s].x, xv[2 * s].x, xv[2 * s].y); PU_W(dA0, dA1, ra[s].y, xv[2 * s].z, xv[2 * s].w); PU_W(dA0, dA1, ra[s].z, xv[2 * s + 1].x, xv[2 * s + 1].y); PU_W(dA0, dA1, ra[s].w, xv[2 * s + 1].z, xv[2 * s + 1].w); }
#pragma unroll
                for (int s = 0; s < 4; ++s) { PU_W(dB0, dB1, rb[s].x, xv[2 * s].x, xv[2 * s].y); PU_W(dB0, dB1, rb[s].y, xv[2 * s].z, xv[2 * s].w); PU_W(dB0, dB1, rb[s].z, xv[2 * s + 1].x, xv[2 * s + 1].y); PU_W(dB0, dB1, rb[s].w, xv[2 * s + 1].z, xv[2 * s + 1].w); }
#undef PU_W
                const float aA = usA * dpp_sum16((dA0 + dA1) - CODE_BIAS * bsum), aB = usB * dpp_sum16((dB0 + dB1) - CODE_BIAS * bsum);
                if (li == 0) {
                    if (k0 + grp < n) { const _Float16 hw = (_Float16)(l_g[kA] * gelu_as(aA) * vsA * 1024.f); W16[(size_t)t * 128 + l_slot[kA]] = __builtin_bit_cast(unsigned short, hw); }
                    if (k0 + 4 + grp < n) { const _Float16 hw = (_Float16)(l_g[kB] * gelu_as(aB) * vsB * 1024.f); W16[(size_t)t * 128 + l_slot[kB]] = __builtin_bit_cast(unsigned short, hw); }
                }
            }
            iw = iwn; gg = ggn;
#pragma unroll
            for (int s = 0; s < 8; ++s) xv[s] = xn[s];
        }
#undef PU_LOAD
    }
}

__device__ __forceinline__ void pv_phase(const Frame& F, ArgsP Ap, int l, int nrows, const bool dry, char* lds) {
    unsigned char* ws = Ap->ws;
    const unsigned short* IDX = (const unsigned short*)(ws + WS_IDX); const unsigned short* W16 = (const unsigned short*)(ws + WS_W2);
    const char* Vt = (const char*)(ws + WS_V + (size_t)l * PEXP * DM);
    const float* MOD = (const float*)(ws + WS_MOD) + (size_t)l * 9 * 6144 + 5 * DM;
    float* hlat = dry ? (float*)(ws + WS_X5) : Ap->out; float* hctx = dry ? (float*)(ws + WS_X5) + (size_t)NLAT * DM : (float*)(ws + WS_HCTX);
    float* g2l = (float*)lds;
    const int lane = F.lane, sub = lane >> 3, dch = lane & 7;
    const bool xs = (F.G % 8) == 0;
    const int wv = xs ? ((F.bid >> 3) * 8 + F.wave) : F.gw, nwv = xs ? (F.G >> 3) * 8 : F.ngw, npass = xs ? 1 : 8;
    for (int pass = 0; pass < npass; ++pass) {
        const int s = xs ? (F.bid & 7) : pass;
        const char* vslice = Vt + (size_t)s * PEXP * 128;
        const unsigned dchb = (unsigned)dch * 16u, coffb = (unsigned)(s * 128 + dch * 16) * 4u, subo = (unsigned)sub * 32u;
        __syncthreads();
        for (int i = F.tid; i < 9 * 128; i += 512) g2l[i] = MOD[(size_t)(i >> 7) * 6144 + s * 128 + (i & 127)];
        __syncthreads();
        u32x4 ia0, ib0, ia1, ib1, rA[8], rB[8], wA, wB; f32x4 h0, h1, h2, h3; float o_[16]; float wsum;
#define PV_IDX(IA, IB, t_) do { const char* ib_ = (const char*)(IDX + (size_t)(t_) * 128); IA = *(const u32x4*)(ib_ + subo); IB = *(const u32x4*)(ib_ + subo + 16u); } while (0)
#define PV_ROWS8(R, I) do { const unsigned iw_[4] = {I.x, I.y, I.z, I.w}; \
            _Pragma("unroll") for (int it = 0; it < 8; ++it) { const unsigned e_ = (it & 1) ? (iw_[it >> 1] >> 16) : (iw_[it >> 1] & 0xffffu); R[it] = *(const u32x4*)(vslice + (e_ * 128u + dchb)); } } while (0)
#define PV_ROWSA(IA, t_) do { PV_ROWS8(rA, IA); wA = *(const u32x4*)((const char*)(W16 + (size_t)(t_) * 128) + subo); } while (0)
#define PV_ROWSB(IB, t_) do { PV_ROWS8(rB, IB); wB = *(const u32x4*)((const char*)(W16 + (size_t)(t_) * 128) + subo + 16u); \
            { const char* hr_ = (const char*)(((t_) < NLAT) ? (hlat + (size_t)(t_) * DM) : (hctx + (size_t)((t_) - NLAT) * DM));     \
              h0 = *(const f32x4*)(hr_ + coffb); h1 = *(const f32x4*)(hr_ + coffb + 16u); h2 = *(const f32x4*)(hr_ + coffb + 32u); h3 = *(const f32x4*)(hr_ + coffb + 48u); } } while (0)
#define PV_C4(A_, B_, wp_, base_) do { \
            o_[(base_) + 0] = dot2h(__builtin_amdgcn_perm((B_), (A_), 0x0C040C00u) | 0x64006400u, (wp_), o_[(base_) + 0]); o_[(base_) + 1] = dot2h(__builtin_amdgcn_perm((B_), (A_), 0x0C050C01u) | 0x64006400u, (wp_), o_[(base_) + 1]); \
            o_[(base_) + 2] = dot2h(__builtin_amdgcn_perm((B_), (A_), 0x0C060C02u) | 0x64006400u, (wp_), o_[(base_) + 2]); o_[(base_) + 3] = dot2h(__builtin_amdgcn_perm((B_), (A_), 0x0C070C03u) | 0x64006400u, (wp_), o_[(base_) + 3]); } while (0)
#define PV_SUM8(R, W) do { const unsigned ww_[4] = {W.x, W.y, W.z, W.w}; \
            _Pragma("unroll") for (int m = 0; m < 4; ++m) { const u32x4 ra_ = R[2 * m], rb_ = R[2 * m + 1]; const unsigned wp_ = ww_[m]; wsum = dot2h(wp_, H_ONES, wsum); \
                PV_C4(ra_.x, rb_.x, wp_, 0); PV_C4(ra_.y, rb_.y, wp_, 4); PV_C4(ra_.z, rb_.z, wp_, 8); PV_C4(ra_.w, rb_.w, wp_, 12); } } while (0)
#define PV_FINA() do { _Pragma("unroll") for (int i = 0; i < 16; ++i) o_[i] = 0.f; wsum = 0.f; PV_SUM8(rA, wA); } while (0)
#define PV_FINB(t_) do { PV_SUM8(rB, wB); \
            const float wsr_ = sum_b345(wsum) * CODE_BIAS; \
            _Pragma("unroll") for (int i = 0; i < 16; ++i) o_[i] = (sum_b345(o_[i]) - wsr_) * (1.f / 1024.f); \
            { const bool lat_ = (t_) < NLAT; float* hr_ = (float*)((char*)(lat_ ? (hlat + (size_t)(t_) * DM) : (hctx + (size_t)((t_) - NLAT) * DM)) + coffb); \
                const f32x4* g2_ = (const f32x4*)(g2l + (lat_ ? ((t_) >> 12) : 8) * 128 + dch * 16); \
                  \
                *(f32x4*)hr_ = h0 + g2_[0] * (f32x4){o_[0], o_[1], o_[2], o_[3]}; *(f32x4*)(hr_ + 4) = h1 + g2_[1] * (f32x4){o_[4], o_[5], o_[6], o_[7]}; \
                *(f32x4*)(hr_ + 8) = h2 + g2_[2] * (f32x4){o_[8], o_[9], o_[10], o_[11]}; *(f32x4*)(hr_ + 12) = h3 + g2_[3] * (f32x4){o_[12], o_[13], o_[14], o_[15]}; } } while (0)
        int t = wv;
        if (t < nrows) { PV_IDX(ia0, ib0, t); PV_ROWSA(ia0, t); }
        for (; t + 2 * nwv < nrows; t += 2 * nwv) {
            PV_IDX(ia1, ib1, t + nwv);     PV_ROWSB(ib0, t);       PV_FINA(); PV_ROWSA(ia1, t + nwv);     PV_FINB(t);
            PV_IDX(ia0, ib0, t + 2 * nwv); PV_ROWSB(ib1, t + nwv); PV_FINA(); PV_ROWSA(ia0, t + 2 * nwv); PV_FINB(t + nwv);
        }
        for (; t < nrows; t += 2 * nwv) {
            const int t1 = t + nwv;
            if (t1 < nrows) PV_IDX(ia1, ib1, t1);
            PV_ROWSB(ib0, t); PV_FINA();
            if (t1 < nrows) PV_ROWSA(ia1, t1);
            PV_FINB(t);
            if (t1 < nrows) { PV_ROWSB(ib1, t1); PV_FINA(); PV_FINB(t1); }
        }
#undef PV_IDX
#undef PV_ROWS8
#undef PV_ROWSA
#undef PV_ROWSB
#undef PV_C4
#undef PV_SUM8
#undef PV_FINA
#undef PV_FINB
    }
}
constexpr int PH_PER_LAYER = 12, N_PHASES = 1 + DEPTH * PH_PER_LAYER;
#ifndef MK_ONE_LAUNCH
#define MK_ONE_LAUNCH 0
#endif
#ifndef MK_MASK
#define MK_MASK 0x1FFF
#endif
#define PON(s) (((MK_MASK) >> (s)) & 1)

#ifndef DBG_NAIVE_GEMM
#define DBG_NAIVE_GEMM 0
#endif
#if DBG_NAIVE_GEMM
__device__ __forceinline__ void naive_gemm(const Frame& F, const pg8::Gemm g, int kind, const pg8::EpiStore es, const pg8::EpiResid er) {
    const int ncg = g.N / 64; const int nunits = g.M * ncg;
    for (int u = F.gw; u < nunits; u += F.ngw) {
        const int row = __builtin_amdgcn_readfirstlane(u / ncg), col = (u % ncg) * 64 + F.lane;
        const bf16* ar = g.A + (size_t)row * g.K; const bf16* br = g.Bt + (size_t)col * g.K; float acc = 0.f;
#pragma unroll 1
        for (int k = 0; k < g.K; k += 8) { const u32x4 a = *(const u32x4*)(ar + k), b = *(const u32x4*)(br + k); float x[8], y[8]; unpack8(a, x); unpack8(b, y);
#pragma unroll
            for (int e = 0; e < 8; ++e) acc = fmaf(x[e], y[e], acc); }
        if (kind == 0) { if (col < es.ncols) es.O[(size_t)row * es.ldc + col] = (bf16)(pk2(acc, 0.f) & 0xffffu); }
        else if (kind == 1) { const int head = col >> 7, j = col & 127; bf16* d = (j < 64) ? (es.O + (size_t)row * 768 + head * 96 + j) : (es.VM + (size_t)row * 512 + head * 64 + (j - 64)); *d = (bf16)(pk2(acc, 0.f) & 0xffffu); }
        else { const bool lat = row < er.nlat; const int sample = lat ? (row >> 12) : 8;
            const float* src = lat ? er.hin_lat + (size_t)row * 1024 : er.hin_ctx + (size_t)(row - er.nlat) * 1024; float* dst = lat ? er.hout_lat + (size_t)row * 1024 : er.hout_ctx + (size_t)(row - er.nlat) * 1024;
            dst[col] = src[col] + er.gate[(size_t)sample * 6144 + col] * acc; }
    }
}
#endif

__global__ void __launch_bounds__(512, 2) mk_fwd(Args args_unused) {
    extern __shared__ __attribute__((aligned(16))) unsigned char lds[];
    LAS unsigned char* lds3 = (LAS unsigned char*)lds;
    ArgsP args0 = (ArgsP)__builtin_amdgcn_kernarg_segment_ptr();
    const int ph_lo = args0->ph_lo, ph_hi = args0->ph_hi;
    const int wave_s = __builtin_amdgcn_readfirstlane((int)threadIdx.x >> 6);
#if MK_ONE_LAUNCH == 2
    {
        volatile LAS unsigned* st = (volatile LAS unsigned*)(lds3 + LDS_BYTES - 64);
        if (threadIdx.x < 2) st[threadIdx.x] = 0u;
        __syncthreads();
        (void)xcd_barrier_post((unsigned*)(args0->ws + WS_CTL), st, threadIdx.x == 0);
    }
#endif
#pragma unroll 1
    for (int pi = ph_lo; pi < ph_hi; ++pi) {
        int zv = 0; asm volatile("" : "+v"(zv));
        ArgsP args = args0; asm volatile("" : "+s"(args));
        Frame F;
        F.zv = zv; F.lane = (int)__builtin_amdgcn_mbcnt_hi(~0u, __builtin_amdgcn_mbcnt_lo(~0u, 0u)) + zv; F.wave = wave_s; F.tid = wave_s * 64 + F.lane;
        { int bx = blockIdx.x, gd = gridDim.x; asm volatile("" : "+s"(bx), "+s"(gd)); F.bid = bx; F.G = gd; F.vcu = (gd % 8 == 0) ? (bx % 8) * (gd / 8) + bx / 8 : bx; }
        F.gw = F.bid * 8 + F.wave; F.ngw = F.G * 8;
        unsigned char* ws = args->ws;
        const int phraw = args->prog[pi], ph = phraw & 63, pvar = phraw >> 6;
        int njobs = 0, jkind = 0;
        pg8::Gemm gj[2]; pg8::EpiStore ej[2];
        int l = 0, mrows = NROWS;
        if (ph == 0) { if (PON(12)) p0_prologue(F, args, lds3); }
        else {
            const int q = ph - 1, s = q % PH_PER_LAYER; l = q / PH_PER_LAYER;
            mrows = (l == DEPTH - 1) ? NLAT : NROWS;
            switch (s) {
            case 0: if (PON(0)) norm_mod_phase(F, args, l, 0, NROWS); break;
            case 1: if (PON(1)) { njobs = 1;
                gj[0] = pg8::Gemm{(const bf16*)(ws + WS_AB), (const bf16*)(ws + WS_WIN) + (size_t)l * DINP * DM, NROWS, DINP, DM};
                ej[0] = pg8::EpiStore{0, (bf16*)(ws + WS_P), DIN, DIN, nullptr}; } break;
            case 2: if (PON(2)) e2_phase(F, args, l, NROWS); break;
            case 3: if (PON(3)) { njobs = 2;
                gj[0] = pg8::Gemm{(const bf16*)(ws + WS_AB), (const bf16*)(ws + WS_WUQ) + (size_t)l * 768 * QRANK, NROWS, 768, QRANK};
                ej[0] = pg8::EpiStore{0, (bf16*)(ws + WS_QM), 768, 768, nullptr};
                gj[1] = pg8::Gemm{(const bf16*)(ws + WS_AB) + (size_t)NROWS * QRANK, (const bf16*)(ws + WS_WUKV) + (size_t)l * 1024 * KVRANK, NROWS, 1024, KVRANK};
                ej[1] = pg8::EpiStore{1, (bf16*)(ws + WS_KM), 768, 1024, (bf16*)(ws + WS_VM)}; } break;
            case 4: if (PON(4)) e3_phase(F, args, l, NROWS); break;
            case 5: if (PON(5)) {
#if DBG_NAIVE_ATTN
                attn_naive_phase(F, args, l);
#else
                attn_phase(F, args, l, (char*)lds);
#endif
                } break;
            case 6: if (PON(6)) { njobs = 1; jkind = 1;
                gj[0] = pg8::Gemm{(const bf16*)(ws + WS_AB), (const bf16*)(ws + WS_WOUT) + (size_t)l * DM * DM, mrows, DM, DM}; } break;
            case 7: if (PON(7)) norm_mod_phase(F, args, l, 1, mrows); break;
            case 8: if (PON(8)) { njobs = 1;
                gj[0] = pg8::Gemm{(const bf16*)(ws + WS_AB), (const bf16*)(ws + WS_PWQ) + (size_t)l * 2048 * DM, mrows, 2048, DM};
                ej[0] = pg8::EpiStore{0, (bf16*)(ws + WS_X5), 2048, 2048, nullptr}; } break;
            case 9: if (PON(9)) topkc_phase(F, args, l, mrows, (char*)lds); break;
            case 10: if (PON(10)) pu_phase(F, args, l, mrows, (char*)lds, pvar); break;
            default: if (PON(11)) pv_phase(F, args, l, mrows, pvar != 0, (char*)lds); break;
            }
        }
        if (njobs > 0) {
#if DBG_NAIVE_GEMM
            { const pg8::EpiResid ER{(l == 0) ? args->in[0] : args->out, args->in[2], args->out, (float*)(ws + WS_HCTX), (const float*)(ws + WS_MOD) + (size_t)l * 9 * 6144 + 2 * DM, NLAT};
              _Pragma("unroll 1") for (int j = 0; j < njobs; ++j) { const pg8::Gemm g = (j == 0) ? gj[0] : gj[1]; const pg8::EpiStore E = (j == 0) ? ej[0] : ej[1]; naive_gemm(F, g, jkind ? 2 : E.mode, E, ER); } }
#else
            if (jkind == 0) {
#pragma unroll 1
                for (int j = 0; j < njobs; ++j) { __syncthreads();
                    const pg8::Gemm g = (j == 0) ? gj[0] : gj[1]; const pg8::EpiStore E = (j == 0) ? ej[0] : ej[1];
                    pg8::StaticOrder S; S.init(g.M, g.N, F.G, F.bid);
                    pg8::gemm_phase<pg8::EpiStore, pg8::StaticOrder, true, true>(lds3, g, S, E, F.tid); }
            } else { __syncthreads();
                const pg8::Gemm g = gj[0];
                pg8::StaticOrder S; S.init(g.M, g.N, F.G, F.bid);
                pg8::EpiResid E{(l == 0) ? args->in[0] : args->out, args->in[2], args->out, (float*)(ws + WS_HCTX), (const float*)(ws + WS_MOD) + (size_t)l * 9 * 6144 + 2 * DM, NLAT};
                pg8::gemm_phase<pg8::EpiResid, pg8::StaticOrder, true, true>(lds3, g, S, E, F.tid); }
#endif
        }
#if MK_ONE_LAUNCH == 1
        if (pi + 1 < ph_hi) cg::this_grid().sync();
#elif MK_ONE_LAUNCH == 2
        if (pi + 1 < ph_hi) { XcdBarrier xb; xb.bar = (unsigned*)(ws + WS_CTL); xb.x = xb_xcc_id(); xb.st = (volatile LAS unsigned*)(lds3 + LDS_BYTES - 64); xcd_barrier(xb, F.tid == 0); }
#endif
    }
}

extern "C" void kernel_launch(void* const* d_in, const int* in_sizes, int n_in, void* d_out, int out_size, void* d_ws, size_t ws_size, hipStream_t stream) {
    static int grid = 0;
    if (grid == 0) {
        if (n_in != 23 || in_sizes[0] != NLAT * DM || out_size != NLAT * DM || ws_size < WS_END) {
            fprintf(stderr, "kernel_launch: unexpected shapes: n_in %d in0 %d out %d ws %zu (need %zu)\n", n_in, n_in > 0 ? in_sizes[0] : -1, out_size, ws_size, (size_t)WS_END); grid = -1; return; }
        int dev = 0, cus = 0, per_cu = 0;
        if (hipGetDevice(&dev) != hipSuccess || hipDeviceGetAttribute(&cus, hipDeviceAttributeMultiprocessorCount, dev) != hipSuccess) { fprintf(stderr, "kernel_launch: device query failed\n"); grid = -1; return; }
        if (hipFuncSetAttribute((const void*)mk_fwd, hipFuncAttributeMaxDynamicSharedMemorySize, LDS_BYTES) != hipSuccess) { fprintf(stderr, "kernel_launch: hipFuncSetAttribute failed\n"); grid = -1; return; }
        if (hipOccupancyMaxActiveBlocksPerMultiprocessor(&per_cu, (const void*)mk_fwd, 512, LDS_BYTES) != hipSuccess || per_cu < 1) { fprintf(stderr, "kernel_launch: occupancy query says %d\n", per_cu); per_cu = 1; }
        (void)hipGetLastError();
        grid = cus;
    }
    if (grid < 0) return;
    Args a{};
    for (int i = 0; i < 23; ++i) a.in[i] = (const float*)d_in[i];
    a.out = (float*)d_out; a.ws = (unsigned char*)d_ws;
    int np = 0;
#ifdef MK_PROG
    { static const int pr[] = {MK_PROG}; for (int i = 0; i < (int)(sizeof(pr) / sizeof(pr[0])); ++i) a.prog[np++] = (unsigned char)pr[i]; }
#else
    for (int p = 0; p < N_PHASES; ++p) a.prog[np++] = (unsigned char)p;
#endif
#if MK_ONE_LAUNCH == 2
    a.ph_lo = 0; a.ph_hi = np;
    if (hipMemsetAsync((char*)d_ws + WS_CTL, 0, CTL_ZERO_BYTES, stream) != hipSuccess) { fprintf(stderr, "kernel_launch: hipMemsetAsync of the barrier words failed\n"); return; }
    hipLaunchKernelGGL(mk_fwd, dim3(grid), dim3(512), LDS_BYTES, stream, a);
    { const hipError_t le = hipPeekAtLastError(); if (le != hipSuccess) fprintf(stderr, "kernel_launch: launch failed: %s\n", hipGetErrorName(le)); }
#elif MK_ONE_LAUNCH == 1
    a.ph_lo = 0; a.ph_hi = np;
    void* kargs[] = {&a};
    hipError_t e = hipLaunchCooperativeKernel((const void*)mk_fwd, dim3(grid), dim3(512), kargs, LDS_BYTES, stream);
    if (e != hipSuccess) fprintf(stderr, "kernel_launch: cooperative launch failed: %s (grid %d)\n", hipGetErrorString(e), grid);
#else
    for (int p = 0; p < np; ++p) {
        a.ph_lo = p; a.ph_hi = p + 1;
        hipLaunchKernelGGL(mk_fwd, dim3(grid), dim3(512), LDS_BYTES, stream, a);
    }
    const hipError_t le = hipPeekAtLastError();
    if (le != hipSuccess) fprintf(stderr, "kernel_launch: launch failed: %s\n", hipGetErrorName(le));
#endif
}
```

```cpp
#define MK_ONE_LAUNCH 2
#define DBG_PRECISE_TOPK 0
#define DBG_NAIVE_ATTN 0
#define DBG_PRECISE_PEER 0
#define DBG_NAIVE_GEMM 0
#define DBG_ASCALE 1.0f
#define DBG_PSCALE 1.0f
#include <hip/hip_runtime.h>
#include <hip/hip_cooperative_groups.h>
#include <cstdio>
#include <cstdint>
#include <cmath>
namespace cg = cooperative_groups;
namespace pg8 {
#define PG8_LAS __attribute__((address_space(3)))
typedef unsigned short bf16_t;
typedef short bf16x8 __attribute__((ext_vector_type(8)));
typedef float f32x4 __attribute__((ext_vector_type(4)));
typedef unsigned u32x4 __attribute__((ext_vector_type(4)));
constexpr int BM = 256, BK = 64, HALF = 128, HTB = HALF * BK * 2  , STAGE_BYTES = 8 * HTB, NXCD = 8, WGM = 8;

__host__ __device__ __forceinline__ int lds_byte(int r, int c) { const int st = (r >> 4) * 2 + (c >> 5), rr = r & 15, cc = c & 31, ob = rr * 64 + cc * 2; return st * 1024 + (ob ^ (((ob >> 9) & 1) << 5)); }
__host__ __device__ __forceinline__ void stage_rc(int b, int& R, int& C) { const int st = b / 1024, sb = b % 1024, swz = sb ^ (((sb >> 9) & 1) << 5); R = (st >> 1) * 16 + swz / 64; C = (st & 1) * 32 + (swz % 64) / 2; }
__host__ __device__ __forceinline__ int perm32(int rho) { const int n = rho >> 4, i = rho & 15; return 8 * (i >> 2) + 4 * n + (i & 3); }

struct Unit { int pm, pn; };
struct Gemm { const bf16_t* A; const bf16_t* Bt; int M, N, K; };

struct StaticOrder {
    int nM, nN, nwg, G, c;
    __host__ __device__ void init(int M, int N, int G_, int c_) { nM = M / BM; nN = N / BM; nwg = nM * nN; G = G_; c = c_; }
    __host__ __device__ bool next(int i, Unit& u) const {
        const long L = (long)i * G + c; if (L >= nwg) return false;
        int wgid = (int)L; { const int q = nwg / NXCD, r = nwg % NXCD, xcd = wgid % NXCD, off = wgid / NXCD; wgid = (xcd < r ? xcd * (q + 1) : r * (q + 1) + (xcd - r) * q) + off; }
        const int nig = WGM * nN, gid = wgid / nig, fm = gid * WGM, gsz = (nM - fm) < WGM ? (nM - fm) : WGM;
        u.pm = fm + ((wgid % nig) % gsz); u.pn = (wgid % nig) / gsz; return true;
    }
    __device__ __forceinline__ void a_ready(const Unit&) const {}
    __device__ __forceinline__ void done(const Unit&) const {}
};

__device__ __forceinline__ unsigned cvt_pk_bf16(float lo, float hi) { unsigned r; asm volatile("v_cvt_pk_bf16_f32 %0, %1, %2" : "=v"(r) : "v"(lo), "v"(hi)); return r; }
typedef float f32x2 __attribute__((ext_vector_type(2)));
typedef unsigned u32x2 __attribute__((ext_vector_type(2)));
#ifndef DBG_ASCALE
#define DBG_ASCALE 1.0f
#endif
#ifndef DBG_PSCALE
#define DBG_PSCALE 1.0f
#endif
struct EpiStore {
    static constexpr bool PERM = true, AFTER_DRAIN = false;
    int mode; bf16_t* O; int ldc; int ncols; bf16_t* VM;
    __device__ __forceinline__ void operator()(const f32x4 (&acc)[2][2][4][2], const Unit& u, int wr, int wc, int fr, int fq) const {
        const int row0 = u.pm * BM + wr * 64 + fr;
        bf16_t* base; int rstride, hstride; bool on0, on1;
        if (mode == 0) { const int col0 = u.pn * BM + wc * 32 + 8 * fq; base = O + (size_t)row0 * ldc + col0; rstride = ldc; hstride = HALF; on0 = col0 < ncols; on1 = col0 + HALF < ncols; }
        else {
            const int j = wc * 32 + 8 * fq; const bool isk = wc < 2;
            base = isk ? (O + (size_t)row0 * 768 + (2 * u.pn) * 96 + j) : (VM + (size_t)row0 * 512 + (2 * u.pn) * 64 + (j - 64));
            rstride = isk ? 768 : 512; hstride = isk ? 96 : 64; on0 = true; on1 = true; }
#pragma unroll
        for (int ai = 0; ai < 2; ++ai)
#pragma unroll
            for (int m = 0; m < 4; ++m) { bf16_t* rowp = base + (size_t)(ai * HALF + m * 16) * rstride;
#pragma unroll
                for (int bj = 0; bj < 2; ++bj) {
                    if (bj == 0 ? on0 : on1) { const f32x4 v0 = acc[ai][bj][m][0], v1 = acc[ai][bj][m][1]; u32x4 w;
                        w.x = cvt_pk_bf16(v0[0], v0[1]); w.y = cvt_pk_bf16(v0[2], v0[3]); w.z = cvt_pk_bf16(v1[0], v1[1]); w.w = cvt_pk_bf16(v1[2], v1[3]);
                        *(u32x4*)(rowp + bj * hstride) = w; } } }
    }
};
struct EpiResid {
    static constexpr bool PERM = false, AFTER_DRAIN = false;
    const float* hin_lat; const float* hin_ctx; float* hout_lat; float* hout_ctx; const float* gate; int nlat;
    __device__ __forceinline__ void operator()(const f32x4 (&acc)[2][2][4][2], const Unit& u, int wr, int wc, int fr, int fq) const {
        const int rowt = u.pm * BM; const bool lat = rowt < nlat; const int sample = lat ? (rowt >> 12) : 8;
        const float* src = lat ? hin_lat + (size_t)rowt * 1024 : hin_ctx + (size_t)(rowt - nlat) * 1024;
        float* dst = lat ? hout_lat + (size_t)rowt * 1024 : hout_ctx + (size_t)(rowt - nlat) * 1024;
        const float* g = gate + (size_t)sample * 6144;
        const int col0 = u.pn * BM + wc * 32 + 4 * fq;
#pragma unroll
        for (int bj = 0; bj < 2; ++bj)
#pragma unroll
            for (int n = 0; n < 2; ++n) { const int c = col0 + bj * HALF + n * 16; const f32x4 gv = *(const f32x4*)(g + c);
#pragma unroll
                for (int ai = 0; ai < 2; ++ai)
#pragma unroll
                    for (int m = 0; m < 4; ++m) { const size_t off = (size_t)(ai * HALF + wr * 64 + m * 16 + fr) * 1024 + c;
                        const f32x4 hv = *(const f32x4*)(src + off); *(f32x4*)(dst + off) = hv + gv * acc[ai][bj][m][n] * (float)(DBG_ASCALE); } }
    }
};
template <class Epi, class Sched, bool ALIGN_EPI = false, bool SP2 = false>
__device__ __forceinline__ void gemm_phase(PG8_LAS unsigned char* lds, const Gemm g, const Sched& S, const Epi& E, const int tid_in) {
    const int tid = tid_in, wid = __builtin_amdgcn_readfirstlane(tid >> 6), lane = tid & 63, wr = wid >> 2, wc = wid & 3, fr = lane & 15, fq = lane >> 4;
    const int K = g.K, nt = K / BK;
    unsigned voffA[2], voffB[2];
#pragma unroll
    for (int i = 0; i < 2; ++i) { int R, C; stage_rc(tid * 16 + i * 8192, R, C); const int Rb = Epi::PERM ? ((R & ~31) + perm32(R & 31)) : R;
        voffA[i] = (unsigned)(R * K + C) * 2u; voffB[i] = (unsigned)(Rb * K + C) * 2u; }
    const size_t kstep = (size_t)(BK * 2);
    const size_t hstep = (size_t)HALF * K * 2;
    const size_t tstep = 2 * hstep;
    const unsigned ldsw = (unsigned)wid * 1024u;
    const int aoff = lds_byte(wr * 64 + fr, fq * 8), boff = lds_byte(wc * 32 + fr, fq * 8);
#define PG8_SA(b, h) (((b) * 2 + (h)) * HTB)
#define PG8_SB(b, h) ((4 + (b) * 2 + (h)) * HTB)
#define PG8_STAGE(bufoff, gbase, voff) do { _Pragma("unroll") for (int _i = 0; _i < 2; ++_i) \
        __builtin_amdgcn_global_load_lds((const unsigned*)((const char*)(gbase) + (voff)[_i]), (PG8_LAS unsigned*)(lds + (bufoff) + ldsw + _i * 8192), 16, 0, 0); } while (0)
#define PG8_LDA(dst, b, h) do { _Pragma("unroll") for (int m = 0; m < 4; ++m) _Pragma("unroll") for (int k = 0; k < 2; ++k) dst[m][k] = *(const PG8_LAS bf16x8*)(lds + PG8_SA(b, h) + aoff + m * 2048 + k * 1024); } while (0)
#define PG8_LDB(dst, b, h) do { _Pragma("unroll") for (int n = 0; n < 2; ++n) _Pragma("unroll") for (int k = 0; k < 2; ++k) dst[n][k] = *(const PG8_LAS bf16x8*)(lds + PG8_SB(b, h) + boff + n * 2048 + k * 1024); } while (0)
#define PG8_MMA(ai, bj, At, Bt) do { __builtin_amdgcn_s_setprio(1); _Pragma("unroll") for (int m = 0; m < 4; ++m) _Pragma("unroll") for (int n = 0; n < 2; ++n) _Pragma("unroll") for (int k = 0; k < 2; ++k) \
        acc[ai][bj][m][n] = __builtin_amdgcn_mfma_f32_16x16x32_bf16(Bt[n][k], At[m][k], acc[ai][bj][m][n], 0, 0, 0); __builtin_amdgcn_s_setprio(0); } while (0)
#define PG8_WAIT_V(n) asm volatile("s_waitcnt vmcnt(" #n ")" ::: "memory")
#define PG8_WAIT_L(n) asm volatile("s_waitcnt lgkmcnt(" #n ")" ::: "memory")
#define PG8_BAR __builtin_amdgcn_s_barrier()
#define PG8_SCHED __builtin_amdgcn_sched_barrier(0)
    Unit cur, nxt; int ui = 0;
    if (!S.next(0, cur)) return;
    f32x4 acc[2][2][4][2];
#pragma unroll
    for (int a = 0; a < 2; ++a)
#pragma unroll
        for (int b = 0; b < 2; ++b)
#pragma unroll
            for (int m = 0; m < 4; ++m)
#pragma unroll
                for (int n = 0; n < 2; ++n) acc[a][b][m][n] = (f32x4){0.f, 0.f, 0.f, 0.f};
    bf16x8 At[4][2], B0[2][2], B1[2][2];
    const char* cA = (const char*)g.A + (size_t)cur.pm * tstep; const char* cB = (const char*)g.Bt + (size_t)cur.pn * tstep;
    S.a_ready(cur);
    if constexpr (SP2) {
        PG8_STAGE(PG8_SB(0, 0), cB, voffB); PG8_STAGE(PG8_SB(0, 1), cB + hstep, voffB); PG8_STAGE(PG8_SA(0, 0), cA, voffA); PG8_STAGE(PG8_SA(0, 1), cA + hstep, voffA);
        if (wr == 1) PG8_BAR;
        PG8_WAIT_V(2); PG8_BAR;
        PG8_STAGE(PG8_SB(1, 0), cB + kstep, voffB); PG8_STAGE(PG8_SA(1, 0), cA + kstep, voffA); PG8_STAGE(PG8_SB(1, 1), cB + hstep + kstep, voffB);
        PG8_WAIT_V(6); PG8_BAR;
    } else {
        PG8_STAGE(PG8_SB(0, 0), cB, voffB); PG8_STAGE(PG8_SA(0, 0), cA, voffA); PG8_STAGE(PG8_SB(0, 1), cB + hstep, voffB); PG8_STAGE(PG8_SA(0, 1), cA + hstep, voffA);
        if (wr == 1) PG8_BAR;
        PG8_WAIT_V(4); PG8_BAR;
        PG8_STAGE(PG8_SB(1, 0), cB + kstep, voffB); PG8_STAGE(PG8_SA(1, 0), cA + kstep, voffA); PG8_STAGE(PG8_SB(1, 1), cB + hstep + kstep, voffB);
        PG8_WAIT_V(6); PG8_BAR;
    }
    for (;;) {
        const bool has_next = S.next(ui + 1, nxt);
        const char* nA = has_next ? (const char*)g.A + (size_t)nxt.pm * tstep : cA; const char* nB = has_next ? (const char*)g.Bt + (size_t)nxt.pn * tstep : cB;
        _Pragma("unroll 1") for (int t = 0; t < nt; t += 2) {
            const bool last = (t == nt - 2);
            const char* a1 = cA + (size_t)(t + 1) * kstep;
            const char* a2 = last ? nA : cA + (size_t)(t + 2) * kstep; const char* b2 = last ? nB : cB + (size_t)(t + 2) * kstep;
            const char* a3 = a2 + kstep; const char* b3 = b2 + kstep;
            if (last && has_next) S.a_ready(nxt);
            if constexpr (SP2) {
            PG8_LDB(B0, 0, 0); PG8_LDB(B1, 0, 1); PG8_SCHED; PG8_LDA(At, 0, 0); PG8_STAGE(PG8_SA(1, 1), a1 + hstep, voffA);
            PG8_WAIT_V(8); PG8_WAIT_L(0); PG8_BAR; PG8_MMA(0, 0, At, B0); PG8_MMA(0, 1, At, B1); PG8_BAR; PG8_SCHED;
            PG8_LDA(At, 0, 1); PG8_STAGE(PG8_SB(0, 0), b2, voffB); PG8_STAGE(PG8_SB(0, 1), b2 + hstep, voffB); PG8_STAGE(PG8_SA(0, 0), a2, voffA);
            PG8_WAIT_V(8); PG8_WAIT_L(0); PG8_BAR; PG8_MMA(1, 0, At, B0); PG8_MMA(1, 1, At, B1); PG8_BAR; PG8_SCHED;
            PG8_LDB(B0, 1, 0); PG8_LDB(B1, 1, 1); PG8_SCHED; PG8_LDA(At, 1, 0); PG8_STAGE(PG8_SA(0, 1), a2 + hstep, voffA);
            PG8_WAIT_V(8); PG8_WAIT_L(0); PG8_BAR; PG8_MMA(0, 0, At, B0); PG8_MMA(0, 1, At, B1); PG8_BAR; PG8_SCHED;
            PG8_LDA(At, 1, 1); PG8_STAGE(PG8_SB(1, 0), b3, voffB); PG8_STAGE(PG8_SB(1, 1), b3 + hstep, voffB); PG8_STAGE(PG8_SA(1, 0), a3, voffA);
            PG8_WAIT_V(8); PG8_WAIT_L(0); PG8_BAR; PG8_MMA(1, 0, At, B0); PG8_MMA(1, 1, At, B1); PG8_BAR; PG8_SCHED;
            } else {
            PG8_LDB(B0, 0, 0); PG8_SCHED; PG8_LDA(At, 0, 0); PG8_STAGE(PG8_SA(1, 1), a1 + hstep, voffA);
            PG8_WAIT_L(8); PG8_BAR; PG8_WAIT_L(0); PG8_MMA(0, 0, At, B0); PG8_BAR; PG8_SCHED;
            PG8_LDB(B1, 0, 1); PG8_STAGE(PG8_SB(0, 0), b2, voffB);
            PG8_BAR; PG8_WAIT_L(0); PG8_MMA(0, 1, At, B1); PG8_BAR;
            PG8_LDA(At, 0, 1); PG8_STAGE(PG8_SA(0, 0), a2, voffA);
            PG8_BAR; PG8_WAIT_L(0); PG8_MMA(1, 0, At, B0); PG8_BAR; PG8_SCHED;
            PG8_STAGE(PG8_SB(0, 1), b2 + hstep, voffB);
            PG8_WAIT_V(6); PG8_BAR; PG8_MMA(1, 1, At, B1); PG8_BAR;
            PG8_LDB(B0, 1, 0); PG8_SCHED; PG8_LDA(At, 1, 0); PG8_STAGE(PG8_SA(0, 1), a2 + hstep, voffA);
            PG8_WAIT_L(8); PG8_BAR; PG8_WAIT_L(0); PG8_MMA(0, 0, At, B0); PG8_BAR; PG8_SCHED;
            PG8_LDB(B1, 1, 1); PG8_STAGE(PG8_SB(1, 0), b3, voffB);
            PG8_BAR; PG8_WAIT_L(0); PG8_MMA(0, 1, At, B1); PG8_BAR;
            PG8_LDA(At, 1, 1); PG8_STAGE(PG8_SA(1, 0), a3, voffA);
            PG8_BAR; PG8_WAIT_L(0); PG8_MMA(1, 0, At, B0); PG8_BAR; PG8_SCHED;
            PG8_STAGE(PG8_SB(1, 1), b3 + hstep, voffB);
            PG8_WAIT_V(6); PG8_BAR; PG8_MMA(1, 1, At, B1); PG8_BAR;
            }
        }
        if constexpr (ALIGN_EPI) { if (wr == 0) PG8_BAR; }
        if constexpr (!Epi::AFTER_DRAIN) { E(acc, cur, wr, wc, fr, fq); S.done(cur); }
        if (!has_next) break;
#pragma unroll
        for (int a = 0; a < 2; ++a)
#pragma unroll
            for (int b = 0; b < 2; ++b)
#pragma unroll
                for (int m = 0; m < 4; ++m)
#pragma unroll
                    for (int n = 0; n < 2; ++n) acc[a][b][m][n] = (f32x4){0.f, 0.f, 0.f, 0.f};
        cur = nxt; cA = nA; cB = nB; ++ui;
        if constexpr (ALIGN_EPI) { if (wr == 1) PG8_BAR; }
    }
    PG8_WAIT_V(0);
    if constexpr (!ALIGN_EPI) { if (wr == 0) PG8_BAR; }
    PG8_BAR;
    if constexpr (Epi::AFTER_DRAIN) { E.fused(acc, cur, wr, wc, fr, fq, lds, wid, lane); S.done(cur); }
#undef PG8_SA
#undef PG8_SB
#undef PG8_STAGE
#undef PG8_LDA
#undef PG8_LDB
#undef PG8_MMA
#undef PG8_WAIT_V
#undef PG8_WAIT_L
#undef PG8_BAR
#undef PG8_SCHED
}
}
constexpr int DM = 1024, NB = 8, SEQ = 4096, CTXL = 256, DEPTH = 2;
constexpr int NLAT = NB * SEQ, NCTX = NB * CTXL, NROWS = NLAT + NCTX;
constexpr int DIN = 1440, DINP = 1536, QRANK = 384, KVRANK = 256;
constexpr int PH = 8, PNK = 128, PDH = 128, PTOPK = 16, PEXP = PNK * PNK;
constexpr float EPS = 1e-6f;
constexpr float LOG2E = 1.4426950408889634f;
constexpr float C_MLA = 0.10206207261596577f * LOG2E;
constexpr float C_SWA = 0.125f * LOG2E;

typedef unsigned short bf16;
typedef short bf16x8 __attribute__((ext_vector_type(8)));
typedef short s16x4 __attribute__((ext_vector_type(4)));
typedef float f32x4 __attribute__((ext_vector_type(4)));
typedef float f32x16 __attribute__((ext_vector_type(16)));
typedef unsigned u32x4 __attribute__((ext_vector_type(4)));
typedef unsigned u32x2v __attribute__((ext_vector_type(2)));
#define LAS __attribute__((address_space(3)))

constexpr size_t MiB = 1u << 20;
constexpr size_t WS_CTL = 0, CTL_ZERO_BYTES = 64 * 1024;
constexpr size_t WS_MOD = 1 * MiB;
constexpr size_t WS_RTS = WS_MOD + 512 * 1024;
constexpr size_t WS_RTM = WS_RTS + 64 * 16 * 2 * 4;
constexpr size_t WS_WIN = 2 * MiB;
constexpr size_t WS_WUQ = WS_WIN + 2ull * DINP * DM * 2;
constexpr size_t WS_WUKV = WS_WUQ + 2ull * 768 * QRANK * 2;
constexpr size_t WS_WOUT = WS_WUKV + 2ull * 1024 * KVRANK * 2;
constexpr size_t WS_PWQ = WS_WOUT + 2ull * 1024 * 1024 * 2;
constexpr size_t WS_PKEY = WS_PWQ + 2ull * 2048 * 1024 * 2;
constexpr size_t WS_HCTX = WS_PKEY + 2ull * 8 * 2 * 128 * 128 * 2;
constexpr size_t WS_US = WS_HCTX + (size_t)NCTX * 1024 * 4;
constexpr size_t WS_VS = WS_US + 2ull * PEXP * 4;
constexpr size_t WS_SB = WS_VS + 2ull * PEXP * 4;
constexpr size_t WS_U = 32 * MiB;
constexpr size_t WS_V = WS_U + 32 * MiB;
constexpr size_t WS_F16B = WS_V + 32 * MiB;
constexpr size_t WS_AB = WS_F16B + (size_t)NROWS * 1024 * 2;
constexpr size_t WS_P = WS_AB + (size_t)NROWS * 1024 * 2;
constexpr size_t WS_X5 = WS_P + (size_t)NROWS * DIN * 2;
constexpr size_t WS_QM = WS_X5, WS_KM = WS_QM + (size_t)NROWS * 768 * 2, WS_VM = WS_KM + (size_t)NROWS * 768 * 2, WS_QS = WS_VM + (size_t)NROWS * 512 * 2,
                 WS_KS = WS_QS + (size_t)NROWS * 512 * 2, WS_END = WS_KS + (size_t)NROWS * 128 * 2;
static_assert(WS_SB + (size_t)NROWS * 4 <= WS_U, "ws map (weights)");
static_assert(WS_END <= 512 * MiB, "ws map");
static_assert((size_t)NROWS * 2048 * 2 <= WS_END - WS_X5, "QP overlay");
static_assert((size_t)NROWS * 1024 <= (size_t)NROWS * DIN * 2, "TK overlay");

constexpr int LDS_BYTES = 163840;

__constant__ float ROPE_INV[24] = {1.0f, 0.5623413324356079f, 0.3162277638912201f, 0.17782793939113617f, 0.10000000149011612f, 0.05623413249850273f, 0.03162277489900589f, 0.017782794311642647f, 0.009999999776482582f, 0.005623413249850273f, 0.003162277629598975f, 0.0017782794311642647f, 0.0010000000474974513f, 0.000562341301701963f, 0.0003162277571391314f, 0.00017782794020604342f, 1.0f, 0.3162277638912201f, 0.10000000149011612f, 0.03162277489900589f, 0.009999999776482582f, 0.003162277629598975f, 0.0010000000474974513f, 0.0003162277571391314f};
struct Args {
    const float* in[23]; float* out; unsigned char* ws; int ph_lo, ph_hi; unsigned char prog[48];
};
typedef const __attribute__((address_space(4))) Args* ArgsP;

struct Frame {
    int tid, lane, wave, G, bid, vcu, gw, ngw, zv;
};

__device__ __forceinline__ float bf_lo(unsigned w) { return __uint_as_float(w << 16); }
__device__ __forceinline__ float bf_hi(unsigned w) { return __uint_as_float(w & 0xffff0000u); }
__device__ __forceinline__ unsigned pk2(float lo, float hi) { return pg8::cvt_pk_bf16(lo, hi); }
__device__ __forceinline__ float wave_sum(float v) {
#pragma unroll
    for (int o = 1; o < 64; o <<= 1) v += __shfl_xor(v, o);
    return v;
}
__device__ __forceinline__ void unpack8(const u32x4 w, float (&x)[8]) {
    x[0] = bf_lo(w.x); x[1] = bf_hi(w.x); x[2] = bf_lo(w.y); x[3] = bf_hi(w.y); x[4] = bf_lo(w.z); x[5] = bf_hi(w.z); x[6] = bf_lo(w.w); x[7] = bf_hi(w.w);
}
__device__ __forceinline__ u32x4 pack8(const float (&x)[8]) {
    u32x4 w; w.x = pk2(x[0], x[1]); w.y = pk2(x[2], x[3]); w.z = pk2(x[4], x[5]); w.w = pk2(x[6], x[7]); return w;
}

__device__ __forceinline__ void p0_transpose_item(const float* W, int K, int N, bf16* WT, LAS float* scr, int item, int lane) {
    const int nblk = N / 32, kb = item / nblk, nb = item % nblk, k0 = 64 * kb, n0 = 32 * nb;
#pragma unroll 8
    for (int i = 0; i < 32; ++i) { const int kk = 2 * i + (lane >> 5); scr[kk * 33 + (lane & 31)] = W[(size_t)(k0 + kk) * N + n0 + (lane & 31)]; }
    asm volatile("s_waitcnt lgkmcnt(0)" ::: "memory");
    const int c = lane & 7;
#pragma unroll
    for (int j = 0; j < 4; ++j) { const int n = (lane >> 3) + 8 * j; const LAS float* s = scr + (8 * c) * 33 + n;
        u32x4 o; o.x = pk2(s[0 * 33], s[1 * 33]); o.y = pk2(s[2 * 33], s[3 * 33]); o.z = pk2(s[4 * 33], s[5 * 33]); o.w = pk2(s[6 * 33], s[7 * 33]);
        *(u32x4*)(WT + (size_t)(n0 + n) * K + k0 + 8 * c) = o; }
    asm volatile("s_waitcnt lgkmcnt(0)" ::: "memory");
}

__device__ __forceinline__ void p0_prologue(const Frame& F, ArgsP Ap, LAS unsigned char* lds) {
    unsigned char* ws = Ap->ws;
    const float* c_in = Ap->in[1]; const float* cctx_in = Ap->in[3]; const float* ada_w = Ap->in[4]; const float* ada_b = Ap->in[5];
    for (int task = F.bid; task < 48; task += F.G) {
        const int l = task / 24, cc = task % 24;
        LAS float* sl = (LAS float*)lds;
        LAS float* red = (LAS float*)(lds + 9 * 1024 * 4);
        __syncthreads();
        for (int i = F.tid; i < 9 * 1024; i += 512) { const int s = i >> 10, k = i & 1023; const float x = (s < 8) ? c_in[s * 1024 + k] : cctx_in[k]; sl[i] = x / (1.f + __expf(-x)); }
        __syncthreads();
        const int c0 = cc * 256 + F.lane * 4; const int kbase = F.wave * 128;
        f32x4 acc[9];
#pragma unroll
        for (int s = 0; s < 9; ++s) acc[s] = (f32x4){0.f, 0.f, 0.f, 0.f};
        const float* wp = ada_w + ((size_t)l * 1024 + kbase) * 6144 + c0;
#pragma unroll 4
        for (int kk = 0; kk < 128; ++kk) { const f32x4 w = *(const f32x4*)(wp + (size_t)kk * 6144);
#pragma unroll
            for (int s = 0; s < 9; ++s) acc[s] += w * sl[s * 1024 + kbase + kk]; }
#pragma unroll
        for (int s = 0; s < 9; ++s) *(LAS f32x4*)(red + (F.wave * 9 + s) * 256 + F.lane * 4) = acc[s];
        __syncthreads();
        float* MOD = (float*)(ws + WS_MOD);
        for (int i = F.tid; i < 9 * 256; i += 512) { const int s = i >> 8, ci = i & 255; float v = ada_b[l * 6144 + cc * 256 + ci];
#pragma unroll
            for (int w = 0; w < 8; ++w) v += red[(w * 9 + s) * 256 + ci];
            MOD[((size_t)l * 9 + s) * 6144 + cc * 256 + ci] = v; }
        __syncthreads();
    }
    __syncthreads();
    if (F.bid == F.G - 1) {
        float* rts = (float*)(ws + WS_RTS); float* rtm = (float*)(ws + WS_RTM);
        for (int i = F.tid; i < 64 * 24; i += 512) {
            const int pos = i / 24, k = i % 24; const float a = (float)pos * ROPE_INV[k];
            const float rev = a * 0.15915494309189535f;
            const float cs = __builtin_amdgcn_cosf(rev), sn = __builtin_amdgcn_sinf(rev);
            if (k < 16) { rts[(pos * 16 + k) * 2] = cs; rts[(pos * 16 + k) * 2 + 1] = sn; } else { rtm[(pos * 8 + (k - 16)) * 2] = cs; rtm[(pos * 8 + (k - 16)) * 2 + 1] = sn; }
        }
    }
    LAS float* scr = (LAS float*)(lds + F.wave * 16384);
    constexpr int I_WIN = (DM / 64) * (DIN / 32), I_WUQ = (QRANK / 64) * (768 / 32), I_WUKV = (KVRANK / 64) * (1024 / 32), I_WOUT = (DM / 64) * (DM / 32), I_PWQ = (DM / 64) * (2048 / 32);
    constexpr int I_L = I_WIN + I_WUQ + I_WUKV + I_WOUT + I_PWQ;
    for (int it = F.gw; it < 2 * I_L; it += F.ngw) {
        const int l = it / I_L; int r = it % I_L;
        if (r < I_WIN) { p0_transpose_item(Ap->in[8] + (size_t)l * DM * DIN, DM, DIN, (bf16*)(ws + WS_WIN) + (size_t)l * DINP * DM, scr, r, F.lane); continue; } r -= I_WIN;
        if (r < I_WUQ) { p0_transpose_item(Ap->in[10] + (size_t)l * QRANK * 768, QRANK, 768, (bf16*)(ws + WS_WUQ) + (size_t)l * 768 * QRANK, scr, r, F.lane); continue; } r -= I_WUQ;
        if (r < I_WUKV) { p0_transpose_item(Ap->in[12] + (size_t)l * KVRANK * 1024, KVRANK, 1024, (bf16*)(ws + WS_WUKV) + (size_t)l * 1024 * KVRANK, scr, r, F.lane); continue; } r -= I_WUKV;
        if (r < I_WOUT) { p0_transpose_item(Ap->in[18] + (size_t)l * DM * DM, DM, DM, (bf16*)(ws + WS_WOUT) + (size_t)l * DM * DM, scr, r, F.lane); continue; } r -= I_WOUT;
        p0_transpose_item(Ap->in[19] + (size_t)l * DM * 2048, DM, 2048, (bf16*)(ws + WS_PWQ) + (size_t)l * 2048 * DM, scr, r, F.lane);
    }
    { const size_t gt = (size_t)F.bid * 512 + F.tid, nt = (size_t)F.G * 512;
      for (size_t i = gt; i < 2ull * 96 * DM / 8; i += nt) { const size_t l = i / (96 * DM / 8), e = i % (96 * DM / 8);
          *(u32x4*)((bf16*)(ws + WS_WIN) + l * DINP * DM + (size_t)DIN * DM + e * 8) = (u32x4){(unsigned)F.zv, (unsigned)F.zv, (unsigned)F.zv, (unsigned)F.zv}; }
      const size_t NKEY8 = 2ull * 8 * 2 * 128 * 128 / 8;
      for (size_t i = gt; i < NKEY8; i += nt) {
          const float* src = Ap->in[20]; bf16* dst = (bf16*)(ws + WS_PKEY);
          const f32x4 a = *(const f32x4*)(src + i * 8), b = *(const f32x4*)(src + i * 8 + 4);
          u32x4 o; o.x = pk2(a[0], a[1]); o.y = pk2(a[2], a[3]); o.z = pk2(b[0], b[1]); o.w = pk2(b[2], b[3]);
          *(u32x4*)(dst + i * 8) = o; }
    }
    for (int rr = F.gw; rr < 2 * 2 * PEXP; rr += F.ngw) {
        const int tab = rr / (2 * PEXP), lay = (rr / PEXP) & 1, e = rr % PEXP;
        const float* src = Ap->in[21 + tab] + ((size_t)lay * PEXP + e) * DM + 16 * F.lane;
        f32x4 x[4]; float mx = 0.f;
#pragma unroll
        for (int j = 0; j < 4; ++j) { x[j] = *(const f32x4*)(src + 4 * j); mx = fmaxf(fmaxf(fmaxf(mx, fabsf(x[j][0])), fmaxf(fabsf(x[j][1]), fabsf(x[j][2]))), fabsf(x[j][3])); }
#pragma unroll
        for (int o = 1; o < 64; o <<= 1) mx = fmaxf(mx, __shfl_xor(mx, o));
        const float inv = (mx > 0.f) ? 127.f / mx : 0.f;
        unsigned w[4]; const int bias = tab ? 128 : 0;
#pragma unroll
        for (int j = 0; j < 4; ++j) { const unsigned c0 = (unsigned)(bias + (int)rintf(x[j][0] * inv)) & 0xffu, c1 = (unsigned)(bias + (int)rintf(x[j][1] * inv)) & 0xffu, c2 = (unsigned)(bias + (int)rintf(x[j][2] * inv)) & 0xffu, c3 = (unsigned)(bias + (int)rintf(x[j][3] * inv)) & 0xffu;
            w[j] = c0 | (c1 << 8) | (c2 << 16) | (c3 << 24); }
        unsigned char* dst = tab ? (ws + WS_V + (size_t)lay * PEXP * DM + ((size_t)(F.lane >> 3) * PEXP + e) * 128 + (F.lane & 7) * 16)
                                 : (ws + WS_U + ((size_t)lay * PEXP + e) * DM + 16 * F.lane);
        *(u32x4*)dst = (u32x4){w[0], w[1], w[2], w[3]};
        if (F.lane == 0) ((float*)(ws + (tab ? WS_VS : WS_US)))[lay * PEXP + e] = (mx > 0.f) ? mx / 127.f : 1.f;
    }
}

#ifndef DBG_PRECISE_TOPK
#define DBG_PRECISE_TOPK 0
#endif
__device__ __forceinline__ void norm_mod_phase(const Frame& F, ArgsP Ap, int l, int which, int nrows) {
    unsigned char* ws = Ap->ws;
    const float* MOD = (const float*)(ws + WS_MOD);
    const float* gn = Ap->in[which ? 7 : 6] + l * DM;
    bf16* AB = (bf16*)(ws + WS_AB);
    const bool from_input = (which == 0 && l == 0);
    for (int r = F.gw; r < nrows; r += F.ngw) {
        const bool lat = r < NLAT;
        const float* hr = lat ? ((from_input ? Ap->in[0] : Ap->out) + (size_t)r * DM) : ((from_input ? Ap->in[2] : (const float*)(ws + WS_HCTX)) + (size_t)(r - NLAT) * DM);
        const int s = lat ? (r >> 12) : 8;
        const float* mp = MOD + ((size_t)l * 9 + s) * 6144 + (which ? 3 * DM : 0);
        f32x4 v[4]; float ss = 0.f;
#pragma unroll
        for (int j = 0; j < 4; ++j) { v[j] = *(const f32x4*)(hr + 256 * j + 4 * F.lane); ss += (v[j][0] * v[j][0] + v[j][1] * v[j][1]) + (v[j][2] * v[j][2] + v[j][3] * v[j][3]); }
        ss = wave_sum(ss);
        const float rinv = rsqrtf(ss * (1.f / DM) + EPS);
        f32x4 bq_[4];
#pragma unroll
        for (int j = 0; j < 4; ++j) { const int c = 256 * j + 4 * F.lane;
            const f32x4 g = *(const f32x4*)(gn + c), sh = *(const f32x4*)(mp + c), sc = *(const f32x4*)(mp + DM + c);
            const f32x4 y = v[j] * rinv * g; const f32x4 a = y * (sc + 1.f) + sh;
            u32x2v o; o.x = pk2(a[0], a[1]); o.y = pk2(a[2], a[3]);
            *(u32x2v*)(AB + (size_t)r * DM + c) = o;
            if (which) bq_[j] = a;
            }
        if (which) {
            float mx = 0.f;
#pragma unroll
            for (int j = 0; j < 4; ++j) mx = fmaxf(fmaxf(fmaxf(mx, fabsf(bq_[j][0])), fmaxf(fabsf(bq_[j][1]), fabsf(bq_[j][2]))), fabsf(bq_[j][3]));
#pragma unroll
            for (int o = 1; o < 64; o <<= 1) mx = fmaxf(mx, __shfl_xor(mx, o));
            const float inv = (mx > 0.f) ? 127.f / mx : 0.f;
#pragma unroll
            for (int j = 0; j < 4; ++j) { const unsigned c0 = (unsigned)((int)rintf(bq_[j][0] * inv)) & 0xffu, c1 = (unsigned)((int)rintf(bq_[j][1] * inv)) & 0xffu, c2 = (unsigned)((int)rintf(bq_[j][2] * inv)) & 0xffu, c3 = (unsigned)((int)rintf(bq_[j][3] * inv)) & 0xffu;
                *(unsigned*)(ws + WS_F16B + (size_t)r * DM + 256 * j + 4 * F.lane) = c0 | (c1 << 8) | (c2 << 16) | (c3 << 24); }
            if (F.lane == 0) ((float*)(ws + WS_SB))[r] = (mx > 0.f) ? mx / 127.f : 1.f;
        }
    }
}

__device__ __forceinline__ void e2_phase(const Frame& F, ArgsP Ap, int l, int nrows) {
    unsigned char* ws = Ap->ws;
    const bf16* P = (const bf16*)(ws + WS_P);
    bf16* QAN = (bf16*)(ws + WS_AB); bf16* KVAN = QAN + (size_t)NROWS * QRANK;
    bf16* QS = (bf16*)(ws + WS_QS); bf16* KS = (bf16*)(ws + WS_KS);
    const float* qa_g = Ap->in[9] + l * QRANK; const float* kva_g = Ap->in[11] + l * KVRANK;
    const float* sqn_g = Ap->in[15] + l * 64; const float* skn_g = Ap->in[16] + l * 64;
    const float* rts = (const float*)(ws + WS_RTS);
    const int lane = F.lane;
    for (int r = F.gw; r < nrows; r += F.ngw) {
        const bf16* pr = P + (size_t)r * DIN;
        const bool lat = r < NLAT; const int pos = r & (SEQ - 1), rp = pos >> 6, cp = pos & 63;
        u32x4 wqa = (u32x4){0u, 0u, 0u, 0u}, wkva = (u32x4){0u, 0u, 0u, 0u}, wsk = (u32x4){0u, 0u, 0u, 0u};
        if (lane < 48) wqa = *(const u32x4*)(pr + 8 * lane);
        const u32x4 wsq = *(const u32x4*)(pr + QRANK + 8 * lane);
        if (lane < 32) wkva = *(const u32x4*)(pr + 896 + 8 * lane);
        if (lane < 16) wsk = *(const u32x4*)(pr + 1184 + 8 * lane);
        float x[8];
        { unpack8(wqa, x); float ss = 0.f;
#pragma unroll
          for (int e = 0; e < 8; ++e) ss += x[e] * x[e];
          ss = wave_sum(ss); const float rinv = rsqrtf(ss * (1.f / QRANK) + EPS);
          if (lane < 48) { float y[8];
#pragma unroll
              for (int e = 0; e < 8; ++e) y[e] = x[e] * rinv * qa_g[8 * lane + e];
              *(u32x4*)(QAN + (size_t)r * QRANK + 8 * lane) = pack8(y); } }
        { unpack8(wkva, x); float ss = 0.f;
#pragma unroll
          for (int e = 0; e < 8; ++e) ss += x[e] * x[e];
          ss = wave_sum(ss); const float rinv = rsqrtf(ss * (1.f / KVRANK) + EPS);
          if (lane < 32) { float y[8];
#pragma unroll
              for (int e = 0; e < 8; ++e) y[e] = x[e] * rinv * kva_g[8 * lane + e];
              *(u32x4*)(KVAN + (size_t)r * KVRANK + 8 * lane) = pack8(y); } }
        const int ch = lane & 7;
        const float* tab = rts + (size_t)((ch < 4) ? rp : cp) * 32 + (ch & 1) * 16;
#pragma unroll
        for (int which = 0; which < 2; ++which) {
            unpack8(which ? wsk : wsq, x); float ss = 0.f;
#pragma unroll
            for (int e = 0; e < 8; ++e) ss += x[e] * x[e];
            ss += __shfl_xor(ss, 1); ss += __shfl_xor(ss, 2); ss += __shfl_xor(ss, 4);
            const float rinv = rsqrtf(ss * (1.f / 64.f) + EPS);
            const float* gg = which ? skn_g : sqn_g;
            float y[8], o[8];
#pragma unroll
            for (int e = 0; e < 8; ++e) y[e] = x[e] * rinv * gg[8 * ch + e];
#pragma unroll
            for (int e = 0; e < 8; ++e) { const float py = __shfl_xor(y[e], 2);
                if (lat) { const float cs = tab[2 * e], sn = tab[2 * e + 1]; o[e] = (ch & 2) ? (y[e] * cs + py * sn) : (y[e] * cs - py * sn); } else o[e] = y[e]; }
            if (which == 0) {
#pragma unroll
                for (int e = 0; e < 8; ++e) o[e] *= C_SWA;
                *(u32x4*)(QS + (size_t)r * 512 + 8 * lane) = pack8(o);
            } else if (lane < 16) *(u32x4*)(KS + (size_t)r * 128 + 8 * lane) = pack8(o);
        }
    }
}

__device__ __forceinline__ void e3_phase(const Frame& F, ArgsP Ap, int l, int nrows) {
    unsigned char* ws = Ap->ws;
    const bf16* P = (const bf16*)(ws + WS_P);
    bf16* QM = (bf16*)(ws + WS_QM); bf16* KM = (bf16*)(ws + WS_KM);
    const float* qn_g = Ap->in[13] + l * 96; const float* kn_g = Ap->in[14] + l * 96;
    const float* rtm = (const float*)(ws + WS_RTM);
    const int lane = F.lane, hl = lane / 12, ch = lane % 12, gbase = hl * 12;
    for (int r = F.gw; r < nrows; r += F.ngw) {
        const bool lat = r < NLAT; const int pos = r & (SEQ - 1), rp = pos >> 6, cp = pos & 63;
        const float* tab = rtm + (size_t)((ch < 10) ? rp : cp) * 16;
#pragma unroll
        for (int pass = 0; pass < 2; ++pass) {
            const int head = pass * 5 + hl; const bool valid = (lane < 60) && (head < 8);
#pragma unroll
            for (int which = 0; which < 2; ++which) {
                u32x4 w = (u32x4){0u, 0u, 0u, 0u};
                bf16* dstp = (which ? KM : QM) + (size_t)r * 768 + head * 96 + ch * 8;
                if (valid) { if (which == 1 && ch >= 8) w = *(const u32x4*)(P + (size_t)r * DIN + 1152 + (ch - 8) * 8); else w = *(const u32x4*)dstp; }
                float x[8]; unpack8(w, x); float ss = 0.f;
#pragma unroll
                for (int e = 0; e < 8; ++e) ss += x[e] * x[e];
                float tot = 0.f;
#pragma unroll
                for (int i = 0; i < 12; ++i) tot += __shfl(ss, (gbase + i) & 63);
                const float rinv = rsqrtf(tot * (1.f / 96.f) + EPS);
                const float* gg = which ? kn_g : qn_g;
                float y[8], o[8];
#pragma unroll
                for (int e = 0; e < 8; ++e) y[e] = x[e] * rinv * gg[8 * ch + e];
#pragma unroll
                for (int e = 0; e < 8; ++e) { const float py = __shfl_xor(y[e], 1);
                    if (lat && ch >= 8) { const float cs = tab[2 * e], sn = tab[2 * e + 1]; o[e] = (ch & 1) ? (y[e] * cs + py * sn) : (y[e] * cs - py * sn); } else o[e] = y[e]; }
                if (which == 0) {
#pragma unroll
                    for (int e = 0; e < 8; ++e) o[e] *= C_MLA;
                }
                if (valid) *(u32x4*)dstp = pack8(o);
            }
        }
    }
}
#define XB_TMO      128
#define XB_XCNT(j)  (256  + 64 * (j))
#define XB_XSUB(j)  (1280 + 64 * (j))
#define XB_XGEN(j)  (2304 + 64 * (j))
#define XB_TOP      3328
#define XB_TOPGEN   3392
#define XCD_BAR_WORDS 3456
#define XB_SPIN_CAP (1u << 18)

__device__ __forceinline__ unsigned xb_ld(unsigned* p)              { return __hip_atomic_load(p, __ATOMIC_RELAXED, __HIP_MEMORY_SCOPE_AGENT); }
__device__ __forceinline__ unsigned xb_add(unsigned* p, unsigned v) { return __hip_atomic_fetch_add(p, v, __ATOMIC_RELAXED, __HIP_MEMORY_SCOPE_AGENT); }
__device__ __forceinline__ unsigned xb_xcc_id() { return (unsigned)__builtin_amdgcn_s_getreg((3 << 11) | 20) & 0xFu; }
#define XB_SPIN(cond, bar) do { unsigned _sp = 0; while (cond) { __builtin_amdgcn_s_sleep(1); \
    if ((++_sp & 255u) == 0u) { if (xb_ld(&(bar)[XB_TMO])) break; if (_sp > XB_SPIN_CAP) { atomicAdd(&(bar)[XB_TMO], 1u); break; } } } } while (0)

struct XcdBarrier {
    unsigned* bar; unsigned x;
    volatile LAS unsigned* st;
};

__device__ __forceinline__ XcdBarrier xcd_barrier_post(unsigned* bar, volatile LAS unsigned* st, const bool t0) {
    XcdBarrier b; b.bar = bar; b.x = xb_xcc_id(); b.st = st;
    if (t0) (void)xb_add(&bar[XB_XCNT(b.x)], 1u);
    return b;
}
__device__ __forceinline__ void xcd_barrier_complete(unsigned* bar, unsigned x, unsigned& nloc, unsigned& nx) {
    const unsigned G = gridDim.x * gridDim.y * gridDim.z;
    unsigned sum, cnt, mine, sp = 0u;
    for (;;) {
        sum = 0u; cnt = 0u; mine = 0u;
#pragma unroll
        for (unsigned j = 0; j < 16; ++j) { const unsigned c = xb_ld(&bar[XB_XCNT(j)]); sum += c; cnt += (c > 0u) ? 1u : 0u; mine = (j == x) ? c : mine; }
        if (sum == G) break;
        __builtin_amdgcn_s_sleep(1);
        if ((++sp & 255u) == 0u) { if (xb_ld(&bar[XB_TMO])) break; if (sp > XB_SPIN_CAP) { atomicAdd(&bar[XB_TMO], 1u); break; } }
    }
    nloc = mine > 0u ? mine : 1u; nx = cnt > 0u ? cnt : 1u;
}

__device__ __forceinline__ void xcd_barrier(const XcdBarrier& b, const bool t0) {
    asm volatile("s_waitcnt vmcnt(0)" ::: "memory");
    __syncthreads();
    if (t0) {
        unsigned* bar = b.bar;
        __builtin_amdgcn_s_waitcnt(0);
        unsigned nloc = b.st[0], nx = b.st[1];
        if (nloc == 0u) { xcd_barrier_complete(bar, b.x, nloc, nx); b.st[0] = nloc; b.st[1] = nx; }
        const unsigned old = xb_add(&bar[XB_XSUB(b.x)], 1u);
        const unsigned gen = old / nloc;
        if (old + 1u == (gen + 1u) * nloc) {
            __builtin_amdgcn_fence(__ATOMIC_RELEASE, "agent");
            asm volatile("s_waitcnt vmcnt(0)" ::: "memory");
            const unsigned og = xb_add(&bar[XB_TOP], 1u);
            const unsigned tg = og / nx;
            if (og + 1u == (tg + 1u) * nx) xb_add(&bar[XB_TOPGEN], 1u);
            else XB_SPIN(xb_ld(&bar[XB_TOPGEN]) == tg, bar);
            __builtin_amdgcn_fence(__ATOMIC_ACQUIRE, "agent");
            xb_add(&bar[XB_XGEN(b.x)], 1u);
            asm volatile("s_waitcnt vmcnt(0)" ::: "memory");
        } else {
            XB_SPIN(xb_ld(&bar[XB_XGEN(b.x)]) == gen, bar);
            __builtin_amdgcn_fence(__ATOMIC_ACQUIRE, "agent");
            asm volatile("s_waitcnt vmcnt(0)" ::: "memory");
        }
    }
    __syncthreads();
}
namespace att {
constexpr int SHM_V = 64 * 64 * 2, SHM_K = 64 * 256, LDS_ATT = 2 * SHM_V + 2 * SHM_K + 8 * 64 * 4;
#define KSWZ(row, colB) ((row) * 256 + ((colB) ^ (((row) & 7) << 4)))
#define SBAR() __builtin_amdgcn_sched_barrier(0)
__device__ __forceinline__ int crow(int r, int hi) { return (r & 3) + 8 * (r >> 2) + 4 * hi; }
__device__ __forceinline__ int v_st(int k, int c) { const int kk = (k & ~0xC) | ((k & 4) << 1) | ((k & 8) >> 1); return ((kk >> 3) * 2 + (c >> 5)) * 512 + ((kk & 7) * 32 + (c & 31)) * 2; }
__device__ __forceinline__ int v_rd_base(int lane) { return ((lane & 3) << 3) | (((lane >> 2) & 3) << 6) | (((lane >> 4) & 1) << 5) | (((lane >> 5) & 1) << 8); }
constexpr int v_rd_off(int d0, int ks, int half) { return d0 * 512 + ks * 2048 + half * 1024; }
template <int OFF> __device__ __forceinline__ s16x4 tr_read(int vb) {
    s16x4 r; asm volatile("ds_read_b64_tr_b16 %0, %1 offset:%2" : "=&v"(r) : "v"(vb), "i"(OFF) : "memory"); return r;
}
template <int D0> __device__ __forceinline__ void pv_one(f32x16& od, int vb, bf16x8 pa0, bf16x8 pa1, bf16x8 pa2, bf16x8 pa3) {
    const s16x4 l0 = tr_read<v_rd_off(D0, 0, 0)>(vb), h0 = tr_read<v_rd_off(D0, 0, 1)>(vb), l1 = tr_read<v_rd_off(D0, 1, 0)>(vb), h1 = tr_read<v_rd_off(D0, 1, 1)>(vb);
    const s16x4 l2 = tr_read<v_rd_off(D0, 2, 0)>(vb), h2 = tr_read<v_rd_off(D0, 2, 1)>(vb), l3 = tr_read<v_rd_off(D0, 3, 0)>(vb), h3 = tr_read<v_rd_off(D0, 3, 1)>(vb);
    asm volatile("s_waitcnt lgkmcnt(0)" ::: "memory"); SBAR();
#define PK(L, H) (bf16x8){L[0], L[1], L[2], L[3], H[0], H[1], H[2], H[3]}
    od = __builtin_amdgcn_mfma_f32_32x32x16_bf16(pa0, PK(l0, h0), od, 0, 0, 0);
    od = __builtin_amdgcn_mfma_f32_32x32x16_bf16(pa1, PK(l1, h1), od, 0, 0, 0);
    od = __builtin_amdgcn_mfma_f32_32x32x16_bf16(pa2, PK(l2, h2), od, 0, 0, 0);
    od = __builtin_amdgcn_mfma_f32_32x32x16_bf16(pa3, PK(l3, h3), od, 0, 0, 0);
#undef PK
}
__device__ __forceinline__ void pv2(f32x16* o, int vb, bf16x8 pa0, bf16x8 pa1, bf16x8 pa2, bf16x8 pa3) {
    pv_one<0>(o[0], vb, pa0, pa1, pa2, pa3); pv_one<1>(o[1], vb, pa0, pa1, pa2, pa3);
}
template <int ND0> __device__ __forceinline__ void qkt(f32x16& p0, f32x16& p1, const char* Ks, const bf16x8* qr, int r32, int hi) {
    p0 = f32x16{}; p1 = f32x16{};
#pragma unroll
    for (int d0 = 0; d0 < ND0; ++d0) { const int cb = (d0 * 16 + hi * 8) * 2;
        const bf16x8 b0 = *reinterpret_cast<const bf16x8*>(Ks + KSWZ(r32, cb));
        const bf16x8 b1 = *reinterpret_cast<const bf16x8*>(Ks + KSWZ(32 + r32, cb));
        p0 = __builtin_amdgcn_mfma_f32_32x32x16_bf16(b0, qr[d0], p0, 0, 0, 0);
        p1 = __builtin_amdgcn_mfma_f32_32x32x16_bf16(b1, qr[d0], p1, 0, 0, 0); }
}
__device__ __forceinline__ void wmask(f32x16& p0, f32x16& p1, int kp0, int qp, int hi) {
#pragma unroll
    for (int r = 0; r < 16; ++r) { const int d0 = kp0 + crow(r, hi) - qp; const int d1 = d0 + 32;
        if (d0 > 128 || d0 < -128) p0[r] = -INFINITY; if (d1 > 128 || d1 < -128) p1[r] = -INFINITY; }
}
__device__ __forceinline__ void smpack(f32x16& p0, f32x16& p1, float& l_reg, bf16x8& pa0, bf16x8& pa1, bf16x8& pa2, bf16x8& pa3) {
#pragma unroll
    for (int r = 0; r < 16; ++r) p0[r] = __builtin_amdgcn_exp2f(p0[r]);
#pragma unroll
    for (int r = 0; r < 16; ++r) p1[r] = __builtin_amdgcn_exp2f(p1[r]);
    float ps = 0.f;
#pragma unroll
    for (int r = 0; r < 16; ++r) ps += p0[r];
#pragma unroll
    for (int r = 0; r < 16; ++r) ps += p1[r];
    l_reg += ps;
#define PK4(P, BASE, OUT) do { unsigned a0 = pk2(P[BASE + 0], P[BASE + 1]), a1 = pk2(P[BASE + 2], P[BASE + 3]);   \
    unsigned b0 = pk2(P[BASE + 4], P[BASE + 5]), b1 = pk2(P[BASE + 6], P[BASE + 7]);                              \
    auto r0 = __builtin_amdgcn_permlane32_swap(a0, b0, false, false); auto r1 = __builtin_amdgcn_permlane32_swap(a1, b1, false, false); \
    u32x4 w = {r0[0], r1[0], r0[1], r1[1]}; OUT = *reinterpret_cast<bf16x8*>(&w); } while (0)
    PK4(p0, 0, pa0); PK4(p0, 8, pa1); PK4(p1, 0, pa2); PK4(p1, 8, pa3);
#undef PK4
}

struct Unit {
    const bf16* Q; int ldq;
    const bf16* K; int ldk;
    const bf16* V; int ldv;
    bf16* O;
    int qrow0;
    int ctx_row0;
    int lat_row0;
    int nt;
    int qpos0;
    int kpos0;
    int masked;
    float l_init;
};

template <int DQK, bool MASKED>
__device__ __forceinline__ void attn_unit(const Unit& U, char* lds, const int tid) {
    constexpr int ND0 = DQK / 16, NCH = DQK / 8;
    const int wid = tid >> 6, lane = tid & 63, r32 = lane & 31, hi = lane >> 5;
    char* V_lds = lds; char* K_lds = lds + 2 * SHM_V;
    float* wsf = (float*)(lds + 2 * SHM_V + 2 * SHM_K) + wid * 64;
    float l_reg = (hi == 0) ? U.l_init : 0.f; f32x16 o[2] = {}; bf16x8 qr[ND0];
    const bf16* Qw = U.Q + (size_t)(U.qrow0 + wid * 32 + r32) * U.ldq + hi * 8;
#pragma unroll
    for (int d0 = 0; d0 < ND0; ++d0) qr[d0] = *reinterpret_cast<const bf16x8*>(Qw + d0 * 16);
    const int vk = tid >> 3, vc = (tid & 7) * 8, vst = v_st(vk, vc);
    const int k0r = tid / NCH, k0c = tid % NCH;
    const bool k1on = (NCH == 12) && (tid < 256);
    const int k1i = k1on ? (tid + 512) : tid, k1r = k1i / NCH, k1c = k1i % NCH;
    const int vb0 = (int)(uintptr_t)V_lds + v_rd_base(lane);
    struct Slot { bf16x8 v, k0, k1; } s0;
    auto tile_row = [&](int t) -> int { return (t < 4) ? (U.ctx_row0 + 64 * t) : (U.lat_row0 + 64 * (t - 4)); };
#define SLOAD(S, t) do { const int kr_ = tile_row(t); \
        S.v = *reinterpret_cast<const bf16x8*>(U.V + (size_t)(kr_ + vk) * U.ldv + vc); \
        S.k0 = *reinterpret_cast<const bf16x8*>(U.K + (size_t)(kr_ + k0r) * U.ldk + k0c * 8); \
        if (NCH == 12) S.k1 = *reinterpret_cast<const bf16x8*>(U.K + (size_t)(kr_ + k1r) * U.ldk + k1c * 8); } while (0)
#define SWRITE(b, S) do { *reinterpret_cast<bf16x8*>(V_lds + (b) * SHM_V + vst) = S.v; \
        *reinterpret_cast<bf16x8*>(K_lds + (b) * SHM_K + KSWZ(k0r, k0c * 16)) = S.k0; \
        if (NCH == 12) { if (k1on) *reinterpret_cast<bf16x8*>(K_lds + (b) * SHM_K + KSWZ(k1r, k1c * 16)) = S.k1; } } while (0)
#define MASK(P0, P1, t) do { if (MASKED && (t) >= 4) wmask(P0, P1, U.kpos0 + 64 * ((t) - 4), U.qpos0 + wid * 32 + r32, hi); } while (0)
    f32x16 pA0, pA1, pB0, pB1; bf16x8 pa0, pa1, pa2, pa3; const int NT = U.nt;
    __syncthreads();
    SLOAD(s0, 0); SWRITE(0, s0); __syncthreads();
    qkt<ND0>(pA0, pA1, K_lds, qr, r32, hi); MASK(pA0, pA1, 0);
    SLOAD(s0, 1);
    SWRITE(1, s0); __syncthreads();
    for (int j = 1; j + 1 < NT; j += 2) {
        SBAR(); qkt<ND0>(pB0, pB1, K_lds + SHM_K, qr, r32, hi); MASK(pB0, pB1, j);
        smpack(pA0, pA1, l_reg, pa0, pa1, pa2, pa3); SBAR();
        SLOAD(s0, j + 1); SBAR();
        pv2(o, vb0, pa0, pa1, pa2, pa3);
        __syncthreads(); SWRITE(0, s0); __syncthreads();
        SBAR(); qkt<ND0>(pA0, pA1, K_lds, qr, r32, hi); MASK(pA0, pA1, j + 1);
        smpack(pB0, pB1, l_reg, pa0, pa1, pa2, pa3); SBAR();
        SLOAD(s0, j + 2); SBAR();
        pv2(o, vb0 + SHM_V, pa0, pa1, pa2, pa3);
        __syncthreads(); SWRITE(1, s0); __syncthreads();
    }
    SBAR(); qkt<ND0>(pB0, pB1, K_lds + SHM_K, qr, r32, hi); MASK(pB0, pB1, NT - 1);
    smpack(pA0, pA1, l_reg, pa0, pa1, pa2, pa3); SBAR();
    pv2(o, vb0, pa0, pa1, pa2, pa3);
    smpack(pB0, pB1, l_reg, pa0, pa1, pa2, pa3); SBAR();
    pv2(o, vb0 + SHM_V, pa0, pa1, pa2, pa3);
    { auto rr = __builtin_amdgcn_permlane32_swap(__float_as_uint(l_reg), __float_as_uint(l_reg), false, false);
      l_reg = __uint_as_float(rr[0]) + __uint_as_float(rr[1]); }
    if (hi == 0) wsf[r32] = l_reg;
    asm volatile("s_waitcnt lgkmcnt(0)" ::: "memory");
    float rli[16];
#pragma unroll
    for (int r = 0; r < 16; ++r) rli[r] = 1.f / wsf[crow(r, hi)];
    bf16* Ow = U.O + (size_t)(U.qrow0 + wid * 32) * 1024;
#pragma unroll
    for (int r = 0; r < 16; ++r) { const int orow = crow(r, hi);
#pragma unroll
        for (int d0 = 0; d0 < 2; ++d0) { const unsigned w = pk2(o[d0][r] * rli[r], 0.f); Ow[(size_t)orow * 1024 + d0 * 32 + r32] = (bf16)(w & 0xffffu); } }
#undef SLOAD
#undef SWRITE
#undef MASK
}
#undef KSWZ
}

__device__ __forceinline__ void attn_phase(const Frame& F, ArgsP Ap, int l, char* lds) {
    unsigned char* ws = Ap->ws;
    const bf16* QM = (const bf16*)(ws + WS_QM); const bf16* KM = (const bf16*)(ws + WS_KM); const bf16* VM = (const bf16*)(ws + WS_VM);
    const bf16* QS = (const bf16*)(ws + WS_QS); const bf16* KS = (const bf16*)(ws + WS_KS); const bf16* VS = (const bf16*)(ws + WS_P) + 1312;
    bf16* OB = (bf16*)(ws + WS_AB);
    const float* sink = Ap->in[17] + l * 8;
    const int nunits = (l == 0) ? 1024 + 64 : 1024;
    for (int u = F.vcu; u < nunits; u += F.G) {
        const bool isl = u < 1024;
        const int i = u >> 8, c = u & 31, b = isl ? ((u & 255) >> 5) : ((u - 1024) >> 3), h = isl ? (2 * i + (c >> 4)) : (u & 7), qb = c & 15;
        att::Unit U; U.Q = QM + h * 96; U.ldq = 768; U.K = KM + h * 96; U.ldk = 768; U.V = VM + h * 64; U.ldv = 512; U.O = OB + h * 64;
        U.qrow0 = isl ? (b * SEQ + qb * 256) : (NLAT + b * CTXL); U.ctx_row0 = NLAT + b * CTXL; U.lat_row0 = b * SEQ; U.nt = isl ? (4 + SEQ / 64) : 4; U.qpos0 = 0; U.kpos0 = 0; U.masked = 0; U.l_init = 0.f;
        att::attn_unit<96, false>(U, lds, F.tid);
    }
    for (int u = F.vcu; u < nunits; u += F.G) {
        const bool isl = u < 1024;
        const int i = u >> 8, c = u & 31, b = isl ? ((u & 255) >> 5) : ((u - 1024) >> 3), h = isl ? (2 * i + (c >> 4)) : (u & 7), qb = c & 15, g = h >> 2;
        const int q0 = qb * 256; int k_lo = q0 - 128; if (k_lo < 0) k_lo = 0; int k_hi = q0 + 256 + 128; if (k_hi > SEQ) k_hi = SEQ;
        att::Unit U; U.Q = QS + h * 64; U.ldq = 512; U.K = KS + g * 64; U.ldk = 128; U.V = VS + g * 64; U.ldv = DIN; U.O = OB + 512 + h * 64;
        U.qrow0 = isl ? (b * SEQ + q0) : (NLAT + b * CTXL); U.ctx_row0 = NLAT + b * CTXL; U.lat_row0 = b * SEQ + k_lo; U.nt = isl ? (4 + (k_hi - k_lo) / 64) : 4; U.qpos0 = q0; U.kpos0 = k_lo; U.masked = 1;
        U.l_init = __builtin_amdgcn_exp2f(sink[h] * LOG2E);
        att::attn_unit<64, true>(U, lds, F.tid);
    }
}

#ifndef DBG_NAIVE_ATTN
#define DBG_NAIVE_ATTN 0
#endif
#if DBG_NAIVE_ATTN
__device__ __forceinline__ void attn_naive_phase(const Frame& F, ArgsP Ap, int l) {
    unsigned char* ws = Ap->ws;
    const bf16* QM = (const bf16*)(ws + WS_QM); const bf16* KM = (const bf16*)(ws + WS_KM); const bf16* VM = (const bf16*)(ws + WS_VM);
    const bf16* QS = (const bf16*)(ws + WS_QS); const bf16* KS = (const bf16*)(ws + WS_KS); const bf16* VS = (const bf16*)(ws + WS_P) + 1312;
    bf16* OB = (bf16*)(ws + WS_AB);
    const float* sink = Ap->in[17] + l * 8;
    const int nrg = ((l == 0) ? NROWS : NLAT) / 64;
    for (int u = F.gw; u < nrg * 8; u += F.ngw) {
        const int h = __builtin_amdgcn_readfirstlane(u & 7), rg = __builtin_amdgcn_readfirstlane(u >> 3), row = rg * 64 + F.lane;
        const bool lat = rg * 64 < NLAT; const int b = lat ? (rg * 64) >> 12 : (rg * 64 - NLAT) >> 8;
        {
            float q[96], o[64]; float lsum = 0.f;
#pragma unroll
            for (int d = 0; d < 96; d += 2) { const unsigned w = *(const unsigned*)(QM + (size_t)row * 768 + h * 96 + d); q[d] = bf_lo(w); q[d + 1] = bf_hi(w); }
#pragma unroll
            for (int d = 0; d < 64; ++d) o[d] = 0.f;
            const int nk = lat ? (CTXL + SEQ) : CTXL;
#pragma unroll 1
            for (int j = 0; j < nk; ++j) { const int kr = (j < CTXL) ? (NLAT + b * CTXL + j) : (b * SEQ + j - CTXL);
                const bf16* kp = KM + (size_t)kr * 768 + h * 96; const bf16* vp = VM + (size_t)kr * 512 + h * 64; float s = 0.f;
#pragma unroll
                for (int d = 0; d < 96; d += 2) { const unsigned w = *(const unsigned*)(kp + d); s = fmaf(q[d], bf_lo(w), s); s = fmaf(q[d + 1], bf_hi(w), s); }
                const float p = exp2f(s); lsum += p;
#pragma unroll
                for (int d = 0; d < 64; d += 2) { const unsigned w = *(const unsigned*)(vp + d); o[d] = fmaf(p, bf_lo(w), o[d]); o[d + 1] = fmaf(p, bf_hi(w), o[d + 1]); } }
            const float rl = 1.f / lsum;
#pragma unroll
            for (int d = 0; d < 64; d += 2) *(unsigned*)(OB + (size_t)row * 1024 + h * 64 + d) = pk2(o[d] * rl, o[d + 1] * rl);
        }
        {
            const int g = h >> 2; const int pos0 = (rg * 64) & (SEQ - 1), pos = pos0 + F.lane;
            float q[64], o[64]; float lsum = exp2f(sink[h] * LOG2E);
#pragma unroll
            for (int d = 0; d < 64; d += 2) { const unsigned w = *(const unsigned*)(QS + (size_t)row * 512 + h * 64 + d); q[d] = bf_lo(w); q[d + 1] = bf_hi(w); }
#pragma unroll
            for (int d = 0; d < 64; ++d) o[d] = 0.f;
            int jlo = pos0 - 128; if (jlo < 0) jlo = 0; int jhi = pos0 + 63 + 128; if (jhi > SEQ - 1) jhi = SEQ - 1;
            const int nk = lat ? (CTXL + (jhi - jlo + 1)) : CTXL;
#pragma unroll 1
            for (int j = 0; j < nk; ++j) { const bool isc = j < CTXL; const int kpos = jlo + j - CTXL; const int kr = isc ? (NLAT + b * CTXL + j) : (b * SEQ + kpos);
                const bf16* kp = KS + (size_t)kr * 128 + g * 64; const bf16* vp = VS + (size_t)kr * DIN + g * 64; float s = 0.f;
#pragma unroll
                for (int d = 0; d < 64; d += 2) { const unsigned w = *(const unsigned*)(kp + d); s = fmaf(q[d], bf_lo(w), s); s = fmaf(q[d + 1], bf_hi(w), s); }
                float p = exp2f(s); if (!isc) { const int dd = kpos - pos; if (dd > 128 || dd < -128) p = 0.f; } lsum += p;
#pragma unroll
                for (int d = 0; d < 64; d += 2) { const unsigned w = *(const unsigned*)(vp + d); o[d] = fmaf(p, bf_lo(w), o[d]); o[d + 1] = fmaf(p, bf_hi(w), o[d + 1]); } }
            const float rl = 1.f / lsum;
#pragma unroll
            for (int d = 0; d < 64; d += 2) *(unsigned*)(OB + (size_t)row * 1024 + 512 + h * 64 + d) = pk2(o[d] * rl, o[d + 1] * rl);
        }
    }
}
#endif
__device__ __forceinline__ unsigned f2key(float f) { const unsigned u = __float_as_uint(f); return (u & 0x80000000u) ? ~u : (u | 0x80000000u); }
__device__ __forceinline__ float key2f(unsigned k) { const unsigned u = (k & 0x80000000u) ? (k & 0x7fffffffu) : ~k; return __uint_as_float(u); }
#define CE_DESC(a, b) do { const unsigned _hi = max(a, b), _lo = min(a, b); a = _hi; b = _lo; } while (0)
__device__ __forceinline__ void sort16_desc(unsigned (&a)[16]) {
#pragma unroll
    for (int k = 2; k <= 16; k <<= 1)
#pragma unroll
        for (int j = k >> 1; j > 0; j >>= 1)
#pragma unroll
            for (int i = 0; i < 16; ++i) { const int p = i ^ j;
                if (p > i) { if ((i & k) == 0) { CE_DESC(a[i], a[p]); } else { CE_DESC(a[p], a[i]); } } }
}
__device__ __forceinline__ void merge16_desc(unsigned (&t)[16], const unsigned (&c)[16]) {
#pragma unroll
    for (int i = 0; i < 16; ++i) t[i] = max(t[i], c[15 - i]);
#pragma unroll
    for (int j = 8; j > 0; j >>= 1)
#pragma unroll
        for (int i = 0; i < 16; ++i) { const int p = i ^ j; if (p > i) CE_DESC(t[i], t[p]); }
}
__device__ __forceinline__ void merge16_partner(unsigned (&t)[16]) {
    unsigned oth[16];
#pragma unroll
    for (int i = 0; i < 16; ++i) oth[i] = (unsigned)__shfl_xor((int)t[i], 32);
    merge16_desc(t, oth);
}

constexpr size_t WS_IDX = WS_P;
constexpr size_t WS_GW = WS_P + (size_t)NROWS * 128 * 2;
constexpr size_t WS_W2 = WS_GW + (size_t)NROWS * 128 * 4;
constexpr size_t WS_USL = WS_W2 + (size_t)NROWS * 128 * 4;
static_assert(WS_USL + (size_t)NROWS * 128 * 4 <= WS_X5, "peer lists inside the P region");

__device__ __forceinline__ void topkc_phase(const Frame& F, ArgsP Ap, int l, int nrows, char* lds) {
    unsigned char* ws = Ap->ws;
    const bf16* QP = (const bf16*)(ws + WS_X5);
    const bf16* PK = (const bf16*)(ws + WS_PKEY) + (size_t)l * 16 * 128 * 128;
    unsigned short* IDX = (unsigned short*)(ws + WS_IDX); float* GW = (float*)(ws + WS_GW); float* USL = (float*)(ws + WS_USL);
    const float* USt = (const float*)(ws + WS_US) + l * PEXP; const float* VSt = (const float*)(ws + WS_VS) + l * PEXP;
    char* Kl = lds;
    unsigned char* sub = (unsigned char*)(lds + 65536) + F.wave * 1024;
    const int lane = F.lane, r32 = lane & 31, hi = lane >> 5;
    const int nunits = (nrows / 256) * 8;
    for (int u = F.bid; u < nunits; u += F.G) {
        const int h = u & 7, rb = u >> 3;
        __syncthreads();
#pragma unroll
        for (int i = 0; i < 8; ++i) { const int ci = F.tid + 512 * i, krow = ci >> 4, ch = ci & 15;
            const u32x4 v = *(const u32x4*)(PK + ((size_t)(2 * h) * 128 + krow) * 128 + ch * 8);
            *(u32x4*)(Kl + krow * 256 + ((ch * 16) ^ ((krow & 7) << 4))) = v; }
        __syncthreads();
        const int row = rb * 256 + F.wave * 32 + r32;
        const unsigned hi4 = (unsigned)hi << 2, hi7 = (unsigned)hi << 7;
        unsigned t0[16], t1[16];
#pragma unroll
        for (int p = 0; p < 2; ++p) {
            const bf16* qrow = QP + (size_t)row * 2048 + (2 * h + p) * 128 + hi * 8;
            bf16x8 bq[8];
#pragma unroll
            for (int s = 0; s < 8; ++s) bq[s] = *reinterpret_cast<const bf16x8*>(qrow + s * 16);
            unsigned top[16];
#pragma unroll
            for (int blk = 0; blk < 4; ++blk) {
                f32x16 acc = f32x16{};
                const char* kb = Kl + (p * 128 + blk * 32 + r32) * 256;
#pragma unroll
                for (int s = 0; s < 8; ++s) { const bf16x8 ka = *reinterpret_cast<const bf16x8*>(kb + (((s * 16 + hi * 8) * 2) ^ ((r32 & 7) << 4)));
                    acc = __builtin_amdgcn_mfma_f32_32x32x16_bf16(ka, bq[s], acc, 0, 0, 0); }
                unsigned c[16];
#pragma unroll
                for (int r = 0; r < 16; ++r) c[r] = ((f2key(acc[r]) & ~127u) | (unsigned)(127 - (blk * 32 + (r & 3) + 8 * (r >> 2)))) ^ hi4;
                sort16_desc(c);
                if (blk == 0) {
#pragma unroll
                    for (int i = 0; i < 16; ++i) top[i] = c[i];
                } else merge16_desc(top, c);
                __builtin_amdgcn_sched_barrier(0);
            }
            merge16_partner(top);
#pragma unroll
            for (int i = 0; i < 16; ++i) { if (p == 0) t0[i] = top[i]; else t1[i] = top[i]; }
        }
        if (hi == 0) { unsigned* sw = (unsigned*)(sub + r32 * 32);
#pragma unroll
            for (int q = 0; q < 4; ++q) {
                sw[q] = (127u - (t0[4 * q] & 127u)) | ((127u - (t0[4 * q + 1] & 127u)) << 8) | ((127u - (t0[4 * q + 2] & 127u)) << 16) | ((127u - (t0[4 * q + 3] & 127u)) << 24);
                sw[4 + q] = (127u - (t1[4 * q] & 127u)) | ((127u - (t1[4 * q + 1] & 127u)) << 8) | ((127u - (t1[4 * q + 2] & 127u)) << 16) | ((127u - (t1[4 * q + 3] & 127u)) << 24); } }
        float f1[16], fa[8];
#pragma unroll
        for (int i = 0; i < 16; ++i) f1[i] = key2f(t1[i] & ~127u);
#pragma unroll
        for (int i = 0; i < 8; ++i) fa[i] = key2f((hi ? t0[8 + i] : t0[i]) & ~127u);
        unsigned top[16];
#pragma unroll
        for (int i = 0; i < 8; ++i) {
            unsigned c[16];
#pragma unroll
            for (int b = 0; b < 16; ++b) c[b] = ((f2key(fa[i] + f1[b]) & ~255u) | (unsigned)(255 - (16 * i + b))) ^ hi7;
            if (i == 0) {
#pragma unroll
                for (int k = 0; k < 16; ++k) top[k] = c[k];
            } else merge16_desc(top, c);
            __builtin_amdgcn_sched_barrier(0);
        }
        merge16_partner(top);
        asm volatile("s_waitcnt lgkmcnt(0)" ::: "memory");
        float cv[16]; float den = 0.f; const float m = key2f(top[0] & ~255u);
#pragma unroll
        for (int i = 0; i < 16; ++i) { cv[i] = __expf(key2f(top[i] & ~255u) - m); den += cv[i]; }
        const float rden = 1.f / den;
        if (hi == 0) {
            unsigned iw[8];
#pragma unroll
            for (int i = 0; i < 16; i += 2) {
                const int fl0 = 255 - (int)(top[i] & 255u), fl1 = 255 - (int)(top[i + 1] & 255u);
                const unsigned e0 = (unsigned)sub[r32 * 32 + (fl0 >> 4)] * PNK + (unsigned)sub[r32 * 32 + 16 + (fl0 & 15)];
                const unsigned e1 = (unsigned)sub[r32 * 32 + (fl1 >> 4)] * PNK + (unsigned)sub[r32 * 32 + 16 + (fl1 & 15)];
                iw[i >> 1] = e0 | (e1 << 16); }
            u32x4* ip = (u32x4*)(IDX + (size_t)row * 128 + h * 16); ip[0] = (u32x4){iw[0], iw[1], iw[2], iw[3]}; ip[1] = (u32x4){iw[4], iw[5], iw[6], iw[7]};
            float us_[16], gv_[16];
#pragma unroll
            for (int i = 0; i < 16; ++i) { const unsigned e_ = (i & 1) ? (iw[i >> 1] >> 16) : (iw[i >> 1] & 0xffffu); us_[i] = USt[e_]; gv_[i] = cv[i] * rden * VSt[e_] * 1024.f; }
            f32x4* gp = (f32x4*)(GW + (size_t)row * 128 + h * 16); f32x4* up = (f32x4*)(USL + (size_t)row * 128 + h * 16);
#pragma unroll
            for (int q = 0; q < 4; ++q) { gp[q] = (f32x4){gv_[4 * q], gv_[4 * q + 1], gv_[4 * q + 2], gv_[4 * q + 3]}; up[q] = (f32x4){us_[4 * q], us_[4 * q + 1], us_[4 * q + 2], us_[4 * q + 3]}; }
        }
    }
}

typedef __bf16 bf16x2_t __attribute__((ext_vector_type(2)));
typedef float f32x2v __attribute__((ext_vector_type(2)));
__device__ __forceinline__ float dot2(unsigned w, unsigned x, float acc) { return __builtin_amdgcn_fdot2_f32_bf16(__builtin_bit_cast(bf16x2_t, w), __builtin_bit_cast(bf16x2_t, x), acc, false); }
__device__ __forceinline__ float dot16(const u32x4 a0, const u32x4 a1, const u32x4 x0, const u32x4 x1) {
    float s0 = dot2(a0.x, x0.x, 0.f), s1 = dot2(a0.y, x0.y, 0.f), s2 = dot2(a0.z, x0.z, 0.f), s3 = dot2(a0.w, x0.w, 0.f);
    s0 = dot2(a1.x, x1.x, s0); s1 = dot2(a1.y, x1.y, s1); s2 = dot2(a1.z, x1.z, s2); s3 = dot2(a1.w, x1.w, s3);
    return (s0 + s1) + (s2 + s3);
}
__device__ __forceinline__ void fma8(float (&o)[8], const u32x4 v, float w) {
    o[0] += w * bf_lo(v.x); o[1] += w * bf_hi(v.x); o[2] += w * bf_lo(v.y); o[3] += w * bf_hi(v.y);
    o[4] += w * bf_lo(v.z); o[5] += w * bf_hi(v.z); o[6] += w * bf_lo(v.w); o[7] += w * bf_hi(v.w);
}

#define DPP_ADD(v, CTRL) ((v) + __builtin_bit_cast(float, __builtin_amdgcn_update_dpp(0, __builtin_bit_cast(int, (v)), (CTRL), 0xF, 0xF, true)))
__device__ __forceinline__ float dpp_sum8(float v) { v = DPP_ADD(v, 0xB1); v = DPP_ADD(v, 0x4E); v = DPP_ADD(v, 0x141); return v; }
__device__ __forceinline__ float dpp_sum16(float v) { v = dpp_sum8(v); v = DPP_ADD(v, 0x140); return v; }
__device__ __forceinline__ float sum_b345(float v) {
    v = DPP_ADD(v, 0x128);
    { unsigned a = __builtin_bit_cast(unsigned, v), b = a; asm volatile("s_nop 1\n\tv_permlane16_swap_b32 %0, %1" : "+v"(a), "+v"(b)); v = __builtin_bit_cast(float, a) + __builtin_bit_cast(float, b); }
    { unsigned a = __builtin_bit_cast(unsigned, v), b = a; asm volatile("s_nop 1\n\tv_permlane32_swap_b32 %0, %1" : "+v"(a), "+v"(b)); v = __builtin_bit_cast(float, a) + __builtin_bit_cast(float, b); }
    return v;
}
__device__ __forceinline__ float gelu_as(float v) {
    const float av = fabsf(v), t = __builtin_amdgcn_rcpf(av * 0.2316418882f + 1.0f);
    float q = t * 0.5307027145f + (-0.7265760135f); q = q * t + 0.7107068705f; q = q * t + (-0.142248368f); q = q * t + 0.127414796f; q = q * t;
    const float e = __builtin_amdgcn_exp2f((v * v) * (-0.72134752044f)); const float m = v * (q * e);
    return v < 0.f ? m : v - m;
}
typedef _Float16 h2_t __attribute__((ext_vector_type(2)));
__device__ __forceinline__ float dot2h(unsigned a, unsigned b, float acc) { return __builtin_amdgcn_fdot2(__builtin_bit_cast(h2_t, a), __builtin_bit_cast(h2_t, b), acc, false); }
constexpr unsigned H_ONES = 0x3C003C00u;
constexpr unsigned H_K64 = 0x64646464u;
constexpr float CODE_BIAS = 1152.f;

typedef int i32x4 __attribute__((ext_vector_type(4)));
__device__ __forceinline__ void pu_phase(const Frame& F, ArgsP Ap, int l, int nrows, char* lds, const int pvar) {
    unsigned char* ws = Ap->ws;
    const unsigned short* IDX = (const unsigned short*)(ws + WS_IDX); const float* GW = (const float*)(ws + WS_GW); const float* USL = (const float*)(ws + WS_USL);
    unsigned short* W16 = (unsigned short*)(ws + (pvar ? WS_W2 + (size_t)NROWS * 128 * 2 : WS_W2));
    const char* Bq = (const char*)(ws + WS_F16B); const float* SB = (const float*)(ws + WS_SB);
    const char* Ut = (const char*)(ws + WS_U + (size_t)l * PEXP * DM);
    const int lane = F.lane, r16 = lane & 15, kg = lane >> 4;
    int* l_slot = (int*)(lds + F.wave * 2048); int* l_idx = l_slot + 128; float* l_g = (float*)(l_idx + 128); float* l_us = l_g + 128;
    LAS char* stage = (LAS char*)(uintptr_t)(unsigned)(uintptr_t)(lds + 16384 + F.wave * 16384);
    const bool xs = (F.G % 8) == 0;
    const int wv = xs ? ((F.bid >> 3) * 8 + F.wave) : F.gw, nwv = xs ? (F.G >> 3) * 8 : F.ngw, npass = xs ? 1 : 8;
    const unsigned long long lt = (1ull << lane) - 1ull;
    const unsigned lo2 = (unsigned)lane * 4u, kg16 = (unsigned)kg * 16u;
    for (int pass = 0; pass < npass; ++pass) {
        const int c = xs ? (F.bid & 7) : pass;
        unsigned iw = 0u; f32x2v gg = {0.f, 0.f}, uu = {0.f, 0.f}; i32x4 xq[16]; float sb = 0.f;
#define PU_LOADI(t_) do { iw = *(const unsigned*)((const char*)(IDX + (size_t)(t_) * 128) + lo2); gg = *(const f32x2v*)((const char*)(GW + (size_t)(t_) * 128) + 2 * lo2); uu = *(const f32x2v*)((const char*)(USL + (size_t)(t_) * 128) + 2 * lo2); } while (0)
#define PU_LOADX(t_) do { const char* xr_ = Bq + (size_t)(t_) * DM; _Pragma("unroll") for (int kk = 0; kk < 16; ++kk) xq[kk] = *(const i32x4*)(xr_ + kk * 64 + kg16); sb = SB[t_]; } while (0)
        int t = wv;
        if (t < nrows) { PU_LOADI(t); PU_LOADX(t); }
        for (; t < nrows; t += nwv) {
            const int i0 = (int)(iw & 0xffffu), i1 = (int)(iw >> 16); const bool m0 = (i0 >> 11) == c, m1 = (i1 >> 11) == c;
            const unsigned long long b0 = __ballot(m0), b1 = __ballot(m1); const int n = (pvar == 1) ? 0 : (__popcll(b0) + __popcll(b1)); const int r0 = __popcll(b0 & lt) + __popcll(b1 & lt);
            if (m0) { l_slot[r0] = 2 * lane; l_idx[r0] = i0; l_g[r0] = gg.x; l_us[r0] = uu.x; }
            if (m1) { const int r1 = r0 + (m0 ? 1 : 0); l_slot[r1] = 2 * lane + 1; l_idx[r1] = i1; l_g[r1] = gg.y; l_us[r1] = uu.y; }
            if (t + nwv < nrows) PU_LOADI(t + nwv);
            asm volatile("s_waitcnt lgkmcnt(0)" ::: "memory");
            const float sbt = sb;
#pragma unroll 1
            for (int k0 = 0; k0 < n; k0 += 16) {
                const int ev = l_idx[((k0 + r16 < n) ? (k0 + r16) : (n - 1))];
#pragma unroll
                for (int r = 0; r < 16; ++r) { if (k0 + r < n) { const unsigned e_ = (unsigned)__builtin_amdgcn_readlane(ev, r);
                    __builtin_amdgcn_global_load_lds((const unsigned*)(Ut + (e_ * 1024u + (unsigned)((lane ^ r) * 16))), (LAS unsigned*)(stage + r * 1024), 16, 0, 0); } }
                asm volatile("s_waitcnt vmcnt(0)" ::: "memory");
                i32x4 acc = {0, 0, 0, 0};
#pragma unroll
                for (int kk = 0; kk < 16; ++kk) { const i32x4 ra = *(const LAS i32x4*)(stage + r16 * 1024 + (((kk * 4 + kg) ^ r16) * 16));
                    acc = __builtin_amdgcn_mfma_i32_16x16x64_i8(ra, xq[kk], acc, 0, 0, 0); }
                asm volatile("s_waitcnt lgkmcnt(0)" ::: "memory");
                if (r16 == 0) {
#pragma unroll
                    for (int j = 0; j < 4; ++j) { const int ke2 = k0 + 4 * kg + j;
                        if (ke2 < n) { const float a = (float)acc[j] * (l_us[ke2] * sbt); const _Float16 hw = (_Float16)(l_g[ke2] * gelu_as(a)); W16[(size_t)t * 128 + l_slot[ke2]] = __builtin_bit_cast(unsigned short, hw); } }
                }
            }
            if (t + nwv < nrows) PU_LOADX(t + nwv);
        }
#undef PU_LOADI
#undef PU_LOADX
    }
}

__device__ __forceinline__ void pv_phase(const Frame& F, ArgsP Ap, int l, int nrows, const bool dry, char* lds) {
    unsigned char* ws = Ap->ws;
    const unsigned short* IDX = (const unsigned short*)(ws + WS_IDX); const unsigned short* W16 = (const unsigned short*)(ws + WS_W2);
    const char* Vt = (const char*)(ws + WS_V + (size_t)l * PEXP * DM);
    const float* MOD = (const float*)(ws + WS_MOD) + (size_t)l * 9 * 6144 + 5 * DM;
    float* hlat = dry ? (float*)(ws + WS_X5) : Ap->out; float* hctx = dry ? (float*)(ws + WS_X5) + (size_t)NLAT * DM : (float*)(ws + WS_HCTX);
    float* g2l = (float*)lds;
    const int lane = F.lane, sub = lane >> 3, dch = lane & 7;
    const bool xs = (F.G % 8) == 0;
    const int wv = xs ? ((F.bid >> 3) * 8 + F.wave) : F.gw, nwv = xs ? (F.G >> 3) * 8 : F.ngw, npass = xs ? 1 : 8;
    for (int pass = 0; pass < npass; ++pass) {
        const int s = xs ? (F.bid & 7) : pass;
        const char* vslice = Vt + (size_t)s * PEXP * 128;
        const unsigned dchb = (unsigned)dch * 16u, coffb = (unsigned)(s * 128 + dch * 16) * 4u, subo = (unsigned)sub * 32u;
        __syncthreads();
        for (int i = F.tid; i < 9 * 128; i += 512) g2l[i] = MOD[(size_t)(i >> 7) * 6144 + s * 128 + (i & 127)];
        __syncthreads();
        u32x4 ia0, ib0, ia1, ib1, rA[8], rB[8], wA, wB; f32x4 h0, h1, h2, h3; float o_[16]; float wsum;
#define PV_IDX(IA, IB, t_) do { const char* ib_ = (const char*)(IDX + (size_t)(t_) * 128); IA = *(const u32x4*)(ib_ + subo); IB = *(const u32x4*)(ib_ + subo + 16u); } while (0)
#define PV_ROWS8(R, I) do { const unsigned iw_[4] = {I.x, I.y, I.z, I.w}; \
            _Pragma("unroll") for (int it = 0; it < 8; ++it) { const unsigned e_ = (it & 1) ? (iw_[it >> 1] >> 16) : (iw_[it >> 1] & 0xffffu); R[it] = *(const u32x4*)(vslice + (e_ * 128u + dchb)); } } while (0)
#define PV_ROWSA(IA, t_) do { PV_ROWS8(rA, IA); wA = *(const u32x4*)((const char*)(W16 + (size_t)(t_) * 128) + subo); } while (0)
#define PV_ROWSB(IB, t_) do { PV_ROWS8(rB, IB); wB = *(const u32x4*)((const char*)(W16 + (size_t)(t_) * 128) + subo + 16u); \
            { const char* hr_ = (const char*)(((t_) < NLAT) ? (hlat + (size_t)(t_) * DM) : (hctx + (size_t)((t_) - NLAT) * DM));     \
              h0 = *(const f32x4*)(hr_ + coffb); h1 = *(const f32x4*)(hr_ + coffb + 16u); h2 = *(const f32x4*)(hr_ + coffb + 32u); h3 = *(const f32x4*)(hr_ + coffb + 48u); } } while (0)
#define PV_C4(A_, B_, wp_, base_) do { \
            o_[(base_) + 0] = dot2h(__builtin_amdgcn_perm((B_), (A_), 0x0C040C00u) | 0x64006400u, (wp_), o_[(base_) + 0]); o_[(base_) + 1] = dot2h(__builtin_amdgcn_perm((B_), (A_), 0x0C050C01u) | 0x64006400u, (wp_), o_[(base_) + 1]); \
            o_[(base_) + 2] = dot2h(__builtin_amdgcn_perm((B_), (A_), 0x0C060C02u) | 0x64006400u, (wp_), o_[(base_) + 2]); o_[(base_) + 3] = dot2h(__builtin_amdgcn_perm((B_), (A_), 0x0C070C03u) | 0x64006400u, (wp_), o_[(base_) + 3]); } while (0)
#define PV_SUM8(R, W) do { const unsigned ww_[4] = {W.x, W.y, W.z, W.w}; \
            _Pragma("unroll") for (int m = 0; m < 4; ++m) { const u32x4 ra_ = R[2 * m], rb_ = R[2 * m + 1]; const unsigned wp_ = ww_[m]; wsum = dot2h(wp_, H_ONES, wsum); \
                PV_C4(ra_.x, rb_.x, wp_, 0); PV_C4(ra_.y, rb_.y, wp_, 4); PV_C4(ra_.z, rb_.z, wp_, 8); PV_C4(ra_.w, rb_.w, wp_, 12); } } while (0)
#define PV_FINA() do { _Pragma("unroll") for (int i = 0; i < 16; ++i) o_[i] = 0.f; wsum = 0.f; PV_SUM8(rA, wA); } while (0)
#define PV_FINB(t_) do { PV_SUM8(rB, wB); \
            const float wsr_ = sum_b345(wsum) * CODE_BIAS; \
            _Pragma("unroll") for (int i = 0; i < 16; ++i) o_[i] = (sum_b345(o_[i]) - wsr_) * (1.f / 1024.f); \
            { const bool lat_ = (t_) < NLAT; float* hr_ = (float*)((char*)(lat_ ? (hlat + (size_t)(t_) * DM) : (hctx + (size_t)((t_) - NLAT) * DM)) + coffb); \
                const f32x4* g2_ = (const f32x4*)(g2l + (lat_ ? ((t_) >> 12) : 8) * 128 + dch * 16); \
                  \
                *(f32x4*)hr_ = h0 + g2_[0] * (f32x4){o_[0], o_[1], o_[2], o_[3]}; *(f32x4*)(hr_ + 4) = h1 + g2_[1] * (f32x4){o_[4], o_[5], o_[6], o_[7]}; \
                *(f32x4*)(hr_ + 8) = h2 + g2_[2] * (f32x4){o_[8], o_[9], o_[10], o_[11]}; *(f32x4*)(hr_ + 12) = h3 + g2_[3] * (f32x4){o_[12], o_[13], o_[14], o_[15]}; } } while (0)
        int t = wv;
        if (t < nrows) { PV_IDX(ia0, ib0, t); PV_ROWSA(ia0, t); }
        for (; t + 2 * nwv < nrows; t += 2 * nwv) {
            PV_IDX(ia1, ib1, t + nwv);     PV_ROWSB(ib0, t);       PV_FINA(); PV_ROWSA(ia1, t + nwv);     PV_FINB(t);
            PV_IDX(ia0, ib0, t + 2 * nwv); PV_ROWSB(ib1, t + nwv); PV_FINA(); PV_ROWSA(ia0, t + 2 * nwv); PV_FINB(t + nwv);
        }
        for (; t < nrows; t += 2 * nwv) {
            const int t1 = t + nwv;
            if (t1 < nrows) PV_IDX(ia1, ib1, t1);
            PV_ROWSB(ib0, t); PV_FINA();
            if (t1 < nrows) PV_ROWSA(ia1, t1);
            PV_FINB(t);
            if (t1 < nrows) { PV_ROWSB(ib1, t1); PV_FINA(); PV_FINB(t1); }
        }
#undef PV_IDX
#undef PV_ROWS8
#undef PV_ROWSA
#undef PV_ROWSB
#undef PV_C4
#undef PV_SUM8
#undef PV_FINA
#undef PV_FINB
    }
}
constexpr int PH_PER_LAYER = 12, N_PHASES = 1 + DEPTH * PH_PER_LAYER;
#ifndef MK_ONE_LAUNCH
#define MK_ONE_LAUNCH 0
#endif
#ifndef MK_MASK
#define MK_MASK 0x1FFF
#endif
#define PON(s) (((MK_MASK) >> (s)) & 1)

#ifndef DBG_NAIVE_GEMM
#define DBG_NAIVE_GEMM 0
#endif
#if DBG_NAIVE_GEMM
__device__ __forceinline__ void naive_gemm(const Frame& F, const pg8::Gemm g, int kind, const pg8::EpiStore es, const pg8::EpiResid er) {
    const int ncg = g.N / 64; const int nunits = g.M * ncg;
    for (int u = F.gw; u < nunits; u += F.ngw) {
        const int row = __builtin_amdgcn_readfirstlane(u / ncg), col = (u % ncg) * 64 + F.lane;
        const bf16* ar = g.A + (size_t)row * g.K; const bf16* br = g.Bt + (size_t)col * g.K; float acc = 0.f;
#pragma unroll 1
        for (int k = 0; k < g.K; k += 8) { const u32x4 a = *(const u32x4*)(ar + k), b = *(const u32x4*)(br + k); float x[8], y[8]; unpack8(a, x); unpack8(b, y);
#pragma unroll
            for (int e = 0; e < 8; ++e) acc = fmaf(x[e], y[e], acc); }
        if (kind == 0) { if (col < es.ncols) es.O[(size_t)row * es.ldc + col] = (bf16)(pk2(acc, 0.f) & 0xffffu); }
        else if (kind == 1) { const int head = col >> 7, j = col & 127; bf16* d = (j < 64) ? (es.O + (size_t)row * 768 + head * 96 + j) : (es.VM + (size_t)row * 512 + head * 64 + (j - 64)); *d = (bf16)(pk2(acc, 0.f) & 0xffffu); }
        else { const bool lat = row < er.nlat; const int sample = lat ? (row >> 12) : 8;
            const float* src = lat ? er.hin_lat + (size_t)row * 1024 : er.hin_ctx + (size_t)(row - er.nlat) * 1024; float* dst = lat ? er.hout_lat + (size_t)row * 1024 : er.hout_ctx + (size_t)(row - er.nlat) * 1024;
            dst[col] = src[col] + er.gate[(size_t)sample * 6144 + col] * acc; }
    }
}
#endif

__global__ void __launch_bounds__(512, 2) mk_fwd(Args args_unused) {
    extern __shared__ __attribute__((aligned(16))) unsigned char lds[];
    LAS unsigned char* lds3 = (LAS unsigned char*)lds;
    ArgsP args0 = (ArgsP)__builtin_amdgcn_kernarg_segment_ptr();
    const int ph_lo = args0->ph_lo, ph_hi = args0->ph_hi;
    const int wave_s = __builtin_amdgcn_readfirstlane((int)threadIdx.x >> 6);
#if MK_ONE_LAUNCH == 2
    {
        volatile LAS unsigned* st = (volatile LAS unsigned*)(lds3 + LDS_BYTES - 64);
        if (threadIdx.x < 2) st[threadIdx.x] = 0u;
        __syncthreads();
        (void)xcd_barrier_post((unsigned*)(args0->ws + WS_CTL), st, threadIdx.x == 0);
    }
#endif
#pragma unroll 1
    for (int pi = ph_lo; pi < ph_hi; ++pi) {
        int zv = 0; asm volatile("" : "+v"(zv));
        ArgsP args = args0; asm volatile("" : "+s"(args));
        Frame F;
        F.zv = zv; F.lane = (int)__builtin_amdgcn_mbcnt_hi(~0u, __builtin_amdgcn_mbcnt_lo(~0u, 0u)) + zv; F.wave = wave_s; F.tid = wave_s * 64 + F.lane;
        { int bx = blockIdx.x, gd = gridDim.x; asm volatile("" : "+s"(bx), "+s"(gd)); F.bid = bx; F.G = gd; F.vcu = (gd % 8 == 0) ? (bx % 8) * (gd / 8) + bx / 8 : bx; }
        F.gw = F.bid * 8 + F.wave; F.ngw = F.G * 8;
        unsigned char* ws = args->ws;
        const int phraw = args->prog[pi], ph = phraw & 63, pvar = phraw >> 6;
        int njobs = 0, jkind = 0;
        pg8::Gemm gj[2]; pg8::EpiStore ej[2];
        int l = 0, mrows = NROWS;
        if (ph == 0) { if (PON(12)) p0_prologue(F, args, lds3); }
        else if (ph == 63) {   }
        else {
            const int q = ph - 1, s = q % PH_PER_LAYER; l = q / PH_PER_LAYER;
            mrows = (l == DEPTH - 1) ? NLAT : NROWS;
            switch (s) {
            case 0: if (PON(0)) norm_mod_phase(F, args, l, 0, NROWS); break;
            case 1: if (PON(1)) { njobs = 1;
                gj[0] = pg8::Gemm{(const bf16*)(ws + WS_AB), (const bf16*)(ws + WS_WIN) + (size_t)l * DINP * DM, NROWS, DINP, DM};
                ej[0] = pg8::EpiStore{0, (bf16*)(ws + WS_P), DIN, DIN, nullptr}; } break;
            case 2: if (PON(2)) e2_phase(F, args, l, NROWS); break;
            case 3: if (PON(3)) { njobs = 2;
                gj[0] = pg8::Gemm{(const bf16*)(ws + WS_AB), (const bf16*)(ws + WS_WUQ) + (size_t)l * 768 * QRANK, NROWS, 768, QRANK};
                ej[0] = pg8::EpiStore{0, (bf16*)(ws + WS_QM), 768, 768, nullptr};
                gj[1] = pg8::Gemm{(const bf16*)(ws + WS_AB) + (size_t)NROWS * QRANK, (const bf16*)(ws + WS_WUKV) + (size_t)l * 1024 * KVRANK, NROWS, 1024, KVRANK};
                ej[1] = pg8::EpiStore{1, (bf16*)(ws + WS_KM), 768, 1024, (bf16*)(ws + WS_VM)}; } break;
            case 4: if (PON(4)) e3_phase(F, args, l, NROWS); break;
            case 5: if (PON(5)) {
#if DBG_NAIVE_ATTN
                attn_naive_phase(F, args, l);
#else
                attn_phase(F, args, l, (char*)lds);
#endif
                } break;
            case 6: if (PON(6)) { njobs = 1; jkind = 1;
                gj[0] = pg8::Gemm{(const bf16*)(ws + WS_AB), (const bf16*)(ws + WS_WOUT) + (size_t)l * DM * DM, mrows, DM, DM}; } break;
            case 7: if (PON(7)) norm_mod_phase(F, args, l, 1, mrows); break;
            case 8: if (PON(8)) { njobs = 1;
                gj[0] = pg8::Gemm{(const bf16*)(ws + WS_AB), (const bf16*)(ws + WS_PWQ) + (size_t)l * 2048 * DM, mrows, 2048, DM};
                ej[0] = pg8::EpiStore{0, (bf16*)(ws + WS_X5), 2048, 2048, nullptr}; } break;
            case 9: if (PON(9)) topkc_phase(F, args, l, mrows, (char*)lds); break;
            case 10: if (PON(10)) pu_phase(F, args, l, mrows, (char*)lds, pvar); break;
            default: if (PON(11)) pv_phase(F, args, l, mrows, pvar != 0, (char*)lds); break;
            }
        }
        if (njobs > 0) {
#if DBG_NAIVE_GEMM
            { const pg8::EpiResid ER{(l == 0) ? args->in[0] : args->out, args->in[2], args->out, (float*)(ws + WS_HCTX), (const float*)(ws + WS_MOD) + (size_t)l * 9 * 6144 + 2 * DM, NLAT};
              _Pragma("unroll 1") for (int j = 0; j < njobs; ++j) { const pg8::Gemm g = (j == 0) ? gj[0] : gj[1]; const pg8::EpiStore E = (j == 0) ? ej[0] : ej[1]; naive_gemm(F, g, jkind ? 2 : E.mode, E, ER); } }
#else
            if (jkind == 0) {
#pragma unroll 1
                for (int j = 0; j < njobs; ++j) { __syncthreads();
                    const pg8::Gemm g = (j == 0) ? gj[0] : gj[1]; const pg8::EpiStore E = (j == 0) ? ej[0] : ej[1];
                    pg8::StaticOrder S; S.init(g.M, g.N, F.G, F.bid);
                    pg8::gemm_phase<pg8::EpiStore, pg8::StaticOrder, true, true>(lds3, g, S, E, F.tid); }
            } else { __syncthreads();
                const pg8::Gemm g = gj[0];
                pg8::StaticOrder S; S.init(g.M, g.N, F.G, F.bid);
                pg8::EpiResid E{(l == 0) ? args->in[0] : args->out, args->in[2], args->out, (float*)(ws + WS_HCTX), (const float*)(ws + WS_MOD) + (size_t)l * 9 * 6144 + 2 * DM, NLAT};
                pg8::gemm_phase<pg8::EpiResid, pg8::StaticOrder, true, true>(lds3, g, S, E, F.tid); }
#endif
        }
#if MK_ONE_LAUNCH == 1
        if (pi + 1 < ph_hi) cg::this_grid().sync();
#elif MK_ONE_LAUNCH == 2
        if (pi + 1 < ph_hi) { XcdBarrier xb; xb.bar = (unsigned*)(ws + WS_CTL); xb.x = xb_xcc_id(); xb.st = (volatile LAS unsigned*)(lds3 + LDS_BYTES - 64); xcd_barrier(xb, F.tid == 0); }
#endif
    }
}

extern "C" void kernel_launch(void* const* d_in, const int* in_sizes, int n_in, void* d_out, int out_size, void* d_ws, size_t ws_size, hipStream_t stream) {
    static int grid = 0;
    if (grid == 0) {
        if (n_in != 23 || in_sizes[0] != NLAT * DM || out_size != NLAT * DM || ws_size < WS_END) {
            fprintf(stderr, "kernel_launch: unexpected shapes: n_in %d in0 %d out %d ws %zu (need %zu)\n", n_in, n_in > 0 ? in_sizes[0] : -1, out_size, ws_size, (size_t)WS_END); grid = -1; return; }
        int dev = 0, cus = 0, per_cu = 0;
        if (hipGetDevice(&dev) != hipSuccess || hipDeviceGetAttribute(&cus, hipDeviceAttributeMultiprocessorCount, dev) != hipSuccess) { fprintf(stderr, "kernel_launch: device query failed\n"); grid = -1; return; }
        if (hipFuncSetAttribute((const void*)mk_fwd, hipFuncAttributeMaxDynamicSharedMemorySize, LDS_BYTES) != hipSuccess) { fprintf(stderr, "kernel_launch: hipFuncSetAttribute failed\n"); grid = -1; return; }
        if (hipOccupancyMaxActiveBlocksPerMultiprocessor(&per_cu, (const void*)mk_fwd, 512, LDS_BYTES) != hipSuccess || per_cu < 1) { fprintf(stderr, "kernel_launch: occupancy query says %d\n", per_cu); per_cu = 1; }
        (void)hipGetLastError();
        grid = cus;
    }
    if (grid < 0) return;
    Args a{};
    for (int i = 0; i < 23; ++i) a.in[i] = (const float*)d_in[i];
    a.out = (float*)d_out; a.ws = (unsigned char*)d_ws;
    int np = 0;
#ifdef MK_PROG
    { static const int pr[] = {MK_PROG}; for (int i = 0; i < (int)(sizeof(pr) / sizeof(pr[0])); ++i) a.prog[np++] = (unsigned char)pr[i]; }
#else
    for (int p = 0; p < N_PHASES; ++p) a.prog[np++] = (unsigned char)p;
#endif
#if MK_ONE_LAUNCH == 2
    a.ph_lo = 0; a.ph_hi = np;
    if (hipMemsetAsync((char*)d_ws + WS_CTL, 0, CTL_ZERO_BYTES, stream) != hipSuccess) { fprintf(stderr, "kernel_launch: hipMemsetAsync of the barrier words failed\n"); return; }
    hipLaunchKernelGGL(mk_fwd, dim3(grid), dim3(512), LDS_BYTES, stream, a);
    { const hipError_t le = hipPeekAtLastError(); if (le != hipSuccess) fprintf(stderr, "kernel_launch: launch failed: %s\n", hipGetErrorName(le)); }
#elif MK_ONE_LAUNCH == 1
    a.ph_lo = 0; a.ph_hi = np;
    void* kargs[] = {&a};
    hipError_t e = hipLaunchCooperativeKernel((const void*)mk_fwd, dim3(grid), dim3(512), kargs, LDS_BYTES, stream);
    if (e != hipSuccess) fprintf(stderr, "kernel_launch: cooperative launch failed: %s (grid %d)\n", hipGetErrorString(e), grid);
#else
    for (int p = 0; p < np; ++p) {
        a.ph_lo = p; a.ph_hi = p + 1;
        hipLaunchKernelGGL(mk_fwd, dim3(grid), dim3(512), LDS_BYTES, stream, a);
    }
    const hipError_t le = hipPeekAtLastError();
    if (le != hipSuccess) fprintf(stderr, "kernel_launch: launch failed: %s\n", hipGetErrorName(le));
#endif
}
```

```cpp
#define MK_ONE_LAUNCH 2
#define DBG_PRECISE_TOPK 0
#define DBG_NAIVE_ATTN 0
#define DBG_PRECISE_PEER 0
#define DBG_NAIVE_GEMM 0
#define DBG_ASCALE 1.0f
#define DBG_PSCALE 1.0f
#include <hip/hip_runtime.h>
#include <hip/hip_cooperative_groups.h>
#include <cstdio>
#include <cstdint>
#include <cmath>
namespace cg = cooperative_groups;
namespace pg8 {
#define PG8_LAS __attribute__((address_space(3)))
typedef unsigned short bf16_t;
typedef short bf16x8 __attribute__((ext_vector_type(8)));
typedef float f32x4 __attribute__((ext_vector_type(4)));
typedef unsigned u32x4 __attribute__((ext_vector_type(4)));
constexpr int BM = 256, BK = 64, HALF = 128, HTB = HALF * BK * 2  , STAGE_BYTES = 8 * HTB, NXCD = 8, WGM = 8;

__host__ __device__ __forceinline__ int lds_byte(int r, int c) { const int st = (r >> 4) * 2 + (c >> 5), rr = r & 15, cc = c & 31, ob = rr * 64 + cc * 2; return st * 1024 + (ob ^ (((ob >> 9) & 1) << 5)); }
__host__ __device__ __forceinline__ void stage_rc(int b, int& R, int& C) { const int st = b / 1024, sb = b % 1024, swz = sb ^ (((sb >> 9) & 1) << 5); R = (st >> 1) * 16 + swz / 64; C = (st & 1) * 32 + (swz % 64) / 2; }
__host__ __device__ __forceinline__ int perm32(int rho) { const int n = rho >> 4, i = rho & 15; return 8 * (i >> 2) + 4 * n + (i & 3); }

struct Unit { int pm, pn; };
struct Gemm { const bf16_t* A; const bf16_t* Bt; int M, N, K; };

struct StaticOrder {
    int nM, nN, nwg, G, c;
    __host__ __device__ void init(int M, int N, int G_, int c_) { nM = M / BM; nN = N / BM; nwg = nM * nN; G = G_; c = c_; }
    __host__ __device__ bool next(int i, Unit& u) const {
        const long L = (long)i * G + c; if (L >= nwg) return false;
        int wgid = (int)L; { const int q = nwg / NXCD, r = nwg % NXCD, xcd = wgid % NXCD, off = wgid / NXCD; wgid = (xcd < r ? xcd * (q + 1) : r * (q + 1) + (xcd - r) * q) + off; }
        const int nig = WGM * nN, gid = wgid / nig, fm = gid * WGM, gsz = (nM - fm) < WGM ? (nM - fm) : WGM;
        u.pm = fm + ((wgid % nig) % gsz); u.pn = (wgid % nig) / gsz; return true;
    }
    __device__ __forceinline__ void a_ready(const Unit&) const {}
    __device__ __forceinline__ void done(const Unit&) const {}
};

__device__ __forceinline__ unsigned cvt_pk_bf16(float lo, float hi) { unsigned r; asm volatile("v_cvt_pk_bf16_f32 %0, %1, %2" : "=v"(r) : "v"(lo), "v"(hi)); return r; }
typedef float f32x2 __attribute__((ext_vector_type(2)));
typedef unsigned u32x2 __attribute__((ext_vector_type(2)));
#ifndef DBG_ASCALE
#define DBG_ASCALE 1.0f
#endif
#ifndef DBG_PSCALE
#define DBG_PSCALE 1.0f
#endif
struct EpiStore {
    static constexpr bool PERM = true, AFTER_DRAIN = false;
    int mode; bf16_t* O; int ldc; int ncols; bf16_t* VM;
    __device__ __forceinline__ void operator()(const f32x4 (&acc)[2][2][4][2], const Unit& u, int wr, int wc, int fr, int fq) const {
        const int row0 = u.pm * BM + wr * 64 + fr;
        bf16_t* base; int rstride, hstride; bool on0, on1;
        if (mode == 0) { const int col0 = u.pn * BM + wc * 32 + 8 * fq; base = O + (size_t)row0 * ldc + col0; rstride = ldc; hstride = HALF; on0 = col0 < ncols; on1 = col0 + HALF < ncols; }
        else {
            const int j = wc * 32 + 8 * fq; const bool isk = wc < 2;
            base = isk ? (O + (size_t)row0 * 768 + (2 * u.pn) * 96 + j) : (VM + (size_t)row0 * 512 + (2 * u.pn) * 64 + (j - 64));
            rstride = isk ? 768 : 512; hstride = isk ? 96 : 64; on0 = true; on1 = true; }
#pragma unroll
        for (int ai = 0; ai < 2; ++ai)
#pragma unroll
            for (int m = 0; m < 4; ++m) { bf16_t* rowp = base + (size_t)(ai * HALF + m * 16) * rstride;
#pragma unroll
                for (int bj = 0; bj < 2; ++bj) {
                    if (bj == 0 ? on0 : on1) { const f32x4 v0 = acc[ai][bj][m][0], v1 = acc[ai][bj][m][1]; u32x4 w;
                        w.x = cvt_pk_bf16(v0[0], v0[1]); w.y = cvt_pk_bf16(v0[2], v0[3]); w.z = cvt_pk_bf16(v1[0], v1[1]); w.w = cvt_pk_bf16(v1[2], v1[3]);
                        *(u32x4*)(rowp + bj * hstride) = w; } } }
    }
};
struct EpiResid {
    static constexpr bool PERM = false, AFTER_DRAIN = false;
    const float* hin_lat; const float* hin_ctx; float* hout_lat; float* hout_ctx; const float* gate; int nlat;
    __device__ __forceinline__ void operator()(const f32x4 (&acc)[2][2][4][2], const Unit& u, int wr, int wc, int fr, int fq) const {
        const int rowt = u.pm * BM; const bool lat = rowt < nlat; const int sample = lat ? (rowt >> 12) : 8;
        const float* src = lat ? hin_lat + (size_t)rowt * 1024 : hin_ctx + (size_t)(rowt - nlat) * 1024;
        float* dst = lat ? hout_lat + (size_t)rowt * 1024 : hout_ctx + (size_t)(rowt - nlat) * 1024;
        const float* g = gate + (size_t)sample * 6144;
        const int col0 = u.pn * BM + wc * 32 + 4 * fq;
#pragma unroll
        for (int bj = 0; bj < 2; ++bj)
#pragma unroll
            for (int n = 0; n < 2; ++n) { const int c = col0 + bj * HALF + n * 16; const f32x4 gv = *(const f32x4*)(g + c);
#pragma unroll
                for (int ai = 0; ai < 2; ++ai)
#pragma unroll
                    for (int m = 0; m < 4; ++m) { const size_t off = (size_t)(ai * HALF + wr * 64 + m * 16 + fr) * 1024 + c;
                        const f32x4 hv = *(const f32x4*)(src + off); *(f32x4*)(dst + off) = hv + gv * acc[ai][bj][m][n] * (float)(DBG_ASCALE); } }
    }
};
template <class Epi, class Sched, bool ALIGN_EPI = false, bool SP2 = false>
__device__ __forceinline__ void gemm_phase(PG8_LAS unsigned char* lds, const Gemm g, const Sched& S, const Epi& E, const int tid_in) {
    const int tid = tid_in, wid = __builtin_amdgcn_readfirstlane(tid >> 6), lane = tid & 63, wr = wid >> 2, wc = wid & 3, fr = lane & 15, fq = lane >> 4;
    const int K = g.K, nt = K / BK;
    unsigned voffA[2], voffB[2];
#pragma unroll
    for (int i = 0; i < 2; ++i) { int R, C; stage_rc(tid * 16 + i * 8192, R, C); const int Rb = Epi::PERM ? ((R & ~31) + perm32(R & 31)) : R;
        voffA[i] = (unsigned)(R * K + C) * 2u; voffB[i] = (unsigned)(Rb * K + C) * 2u; }
    const size_t kstep = (size_t)(BK * 2);
    const size_t hstep = (size_t)HALF * K * 2;
    const size_t tstep = 2 * hstep;
    const unsigned ldsw = (unsigned)wid * 1024u;
    const int aoff = lds_byte(wr * 64 + fr, fq * 8), boff = lds_byte(wc * 32 + fr, fq * 8);
#define PG8_SA(b, h) (((b) * 2 + (h)) * HTB)
#define PG8_SB(b, h) ((4 + (b) * 2 + (h)) * HTB)
#define PG8_STAGE(bufoff, gbase, voff) do { _Pragma("unroll") for (int _i = 0; _i < 2; ++_i) \
        __builtin_amdgcn_global_load_lds((const unsigned*)((const char*)(gbase) + (voff)[_i]), (PG8_LAS unsigned*)(lds + (bufoff) + ldsw + _i * 8192), 16, 0, 0); } while (0)
#define PG8_LDA(dst, b, h) do { _Pragma("unroll") for (int m = 0; m < 4; ++m) _Pragma("unroll") for (int k = 0; k < 2; ++k) dst[m][k] = *(const PG8_LAS bf16x8*)(lds + PG8_SA(b, h) + aoff + m * 2048 + k * 1024); } while (0)
#define PG8_LDB(dst, b, h) do { _Pragma("unroll") for (int n = 0; n < 2; ++n) _Pragma("unroll") for (int k = 0; k < 2; ++k) dst[n][k] = *(const PG8_LAS bf16x8*)(lds + PG8_SB(b, h) + boff + n * 2048 + k * 1024); } while (0)
#define PG8_MMA(ai, bj, At, Bt) do { __builtin_amdgcn_s_setprio(1); _Pragma("unroll") for (int m = 0; m < 4; ++m) _Pragma("unroll") for (int n = 0; n < 2; ++n) _Pragma("unroll") for (int k = 0; k < 2; ++k) \
        acc[ai][bj][m][n] = __builtin_amdgcn_mfma_f32_16x16x32_bf16(Bt[n][k], At[m][k], acc[ai][bj][m][n], 0, 0, 0); __builtin_amdgcn_s_setprio(0); } while (0)
#define PG8_WAIT_V(n) asm volatile("s_waitcnt vmcnt(" #n ")" ::: "memory")
#define PG8_WAIT_L(n) asm volatile("s_waitcnt lgkmcnt(" #n ")" ::: "memory")
#define PG8_BAR __builtin_amdgcn_s_barrier()
#define PG8_SCHED __builtin_amdgcn_sched_barrier(0)
    Unit cur, nxt; int ui = 0;
    if (!S.next(0, cur)) return;
    f32x4 acc[2][2][4][2];
#pragma unroll
    for (int a = 0; a < 2; ++a)
#pragma unroll
        for (int b = 0; b < 2; ++b)
#pragma unroll
            for (int m = 0; m < 4; ++m)
#pragma unroll
                for (int n = 0; n < 2; ++n) acc[a][b][m][n] = (f32x4){0.f, 0.f, 0.f, 0.f};
    bf16x8 At[4][2], B0[2][2], B1[2][2];
    const char* cA = (const char*)g.A + (size_t)cur.pm * tstep; const char* cB = (const char*)g.Bt + (size_t)cur.pn * tstep;
    S.a_ready(cur);
    if constexpr (SP2) {
        PG8_STAGE(PG8_SB(0, 0), cB, voffB); PG8_STAGE(PG8_SB(0, 1), cB + hstep, voffB); PG8_STAGE(PG8_SA(0, 0), cA, voffA); PG8_STAGE(PG8_SA(0, 1), cA + hstep, voffA);
        if (wr == 1) PG8_BAR;
        PG8_WAIT_V(2); PG8_BAR;
        PG8_STAGE(PG8_SB(1, 0), cB + kstep, voffB); PG8_STAGE(PG8_SA(1, 0), cA + kstep, voffA); PG8_STAGE(PG8_SB(1, 1), cB + hstep + kstep, voffB);
        PG8_WAIT_V(6); PG8_BAR;
    } else {
        PG8_STAGE(PG8_SB(0, 0), cB, voffB); PG8_STAGE(PG8_SA(0, 0), cA, voffA); PG8_STAGE(PG8_SB(0, 1), cB + hstep, voffB); PG8_STAGE(PG8_SA(0, 1), cA + hstep, voffA);
        if (wr == 1) PG8_BAR;
        PG8_WAIT_V(4); PG8_BAR;
        PG8_STAGE(PG8_SB(1, 0), cB + kstep, voffB); PG8_STAGE(PG8_SA(1, 0), cA + kstep, voffA); PG8_STAGE(PG8_SB(1, 1), cB + hstep + kstep, voffB);
        PG8_WAIT_V(6); PG8_BAR;
    }
    for (;;) {
        const bool has_next = S.next(ui + 1, nxt);
        const char* nA = has_next ? (const char*)g.A + (size_t)nxt.pm * tstep : cA; const char* nB = has_next ? (const char*)g.Bt + (size_t)nxt.pn * tstep : cB;
        _Pragma("unroll 1") for (int t = 0; t < nt; t += 2) {
            const bool last = (t == nt - 2);
            const char* a1 = cA + (size_t)(t + 1) * kstep;
            const char* a2 = last ? nA : cA + (size_t)(t + 2) * kstep; const char* b2 = last ? nB : cB + (size_t)(t + 2) * kstep;
            const char* a3 = a2 + kstep; const char* b3 = b2 + kstep;
            if (last && has_next) S.a_ready(nxt);
            if constexpr (SP2) {
            PG8_LDB(B0, 0, 0); PG8_LDB(B1, 0, 1); PG8_SCHED; PG8_LDA(At, 0, 0); PG8_STAGE(PG8_SA(1, 1), a1 + hstep, voffA);
            PG8_WAIT_V(8); PG8_WAIT_L(0); PG8_BAR; PG8_MMA(0, 0, At, B0); PG8_MMA(0, 1, At, B1); PG8_BAR; PG8_SCHED;
            PG8_LDA(At, 0, 1); PG8_STAGE(PG8_SB(0, 0), b2, voffB); PG8_STAGE(PG8_SB(0, 1), b2 + hstep, voffB); PG8_STAGE(PG8_SA(0, 0), a2, voffA);
            PG8_WAIT_V(8); PG8_WAIT_L(0); PG8_BAR; PG8_MMA(1, 0, At, B0); PG8_MMA(1, 1, At, B1); PG8_BAR; PG8_SCHED;
            PG8_LDB(B0, 1, 0); PG8_LDB(B1, 1, 1); PG8_SCHED; PG8_LDA(At, 1, 0); PG8_STAGE(PG8_SA(0, 1), a2 + hstep, voffA);
            PG8_WAIT_V(8); PG8_WAIT_L(0); PG8_BAR; PG8_MMA(0, 0, At, B0); PG8_MMA(0, 1, At, B1); PG8_BAR; PG8_SCHED;
            PG8_LDA(At, 1, 1); PG8_STAGE(PG8_SB(1, 0), b3, voffB); PG8_STAGE(PG8_SB(1, 1), b3 + hstep, voffB); PG8_STAGE(PG8_SA(1, 0), a3, voffA);
            PG8_WAIT_V(8); PG8_WAIT_L(0); PG8_BAR; PG8_MMA(1, 0, At, B0); PG8_MMA(1, 1, At, B1); PG8_BAR; PG8_SCHED;
            } else {
            PG8_LDB(B0, 0, 0); PG8_SCHED; PG8_LDA(At, 0, 0); PG8_STAGE(PG8_SA(1, 1), a1 + hstep, voffA);
            PG8_WAIT_L(8); PG8_BAR; PG8_WAIT_L(0); PG8_MMA(0, 0, At, B0); PG8_BAR; PG8_SCHED;
            PG8_LDB(B1, 0, 1); PG8_STAGE(PG8_SB(0, 0), b2, voffB);
            PG8_BAR; PG8_WAIT_L(0); PG8_MMA(0, 1, At, B1); PG8_BAR;
            PG8_LDA(At, 0, 1); PG8_STAGE(PG8_SA(0, 0), a2, voffA);
            PG8_BAR; PG8_WAIT_L(0); PG8_MMA(1, 0, At, B0); PG8_BAR; PG8_SCHED;
            PG8_STAGE(PG8_SB(0, 1), b2 + hstep, voffB);
            PG8_WAIT_V(6); PG8_BAR; PG8_MMA(1, 1, At, B1); PG8_BAR;
            PG8_LDB(B0, 1, 0); PG8_SCHED; PG8_LDA(At, 1, 0); PG8_STAGE(PG8_SA(0, 1), a2 + hstep, voffA);
            PG8_WAIT_L(8); PG8_BAR; PG8_WAIT_L(0); PG8_MMA(0, 0, At, B0); PG8_BAR; PG8_SCHED;
            PG8_LDB(B1, 1, 1); PG8_STAGE(PG8_SB(1, 0), b3, voffB);
            PG8_BAR; PG8_WAIT_L(0); PG8_MMA(0, 1, At, B1); PG8_BAR;
            PG8_LDA(At, 1, 1); PG8_STAGE(PG8_SA(1, 0), a3, voffA);
            PG8_BAR; PG8_WAIT_L(0); PG8_MMA(1, 0, At, B0); PG8_BAR; PG8_SCHED;
            PG8_STAGE(PG8_SB(1, 1), b3 + hstep, voffB);
            PG8_WAIT_V(6); PG8_BAR; PG8_MMA(1, 1, At, B1); PG8_BAR;
            }
        }
        if constexpr (ALIGN_EPI) { if (wr == 0) PG8_BAR; }
        if constexpr (!Epi::AFTER_DRAIN) { E(acc, cur, wr, wc, fr, fq); S.done(cur); }
        if (!has_next) break;
#pragma unroll
        for (int a = 0; a < 2; ++a)
#pragma unroll
            for (int b = 0; b < 2; ++b)
#pragma unroll
                for (int m = 0; m < 4; ++m)
#pragma unroll
                    for (int n = 0; n < 2; ++n) acc[a][b][m][n] = (f32x4){0.f, 0.f, 0.f, 0.f};
        cur = nxt; cA = nA; cB = nB; ++ui;
        if constexpr (ALIGN_EPI) { if (wr == 1) PG8_BAR; }
    }
    PG8_WAIT_V(0);
    if constexpr (!ALIGN_EPI) { if (wr == 0) PG8_BAR; }
    PG8_BAR;
    if constexpr (Epi::AFTER_DRAIN) { E.fused(acc, cur, wr, wc, fr, fq, lds, wid, lane); S.done(cur); }
#undef PG8_SA
#undef PG8_SB
#undef PG8_STAGE
#undef PG8_LDA
#undef PG8_LDB
#undef PG8_MMA
#undef PG8_WAIT_V
#undef PG8_WAIT_L
#undef PG8_BAR
#undef PG8_SCHED
}
}
constexpr int DM = 1024, NB = 8, SEQ = 4096, CTXL = 256, DEPTH = 2;
constexpr int NLAT = NB * SEQ, NCTX = NB * CTXL, NROWS = NLAT + NCTX;
constexpr int DIN = 1440, DINP = 1536, QRANK = 384, KVRANK = 256;
constexpr int PH = 8, PNK = 128, PDH = 128, PTOPK = 16, PEXP = PNK * PNK;
constexpr float EPS = 1e-6f;
constexpr float LOG2E = 1.4426950408889634f;
constexpr float C_MLA = 0.10206207261596577f * LOG2E;
constexpr float C_SWA = 0.125f * LOG2E;

typedef unsigned short bf16;
typedef short bf16x8 __attribute__((ext_vector_type(8)));
typedef short s16x4 __attribute__((ext_vector_type(4)));
typedef float f32x4 __attribute__((ext_vector_type(4)));
typedef float f32x16 __attribute__((ext_vector_type(16)));
typedef unsigned u32x4 __attribute__((ext_vector_type(4)));
typedef unsigned u32x2v __attribute__((ext_vector_type(2)));
#define LAS __attribute__((address_space(3)))

constexpr size_t MiB = 1u << 20;
constexpr size_t WS_CTL = 0, CTL_ZERO_BYTES = 64 * 1024;
constexpr size_t WS_MOD = 1 * MiB;
constexpr size_t WS_RTS = WS_MOD + 512 * 1024;
constexpr size_t WS_RTM = WS_RTS + 64 * 16 * 2 * 4;
constexpr size_t WS_WIN = 2 * MiB;
constexpr size_t WS_WUQ = WS_WIN + 2ull * DINP * DM * 2;
constexpr size_t WS_WUKV = WS_WUQ + 2ull * 768 * QRANK * 2;
constexpr size_t WS_WOUT = WS_WUKV + 2ull * 1024 * KVRANK * 2;
constexpr size_t WS_PWQ = WS_WOUT + 2ull * 1024 * 1024 * 2;
constexpr size_t WS_PKEY = WS_PWQ + 2ull * 2048 * 1024 * 2;
constexpr size_t WS_HCTX = WS_PKEY + 2ull * 8 * 2 * 128 * 128 * 2;
constexpr size_t WS_US = WS_HCTX + (size_t)NCTX * 1024 * 4;
constexpr size_t WS_VS = WS_US + 2ull * PEXP * 4;
constexpr size_t WS_SB = WS_VS + 2ull * PEXP * 4;
constexpr size_t WS_U = 32 * MiB;
constexpr size_t WS_V = WS_U + 32 * MiB;
constexpr size_t WS_F16B = WS_V + 32 * MiB;
constexpr size_t WS_AB = WS_F16B + (size_t)NROWS * 1024 * 2;
constexpr size_t WS_P = WS_AB + (size_t)NROWS * 1024 * 2;
constexpr size_t WS_X5 = WS_P + (size_t)NROWS * DIN * 2;
constexpr size_t WS_QM = WS_X5, WS_KM = WS_QM + (size_t)NROWS * 768 * 2, WS_VM = WS_KM + (size_t)NROWS * 768 * 2, WS_QS = WS_VM + (size_t)NROWS * 512 * 2,
                 WS_KS = WS_QS + (size_t)NROWS * 512 * 2, WS_END = WS_KS + (size_t)NROWS * 128 * 2;
static_assert(WS_SB + (size_t)NROWS * 4 <= WS_U, "ws map (weights)");
static_assert(WS_END <= 512 * MiB, "ws map");
static_assert((size_t)NROWS * 2048 * 2 <= WS_END - WS_X5, "QP overlay");
static_assert((size_t)NROWS * 1024 <= (size_t)NROWS * DIN * 2, "TK overlay");

constexpr int LDS_BYTES = 163840;

__constant__ float ROPE_INV[24] = {1.0f, 0.5623413324356079f, 0.3162277638912201f, 0.17782793939113617f, 0.10000000149011612f, 0.05623413249850273f, 0.03162277489900589f, 0.017782794311642647f, 0.009999999776482582f, 0.005623413249850273f, 0.003162277629598975f, 0.0017782794311642647f, 0.0010000000474974513f, 0.000562341301701963f, 0.0003162277571391314f, 0.00017782794020604342f, 1.0f, 0.3162277638912201f, 0.10000000149011612f, 0.03162277489900589f, 0.009999999776482582f, 0.003162277629598975f, 0.0010000000474974513f, 0.0003162277571391314f};
struct Args {
    const float* in[23]; float* out; unsigned char* ws; int ph_lo, ph_hi; unsigned char prog[48];
};
typedef const __attribute__((address_space(4))) Args* ArgsP;

struct Frame {
    int tid, lane, wave, G, bid, vcu, gw, ngw, zv;
};

__device__ __forceinline__ float bf_lo(unsigned w) { return __uint_as_float(w << 16); }
__device__ __forceinline__ float bf_hi(unsigned w) { return __uint_as_float(w & 0xffff0000u); }
__device__ __forceinline__ unsigned pk2(float lo, float hi) { return pg8::cvt_pk_bf16(lo, hi); }
__device__ __forceinline__ float wave_sum(float v) {
#pragma unroll
    for (int o = 1; o < 64; o <<= 1) v += __shfl_xor(v, o);
    return v;
}
__device__ __forceinline__ void unpack8(const u32x4 w, float (&x)[8]) {
    x[0] = bf_lo(w.x); x[1] = bf_hi(w.x); x[2] = bf_lo(w.y); x[3] = bf_hi(w.y); x[4] = bf_lo(w.z); x[5] = bf_hi(w.z); x[6] = bf_lo(w.w); x[7] = bf_hi(w.w);
}
__device__ __forceinline__ u32x4 pack8(const float (&x)[8]) {
    u32x4 w; w.x = pk2(x[0], x[1]); w.y = pk2(x[2], x[3]); w.z = pk2(x[4], x[5]); w.w = pk2(x[6], x[7]); return w;
}

__device__ __forceinline__ void p0_transpose_item(const float* W, int K, int N, bf16* WT, LAS float* scr, int item, int lane) {
    const int nblk = N / 32, kb = item / nblk, nb = item % nblk, k0 = 64 * kb, n0 = 32 * nb;
#pragma unroll 8
    for (int i = 0; i < 32; ++i) { const int kk = 2 * i + (lane >> 5); scr[kk * 33 + (lane & 31)] = W[(size_t)(k0 + kk) * N + n0 + (lane & 31)]; }
    asm volatile("s_waitcnt lgkmcnt(0)" ::: "memory");
    const int c = lane & 7;
#pragma unroll
    for (int j = 0; j < 4; ++j) { const int n = (lane >> 3) + 8 * j; const LAS float* s = scr + (8 * c) * 33 + n;
        u32x4 o; o.x = pk2(s[0 * 33], s[1 * 33]); o.y = pk2(s[2 * 33], s[3 * 33]); o.z = pk2(s[4 * 33], s[5 * 33]); o.w = pk2(s[6 * 33], s[7 * 33]);
        *(u32x4*)(WT + (size_t)(n0 + n) * K + k0 + 8 * c) = o; }
    asm volatile("s_waitcnt lgkmcnt(0)" ::: "memory");
}

__device__ __forceinline__ void p0_prologue(const Frame& F, ArgsP Ap, LAS unsigned char* lds) {
    unsigned char* ws = Ap->ws;
    const float* c_in = Ap->in[1]; const float* cctx_in = Ap->in[3]; const float* ada_w = Ap->in[4]; const float* ada_b = Ap->in[5];
    for (int task = F.bid; task < 48; task += F.G) {
        const int l = task / 24, cc = task % 24;
        LAS float* sl = (LAS float*)lds;
        LAS float* red = (LAS float*)(lds + 9 * 1024 * 4);
        __syncthreads();
        for (int i = F.tid; i < 9 * 1024; i += 512) { const int s = i >> 10, k = i & 1023; const float x = (s < 8) ? c_in[s * 1024 + k] : cctx_in[k]; sl[i] = x / (1.f + __expf(-x)); }
        __syncthreads();
        const int c0 = cc * 256 + F.lane * 4; const int kbase = F.wave * 128;
        f32x4 acc[9];
#pragma unroll
        for (int s = 0; s < 9; ++s) acc[s] = (f32x4){0.f, 0.f, 0.f, 0.f};
        const float* wp = ada_w + ((size_t)l * 1024 + kbase) * 6144 + c0;
#pragma unroll 4
        for (int kk = 0; kk < 128; ++kk) { const f32x4 w = *(const f32x4*)(wp + (size_t)kk * 6144);
#pragma unroll
            for (int s = 0; s < 9; ++s) acc[s] += w * sl[s * 1024 + kbase + kk]; }
#pragma unroll
        for (int s = 0; s < 9; ++s) *(LAS f32x4*)(red + (F.wave * 9 + s) * 256 + F.lane * 4) = acc[s];
        __syncthreads();
        float* MOD = (float*)(ws + WS_MOD);
        for (int i = F.tid; i < 9 * 256; i += 512) { const int s = i >> 8, ci = i & 255; float v = ada_b[l * 6144 + cc * 256 + ci];
#pragma unroll
            for (int w = 0; w < 8; ++w) v += red[(w * 9 + s) * 256 + ci];
            MOD[((size_t)l * 9 + s) * 6144 + cc * 256 + ci] = v; }
        __syncthreads();
    }
    __syncthreads();
    if (F.bid == F.G - 1) {
        float* rts = (float*)(ws + WS_RTS); float* rtm = (float*)(ws + WS_RTM);
        for (int i = F.tid; i < 64 * 24; i += 512) {
            const int pos = i / 24, k = i % 24; const float a = (float)pos * ROPE_INV[k];
            const float rev = a * 0.15915494309189535f;
            const float cs = __builtin_amdgcn_cosf(rev), sn = __builtin_amdgcn_sinf(rev);
            if (k < 16) { rts[(pos * 16 + k) * 2] = cs; rts[(pos * 16 + k) * 2 + 1] = sn; } else { rtm[(pos * 8 + (k - 16)) * 2] = cs; rtm[(pos * 8 + (k - 16)) * 2 + 1] = sn; }
        }
    }
    LAS float* scr = (LAS float*)(lds + F.wave * 16384);
    constexpr int I_WIN = (DM / 64) * (DIN / 32), I_WUQ = (QRANK / 64) * (768 / 32), I_WUKV = (KVRANK / 64) * (1024 / 32), I_WOUT = (DM / 64) * (DM / 32), I_PWQ = (DM / 64) * (2048 / 32);
    constexpr int I_L = I_WIN + I_WUQ + I_WUKV + I_WOUT + I_PWQ;
    for (int it = F.gw; it < 2 * I_L; it += F.ngw) {
        const int l = it / I_L; int r = it % I_L;
        if (r < I_WIN) { p0_transpose_item(Ap->in[8] + (size_t)l * DM * DIN, DM, DIN, (bf16*)(ws + WS_WIN) + (size_t)l * DINP * DM, scr, r, F.lane); continue; } r -= I_WIN;
        if (r < I_WUQ) { p0_transpose_item(Ap->in[10] + (size_t)l * QRANK * 768, QRANK, 768, (bf16*)(ws + WS_WUQ) + (size_t)l * 768 * QRANK, scr, r, F.lane); continue; } r -= I_WUQ;
        if (r < I_WUKV) { p0_transpose_item(Ap->in[12] + (size_t)l * KVRANK * 1024, KVRANK, 1024, (bf16*)(ws + WS_WUKV) + (size_t)l * 1024 * KVRANK, scr, r, F.lane); continue; } r -= I_WUKV;
        if (r < I_WOUT) { p0_transpose_item(Ap->in[18] + (size_t)l * DM * DM, DM, DM, (bf16*)(ws + WS_WOUT) + (size_t)l * DM * DM, scr, r, F.lane); continue; } r -= I_WOUT;
        p0_transpose_item(Ap->in[19] + (size_t)l * DM * 2048, DM, 2048, (bf16*)(ws + WS_PWQ) + (size_t)l * 2048 * DM, scr, r, F.lane);
    }
    { const size_t gt = (size_t)F.bid * 512 + F.tid, nt = (size_t)F.G * 512;
      for (size_t i = gt; i < 2ull * 96 * DM / 8; i += nt) { const size_t l = i / (96 * DM / 8), e = i % (96 * DM / 8);
          *(u32x4*)((bf16*)(ws + WS_WIN) + l * DINP * DM + (size_t)DIN * DM + e * 8) = (u32x4){(unsigned)F.zv, (unsigned)F.zv, (unsigned)F.zv, (unsigned)F.zv}; }
      const size_t NKEY8 = 2ull * 8 * 2 * 128 * 128 / 8;
      for (size_t i = gt; i < NKEY8; i += nt) {
          const float* src = Ap->in[20]; bf16* dst = (bf16*)(ws + WS_PKEY);
          const f32x4 a = *(const f32x4*)(src + i * 8), b = *(const f32x4*)(src + i * 8 + 4);
          u32x4 o; o.x = pk2(a[0], a[1]); o.y = pk2(a[2], a[3]); o.z = pk2(b[0], b[1]); o.w = pk2(b[2], b[3]);
          *(u32x4*)(dst + i * 8) = o; }
    }
    for (int rr = F.gw; rr < 2 * 2 * PEXP; rr += F.ngw) {
        const int tab = rr / (2 * PEXP), lay = (rr / PEXP) & 1, e = rr % PEXP;
        const float* src = Ap->in[21 + tab] + ((size_t)lay * PEXP + e) * DM + 16 * F.lane;
        f32x4 x[4]; float mx = 0.f;
#pragma unroll
        for (int j = 0; j < 4; ++j) { x[j] = *(const f32x4*)(src + 4 * j); mx = fmaxf(fmaxf(fmaxf(mx, fabsf(x[j][0])), fmaxf(fabsf(x[j][1]), fabsf(x[j][2]))), fabsf(x[j][3])); }
#pragma unroll
        for (int o = 1; o < 64; o <<= 1) mx = fmaxf(mx, __shfl_xor(mx, o));
        const float inv = (mx > 0.f) ? 127.f / mx : 0.f;
        unsigned w[4]; const int bias = 128;
#pragma unroll
        for (int j = 0; j < 4; ++j) { const unsigned c0 = (unsigned)(bias + (int)rintf(x[j][0] * inv)) & 0xffu, c1 = (unsigned)(bias + (int)rintf(x[j][1] * inv)) & 0xffu, c2 = (unsigned)(bias + (int)rintf(x[j][2] * inv)) & 0xffu, c3 = (unsigned)(bias + (int)rintf(x[j][3] * inv)) & 0xffu;
            w[j] = c0 | (c1 << 8) | (c2 << 16) | (c3 << 24); }
        unsigned char* dst = tab ? (ws + WS_V + (size_t)lay * PEXP * DM + ((size_t)(F.lane >> 3) * PEXP + e) * 128 + (F.lane & 7) * 16)
                                 : (ws + WS_U + ((size_t)lay * PEXP + e) * DM + 16 * F.lane);
        *(u32x4*)dst = (u32x4){w[0], w[1], w[2], w[3]};
        if (F.lane == 0) ((float*)(ws + (tab ? WS_VS : WS_US)))[lay * PEXP + e] = (mx > 0.f) ? mx / 127.f : 1.f;
    }
}

#ifndef DBG_PRECISE_TOPK
#define DBG_PRECISE_TOPK 0
#endif
__device__ __forceinline__ void norm_mod_phase(const Frame& F, ArgsP Ap, int l, int which, int nrows) {
    unsigned char* ws = Ap->ws;
    const float* MOD = (const float*)(ws + WS_MOD);
    const float* gn = Ap->in[which ? 7 : 6] + l * DM;
    bf16* AB = (bf16*)(ws + WS_AB);
    const bool from_input = (which == 0 && l == 0);
    const float* hlat_ = from_input ? Ap->in[0] : Ap->out; const float* hctx_ = from_input ? Ap->in[2] : (const float*)(ws + WS_HCTX);
#define NM_ROWPTR(r_) (((r_) < NLAT) ? (hlat_ + (size_t)(r_) * DM) : (hctx_ + (size_t)((r_) - NLAT) * DM))
    f32x4 v[4], vn[4];
    if (F.gw < nrows) { const float* hr0 = NM_ROWPTR(F.gw);
#pragma unroll
        for (int j = 0; j < 4; ++j) v[j] = *(const f32x4*)(hr0 + 256 * j + 4 * F.lane); }
    for (int r = F.gw; r < nrows; r += F.ngw) {
        const bool lat = r < NLAT;
        { const int rn = (r + F.ngw < nrows) ? (r + F.ngw) : r; const float* hn = NM_ROWPTR(rn);
#pragma unroll
          for (int j = 0; j < 4; ++j) vn[j] = *(const f32x4*)(hn + 256 * j + 4 * F.lane); }
        const int s = lat ? (r >> 12) : 8;
        const float* mp = MOD + ((size_t)l * 9 + s) * 6144 + (which ? 3 * DM : 0);
        float ss = 0.f;
#pragma unroll
        for (int j = 0; j < 4; ++j) ss += (v[j][0] * v[j][0] + v[j][1] * v[j][1]) + (v[j][2] * v[j][2] + v[j][3] * v[j][3]);
        ss = wave_sum(ss);
        const float rinv = rsqrtf(ss * (1.f / DM) + EPS);
#pragma unroll
        for (int j = 0; j < 4; ++j) { const int c = 256 * j + 4 * F.lane;
            const f32x4 g = *(const f32x4*)(gn + c), sh = *(const f32x4*)(mp + c), sc = *(const f32x4*)(mp + DM + c);
            const f32x4 y = v[j] * rinv * g; const f32x4 a = y * (sc + 1.f) + sh;
            u32x2v o; o.x = pk2(a[0], a[1]); o.y = pk2(a[2], a[3]);
            *(u32x2v*)(AB + (size_t)r * DM + c) = o;
            if (which) { typedef _Float16 h2_t __attribute__((ext_vector_type(2))); const h2_t p0 = {(_Float16)a[0], (_Float16)a[1]}, p1 = {(_Float16)a[2], (_Float16)a[3]};
                u32x2v oh; oh.x = __builtin_bit_cast(unsigned, p0); oh.y = __builtin_bit_cast(unsigned, p1); *(u32x2v*)((unsigned short*)(ws + WS_F16B) + (size_t)r * DM + c) = oh; }
            }
#pragma unroll
        for (int j = 0; j < 4; ++j) v[j] = vn[j];
    }
#undef NM_ROWPTR
}

__device__ __forceinline__ void e2_phase(const Frame& F, ArgsP Ap, int l, int nrows) {
    unsigned char* ws = Ap->ws;
    const bf16* P = (const bf16*)(ws + WS_P);
    bf16* QAN = (bf16*)(ws + WS_AB); bf16* KVAN = QAN + (size_t)NROWS * QRANK;
    bf16* QS = (bf16*)(ws + WS_QS); bf16* KS = (bf16*)(ws + WS_KS);
    const float* qa_g = Ap->in[9] + l * QRANK; const float* kva_g = Ap->in[11] + l * KVRANK;
    const float* sqn_g = Ap->in[15] + l * 64; const float* skn_g = Ap->in[16] + l * 64;
    const float* rts = (const float*)(ws + WS_RTS);
    const int lane = F.lane;
    const int lqa = (lane < 48) ? lane : 47, lkva = (lane < 32) ? lane : 31, lsk = (lane < 16) ? lane : 15;
    u32x4 wqa, wsq, wkva, wsk, nqa, nsq, nkva, nsk;
#define E2_LOAD(A_, B_, C_, D_, r_) do { const bf16* pr_ = P + (size_t)(r_) * DIN; A_ = *(const u32x4*)(pr_ + 8 * lqa); B_ = *(const u32x4*)(pr_ + QRANK + 8 * lane); C_ = *(const u32x4*)(pr_ + 896 + 8 * lkva); D_ = *(const u32x4*)(pr_ + 1184 + 8 * lsk); } while (0)
    if (F.gw < nrows) E2_LOAD(wqa, wsq, wkva, wsk, F.gw);
    for (int r = F.gw; r < nrows; r += F.ngw) {
        const bool lat = r < NLAT; const int pos = r & (SEQ - 1), rp = pos >> 6, cp = pos & 63;
        { const int rn = (r + F.ngw < nrows) ? (r + F.ngw) : r; E2_LOAD(nqa, nsq, nkva, nsk, rn); }
        if (lane >= 48) wqa = (u32x4){0u, 0u, 0u, 0u};
        if (lane >= 32) wkva = (u32x4){0u, 0u, 0u, 0u};
        float x[8];
        { unpack8(wqa, x); float ss = 0.f;
#pragma unroll
          for (int e = 0; e < 8; ++e) ss += x[e] * x[e];
          ss = wave_sum(ss); const float rinv = rsqrtf(ss * (1.f / QRANK) + EPS);
          if (lane < 48) { float y[8];
#pragma unroll
              for (int e = 0; e < 8; ++e) y[e] = x[e] * rinv * qa_g[8 * lane + e];
              *(u32x4*)(QAN + (size_t)r * QRANK + 8 * lane) = pack8(y); } }
        { unpack8(wkva, x); float ss = 0.f;
#pragma unroll
          for (int e = 0; e < 8; ++e) ss += x[e] * x[e];
          ss = wave_sum(ss); const float rinv = rsqrtf(ss * (1.f / KVRANK) + EPS);
          if (lane < 32) { float y[8];
#pragma unroll
              for (int e = 0; e < 8; ++e) y[e] = x[e] * rinv * kva_g[8 * lane + e];
              *(u32x4*)(KVAN + (size_t)r * KVRANK + 8 * lane) = pack8(y); } }
        const int ch = lane & 7;
        const float* tab = rts + (size_t)((ch < 4) ? rp : cp) * 32 + (ch & 1) * 16;
#pragma unroll
        for (int which = 0; which < 2; ++which) {
            unpack8(which ? wsk : wsq, x); float ss = 0.f;
#pragma unroll
            for (int e = 0; e < 8; ++e) ss += x[e] * x[e];
            ss += __shfl_xor(ss, 1); ss += __shfl_xor(ss, 2); ss += __shfl_xor(ss, 4);
            const float rinv = rsqrtf(ss * (1.f / 64.f) + EPS);
            const float* gg = which ? skn_g : sqn_g;
            float y[8], o[8];
#pragma unroll
            for (int e = 0; e < 8; ++e) y[e] = x[e] * rinv * gg[8 * ch + e];
#pragma unroll
            for (int e = 0; e < 8; ++e) { const float py = __shfl_xor(y[e], 2);
                if (lat) { const float cs = tab[2 * e], sn = tab[2 * e + 1]; o[e] = (ch & 2) ? (y[e] * cs + py * sn) : (y[e] * cs - py * sn); } else o[e] = y[e]; }
            if (which == 0) {
#pragma unroll
                for (int e = 0; e < 8; ++e) o[e] *= C_SWA;
                *(u32x4*)(QS + (size_t)r * 512 + 8 * lane) = pack8(o);
            } else if (lane < 16) *(u32x4*)(KS + (size_t)r * 128 + 8 * lane) = pack8(o);
        }
        wqa = nqa; wsq = nsq; wkva = nkva; wsk = nsk;
    }
#undef E2_LOAD
}

__device__ __forceinline__ void e3_phase(const Frame& F, ArgsP Ap, int l, int nrows) {
    unsigned char* ws = Ap->ws;
    const bf16* P = (const bf16*)(ws + WS_P);
    bf16* QM = (bf16*)(ws + WS_QM); bf16* KM = (bf16*)(ws + WS_KM);
    const float* qn_g = Ap->in[13] + l * 96; const float* kn_g = Ap->in[14] + l * 96;
    const float* rtm = (const float*)(ws + WS_RTM);
    const int lane = F.lane, hl = lane / 12, ch = lane % 12, gbase = hl * 12;
    const bool val0 = lane < 60, val1 = (lane < 60) && (5 + hl < 8);
    const int h0 = val0 ? hl : 0, h1 = val1 ? (5 + hl) : 0;
    const int qo0 = h0 * 96 + ch * 8, qo1 = h1 * 96 + ch * 8; const bool krope = ch >= 8; const int kro = 1152 + (krope ? (ch - 8) * 8 : 0);
    u32x4 wq0, wk0, wq1, wk1, nq0, nk0, nq1, nk1;
#define E3_LOAD(A_, B_, C_, D_, r_) do { const bf16* qr_ = QM + (size_t)(r_) * 768; const bf16* kr_ = KM + (size_t)(r_) * 768; const bf16* pr_ = P + (size_t)(r_) * DIN + kro; \
        A_ = *(const u32x4*)(qr_ + qo0); C_ = *(const u32x4*)(qr_ + qo1); B_ = *(const u32x4*)(krope ? pr_ : (kr_ + qo0)); D_ = *(const u32x4*)(krope ? pr_ : (kr_ + qo1)); } while (0)
    if (F.gw < nrows) E3_LOAD(wq0, wk0, wq1, wk1, F.gw);
    for (int r = F.gw; r < nrows; r += F.ngw) {
        const bool lat = r < NLAT; const int pos = r & (SEQ - 1), rp = pos >> 6, cp = pos & 63;
        { const int rn = (r + F.ngw < nrows) ? (r + F.ngw) : r; if (rn != r) E3_LOAD(nq0, nk0, nq1, nk1, rn); }
        const float* tab = rtm + (size_t)((ch < 10) ? rp : cp) * 16;
#pragma unroll
        for (int pass = 0; pass < 2; ++pass) {
            const int head = pass ? h1 : h0; const bool valid = pass ? val1 : val0;
#pragma unroll
            for (int which = 0; which < 2; ++which) {
                u32x4 w = which ? (pass ? wk1 : wk0) : (pass ? wq1 : wq0);
                if (!valid) w = (u32x4){0u, 0u, 0u, 0u};
                bf16* dstp = (which ? KM : QM) + (size_t)r * 768 + head * 96 + ch * 8;
                float x[8]; unpack8(w, x); float ss = 0.f;
#pragma unroll
                for (int e = 0; e < 8; ++e) ss += x[e] * x[e];
                float tot = 0.f;
#pragma unroll
                for (int i = 0; i < 12; ++i) tot += __shfl(ss, (gbase + i) & 63);
                const float rinv = rsqrtf(tot * (1.f / 96.f) + EPS);
                const float* gg = which ? kn_g : qn_g;
                float y[8], o[8];
#pragma unroll
                for (int e = 0; e < 8; ++e) y[e] = x[e] * rinv * gg[8 * ch + e];
#pragma unroll
                for (int e = 0; e < 8; ++e) { const float py = __shfl_xor(y[e], 1);
                    if (lat && ch >= 8) { const float cs = tab[2 * e], sn = tab[2 * e + 1]; o[e] = (ch & 1) ? (y[e] * cs + py * sn) : (y[e] * cs - py * sn); } else o[e] = y[e]; }
                if (which == 0) {
#pragma unroll
                    for (int e = 0; e < 8; ++e) o[e] *= C_MLA;
                }
                if (valid) *(u32x4*)dstp = pack8(o);
            }
        }
        wq0 = nq0; wk0 = nk0; wq1 = nq1; wk1 = nk1;
    }
#undef E3_LOAD
}
#define XB_TMO      128
#define XB_XCNT(j)  (256  + 64 * (j))
#define XB_XSUB(j)  (1280 + 64 * (j))
#define XB_XGEN(j)  (2304 + 64 * (j))
#define XB_TOP      3328
#define XB_TOPGEN   3392
#define XCD_BAR_WORDS 3456
#define XB_SPIN_CAP (1u << 18)

__device__ __forceinline__ unsigned xb_ld(unsigned* p)              { return __hip_atomic_load(p, __ATOMIC_RELAXED, __HIP_MEMORY_SCOPE_AGENT); }
__device__ __forceinline__ unsigned xb_add(unsigned* p, unsigned v) { return __hip_atomic_fetch_add(p, v, __ATOMIC_RELAXED, __HIP_MEMORY_SCOPE_AGENT); }
__device__ __forceinline__ unsigned xb_xcc_id() { return (unsigned)__builtin_amdgcn_s_getreg((3 << 11) | 20) & 0xFu; }
#define XB_SPIN(cond, bar) do { unsigned _sp = 0; while (cond) { __builtin_amdgcn_s_sleep(1); \
    if ((++_sp & 255u) == 0u) { if (xb_ld(&(bar)[XB_TMO])) break; if (_sp > XB_SPIN_CAP) { atomicAdd(&(bar)[XB_TMO], 1u); break; } } } } while (0)

struct XcdBarrier {
    unsigned* bar; unsigned x;
    volatile LAS unsigned* st;
};

__device__ __forceinline__ XcdBarrier xcd_barrier_post(unsigned* bar, volatile LAS unsigned* st, const bool t0) {
    XcdBarrier b; b.bar = bar; b.x = xb_xcc_id(); b.st = st;
    if (t0) (void)xb_add(&bar[XB_XCNT(b.x)], 1u);
    return b;
}
__device__ __forceinline__ void xcd_barrier_complete(unsigned* bar, unsigned x, unsigned& nloc, unsigned& nx) {
    const unsigned G = gridDim.x * gridDim.y * gridDim.z;
    unsigned sum, cnt, mine, sp = 0u;
    for (;;) {
        sum = 0u; cnt = 0u; mine = 0u;
#pragma unroll
        for (unsigned j = 0; j < 16; ++j) { const unsigned c = xb_ld(&bar[XB_XCNT(j)]); sum += c; cnt += (c > 0u) ? 1u : 0u; mine = (j == x) ? c : mine; }
        if (sum == G) break;
        __builtin_amdgcn_s_sleep(1);
        if ((++sp & 255u) == 0u) { if (xb_ld(&bar[XB_TMO])) break; if (sp > XB_SPIN_CAP) { atomicAdd(&bar[XB_TMO], 1u); break; } }
    }
    nloc = mine > 0u ? mine : 1u; nx = cnt > 0u ? cnt : 1u;
}

__device__ __forceinline__ void xcd_barrier(const XcdBarrier& b, const bool t0) {
    asm volatile("s_waitcnt vmcnt(0)" ::: "memory");
    __syncthreads();
    if (t0) {
        unsigned* bar = b.bar;
        __builtin_amdgcn_s_waitcnt(0);
        unsigned nloc = b.st[0], nx = b.st[1];
        if (nloc == 0u) { xcd_barrier_complete(bar, b.x, nloc, nx); b.st[0] = nloc; b.st[1] = nx; }
        const unsigned old = xb_add(&bar[XB_XSUB(b.x)], 1u);
        const unsigned gen = old / nloc;
        if (old + 1u == (gen + 1u) * nloc) {
            __builtin_amdgcn_fence(__ATOMIC_RELEASE, "agent");
            asm volatile("s_waitcnt vmcnt(0)" ::: "memory");
            const unsigned og = xb_add(&bar[XB_TOP], 1u);
            const unsigned tg = og / nx;
            if (og + 1u == (tg + 1u) * nx) xb_add(&bar[XB_TOPGEN], 1u);
            else XB_SPIN(xb_ld(&bar[XB_TOPGEN]) == tg, bar);
            __builtin_amdgcn_fence(__ATOMIC_ACQUIRE, "agent");
            xb_add(&bar[XB_XGEN(b.x)], 1u);
            asm volatile("s_waitcnt vmcnt(0)" ::: "memory");
        } else {
            XB_SPIN(xb_ld(&bar[XB_XGEN(b.x)]) == gen, bar);
            __builtin_amdgcn_fence(__ATOMIC_ACQUIRE, "agent");
            asm volatile("s_waitcnt vmcnt(0)" ::: "memory");
        }
    }
    __syncthreads();
}
namespace att {
constexpr int SHM_V = 64 * 64 * 2, SHM_K = 64 * 256, LDS_ATT = 2 * SHM_V + 2 * SHM_K + 8 * 64 * 4;
#define KSWZ(row, colB) ((row) * 256 + ((colB) ^ (((row) & 7) << 4)))
#define SBAR() __builtin_amdgcn_sched_barrier(0)
__device__ __forceinline__ int crow(int r, int hi) { return (r & 3) + 8 * (r >> 2) + 4 * hi; }
__device__ __forceinline__ int v_st(int k, int c) { const int kk = (k & ~0xC) | ((k & 4) << 1) | ((k & 8) >> 1); return ((kk >> 3) * 2 + (c >> 5)) * 512 + ((kk & 7) * 32 + (c & 31)) * 2; }
__device__ __forceinline__ int v_rd_base(int lane) { return ((lane & 3) << 3) | (((lane >> 2) & 3) << 6) | (((lane >> 4) & 1) << 5) | (((lane >> 5) & 1) << 8); }
constexpr int v_rd_off(int d0, int ks, int half) { return d0 * 512 + ks * 2048 + half * 1024; }
template <int OFF> __device__ __forceinline__ s16x4 tr_read(int vb) {
    s16x4 r; asm volatile("ds_read_b64_tr_b16 %0, %1 offset:%2" : "=&v"(r) : "v"(vb), "i"(OFF) : "memory"); return r;
}
template <int D0> __device__ __forceinline__ void pv_one(f32x16& od, int vb, bf16x8 pa0, bf16x8 pa1, bf16x8 pa2, bf16x8 pa3) {
    const s16x4 l0 = tr_read<v_rd_off(D0, 0, 0)>(vb), h0 = tr_read<v_rd_off(D0, 0, 1)>(vb), l1 = tr_read<v_rd_off(D0, 1, 0)>(vb), h1 = tr_read<v_rd_off(D0, 1, 1)>(vb);
    const s16x4 l2 = tr_read<v_rd_off(D0, 2, 0)>(vb), h2 = tr_read<v_rd_off(D0, 2, 1)>(vb), l3 = tr_read<v_rd_off(D0, 3, 0)>(vb), h3 = tr_read<v_rd_off(D0, 3, 1)>(vb);
    asm volatile("s_waitcnt lgkmcnt(0)" ::: "memory"); SBAR();
#define PK(L, H) (bf16x8){L[0], L[1], L[2], L[3], H[0], H[1], H[2], H[3]}
    od = __builtin_amdgcn_mfma_f32_32x32x16_bf16(pa0, PK(l0, h0), od, 0, 0, 0);
    od = __builtin_amdgcn_mfma_f32_32x32x16_bf16(pa1, PK(l1, h1), od, 0, 0, 0);
    od = __builtin_amdgcn_mfma_f32_32x32x16_bf16(pa2, PK(l2, h2), od, 0, 0, 0);
    od = __builtin_amdgcn_mfma_f32_32x32x16_bf16(pa3, PK(l3, h3), od, 0, 0, 0);
#undef PK
}
__device__ __forceinline__ void pv2(f32x16* o, int vb, bf16x8 pa0, bf16x8 pa1, bf16x8 pa2, bf16x8 pa3) {
    pv_one<0>(o[0], vb, pa0, pa1, pa2, pa3); pv_one<1>(o[1], vb, pa0, pa1, pa2, pa3);
}
template <int ND0> __device__ __forceinline__ void qkt(f32x16& p0, f32x16& p1, const char* Ks, const bf16x8* qr, int r32, int hi) {
    p0 = f32x16{}; p1 = f32x16{};
#pragma unroll
    for (int d0 = 0; d0 < ND0; ++d0) { const int cb = (d0 * 16 + hi * 8) * 2;
        const bf16x8 b0 = *reinterpret_cast<const bf16x8*>(Ks + KSWZ(r32, cb));
        const bf16x8 b1 = *reinterpret_cast<const bf16x8*>(Ks + KSWZ(32 + r32, cb));
        p0 = __builtin_amdgcn_mfma_f32_32x32x16_bf16(b0, qr[d0], p0, 0, 0, 0);
        p1 = __builtin_amdgcn_mfma_f32_32x32x16_bf16(b1, qr[d0], p1, 0, 0, 0); }
}
__device__ __forceinline__ void wmask(f32x16& p0, f32x16& p1, int kp0, int qp, int hi) {
#pragma unroll
    for (int r = 0; r < 16; ++r) { const int d0 = kp0 + crow(r, hi) - qp; const int d1 = d0 + 32;
        if (d0 > 128 || d0 < -128) p0[r] = -INFINITY; if (d1 > 128 || d1 < -128) p1[r] = -INFINITY; }
}
__device__ __forceinline__ void smpack(f32x16& p0, f32x16& p1, float& l_reg, bf16x8& pa0, bf16x8& pa1, bf16x8& pa2, bf16x8& pa3) {
#pragma unroll
    for (int r = 0; r < 16; ++r) p0[r] = __builtin_amdgcn_exp2f(p0[r]);
#pragma unroll
    for (int r = 0; r < 16; ++r) p1[r] = __builtin_amdgcn_exp2f(p1[r]);
    float ps = 0.f;
#pragma unroll
    for (int r = 0; r < 16; ++r) ps += p0[r];
#pragma unroll
    for (int r = 0; r < 16; ++r) ps += p1[r];
    l_reg += ps;
#define PK4(P, BASE, OUT) do { unsigned a0 = pk2(P[BASE + 0], P[BASE + 1]), a1 = pk2(P[BASE + 2], P[BASE + 3]);   \
    unsigned b0 = pk2(P[BASE + 4], P[BASE + 5]), b1 = pk2(P[BASE + 6], P[BASE + 7]);                              \
    auto r0 = __builtin_amdgcn_permlane32_swap(a0, b0, false, false); auto r1 = __builtin_amdgcn_permlane32_swap(a1, b1, false, false); \
    u32x4 w = {r0[0], r1[0], r0[1], r1[1]}; OUT = *reinterpret_cast<bf16x8*>(&w); } while (0)
    PK4(p0, 0, pa0); PK4(p0, 8, pa1); PK4(p1, 0, pa2); PK4(p1, 8, pa3);
#undef PK4
}

struct Unit {
    const bf16* Q; int ldq;
    const bf16* K; int ldk;
    const bf16* V; int ldv;
    bf16* O;
    int qrow0;
    int ctx_row0;
    int lat_row0;
    int nt;
    int qpos0;
    int kpos0;
    int masked;
    float l_init;
};

template <int DQK, bool MASKED>
__device__ __forceinline__ void attn_unit(const Unit& U, char* lds, const int tid) {
    constexpr int ND0 = DQK / 16, NCH = DQK / 8;
    const int wid = tid >> 6, lane = tid & 63, r32 = lane & 31, hi = lane >> 5;
    char* V_lds = lds; char* K_lds = lds + 2 * SHM_V;
    float* wsf = (float*)(lds + 2 * SHM_V + 2 * SHM_K) + wid * 64;
    float l_reg = (hi == 0) ? U.l_init : 0.f; f32x16 o[2] = {}; bf16x8 qr[ND0];
    const bf16* Qw = U.Q + (size_t)(U.qrow0 + wid * 32 + r32) * U.ldq + hi * 8;
#pragma unroll
    for (int d0 = 0; d0 < ND0; ++d0) qr[d0] = *reinterpret_cast<const bf16x8*>(Qw + d0 * 16);
    const int vk = tid >> 3, vc = (tid & 7) * 8, vst = v_st(vk, vc);
    const int k0r = tid / NCH, k0c = tid % NCH;
    const bool k1on = (NCH == 12) && (tid < 256);
    const int k1i = k1on ? (tid + 512) : tid, k1r = k1i / NCH, k1c = k1i % NCH;
    const int vb0 = (int)(uintptr_t)V_lds + v_rd_base(lane);
    struct Slot { bf16x8 v, k0, k1; } s0;
    auto tile_row = [&](int t) -> int { return (t < 4) ? (U.ctx_row0 + 64 * t) : (U.lat_row0 + 64 * (t - 4)); };
#define SLOAD(S, t) do { const int kr_ = tile_row(t); \
        S.v = *reinterpret_cast<const bf16x8*>(U.V + (size_t)(kr_ + vk) * U.ldv + vc); \
        S.k0 = *reinterpret_cast<const bf16x8*>(U.K + (size_t)(kr_ + k0r) * U.ldk + k0c * 8); \
        if (NCH == 12) S.k1 = *reinterpret_cast<const bf16x8*>(U.K + (size_t)(kr_ + k1r) * U.ldk + k1c * 8); } while (0)
#define SWRITE(b, S) do { *reinterpret_cast<bf16x8*>(V_lds + (b) * SHM_V + vst) = S.v; \
        *reinterpret_cast<bf16x8*>(K_lds + (b) * SHM_K + KSWZ(k0r, k0c * 16)) = S.k0; \
        if (NCH == 12) { if (k1on) *reinterpret_cast<bf16x8*>(K_lds + (b) * SHM_K + KSWZ(k1r, k1c * 16)) = S.k1; } } while (0)
#define MASK(P0, P1, t) do { if (MASKED && (t) >= 4) wmask(P0, P1, U.kpos0 + 64 * ((t) - 4), U.qpos0 + wid * 32 + r32, hi); } while (0)
    f32x16 pA0, pA1, pB0, pB1; bf16x8 pa0, pa1, pa2, pa3; const int NT = U.nt;
    __syncthreads();
    SLOAD(s0, 0); SWRITE(0, s0); __syncthreads();
    qkt<ND0>(pA0, pA1, K_lds, qr, r32, hi); MASK(pA0, pA1, 0);
    SLOAD(s0, 1);
    SWRITE(1, s0); __syncthreads();
    for (int j = 1; j + 1 < NT; j += 2) {
        SBAR(); qkt<ND0>(pB0, pB1, K_lds + SHM_K, qr, r32, hi); MASK(pB0, pB1, j);
        smpack(pA0, pA1, l_reg, pa0, pa1, pa2, pa3); SBAR();
        SLOAD(s0, j + 1); SBAR();
        pv2(o, vb0, pa0, pa1, pa2, pa3);
        __syncthreads(); SWRITE(0, s0); __syncthreads();
        SBAR(); qkt<ND0>(pA0, pA1, K_lds, qr, r32, hi); MASK(pA0, pA1, j + 1);
        smpack(pB0, pB1, l_reg, pa0, pa1, pa2, pa3); SBAR();
        SLOAD(s0, j + 2); SBAR();
        pv2(o, vb0 + SHM_V, pa0, pa1, pa2, pa3);
        __syncthreads(); SWRITE(1, s0); __syncthreads();
    }
    SBAR(); qkt<ND0>(pB0, pB1, K_lds + SHM_K, qr, r32, hi); MASK(pB0, pB1, NT - 1);
    smpack(pA0, pA1, l_reg, pa0, pa1, pa2, pa3); SBAR();
    pv2(o, vb0, pa0, pa1, pa2, pa3);
    smpack(pB0, pB1, l_reg, pa0, pa1, pa2, pa3); SBAR();
    pv2(o, vb0 + SHM_V, pa0, pa1, pa2, pa3);
    { auto rr = __builtin_amdgcn_permlane32_swap(__float_as_uint(l_reg), __float_as_uint(l_reg), false, false);
      l_reg = __uint_as_float(rr[0]) + __uint_as_float(rr[1]); }
    if (hi == 0) wsf[r32] = l_reg;
    asm volatile("s_waitcnt lgkmcnt(0)" ::: "memory");
    float rli[16];
#pragma unroll
    for (int r = 0; r < 16; ++r) rli[r] = 1.f / wsf[crow(r, hi)];
    bf16* Ow = U.O + (size_t)(U.qrow0 + wid * 32) * 1024;
#pragma unroll
    for (int r = 0; r < 16; ++r) { const int orow = crow(r, hi);
#pragma unroll
        for (int d0 = 0; d0 < 2; ++d0) { const unsigned w = pk2(o[d0][r] * rli[r], 0.f); Ow[(size_t)orow * 1024 + d0 * 32 + r32] = (bf16)(w & 0xffffu); } }
#undef SLOAD
#undef SWRITE
#undef MASK
}
#undef KSWZ
}

__device__ __forceinline__ void attn_phase(const Frame& F, ArgsP Ap, int l, char* lds) {
    unsigned char* ws = Ap->ws;
    const bf16* QM = (const bf16*)(ws + WS_QM); const bf16* KM = (const bf16*)(ws + WS_KM); const bf16* VM = (const bf16*)(ws + WS_VM);
    const bf16* QS = (const bf16*)(ws + WS_QS); const bf16* KS = (const bf16*)(ws + WS_KS); const bf16* VS = (const bf16*)(ws + WS_P) + 1312;
    bf16* OB = (bf16*)(ws + WS_AB);
    const float* sink = Ap->in[17] + l * 8;
    const int nunits = (l == 0) ? 1024 + 64 : 1024;
    for (int u = F.vcu; u < nunits; u += F.G) {
        const bool isl = u < 1024;
        const int i = u >> 8, c = u & 31, b = isl ? ((u & 255) >> 5) : ((u - 1024) >> 3), h = isl ? (2 * i + (c >> 4)) : (u & 7), qb = c & 15;
        att::Unit U; U.Q = QM + h * 96; U.ldq = 768; U.K = KM + h * 96; U.ldk = 768; U.V = VM + h * 64; U.ldv = 512; U.O = OB + h * 64;
        U.qrow0 = isl ? (b * SEQ + qb * 256) : (NLAT + b * CTXL); U.ctx_row0 = NLAT + b * CTXL; U.lat_row0 = b * SEQ; U.nt = isl ? (4 + SEQ / 64) : 4; U.qpos0 = 0; U.kpos0 = 0; U.masked = 0; U.l_init = 0.f;
        att::attn_unit<96, false>(U, lds, F.tid);
    }
    for (int u = F.vcu; u < nunits; u += F.G) {
        const bool isl = u < 1024;
        const int i = u >> 8, c = u & 31, b = isl ? ((u & 255) >> 5) : ((u - 1024) >> 3), h = isl ? (2 * i + (c >> 4)) : (u & 7), qb = c & 15, g = h >> 2;
        const int q0 = qb * 256; int k_lo = q0 - 128; if (k_lo < 0) k_lo = 0; int k_hi = q0 + 256 + 128; if (k_hi > SEQ) k_hi = SEQ;
        att::Unit U; U.Q = QS + h * 64; U.ldq = 512; U.K = KS + g * 64; U.ldk = 128; U.V = VS + g * 64; U.ldv = DIN; U.O = OB + 512 + h * 64;
        U.qrow0 = isl ? (b * SEQ + q0) : (NLAT + b * CTXL); U.ctx_row0 = NLAT + b * CTXL; U.lat_row0 = b * SEQ + k_lo; U.nt = isl ? (4 + (k_hi - k_lo) / 64) : 4; U.qpos0 = q0; U.kpos0 = k_lo; U.masked = 1;
        U.l_init = __builtin_amdgcn_exp2f(sink[h] * LOG2E);
        att::attn_unit<64, true>(U, lds, F.tid);
    }
}

#ifndef DBG_NAIVE_ATTN
#define DBG_NAIVE_ATTN 0
#endif
#if DBG_NAIVE_ATTN
__device__ __forceinline__ void attn_naive_phase(const Frame& F, ArgsP Ap, int l) {
    unsigned char* ws = Ap->ws;
    const bf16* QM = (const bf16*)(ws + WS_QM); const bf16* KM = (const bf16*)(ws + WS_KM); const bf16* VM = (const bf16*)(ws + WS_VM);
    const bf16* QS = (const bf16*)(ws + WS_QS); const bf16* KS = (const bf16*)(ws + WS_KS); const bf16* VS = (const bf16*)(ws + WS_P) + 1312;
    bf16* OB = (bf16*)(ws + WS_AB);
    const float* sink = Ap->in[17] + l * 8;
    const int nrg = ((l == 0) ? NROWS : NLAT) / 64;
    for (int u = F.gw; u < nrg * 8; u += F.ngw) {
        const int h = __builtin_amdgcn_readfirstlane(u & 7), rg = __builtin_amdgcn_readfirstlane(u >> 3), row = rg * 64 + F.lane;
        const bool lat = rg * 64 < NLAT; const int b = lat ? (rg * 64) >> 12 : (rg * 64 - NLAT) >> 8;
        {
            float q[96], o[64]; float lsum = 0.f;
#pragma unroll
            for (int d = 0; d < 96; d += 2) { const unsigned w = *(const unsigned*)(QM + (size_t)row * 768 + h * 96 + d); q[d] = bf_lo(w); q[d + 1] = bf_hi(w); }
#pragma unroll
            for (int d = 0; d < 64; ++d) o[d] = 0.f;
            const int nk = lat ? (CTXL + SEQ) : CTXL;
#pragma unroll 1
            for (int j = 0; j < nk; ++j) { const int kr = (j < CTXL) ? (NLAT + b * CTXL + j) : (b * SEQ + j - CTXL);
                const bf16* kp = KM + (size_t)kr * 768 + h * 96; const bf16* vp = VM + (size_t)kr * 512 + h * 64; float s = 0.f;
#pragma unroll
                for (int d = 0; d < 96; d += 2) { const unsigned w = *(const unsigned*)(kp + d); s = fmaf(q[d], bf_lo(w), s); s = fmaf(q[d + 1], bf_hi(w), s); }
                const float p = exp2f(s); lsum += p;
#pragma unroll
                for (int d = 0; d < 64; d += 2) { const unsigned w = *(const unsigned*)(vp + d); o[d] = fmaf(p, bf_lo(w), o[d]); o[d + 1] = fmaf(p, bf_hi(w), o[d + 1]); } }
            const float rl = 1.f / lsum;
#pragma unroll
            for (int d = 0; d < 64; d += 2) *(unsigned*)(OB + (size_t)row * 1024 + h * 64 + d) = pk2(o[d] * rl, o[d + 1] * rl);
        }
        {
            const int g = h >> 2; const int pos0 = (rg * 64) & (SEQ - 1), pos = pos0 + F.lane;
            float q[64], o[64]; float lsum = exp2f(sink[h] * LOG2E);
#pragma unroll
            for (int d = 0; d < 64; d += 2) { const unsigned w = *(const unsigned*)(QS + (size_t)row * 512 + h * 64 + d); q[d] = bf_lo(w); q[d + 1] = bf_hi(w); }
#pragma unroll
            for (int d = 0; d < 64; ++d) o[d] = 0.f;
            int jlo = pos0 - 128; if (jlo < 0) jlo = 0; int jhi = pos0 + 63 + 128; if (jhi > SEQ - 1) jhi = SEQ - 1;
            const int nk = lat ? (CTXL + (jhi - jlo + 1)) : CTXL;
#pragma unroll 1
            for (int j = 0; j < nk; ++j) { const bool isc = j < CTXL; const int kpos = jlo + j - CTXL; const int kr = isc ? (NLAT + b * CTXL + j) : (b * SEQ + kpos);
                const bf16* kp = KS + (size_t)kr * 128 + g * 64; const bf16* vp = VS + (size_t)kr * DIN + g * 64; float s = 0.f;
#pragma unroll
                for (int d = 0; d < 64; d += 2) { const unsigned w = *(const unsigned*)(kp + d); s = fmaf(q[d], bf_lo(w), s); s = fmaf(q[d + 1], bf_hi(w), s); }
                float p = exp2f(s); if (!isc) { const int dd = kpos - pos; if (dd > 128 || dd < -128) p = 0.f; } lsum += p;
#pragma unroll
                for (int d = 0; d < 64; d += 2) { const unsigned w = *(const unsigned*)(vp + d); o[d] = fmaf(p, bf_lo(w), o[d]); o[d + 1] = fmaf(p, bf_hi(w), o[d + 1]); } }
            const float rl = 1.f / lsum;
#pragma unroll
            for (int d = 0; d < 64; d += 2) *(unsigned*)(OB + (size_t)row * 1024 + 512 + h * 64 + d) = pk2(o[d] * rl, o[d + 1] * rl);
        }
    }
}
#endif
__device__ __forceinline__ unsigned f2key(float f) { const unsigned u = __float_as_uint(f); return (u & 0x80000000u) ? ~u : (u | 0x80000000u); }
__device__ __forceinline__ float key2f(unsigned k) { const unsigned u = (k & 0x80000000u) ? (k & 0x7fffffffu) : ~k; return __uint_as_float(u); }
#define CE_DESC(a, b) do { const unsigned _hi = max(a, b), _lo = min(a, b); a = _hi; b = _lo; } while (0)
__device__ __forceinline__ void sort16_desc(unsigned (&a)[16]) {
#pragma unroll
    for (int k = 2; k <= 16; k <<= 1)
#pragma unroll
        for (int j = k >> 1; j > 0; j >>= 1)
#pragma unroll
            for (int i = 0; i < 16; ++i) { const int p = i ^ j;
                if (p > i) { if ((i & k) == 0) { CE_DESC(a[i], a[p]); } else { CE_DESC(a[p], a[i]); } } }
}
__device__ __forceinline__ void merge16_desc(unsigned (&t)[16], const unsigned (&c)[16]) {
#pragma unroll
    for (int i = 0; i < 16; ++i) t[i] = max(t[i], c[15 - i]);
#pragma unroll
    for (int j = 8; j > 0; j >>= 1)
#pragma unroll
        for (int i = 0; i < 16; ++i) { const int p = i ^ j; if (p > i) CE_DESC(t[i], t[p]); }
}
__device__ __forceinline__ void merge16_partner(unsigned (&t)[16]) {
    unsigned oth[16];
#pragma unroll
    for (int i = 0; i < 16; ++i) oth[i] = (unsigned)__shfl_xor((int)t[i], 32);
    merge16_desc(t, oth);
}

constexpr size_t WS_IDX = WS_P;
constexpr size_t WS_GW = WS_P + (size_t)NROWS * 128 * 2;
constexpr size_t WS_W2 = WS_GW + (size_t)NROWS * 128 * 4;
constexpr size_t WS_USL = WS_W2 + (size_t)NROWS * 128 * 4;
static_assert(WS_USL + (size_t)NROWS * 128 * 4 <= WS_X5, "peer lists inside the P region");

__device__ __forceinline__ void topkc_phase(const Frame& F, ArgsP Ap, int l, int nrows, char* lds) {
    unsigned char* ws = Ap->ws;
    const bf16* QP = (const bf16*)(ws + WS_X5);
    const bf16* PK = (const bf16*)(ws + WS_PKEY) + (size_t)l * 16 * 128 * 128;
    unsigned short* IDX = (unsigned short*)(ws + WS_IDX); float* GW = (float*)(ws + WS_GW); float* USL = (float*)(ws + WS_USL);
    const float* USt = (const float*)(ws + WS_US) + l * PEXP; const float* VSt = (const float*)(ws + WS_VS) + l * PEXP;
    char* Kl = lds;
    unsigned char* sub = (unsigned char*)(lds + 65536) + F.wave * 1024;
    const int lane = F.lane, r32 = lane & 31, hi = lane >> 5;
    const int nunits = (nrows / 256) * 8;
    for (int u = F.bid; u < nunits; u += F.G) {
        const int h = u & 7, rb = u >> 3;
        __syncthreads();
#pragma unroll
        for (int i = 0; i < 8; ++i) { const int ci = F.tid + 512 * i, krow = ci >> 4, ch = ci & 15;
            const u32x4 v = *(const u32x4*)(PK + ((size_t)(2 * h) * 128 + krow) * 128 + ch * 8);
            *(u32x4*)(Kl + krow * 256 + ((ch * 16) ^ ((krow & 7) << 4))) = v; }
        __syncthreads();
        const int row = rb * 256 + F.wave * 32 + r32;
        const unsigned hi4 = (unsigned)hi << 2, hi7 = (unsigned)hi << 7;
        unsigned t0[16], t1[16];
#pragma unroll
        for (int p = 0; p < 2; ++p) {
            const bf16* qrow = QP + (size_t)row * 2048 + (2 * h + p) * 128 + hi * 8;
            bf16x8 bq[8];
#pragma unroll
            for (int s = 0; s < 8; ++s) bq[s] = *reinterpret_cast<const bf16x8*>(qrow + s * 16);
            unsigned top[16];
#pragma unroll
            for (int blk = 0; blk < 4; ++blk) {
                f32x16 acc = f32x16{};
                const char* kb = Kl + (p * 128 + blk * 32 + r32) * 256;
#pragma unroll
                for (int s = 0; s < 8; ++s) { const bf16x8 ka = *reinterpret_cast<const bf16x8*>(kb + (((s * 16 + hi * 8) * 2) ^ ((r32 & 7) << 4)));
                    acc = __builtin_amdgcn_mfma_f32_32x32x16_bf16(ka, bq[s], acc, 0, 0, 0); }
                unsigned c[16];
#pragma unroll
                for (int r = 0; r < 16; ++r) c[r] = ((f2key(acc[r]) & ~127u) | (unsigned)(127 - (blk * 32 + (r & 3) + 8 * (r >> 2)))) ^ hi4;
                sort16_desc(c);
                if (blk == 0) {
#pragma unroll
                    for (int i = 0; i < 16; ++i) top[i] = c[i];
                } else merge16_desc(top, c);
                __builtin_amdgcn_sched_barrier(0);
            }
            merge16_partner(top);
#pragma unroll
            for (int i = 0; i < 16; ++i) { if (p == 0) t0[i] = top[i]; else t1[i] = top[i]; }
        }
        if (hi == 0) { unsigned* sw = (unsigned*)(sub + r32 * 32);
#pragma unroll
            for (int q = 0; q < 4; ++q) {
                sw[q] = (127u - (t0[4 * q] & 127u)) | ((127u - (t0[4 * q + 1] & 127u)) << 8) | ((127u - (t0[4 * q + 2] & 127u)) << 16) | ((127u - (t0[4 * q + 3] & 127u)) << 24);
                sw[4 + q] = (127u - (t1[4 * q] & 127u)) | ((127u - (t1[4 * q + 1] & 127u)) << 8) | ((127u - (t1[4 * q + 2] & 127u)) << 16) | ((127u - (t1[4 * q + 3] & 127u)) << 24); } }
        float f1[16], fa[8];
#pragma unroll
        for (int i = 0; i < 16; ++i) f1[i] = key2f(t1[i] & ~127u);
#pragma unroll
        for (int i = 0; i < 8; ++i) fa[i] = key2f((hi ? t0[8 + i] : t0[i]) & ~127u);
        unsigned top[16];
#pragma unroll
        for (int i = 0; i < 8; ++i) {
            unsigned c[16];
#pragma unroll
            for (int b = 0; b < 16; ++b) c[b] = ((f2key(fa[i] + f1[b]) & ~255u) | (unsigned)(255 - (16 * i + b))) ^ hi7;
            if (i == 0) {
#pragma unroll
                for (int k = 0; k < 16; ++k) top[k] = c[k];
            } else merge16_desc(top, c);
            __builtin_amdgcn_sched_barrier(0);
        }
        merge16_partner(top);
        asm volatile("s_waitcnt lgkmcnt(0)" ::: "memory");
        float cv[16]; float den = 0.f; const float m = key2f(top[0] & ~255u);
#pragma unroll
        for (int i = 0; i < 16; ++i) { cv[i] = __expf(key2f(top[i] & ~255u) - m); den += cv[i]; }
        const float rden = 1.f / den;
        if (hi == 0) {
            unsigned iw[8];
#pragma unroll
            for (int i = 0; i < 16; i += 2) {
                const int fl0 = 255 - (int)(top[i] & 255u), fl1 = 255 - (int)(top[i + 1] & 255u);
                const unsigned e0 = (unsigned)sub[r32 * 32 + (fl0 >> 4)] * PNK + (unsigned)sub[r32 * 32 + 16 + (fl0 & 15)];
                const unsigned e1 = (unsigned)sub[r32 * 32 + (fl1 >> 4)] * PNK + (unsigned)sub[r32 * 32 + 16 + (fl1 & 15)];
                iw[i >> 1] = e0 | (e1 << 16); }
            u32x4* ip = (u32x4*)(IDX + (size_t)row * 128 + h * 16); ip[0] = (u32x4){iw[0], iw[1], iw[2], iw[3]}; ip[1] = (u32x4){iw[4], iw[5], iw[6], iw[7]};
            float us_[16], gv_[16];
#pragma unroll
            for (int i = 0; i < 16; ++i) { const unsigned e_ = (i & 1) ? (iw[i >> 1] >> 16) : (iw[i >> 1] & 0xffffu); us_[i] = USt[e_]; gv_[i] = cv[i] * rden * VSt[e_] * 1024.f; }
            f32x4* gp = (f32x4*)(GW + (size_t)row * 128 + h * 16); f32x4* up = (f32x4*)(USL + (size_t)row * 128 + h * 16);
#pragma unroll
            for (int q = 0; q < 4; ++q) { gp[q] = (f32x4){gv_[4 * q], gv_[4 * q + 1], gv_[4 * q + 2], gv_[4 * q + 3]}; up[q] = (f32x4){us_[4 * q], us_[4 * q + 1], us_[4 * q + 2], us_[4 * q + 3]}; }
        }
    }
}

typedef __bf16 bf16x2_t __attribute__((ext_vector_type(2)));
typedef float f32x2v __attribute__((ext_vector_type(2)));
__device__ __forceinline__ float dot2(unsigned w, unsigned x, float acc) { return __builtin_amdgcn_fdot2_f32_bf16(__builtin_bit_cast(bf16x2_t, w), __builtin_bit_cast(bf16x2_t, x), acc, false); }
__device__ __forceinline__ float dot16(const u32x4 a0, const u32x4 a1, const u32x4 x0, const u32x4 x1) {
    float s0 = dot2(a0.x, x0.x, 0.f), s1 = dot2(a0.y, x0.y, 0.f), s2 = dot2(a0.z, x0.z, 0.f), s3 = dot2(a0.w, x0.w, 0.f);
    s0 = dot2(a1.x, x1.x, s0); s1 = dot2(a1.y, x1.y, s1); s2 = dot2(a1.z, x1.z, s2); s3 = dot2(a1.w, x1.w, s3);
    return (s0 + s1) + (s2 + s3);
}
__device__ __forceinline__ void fma8(float (&o)[8], const u32x4 v, float w) {
    o[0] += w * bf_lo(v.x); o[1] += w * bf_hi(v.x); o[2] += w * bf_lo(v.y); o[3] += w * bf_hi(v.y);
    o[4] += w * bf_lo(v.z); o[5] += w * bf_hi(v.z); o[6] += w * bf_lo(v.w); o[7] += w * bf_hi(v.w);
}

#define DPP_ADD(v, CTRL) ((v) + __builtin_bit_cast(float, __builtin_amdgcn_update_dpp(0, __builtin_bit_cast(int, (v)), (CTRL), 0xF, 0xF, true)))
__device__ __forceinline__ float dpp_sum8(float v) { v = DPP_ADD(v, 0xB1); v = DPP_ADD(v, 0x4E); v = DPP_ADD(v, 0x141); return v; }
__device__ __forceinline__ float dpp_sum16(float v) { v = dpp_sum8(v); v = DPP_ADD(v, 0x140); return v; }
__device__ __forceinline__ float sum_b345(float v) {
    v = DPP_ADD(v, 0x128);
    { unsigned a = __builtin_bit_cast(unsigned, v), b = a; asm volatile("s_nop 1\n\tv_permlane16_swap_b32 %0, %1" : "+v"(a), "+v"(b)); v = __builtin_bit_cast(float, a) + __builtin_bit_cast(float, b); }
    { unsigned a = __builtin_bit_cast(unsigned, v), b = a; asm volatile("s_nop 1\n\tv_permlane32_swap_b32 %0, %1" : "+v"(a), "+v"(b)); v = __builtin_bit_cast(float, a) + __builtin_bit_cast(float, b); }
    return v;
}
__device__ __forceinline__ float gelu_as(float v) {
    const float av = fabsf(v), t = __builtin_amdgcn_rcpf(av * 0.2316418882f + 1.0f);
    float q = t * 0.5307027145f + (-0.7265760135f); q = q * t + 0.7107068705f; q = q * t + (-0.142248368f); q = q * t + 0.127414796f; q = q * t;
    const float e = __builtin_amdgcn_exp2f((v * v) * (-0.72134752044f)); const float m = v * (q * e);
    return v < 0.f ? m : v - m;
}
typedef _Float16 h2_t __attribute__((ext_vector_type(2)));
__device__ __forceinline__ float dot2h(unsigned a, unsigned b, float acc) { return __builtin_amdgcn_fdot2(__builtin_bit_cast(h2_t, a), __builtin_bit_cast(h2_t, b), acc, false); }
constexpr unsigned H_ONES = 0x3C003C00u;
constexpr unsigned H_K64 = 0x64646464u;
constexpr float CODE_BIAS = 1152.f;

__device__ __forceinline__ void pu_phase(const Frame& F, ArgsP Ap, int l, int nrows, char* lds, const int pvar) {
    unsigned char* ws = Ap->ws;
    const unsigned short* IDX = (const unsigned short*)(ws + WS_IDX); const float* GW = (const float*)(ws + WS_GW);
    unsigned short* W16 = (unsigned short*)(ws + (pvar ? WS_W2 + (size_t)NROWS * 128 * 2 : WS_W2));
    const unsigned short* Bh = (const unsigned short*)(ws + WS_F16B);
    const char* Ut = (const char*)(ws + WS_U + (size_t)l * PEXP * DM);
    const float* USL = (const float*)(ws + WS_USL);
    const int lane = F.lane, grp = lane >> 4, li = lane & 15;
    int* l_slot = (int*)(lds + F.wave * 2048); int* l_idx = l_slot + 128; float* l_g = (float*)(l_idx + 128); float* l_us = l_g + 128;
    const bool xs = (F.G % 8) == 0;
    const int wv = xs ? ((F.bid >> 3) * 8 + F.wave) : F.gw, nwv = xs ? (F.G >> 3) * 8 : F.ngw, npass = xs ? 1 : 8;
    const unsigned long long lt = (1ull << lane) - 1ull;
    const unsigned lo2 = (unsigned)lane * 4u, li16 = (unsigned)li * 16u, li32 = (unsigned)li * 32u;
    for (int pass = 0; pass < npass; ++pass) {
        const int c = xs ? (F.bid & 7) : pass;
        unsigned iw = 0u, iwn = 0u; f32x2v gg = {0.f, 0.f}, ggn = {0.f, 0.f}, uu = {0.f, 0.f}, uun = {0.f, 0.f}; u32x4 xv[8], xn[8];
#define PU_LOAD(IW, GG, UU, X, t_) do { IW = *(const unsigned*)((const char*)(IDX + (size_t)(t_) * 128) + lo2); GG = *(const f32x2v*)((const char*)(GW + (size_t)(t_) * 128) + 2 * lo2); UU = *(const f32x2v*)((const char*)(USL + (size_t)(t_) * 128) + 2 * lo2); \
        const char* xr_ = (const char*)(Bh + (size_t)(t_) * DM); _Pragma("unroll") for (int s = 0; s < 4; ++s) { X[2 * s] = *(const u32x4*)(xr_ + s * 512 + li32); X[2 * s + 1] = *(const u32x4*)(xr_ + s * 512 + li32 + 16u); } } while (0)
        int t = wv;
        if (t < nrows) PU_LOAD(iw, gg, uu, xv, t);
        for (; t < nrows; t += nwv) {
            const int i0 = (int)(iw & 0xffffu), i1 = (int)(iw >> 16); const bool m0 = (i0 >> 11) == c, m1 = (i1 >> 11) == c;
            const unsigned long long b0 = __ballot(m0), b1 = __ballot(m1); const int n = (pvar == 1) ? 0 : (__popcll(b0) + __popcll(b1)); const int r0 = __popcll(b0 & lt) + __popcll(b1 & lt);
            if (m0) { l_slot[r0] = 2 * lane; l_idx[r0] = i0; l_g[r0] = gg.x; l_us[r0] = uu.x; }
            if (m1) { const int r1 = r0 + (m0 ? 1 : 0); l_slot[r1] = 2 * lane + 1; l_idx[r1] = i1; l_g[r1] = gg.y; l_us[r1] = uu.y; }
            if (t + nwv < nrows) PU_LOAD(iwn, ggn, uun, xn, t + nwv);
            float bsum = 0.f;
#pragma unroll
            for (int s = 0; s < 8; ++s) { bsum = dot2h(xv[s].x, H_ONES, bsum); bsum = dot2h(xv[s].y, H_ONES, bsum); bsum = dot2h(xv[s].z, H_ONES, bsum); bsum = dot2h(xv[s].w, H_ONES, bsum); }
            asm volatile("s_waitcnt lgkmcnt(0)" ::: "memory");
            u32x4 qa[4], qb[4], sa[4], sb[4];
#define PU_RLOAD(RA, RB, k0_) do { const int kA_ = ((k0_) + grp < n) ? ((k0_) + grp) : (n - 1), kB_ = ((k0_) + 4 + grp < n) ? ((k0_) + 4 + grp) : (n - 1);       \
                const char* uA_ = Ut + ((unsigned)l_idx[kA_] * 1024u + li16); const char* uB_ = Ut + ((unsigned)l_idx[kB_] * 1024u + li16); \
                _Pragma("unroll") for (int s = 0; s < 4; ++s) RA[s] = *(const u32x4*)(uA_ + s * 256); _Pragma("unroll") for (int s = 0; s < 4; ++s) RB[s] = *(const u32x4*)(uB_ + s * 256); } while (0)
#define PU_W(acc0, acc1, w_, xa_, xb_) do { acc0 = dot2h(__builtin_amdgcn_perm(H_K64, (w_), 0x04010400u), (xa_), acc0); acc1 = dot2h(__builtin_amdgcn_perm(H_K64, (w_), 0x04030402u), (xb_), acc1); } while (0)
#define PU_COMP(RA, RB, k0_) do { const int kA_ = ((k0_) + grp < n) ? ((k0_) + grp) : (n - 1), kB_ = ((k0_) + 4 + grp < n) ? ((k0_) + 4 + grp) : (n - 1); \
                float dA0 = 0.f, dA1 = 0.f, dB0 = 0.f, dB1 = 0.f; \
                _Pragma("unroll") for (int s = 0; s < 4; ++s) { PU_W(dA0, dA1, RA[s].x, xv[2 * s].x, xv[2 * s].y); PU_W(dA0, dA1, RA[s].y, xv[2 * s].z, xv[2 * s].w); PU_W(dA0, dA1, RA[s].z, xv[2 * s + 1].x, xv[2 * s + 1].y); PU_W(dA0, dA1, RA[s].w, xv[2 * s + 1].z, xv[2 * s + 1].w); } \
                _Pragma("unroll") for (int s = 0; s < 4; ++s) { PU_W(dB0, dB1, RB[s].x, xv[2 * s].x, xv[2 * s].y); PU_W(dB0, dB1, RB[s].y, xv[2 * s].z, xv[2 * s].w); PU_W(dB0, dB1, RB[s].z, xv[2 * s + 1].x, xv[2 * s + 1].y); PU_W(dB0, dB1, RB[s].w, xv[2 * s + 1].z, xv[2 * s + 1].w); } \
                const float aA_ = l_us[kA_] * dpp_sum16((dA0 + dA1) - CODE_BIAS * bsum), aB_ = l_us[kB_] * dpp_sum16((dB0 + dB1) - CODE_BIAS * bsum); \
                if (li == 0) { \
                    if ((k0_) + grp < n) { const _Float16 hw = (_Float16)(l_g[kA_] * gelu_as(aA_)); W16[(size_t)t * 128 + l_slot[kA_]] = __builtin_bit_cast(unsigned short, hw); } \
                    if ((k0_) + 4 + grp < n) { const _Float16 hw = (_Float16)(l_g[kB_] * gelu_as(aB_)); W16[(size_t)t * 128 + l_slot[kB_]] = __builtin_bit_cast(unsigned short, hw); } } } while (0)
            PU_RLOAD(qa, qb, 0);
#pragma unroll 1
            for (int k0 = 0; k0 < n; k0 += 16) {
                PU_RLOAD(sa, sb, k0 + 8);
                PU_COMP(qa, qb, k0);
                if (k0 + 8 >= n) break;
                PU_RLOAD(qa, qb, k0 + 16);
                PU_COMP(sa, sb, k0 + 8);
            }
#undef PU_RLOAD
#undef PU_W
#undef PU_COMP
            iw = iwn; gg = ggn; uu = uun;
#pragma unroll
            for (int s = 0; s < 8; ++s) xv[s] = xn[s];
        }
#undef PU_LOAD
    }
}

__device__ __forceinline__ void pv_phase(const Frame& F, ArgsP Ap, int l, int nrows, const bool dry, char* lds) {
    unsigned char* ws = Ap->ws;
    const unsigned short* IDX = (const unsigned short*)(ws + WS_IDX); const unsigned short* W16 = (const unsigned short*)(ws + WS_W2);
    const char* Vt = (const char*)(ws + WS_V + (size_t)l * PEXP * DM);
    const float* MOD = (const float*)(ws + WS_MOD) + (size_t)l * 9 * 6144 + 5 * DM;
    float* hlat = dry ? (float*)(ws + WS_X5) : Ap->out; float* hctx = dry ? (float*)(ws + WS_X5) + (size_t)NLAT * DM : (float*)(ws + WS_HCTX);
    float* g2l = (float*)lds;
    const int lane = F.lane, sub = lane >> 3, dch = lane & 7;
    const bool xs = (F.G % 8) == 0;
    const int wv = xs ? ((F.bid >> 3) * 8 + F.wave) : F.gw, nwv = xs ? (F.G >> 3) * 8 : F.ngw, npass = xs ? 1 : 8;
    for (int pass = 0; pass < npass; ++pass) {
        const int s = xs ? (F.bid & 7) : pass;
        const char* vslice = Vt + (size_t)s * PEXP * 128;
        const unsigned dchb = (unsigned)dch * 16u, coffb = (unsigned)(s * 128 + dch * 16) * 4u, subo = (unsigned)sub * 32u;
        __syncthreads();
        for (int i = F.tid; i < 9 * 128; i += 512) g2l[i] = MOD[(size_t)(i >> 7) * 6144 + s * 128 + (i & 127)];
        __syncthreads();
        u32x4 ia0, ib0, ia1, ib1, rA[8], rB[8], wA, wB; f32x4 h0, h1, h2, h3; float o_[16]; float wsum;
#define PV_IDX(IA, IB, t_) do { const char* ib_ = (const char*)(IDX + (size_t)(t_) * 128); IA = *(const u32x4*)(ib_ + subo); IB = *(const u32x4*)(ib_ + subo + 16u); } while (0)
#define PV_ROWS8(R, I) do { const unsigned iw_[4] = {I.x, I.y, I.z, I.w}; \
            _Pragma("unroll") for (int it = 0; it < 8; ++it) { const unsigned e_ = (it & 1) ? (iw_[it >> 1] >> 16) : (iw_[it >> 1] & 0xffffu); R[it] = *(const u32x4*)(vslice + (e_ * 128u + dchb)); } } while (0)
#define PV_ROWSA(IA, t_) do { PV_ROWS8(rA, IA); wA = *(const u32x4*)((const char*)(W16 + (size_t)(t_) * 128) + subo); } while (0)
#define PV_ROWSB(IB, t_) do { PV_ROWS8(rB, IB); wB = *(const u32x4*)((const char*)(W16 + (size_t)(t_) * 128) + subo + 16u); \
            { const char* hr_ = (const char*)(((t_) < NLAT) ? (hlat + (size_t)(t_) * DM) : (hctx + (size_t)((t_) - NLAT) * DM));     \
              h0 = *(const f32x4*)(hr_ + coffb); h1 = *(const f32x4*)(hr_ + coffb + 16u); h2 = *(const f32x4*)(hr_ + coffb + 32u); h3 = *(const f32x4*)(hr_ + coffb + 48u); } } while (0)
#define PV_C4(A_, B_, wp_, base_) do { \
            o_[(base_) + 0] = dot2h(__builtin_amdgcn_perm((B_), (A_), 0x0C040C00u) | 0x64006400u, (wp_), o_[(base_) + 0]); o_[(base_) + 1] = dot2h(__builtin_amdgcn_perm((B_), (A_), 0x0C050C01u) | 0x64006400u, (wp_), o_[(base_) + 1]); \
            o_[(base_) + 2] = dot2h(__builtin_amdgcn_perm((B_), (A_), 0x0C060C02u) | 0x64006400u, (wp_), o_[(base_) + 2]); o_[(base_) + 3] = dot2h(__builtin_amdgcn_perm((B_), (A_), 0x0C070C03u) | 0x64006400u, (wp_), o_[(base_) + 3]); } while (0)
#define PV_SUM8(R, W) do { const unsigned ww_[4] = {W.x, W.y, W.z, W.w}; \
            _Pragma("unroll") for (int m = 0; m < 4; ++m) { const u32x4 ra_ = R[2 * m], rb_ = R[2 * m + 1]; const unsigned wp_ = ww_[m]; wsum = dot2h(wp_, H_ONES, wsum); \
                PV_C4(ra_.x, rb_.x, wp_, 0); PV_C4(ra_.y, rb_.y, wp_, 4); PV_C4(ra_.z, rb_.z, wp_, 8); PV_C4(ra_.w, rb_.w, wp_, 12); } } while (0)
#define PV_FINA() do { _Pragma("unroll") for (int i = 0; i < 16; ++i) o_[i] = 0.f; wsum = 0.f; PV_SUM8(rA, wA); } while (0)
#define PV_FINB(t_) do { PV_SUM8(rB, wB); \
            const float wsr_ = sum_b345(wsum) * CODE_BIAS; \
            _Pragma("unroll") for (int i = 0; i < 16; ++i) o_[i] = (sum_b345(o_[i]) - wsr_) * (1.f / 1024.f); \
            { const bool lat_ = (t_) < NLAT; float* hr_ = (float*)((char*)(lat_ ? (hlat + (size_t)(t_) * DM) : (hctx + (size_t)((t_) - NLAT) * DM)) + coffb); \
                const f32x4* g2_ = (const f32x4*)(g2l + (lat_ ? ((t_) >> 12) : 8) * 128 + dch * 16); \
                  \
                *(f32x4*)hr_ = h0 + g2_[0] * (f32x4){o_[0], o_[1], o_[2], o_[3]}; *(f32x4*)(hr_ + 4) = h1 + g2_[1] * (f32x4){o_[4], o_[5], o_[6], o_[7]}; \
                *(f32x4*)(hr_ + 8) = h2 + g2_[2] * (f32x4){o_[8], o_[9], o_[10], o_[11]}; *(f32x4*)(hr_ + 12) = h3 + g2_[3] * (f32x4){o_[12], o_[13], o_[14], o_[15]}; } } while (0)
        int t = wv;
        if (t < nrows) { PV_IDX(ia0, ib0, t); PV_ROWSA(ia0, t); }
        for (; t + 2 * nwv < nrows; t += 2 * nwv) {
            PV_IDX(ia1, ib1, t + nwv);     PV_ROWSB(ib0, t);       PV_FINA(); PV_ROWSA(ia1, t + nwv);     PV_FINB(t);
            PV_IDX(ia0, ib0, t + 2 * nwv); PV_ROWSB(ib1, t + nwv); PV_FINA(); PV_ROWSA(ia0, t + 2 * nwv); PV_FINB(t + nwv);
        }
        for (; t < nrows; t += 2 * nwv) {
            const int t1 = t + nwv;
            if (t1 < nrows) PV_IDX(ia1, ib1, t1);
            PV_ROWSB(ib0, t); PV_FINA();
            if (t1 < nrows) PV_ROWSA(ia1, t1);
            PV_FINB(t);
            if (t1 < nrows) { PV_ROWSB(ib1, t1); PV_FINA(); PV_FINB(t1); }
        }
#undef PV_IDX
#undef PV_ROWS8
#undef PV_ROWSA
#undef PV_ROWSB
#undef PV_C4
#undef PV_SUM8
#undef PV_FINA
#undef PV_FINB
    }
}
constexpr int PH_PER_LAYER = 12, N_PHASES = 1 + DEPTH * PH_PER_LAYER;
#ifndef MK_ONE_LAUNCH
#define MK_ONE_LAUNCH 0
#endif
#ifndef MK_MASK
#define MK_MASK 0x1FFF
#endif
#define PON(s) (((MK_MASK) >> (s)) & 1)

#ifndef DBG_NAIVE_GEMM
#define DBG_NAIVE_GEMM 0
#endif
#if DBG_NAIVE_GEMM
__device__ __forceinline__ void naive_gemm(const Frame& F, const pg8::Gemm g, int kind, const pg8::EpiStore es, const pg8::EpiResid er) {
    const int ncg = g.N / 64; const int nunits = g.M * ncg;
    for (int u = F.gw; u < nunits; u += F.ngw) {
        const int row = __builtin_amdgcn_readfirstlane(u / ncg), col = (u % ncg) * 64 + F.lane;
        const bf16* ar = g.A + (size_t)row * g.K; const bf16* br = g.Bt + (size_t)col * g.K; float acc = 0.f;
#pragma unroll 1
        for (int k = 0; k < g.K; k += 8) { const u32x4 a = *(const u32x4*)(ar + k), b = *(const u32x4*)(br + k); float x[8], y[8]; unpack8(a, x); unpack8(b, y);
#pragma unroll
            for (int e = 0; e < 8; ++e) acc = fmaf(x[e], y[e], acc); }
        if (kind == 0) { if (col < es.ncols) es.O[(size_t)row * es.ldc + col] = (bf16)(pk2(acc, 0.f) & 0xffffu); }
        else if (kind == 1) { const int head = col >> 7, j = col & 127; bf16* d = (j < 64) ? (es.O + (size_t)row * 768 + head * 96 + j) : (es.VM + (size_t)row * 512 + head * 64 + (j - 64)); *d = (bf16)(pk2(acc, 0.f) & 0xffffu); }
        else { const bool lat = row < er.nlat; const int sample = lat ? (row >> 12) : 8;
            const float* src = lat ? er.hin_lat + (size_t)row * 1024 : er.hin_ctx + (size_t)(row - er.nlat) * 1024; float* dst = lat ? er.hout_lat + (size_t)row * 1024 : er.hout_ctx + (size_t)(row - er.nlat) * 1024;
            dst[col] = src[col] + er.gate[(size_t)sample * 6144 + col] * acc; }
    }
}
#endif

__global__ void __launch_bounds__(512, 2) mk_fwd(Args args_unused) {
    extern __shared__ __attribute__((aligned(16))) unsigned char lds[];
    LAS unsigned char* lds3 = (LAS unsigned char*)lds;
    ArgsP args0 = (ArgsP)__builtin_amdgcn_kernarg_segment_ptr();
    const int ph_lo = args0->ph_lo, ph_hi = args0->ph_hi;
    const int wave_s = __builtin_amdgcn_readfirstlane((int)threadIdx.x >> 6);
#if MK_ONE_LAUNCH == 2
    {
        volatile LAS unsigned* st = (volatile LAS unsigned*)(lds3 + LDS_BYTES - 64);
        if (threadIdx.x < 2) st[threadIdx.x] = 0u;
        __syncthreads();
        (void)xcd_barrier_post((unsigned*)(args0->ws + WS_CTL), st, threadIdx.x == 0);
    }
#endif
#pragma unroll 1
    for (int pi = ph_lo; pi < ph_hi; ++pi) {
        int zv = 0; asm volatile("" : "+v"(zv));
        ArgsP args = args0; asm volatile("" : "+s"(args));
        Frame F;
        F.zv = zv; F.lane = (int)__builtin_amdgcn_mbcnt_hi(~0u, __builtin_amdgcn_mbcnt_lo(~0u, 0u)) + zv; F.wave = wave_s; F.tid = wave_s * 64 + F.lane;
        { int bx = blockIdx.x, gd = gridDim.x; asm volatile("" : "+s"(bx), "+s"(gd)); F.bid = bx; F.G = gd; F.vcu = (gd % 8 == 0) ? (bx % 8) * (gd / 8) + bx / 8 : bx; }
        F.gw = F.bid * 8 + F.wave; F.ngw = F.G * 8;
        unsigned char* ws = args->ws;
        const int phraw = args->prog[pi], ph = phraw & 63, pvar = phraw >> 6;
        int njobs = 0, jkind = 0;
        pg8::Gemm gj[2]; pg8::EpiStore ej[2];
        int l = 0, mrows = NROWS;
        if (ph == 0) { if (PON(12)) p0_prologue(F, args, lds3); }
        else if (ph == 63) {   }
        else {
            const int q = ph - 1, s = q % PH_PER_LAYER; l = q / PH_PER_LAYER;
            mrows = (l == DEPTH - 1) ? NLAT : NROWS;
            switch (s) {
            case 0: if (PON(0)) norm_mod_phase(F, args, l, 0, NROWS); break;
            case 1: if (PON(1)) { njobs = 1;
                gj[0] = pg8::Gemm{(const bf16*)(ws + WS_AB), (const bf16*)(ws + WS_WIN) + (size_t)l * DINP * DM, NROWS, DINP, DM};
                ej[0] = pg8::EpiStore{0, (bf16*)(ws + WS_P), DIN, DIN, nullptr}; } break;
            case 2: if (PON(2)) e2_phase(F, args, l, NROWS); break;
            case 3: if (PON(3)) { njobs = 2;
                gj[0] = pg8::Gemm{(const bf16*)(ws + WS_AB), (const bf16*)(ws + WS_WUQ) + (size_t)l * 768 * QRANK, NROWS, 768, QRANK};
                ej[0] = pg8::EpiStore{0, (bf16*)(ws + WS_QM), 768, 768, nullptr};
                gj[1] = pg8::Gemm{(const bf16*)(ws + WS_AB) + (size_t)NROWS * QRANK, (const bf16*)(ws + WS_WUKV) + (size_t)l * 1024 * KVRANK, NROWS, 1024, KVRANK};
                ej[1] = pg8::EpiStore{1, (bf16*)(ws + WS_KM), 768, 1024, (bf16*)(ws + WS_VM)}; } break;
            case 4: if (PON(4)) e3_phase(F, args, l, NROWS); break;
            case 5: if (PON(5)) {
#if DBG_NAIVE_ATTN
                attn_naive_phase(F, args, l);
#else
                attn_phase(F, args, l, (char*)lds);
#endif
                } break;
            case 6: if (PON(6)) { njobs = 1; jkind = 1;
                gj[0] = pg8::Gemm{(const bf16*)(ws + WS_AB), (const bf16*)(ws + WS_WOUT) + (size_t)l * DM * DM, mrows, DM, DM}; } break;
            case 7: if (PON(7)) norm_mod_phase(F, args, l, 1, mrows); break;
            case 8: if (PON(8)) { njobs = 1;
                gj[0] = pg8::Gemm{(const bf16*)(ws + WS_AB), (const bf16*)(ws + WS_PWQ) + (size_t)l * 2048 * DM, mrows, 2048, DM};
                ej[0] = pg8::EpiStore{0, (bf16*)(ws + WS_X5), 2048, 2048, nullptr}; } break;
            case 9: if (PON(9)) topkc_phase(F, args, l, mrows, (char*)lds); break;
            case 10: if (PON(10)) pu_phase(F, args, l, mrows, (char*)lds, pvar); break;
            default: if (PON(11)) pv_phase(F, args, l, mrows, pvar != 0, (char*)lds); break;
            }
        }
        if (njobs > 0) {
#if DBG_NAIVE_GEMM
            { const pg8::EpiResid ER{(l == 0) ? args->in[0] : args->out, args->in[2], args->out, (float*)(ws + WS_HCTX), (const float*)(ws + WS_MOD) + (size_t)l * 9 * 6144 + 2 * DM, NLAT};
              _Pragma("unroll 1") for (int j = 0; j < njobs; ++j) { const pg8::Gemm g = (j == 0) ? gj[0] : gj[1]; const pg8::EpiStore E = (j == 0) ? ej[0] : ej[1]; naive_gemm(F, g, jkind ? 2 : E.mode, E, ER); } }
#else
            if (jkind == 0) {
#pragma unroll 1
                for (int j = 0; j < njobs; ++j) { __syncthreads();
                    const pg8::Gemm g = (j == 0) ? gj[0] : gj[1]; const pg8::EpiStore E = (j == 0) ? ej[0] : ej[1];
                    pg8::StaticOrder S; S.init(g.M, g.N, F.G, F.bid);
                    pg8::gemm_phase<pg8::EpiStore, pg8::StaticOrder, true, true>(lds3, g, S, E, F.tid); }
            } else { __syncthreads();
                const pg8::Gemm g = gj[0];
                pg8::StaticOrder S; S.init(g.M, g.N, F.G, F.bid);
                pg8::EpiResid E{(l == 0) ? args->in[0] : args->out, args->in[2], args->out, (float*)(ws + WS_HCTX), (const float*)(ws + WS_MOD) + (size_t)l * 9 * 6144 + 2 * DM, NLAT};
                pg8::gemm_phase<pg8::EpiResid, pg8::StaticOrder, true, true>(lds3, g, S, E, F.tid); }
#endif
        }
#if MK_ONE_LAUNCH == 1
        if (pi + 1 < ph_hi) cg::this_grid().sync();
#elif MK_ONE_LAUNCH == 2
        if (pi + 1 < ph_hi) { XcdBarrier xb; xb.bar = (unsigned*)(ws + WS_CTL); xb.x = xb_xcc_id(); xb.st = (volatile LAS unsigned*)(lds3 + LDS_BYTES - 64); xcd_barrier(xb, F.tid == 0); }
#endif
    }
}

extern "C" void kernel_launch(void* const* d_in, const int* in_sizes, int n_in, void* d_out, int out_size, void* d_ws, size_t ws_size, hipStream_t stream) {
    static int grid = 0;
    if (grid == 0) {
        if (n_in != 23 || in_sizes[0] != NLAT * DM || out_size != NLAT * DM || ws_size < WS_END) {
            fprintf(stderr, "kernel_launch: unexpected shapes: n_in %d in0 %d out %d ws %zu (need %zu)\n", n_in, n_in > 0 ? in_sizes[0] : -1, out_size, ws_size, (size_t)WS_END); grid = -1; return; }
        int dev = 0, cus = 0, per_cu = 0;
        if (hipGetDevice(&dev) != hipSuccess || hipDeviceGetAttribute(&cus, hipDeviceAttributeMultiprocessorCount, dev) != hipSuccess) { fprintf(stderr, "kernel_launch: device query failed\n"); grid = -1; return; }
        if (hipFuncSetAttribute((const void*)mk_fwd, hipFuncAttributeMaxDynamicSharedMemorySize, LDS_BYTES) != hipSuccess) { fprintf(stderr, "kernel_launch: hipFuncSetAttribute failed\n"); grid = -1; return; }
        if (hipOccupancyMaxActiveBlocksPerMultiprocessor(&per_cu, (const void*)mk_fwd, 512, LDS_BYTES) != hipSuccess || per_cu < 1) { fprintf(stderr, "kernel_launch: occupancy query says %d\n", per_cu); per_cu = 1; }
        (void)hipGetLastError();
        grid = cus;
    }
    if (grid < 0) return;
    Args a{};
    for (int i = 0; i < 23; ++i) a.in[i] = (const float*)d_in[i];
    a.out = (float*)d_out; a.ws = (unsigned char*)d_ws;
    int np = 0;
#ifdef MK_PROG
    { static const int pr[] = {MK_PROG}; for (int i = 0; i < (int)(sizeof(pr) / sizeof(pr[0])); ++i) a.prog[np++] = (unsigned char)pr[i]; }
#else
    for (int p = 0; p < N_PHASES; ++p) a.prog[np++] = (unsigned char)p;
#endif
#if MK_ONE_LAUNCH == 2
    a.ph_lo = 0; a.ph_hi = np;
    if (hipMemsetAsync((char*)d_ws + WS_CTL, 0, CTL_ZERO_BYTES, stream) != hipSuccess) { fprintf(stderr, "kernel_launch: hipMemsetAsync of the barrier words failed\n"); return; }
    hipLaunchKernelGGL(mk_fwd, dim3(grid), dim3(512), LDS_BYTES, stream, a);
    { const hipError_t le = hipPeekAtLastError(); if (le != hipSuccess) fprintf(stderr, "kernel_launch: launch failed: %s\n", hipGetErrorName(le)); }
#elif MK_ONE_LAUNCH == 1
    a.ph_lo = 0; a.ph_hi = np;
    void* kargs[] = {&a};
    hipError_t e = hipLaunchCooperativeKernel((const void*)mk_fwd, dim3(grid), dim3(512), kargs, LDS_BYTES, stream);
    if (e != hipSuccess) fprintf(stderr, "kernel_launch: cooperative launch failed: %s (grid %d)\n", hipGetErrorString(e), grid);
#else
    for (int p = 0; p < np; ++p) {
        a.ph_lo = p; a.ph_hi = p + 1;
        hipLaunchKernelGGL(mk_fwd, dim3(grid), dim3(512), LDS_BYTES, stream, a);
    }
    const hipError_t le = hipPeekAtLastError();
    if (le != hipSuccess) fprintf(stderr, "kernel_launch: launch failed: %s\n", hipGetErrorName(le));
#endif
}
```

```cpp
#define MK_ONE_LAUNCH 2
#define DBG_PRECISE_TOPK 0
#define DBG_NAIVE_ATTN 0
#define DBG_PRECISE_PEER 0
#define DBG_NAIVE_GEMM 0
#define DBG_ASCALE 1.0f
#define DBG_PSCALE 1.0f
#include <hip/hip_runtime.h>
#include <hip/hip_cooperative_groups.h>
#include <cstdio>
#include <cstdint>
#include <cmath>
namespace cg = cooperative_groups;
namespace pg8 {
#define PG8_LAS __attribute__((address_space(3)))
typedef unsigned short bf16_t;
typedef short bf16x8 __attribute__((ext_vector_type(8)));
typedef float f32x4 __attribute__((ext_vector_type(4)));
typedef unsigned u32x4 __attribute__((ext_vector_type(4)));
constexpr int BM = 256, BK = 64, HALF = 128, HTB = HALF * BK * 2  , STAGE_BYTES = 8 * HTB, NXCD = 8, WGM = 8;

__host__ __device__ __forceinline__ int lds_byte(int r, int c) { const int st = (r >> 4) * 2 + (c >> 5), rr = r & 15, cc = c & 31, ob = rr * 64 + cc * 2; return st * 1024 + (ob ^ (((ob >> 9) & 1) << 5)); }
__host__ __device__ __forceinline__ void stage_rc(int b, int& R, int& C) { const int st = b / 1024, sb = b % 1024, swz = sb ^ (((sb >> 9) & 1) << 5); R = (st >> 1) * 16 + swz / 64; C = (st & 1) * 32 + (swz % 64) / 2; }
__host__ __device__ __forceinline__ int perm32(int rho) { const int n = rho >> 4, i = rho & 15; return 8 * (i >> 2) + 4 * n + (i & 3); }

struct Unit { int pm, pn; };
struct Gemm { const bf16_t* A; const bf16_t* Bt; int M, N, K; };

struct StaticOrder {
    int nM, nN, nwg, G, c;
    __host__ __device__ void init(int M, int N, int G_, int c_) { nM = M / BM; nN = N / BM; nwg = nM * nN; G = G_; c = c_; }
    __host__ __device__ bool next(int i, Unit& u) const {
        const long L = (long)i * G + c; if (L >= nwg) return false;
        int wgid = (int)L; { const int q = nwg / NXCD, r = nwg % NXCD, xcd = wgid % NXCD, off = wgid / NXCD; wgid = (xcd < r ? xcd * (q + 1) : r * (q + 1) + (xcd - r) * q) + off; }
        const int nig = WGM * nN, gid = wgid / nig, fm = gid * WGM, gsz = (nM - fm) < WGM ? (nM - fm) : WGM;
        u.pm = fm + ((wgid % nig) % gsz); u.pn = (wgid % nig) / gsz; return true;
    }
    __device__ __forceinline__ void a_ready(const Unit&) const {}
    __device__ __forceinline__ void done(const Unit&) const {}
};

typedef float cvt_f32x2 __attribute__((ext_vector_type(2))); typedef __bf16 cvt_bf16x2 __attribute__((ext_vector_type(2)));
__device__ __forceinline__ unsigned cvt_pk_bf16(float lo, float hi) { const cvt_f32x2 v = {lo, hi}; const cvt_bf16x2 b = __builtin_convertvector(v, cvt_bf16x2); return __builtin_bit_cast(unsigned, b); }
typedef float f32x2 __attribute__((ext_vector_type(2)));
typedef unsigned u32x2 __attribute__((ext_vector_type(2)));
#ifndef DBG_ASCALE
#define DBG_ASCALE 1.0f
#endif
#ifndef DBG_PSCALE
#define DBG_PSCALE 1.0f
#endif
struct EpiStore {
    static constexpr bool PERM = true, AFTER_DRAIN = false;
    int mode; bf16_t* O; int ldc; int ncols; bf16_t* VM;
    __device__ __forceinline__ void operator()(const f32x4 (&acc)[2][2][4][2], const Unit& u, int wr, int wc, int fr, int fq) const {
        const int row0 = u.pm * BM + wr * 64 + fr;
        bf16_t* base; int rstride, hstride; bool on0, on1;
        if (mode == 0) { const int col0 = u.pn * BM + wc * 32 + 8 * fq; base = O + (size_t)row0 * ldc + col0; rstride = ldc; hstride = HALF; on0 = col0 < ncols; on1 = col0 + HALF < ncols; }
        else {
            const int j = wc * 32 + 8 * fq; const bool isk = wc < 2;
            base = isk ? (O + (size_t)row0 * 768 + (2 * u.pn) * 96 + j) : (VM + (size_t)row0 * 512 + (2 * u.pn) * 64 + (j - 64));
            rstride = isk ? 768 : 512; hstride = isk ? 96 : 64; on0 = true; on1 = true; }
#pragma unroll
        for (int ai = 0; ai < 2; ++ai)
#pragma unroll
            for (int m = 0; m < 4; ++m) { bf16_t* rowp = base + (size_t)(ai * HALF + m * 16) * rstride;
#pragma unroll
                for (int bj = 0; bj < 2; ++bj) {
                    if (bj == 0 ? on0 : on1) { const f32x4 v0 = acc[ai][bj][m][0], v1 = acc[ai][bj][m][1]; u32x4 w;
                        w.x = cvt_pk_bf16(v0[0], v0[1]); w.y = cvt_pk_bf16(v0[2], v0[3]); w.z = cvt_pk_bf16(v1[0], v1[1]); w.w = cvt_pk_bf16(v1[2], v1[3]);
                        *(u32x4*)(rowp + bj * hstride) = w; } } }
    }
};
struct EpiResid {
    static constexpr bool PERM = false, AFTER_DRAIN = false;
    const float* hin_lat; const float* hin_ctx; float* hout_lat; float* hout_ctx; const float* gate; int nlat;
    __device__ __forceinline__ void operator()(const f32x4 (&acc)[2][2][4][2], const Unit& u, int wr, int wc, int fr, int fq) const {
        const int rowt = u.pm * BM; const bool lat = rowt < nlat; const int sample = lat ? (rowt >> 12) : 8;
        const float* src = lat ? hin_lat + (size_t)rowt * 1024 : hin_ctx + (size_t)(rowt - nlat) * 1024;
        float* dst = lat ? hout_lat + (size_t)rowt * 1024 : hout_ctx + (size_t)(rowt - nlat) * 1024;
        const float* g = gate + (size_t)sample * 6144;
        const int col0 = u.pn * BM + wc * 32 + 4 * fq;
#pragma unroll
        for (int bj = 0; bj < 2; ++bj)
#pragma unroll
            for (int n = 0; n < 2; ++n) { const int c = col0 + bj * HALF + n * 16; const f32x4 gv = *(const f32x4*)(g + c);
#pragma unroll
                for (int ai = 0; ai < 2; ++ai)
#pragma unroll
                    for (int m = 0; m < 4; ++m) { const size_t off = (size_t)(ai * HALF + wr * 64 + m * 16 + fr) * 1024 + c;
                        const f32x4 hv = *(const f32x4*)(src + off); *(f32x4*)(dst + off) = hv + gv * acc[ai][bj][m][n] * (float)(DBG_ASCALE); } }
    }
};
template <class Epi, class Sched, bool ALIGN_EPI = false, bool SP2 = false>
__device__ __forceinline__ void gemm_phase(PG8_LAS unsigned char* lds, const Gemm g, const Sched& S, const Epi& E, const int tid_in) {
    const int tid = tid_in, wid = __builtin_amdgcn_readfirstlane(tid >> 6), lane = tid & 63, wr = wid >> 2, wc = wid & 3, fr = lane & 15, fq = lane >> 4;
    const int K = g.K, nt = K / BK;
    unsigned voffA[2], voffB[2];
#pragma unroll
    for (int i = 0; i < 2; ++i) { int R, C; stage_rc(tid * 16 + i * 8192, R, C); const int Rb = Epi::PERM ? ((R & ~31) + perm32(R & 31)) : R;
        voffA[i] = (unsigned)(R * K + C) * 2u; voffB[i] = (unsigned)(Rb * K + C) * 2u; }
    const size_t kstep = (size_t)(BK * 2);
    const size_t hstep = (size_t)HALF * K * 2;
    const size_t tstep = 2 * hstep;
    const unsigned ldsw = (unsigned)wid * 1024u;
    const int aoff = lds_byte(wr * 64 + fr, fq * 8), boff = lds_byte(wc * 32 + fr, fq * 8);
#define PG8_SA(b, h) (((b) * 2 + (h)) * HTB)
#define PG8_SB(b, h) ((4 + (b) * 2 + (h)) * HTB)
#define PG8_STAGE(bufoff, gbase, voff) do { _Pragma("unroll") for (int _i = 0; _i < 2; ++_i) \
        __builtin_amdgcn_global_load_lds((const unsigned*)((const char*)(gbase) + (voff)[_i]), (PG8_LAS unsigned*)(lds + (bufoff) + ldsw + _i * 8192), 16, 0, 0); } while (0)
#define PG8_LDA(dst, b, h) do { _Pragma("unroll") for (int m = 0; m < 4; ++m) _Pragma("unroll") for (int k = 0; k < 2; ++k) dst[m][k] = *(const PG8_LAS bf16x8*)(lds + PG8_SA(b, h) + aoff + m * 2048 + k * 1024); } while (0)
#define PG8_LDB(dst, b, h) do { _Pragma("unroll") for (int n = 0; n < 2; ++n) _Pragma("unroll") for (int k = 0; k < 2; ++k) dst[n][k] = *(const PG8_LAS bf16x8*)(lds + PG8_SB(b, h) + boff + n * 2048 + k * 1024); } while (0)
#define PG8_MMA(ai, bj, At, Bt) do { __builtin_amdgcn_s_setprio(1); _Pragma("unroll") for (int m = 0; m < 4; ++m) _Pragma("unroll") for (int n = 0; n < 2; ++n) _Pragma("unroll") for (int k = 0; k < 2; ++k) \
        acc[ai][bj][m][n] = __builtin_amdgcn_mfma_f32_16x16x32_bf16(Bt[n][k], At[m][k], acc[ai][bj][m][n], 0, 0, 0); __builtin_amdgcn_s_setprio(0); } while (0)
#define PG8_WAIT_V(n) asm volatile("s_waitcnt vmcnt(" #n ")" ::: "memory")
#define PG8_WAIT_L(n) asm volatile("s_waitcnt lgkmcnt(" #n ")" ::: "memory")
#define PG8_BAR __builtin_amdgcn_s_barrier()
#define PG8_SCHED __builtin_amdgcn_sched_barrier(0)
    Unit cur, nxt; int ui = 0;
    if (!S.next(0, cur)) return;
    f32x4 acc[2][2][4][2];
#pragma unroll
    for (int a = 0; a < 2; ++a)
#pragma unroll
        for (int b = 0; b < 2; ++b)
#pragma unroll
            for (int m = 0; m < 4; ++m)
#pragma unroll
                for (int n = 0; n < 2; ++n) acc[a][b][m][n] = (f32x4){0.f, 0.f, 0.f, 0.f};
    bf16x8 At[4][2], B0[2][2], B1[2][2];
    const char* cA = (const char*)g.A + (size_t)cur.pm * tstep; const char* cB = (const char*)g.Bt + (size_t)cur.pn * tstep;
    S.a_ready(cur);
    if constexpr (SP2) {
        PG8_STAGE(PG8_SB(0, 0), cB, voffB); PG8_STAGE(PG8_SB(0, 1), cB + hstep, voffB); PG8_STAGE(PG8_SA(0, 0), cA, voffA); PG8_STAGE(PG8_SA(0, 1), cA + hstep, voffA);
        if (wr == 1) PG8_BAR;
        PG8_WAIT_V(2); PG8_BAR;
        PG8_STAGE(PG8_SB(1, 0), cB + kstep, voffB); PG8_STAGE(PG8_SA(1, 0), cA + kstep, voffA); PG8_STAGE(PG8_SB(1, 1), cB + hstep + kstep, voffB);
        PG8_WAIT_V(6); PG8_BAR;
    } else {
        PG8_STAGE(PG8_SB(0, 0), cB, voffB); PG8_STAGE(PG8_SA(0, 0), cA, voffA); PG8_STAGE(PG8_SB(0, 1), cB + hstep, voffB); PG8_STAGE(PG8_SA(0, 1), cA + hstep, voffA);
        if (wr == 1) PG8_BAR;
        PG8_WAIT_V(4); PG8_BAR;
        PG8_STAGE(PG8_SB(1, 0), cB + kstep, voffB); PG8_STAGE(PG8_SA(1, 0), cA + kstep, voffA); PG8_STAGE(PG8_SB(1, 1), cB + hstep + kstep, voffB);
        PG8_WAIT_V(6); PG8_BAR;
    }
    for (;;) {
        const bool has_next = S.next(ui + 1, nxt);
        const char* nA = has_next ? (const char*)g.A + (size_t)nxt.pm * tstep : cA; const char* nB = has_next ? (const char*)g.Bt + (size_t)nxt.pn * tstep : cB;
        _Pragma("unroll 1") for (int t = 0; t < nt; t += 2) {
            const bool last = (t == nt - 2);
            const char* a1 = cA + (size_t)(t + 1) * kstep;
            const char* a2 = last ? nA : cA + (size_t)(t + 2) * kstep; const char* b2 = last ? nB : cB + (size_t)(t + 2) * kstep;
            const char* a3 = a2 + kstep; const char* b3 = b2 + kstep;
            if (last && has_next) S.a_ready(nxt);
            if constexpr (SP2) {
            PG8_LDB(B0, 0, 0); PG8_LDB(B1, 0, 1); PG8_SCHED; PG8_LDA(At, 0, 0); PG8_STAGE(PG8_SA(1, 1), a1 + hstep, voffA);
            PG8_WAIT_V(8); PG8_WAIT_L(0); PG8_BAR; PG8_MMA(0, 0, At, B0); PG8_MMA(0, 1, At, B1); PG8_BAR; PG8_SCHED;
            PG8_LDA(At, 0, 1); PG8_STAGE(PG8_SB(0, 0), b2, voffB); PG8_STAGE(PG8_SB(0, 1), b2 + hstep, voffB); PG8_STAGE(PG8_SA(0, 0), a2, voffA);
            PG8_WAIT_V(8); PG8_WAIT_L(0); PG8_BAR; PG8_MMA(1, 0, At, B0); PG8_MMA(1, 1, At, B1); PG8_BAR; PG8_SCHED;
            PG8_LDB(B0, 1, 0); PG8_LDB(B1, 1, 1); PG8_SCHED; PG8_LDA(At, 1, 0); PG8_STAGE(PG8_SA(0, 1), a2 + hstep, voffA);
            PG8_WAIT_V(8); PG8_WAIT_L(0); PG8_BAR; PG8_MMA(0, 0, At, B0); PG8_MMA(0, 1, At, B1); PG8_BAR; PG8_SCHED;
            PG8_LDA(At, 1, 1); PG8_STAGE(PG8_SB(1, 0), b3, voffB); PG8_STAGE(PG8_SB(1, 1), b3 + hstep, voffB); PG8_STAGE(PG8_SA(1, 0), a3, voffA);
            PG8_WAIT_V(8); PG8_WAIT_L(0); PG8_BAR; PG8_MMA(1, 0, At, B0); PG8_MMA(1, 1, At, B1); PG8_BAR; PG8_SCHED;
            } else {
            PG8_LDB(B0, 0, 0); PG8_SCHED; PG8_LDA(At, 0, 0); PG8_STAGE(PG8_SA(1, 1), a1 + hstep, voffA);
            PG8_WAIT_L(8); PG8_BAR; PG8_WAIT_L(0); PG8_MMA(0, 0, At, B0); PG8_BAR; PG8_SCHED;
            PG8_LDB(B1, 0, 1); PG8_STAGE(PG8_SB(0, 0), b2, voffB);
            PG8_BAR; PG8_WAIT_L(0); PG8_MMA(0, 1, At, B1); PG8_BAR;
            PG8_LDA(At, 0, 1); PG8_STAGE(PG8_SA(0, 0), a2, voffA);
            PG8_BAR; PG8_WAIT_L(0); PG8_MMA(1, 0, At, B0); PG8_BAR; PG8_SCHED;
            PG8_STAGE(PG8_SB(0, 1), b2 + hstep, voffB);
            PG8_WAIT_V(6); PG8_BAR; PG8_MMA(1, 1, At, B1); PG8_BAR;
            PG8_LDB(B0, 1, 0); PG8_SCHED; PG8_LDA(At, 1, 0); PG8_STAGE(PG8_SA(0, 1), a2 + hstep, voffA);
            PG8_WAIT_L(8); PG8_BAR; PG8_WAIT_L(0); PG8_MMA(0, 0, At, B0); PG8_BAR; PG8_SCHED;
            PG8_LDB(B1, 1, 1); PG8_STAGE(PG8_SB(1, 0), b3, voffB);
            PG8_BAR; PG8_WAIT_L(0); PG8_MMA(0, 1, At, B1); PG8_BAR;
            PG8_LDA(At, 1, 1); PG8_STAGE(PG8_SA(1, 0), a3, voffA);
            PG8_BAR; PG8_WAIT_L(0); PG8_MMA(1, 0, At, B0); PG8_BAR; PG8_SCHED;
            PG8_STAGE(PG8_SB(1, 1), b3 + hstep, voffB);
            PG8_WAIT_V(6); PG8_BAR; PG8_MMA(1, 1, At, B1); PG8_BAR;
            }
        }
        if constexpr (ALIGN_EPI) { if (wr == 0) PG8_BAR; }
        if constexpr (!Epi::AFTER_DRAIN) { E(acc, cur, wr, wc, fr, fq); S.done(cur); }
        if (!has_next) break;
#pragma unroll
        for (int a = 0; a < 2; ++a)
#pragma unroll
            for (int b = 0; b < 2; ++b)
#pragma unroll
                for (int m = 0; m < 4; ++m)
#pragma unroll
                    for (int n = 0; n < 2; ++n) acc[a][b][m][n] = (f32x4){0.f, 0.f, 0.f, 0.f};
        cur = nxt; cA = nA; cB = nB; ++ui;
        if constexpr (ALIGN_EPI) { if (wr == 1) PG8_BAR; }
    }
    PG8_WAIT_V(0);
    if constexpr (!ALIGN_EPI) { if (wr == 0) PG8_BAR; }
    PG8_BAR;
    if constexpr (Epi::AFTER_DRAIN) { E.fused(acc, cur, wr, wc, fr, fq, lds, wid, lane); S.done(cur); }
#undef PG8_SA
#undef PG8_SB
#undef PG8_STAGE
#undef PG8_LDA
#undef PG8_LDB
#undef PG8_MMA
#undef PG8_WAIT_V
#undef PG8_WAIT_L
#undef PG8_BAR
#undef PG8_SCHED
}
}
constexpr int DM = 1024, NB = 8, SEQ = 4096, CTXL = 256, DEPTH = 2;
constexpr int NLAT = NB * SEQ, NCTX = NB * CTXL, NROWS = NLAT + NCTX;
constexpr int DIN = 1440, DINP = 1536, QRANK = 384, KVRANK = 256;
constexpr int PH = 8, PNK = 128, PDH = 128, PTOPK = 16, PEXP = PNK * PNK;
constexpr float EPS = 1e-6f;
constexpr float LOG2E = 1.4426950408889634f;
constexpr float C_MLA = 0.10206207261596577f * LOG2E;
constexpr float C_SWA = 0.125f * LOG2E;

typedef unsigned short bf16;
typedef short bf16x8 __attribute__((ext_vector_type(8)));
typedef short s16x4 __attribute__((ext_vector_type(4)));
typedef float f32x4 __attribute__((ext_vector_type(4)));
typedef float f32x16 __attribute__((ext_vector_type(16)));
typedef unsigned u32x4 __attribute__((ext_vector_type(4)));
typedef unsigned u32x2v __attribute__((ext_vector_type(2)));
#define LAS __attribute__((address_space(3)))

constexpr size_t MiB = 1u << 20;
constexpr size_t WS_CTL = 0, CTL_ZERO_BYTES = 64 * 1024;
constexpr size_t WS_MOD = 1 * MiB;
constexpr size_t WS_RTS = WS_MOD + 512 * 1024;
constexpr size_t WS_RTM = WS_RTS + 64 * 16 * 2 * 4;
constexpr size_t WS_WIN = 2 * MiB;
constexpr size_t WS_WUQ = WS_WIN + 2ull * DINP * DM * 2;
constexpr size_t WS_WUKV = WS_WUQ + 2ull * 768 * QRANK * 2;
constexpr size_t WS_WOUT = WS_WUKV + 2ull * 1024 * KVRANK * 2;
constexpr size_t WS_PWQ = WS_WOUT + 2ull * 1024 * 1024 * 2;
constexpr size_t WS_PKEY = WS_PWQ + 2ull * 2048 * 1024 * 2;
constexpr size_t WS_HCTX = WS_PKEY + 2ull * 8 * 2 * 128 * 128 * 2;
constexpr size_t WS_US = WS_HCTX + (size_t)NCTX * 1024 * 4;
constexpr size_t WS_VS = WS_US + 2ull * PEXP * 4;
constexpr size_t WS_SB = WS_VS + 2ull * PEXP * 4;
constexpr size_t WS_U = 32 * MiB;
constexpr size_t WS_V = WS_U + 32 * MiB;
constexpr size_t WS_F16B = WS_V + 32 * MiB;
constexpr size_t WS_AB = WS_F16B + (size_t)NROWS * 1024 * 2;
constexpr size_t WS_P = WS_AB + (size_t)NROWS * 1024 * 2;
constexpr size_t WS_X5 = WS_P + (size_t)NROWS * DIN * 2;
constexpr size_t WS_QM = WS_X5, WS_KM = WS_QM + (size_t)NROWS * 768 * 2, WS_VM = WS_KM + (size_t)NROWS * 768 * 2, WS_QS = WS_VM + (size_t)NROWS * 512 * 2,
                 WS_KS = WS_QS + (size_t)NROWS * 512 * 2, WS_END = WS_KS + (size_t)NROWS * 128 * 2;
static_assert(WS_SB + (size_t)NROWS * 4 <= WS_U, "ws map (weights)");
static_assert(WS_END <= 512 * MiB, "ws map");
static_assert((size_t)NROWS * 2048 * 2 <= WS_END - WS_X5, "QP overlay");
static_assert((size_t)NROWS * 1024 <= (size_t)NROWS * DIN * 2, "TK overlay");

constexpr int LDS_BYTES = 163840;

__constant__ float ROPE_INV[24] = {1.0f, 0.5623413324356079f, 0.3162277638912201f, 0.17782793939113617f, 0.10000000149011612f, 0.05623413249850273f, 0.03162277489900589f, 0.017782794311642647f, 0.009999999776482582f, 0.005623413249850273f, 0.003162277629598975f, 0.0017782794311642647f, 0.0010000000474974513f, 0.000562341301701963f, 0.0003162277571391314f, 0.00017782794020604342f, 1.0f, 0.3162277638912201f, 0.10000000149011612f, 0.03162277489900589f, 0.009999999776482582f, 0.003162277629598975f, 0.0010000000474974513f, 0.0003162277571391314f};
struct Args {
    const float* in[23]; float* out; unsigned char* ws; int ph_lo, ph_hi; unsigned char prog[48];
};
typedef const __attribute__((address_space(4))) Args* ArgsP;

struct Frame {
    int tid, lane, wave, G, bid, vcu, gw, ngw, zv;
};

__device__ __forceinline__ float bf_lo(unsigned w) { return __uint_as_float(w << 16); }
__device__ __forceinline__ float bf_hi(unsigned w) { return __uint_as_float(w & 0xffff0000u); }
__device__ __forceinline__ unsigned pk2(float lo, float hi) { return pg8::cvt_pk_bf16(lo, hi); }
__device__ __forceinline__ float wave_sum(float v) {
#pragma unroll
    for (int o = 1; o < 64; o <<= 1) v += __shfl_xor(v, o);
    return v;
}
__device__ __forceinline__ void unpack8(const u32x4 w, float (&x)[8]) {
    x[0] = bf_lo(w.x); x[1] = bf_hi(w.x); x[2] = bf_lo(w.y); x[3] = bf_hi(w.y); x[4] = bf_lo(w.z); x[5] = bf_hi(w.z); x[6] = bf_lo(w.w); x[7] = bf_hi(w.w);
}
__device__ __forceinline__ u32x4 pack8(const float (&x)[8]) {
    u32x4 w; w.x = pk2(x[0], x[1]); w.y = pk2(x[2], x[3]); w.z = pk2(x[4], x[5]); w.w = pk2(x[6], x[7]); return w;
}

__device__ __forceinline__ void p0_transpose_item(const float* W, int K, int N, bf16* WT, LAS float* scr, int item, int lane) {
    const int nblk = N / 32, kb = item / nblk, nb = item % nblk, k0 = 64 * kb, n0 = 32 * nb;
#pragma unroll 8
    for (int i = 0; i < 32; ++i) { const int kk = 2 * i + (lane >> 5); scr[kk * 33 + (lane & 31)] = W[(size_t)(k0 + kk) * N + n0 + (lane & 31)]; }
    asm volatile("s_waitcnt lgkmcnt(0)" ::: "memory");
    const int c = lane & 7;
#pragma unroll
    for (int j = 0; j < 4; ++j) { const int n = (lane >> 3) + 8 * j; const LAS float* s = scr + (8 * c) * 33 + n;
        u32x4 o; o.x = pk2(s[0 * 33], s[1 * 33]); o.y = pk2(s[2 * 33], s[3 * 33]); o.z = pk2(s[4 * 33], s[5 * 33]); o.w = pk2(s[6 * 33], s[7 * 33]);
        *(u32x4*)(WT + (size_t)(n0 + n) * K + k0 + 8 * c) = o; }
    asm volatile("s_waitcnt lgkmcnt(0)" ::: "memory");
}

__device__ __forceinline__ void p0_prologue(const Frame& F, ArgsP Ap, LAS unsigned char* lds) {
    unsigned char* ws = Ap->ws;
    const float* c_in = Ap->in[1]; const float* cctx_in = Ap->in[3]; const float* ada_w = Ap->in[4]; const float* ada_b = Ap->in[5];
    for (int task = F.bid; task < 48; task += F.G) {
        const int l = task / 24, cc = task % 24;
        LAS float* sl = (LAS float*)lds;
        LAS float* red = (LAS float*)(lds + 9 * 1024 * 4);
        __syncthreads();
        for (int i = F.tid; i < 9 * 1024; i += 512) { const int s = i >> 10, k = i & 1023; const float x = (s < 8) ? c_in[s * 1024 + k] : cctx_in[k]; sl[i] = x / (1.f + __expf(-x)); }
        __syncthreads();
        const int c0 = cc * 256 + F.lane * 4; const int kbase = F.wave * 128;
        f32x4 acc[9];
#pragma unroll
        for (int s = 0; s < 9; ++s) acc[s] = (f32x4){0.f, 0.f, 0.f, 0.f};
        const float* wp = ada_w + ((size_t)l * 1024 + kbase) * 6144 + c0;
#pragma unroll 4
        for (int kk = 0; kk < 128; ++kk) { const f32x4 w = *(const f32x4*)(wp + (size_t)kk * 6144);
#pragma unroll
            for (int s = 0; s < 9; ++s) acc[s] += w * sl[s * 1024 + kbase + kk]; }
#pragma unroll
        for (int s = 0; s < 9; ++s) *(LAS f32x4*)(red + (F.wave * 9 + s) * 256 + F.lane * 4) = acc[s];
        __syncthreads();
        float* MOD = (float*)(ws + WS_MOD);
        for (int i = F.tid; i < 9 * 256; i += 512) { const int s = i >> 8, ci = i & 255; float v = ada_b[l * 6144 + cc * 256 + ci];
#pragma unroll
            for (int w = 0; w < 8; ++w) v += red[(w * 9 + s) * 256 + ci];
            MOD[((size_t)l * 9 + s) * 6144 + cc * 256 + ci] = v; }
        __syncthreads();
    }
    __syncthreads();
    if (F.bid == F.G - 1) {
        float* rts = (float*)(ws + WS_RTS); float* rtm = (float*)(ws + WS_RTM);
        for (int i = F.tid; i < 64 * 24; i += 512) {
            const int pos = i / 24, k = i % 24; const float a = (float)pos * ROPE_INV[k];
            const float rev = a * 0.15915494309189535f;
            const float cs = __builtin_amdgcn_cosf(rev), sn = __builtin_amdgcn_sinf(rev);
            if (k < 16) { rts[(pos * 16 + k) * 2] = cs; rts[(pos * 16 + k) * 2 + 1] = sn; } else { rtm[(pos * 8 + (k - 16)) * 2] = cs; rtm[(pos * 8 + (k - 16)) * 2 + 1] = sn; }
        }
    }
    LAS float* scr = (LAS float*)(lds + F.wave * 16384);
    constexpr int I_WIN = (DM / 64) * (DIN / 32), I_WUQ = (QRANK / 64) * (768 / 32), I_WUKV = (KVRANK / 64) * (1024 / 32), I_WOUT = (DM / 64) * (DM / 32), I_PWQ = (DM / 64) * (2048 / 32);
    constexpr int I_L = I_WIN + I_WUQ + I_WUKV + I_WOUT + I_PWQ;
    for (int it = F.gw; it < 2 * I_L; it += F.ngw) {
        const int l = it / I_L; int r = it % I_L;
        if (r < I_WIN) { p0_transpose_item(Ap->in[8] + (size_t)l * DM * DIN, DM, DIN, (bf16*)(ws + WS_WIN) + (size_t)l * DINP * DM, scr, r, F.lane); continue; } r -= I_WIN;
        if (r < I_WUQ) { p0_transpose_item(Ap->in[10] + (size_t)l * QRANK * 768, QRANK, 768, (bf16*)(ws + WS_WUQ) + (size_t)l * 768 * QRANK, scr, r, F.lane); continue; } r -= I_WUQ;
        if (r < I_WUKV) { p0_transpose_item(Ap->in[12] + (size_t)l * KVRANK * 1024, KVRANK, 1024, (bf16*)(ws + WS_WUKV) + (size_t)l * 1024 * KVRANK, scr, r, F.lane); continue; } r -= I_WUKV;
        if (r < I_WOUT) { p0_transpose_item(Ap->in[18] + (size_t)l * DM * DM, DM, DM, (bf16*)(ws + WS_WOUT) + (size_t)l * DM * DM, scr, r, F.lane); continue; } r -= I_WOUT;
        p0_transpose_item(Ap->in[19] + (size_t)l * DM * 2048, DM, 2048, (bf16*)(ws + WS_PWQ) + (size_t)l * 2048 * DM, scr, r, F.lane);
    }
    { const size_t gt = (size_t)F.bid * 512 + F.tid, nt = (size_t)F.G * 512;
      for (size_t i = gt; i < 2ull * 96 * DM / 8; i += nt) { const size_t l = i / (96 * DM / 8), e = i % (96 * DM / 8);
          *(u32x4*)((bf16*)(ws + WS_WIN) + l * DINP * DM + (size_t)DIN * DM + e * 8) = (u32x4){(unsigned)F.zv, (unsigned)F.zv, (unsigned)F.zv, (unsigned)F.zv}; }
      const size_t NKEY8 = 2ull * 8 * 2 * 128 * 128 / 8;
      for (size_t i = gt; i < NKEY8; i += nt) {
          const float* src = Ap->in[20]; bf16* dst = (bf16*)(ws + WS_PKEY);
          const f32x4 a = *(const f32x4*)(src + i * 8), b = *(const f32x4*)(src + i * 8 + 4);
          u32x4 o; o.x = pk2(a[0], a[1]); o.y = pk2(a[2], a[3]); o.z = pk2(b[0], b[1]); o.w = pk2(b[2], b[3]);
          *(u32x4*)(dst + i * 8) = o; }
    }
    for (int rr = F.gw; rr < 2 * 2 * PEXP; rr += F.ngw) {
        const int tab = rr / (2 * PEXP), lay = (rr / PEXP) & 1, e = rr % PEXP;
        const float* src = Ap->in[21 + tab] + ((size_t)lay * PEXP + e) * DM + 16 * F.lane;
        f32x4 x[4]; float mx = 0.f;
#pragma unroll
        for (int j = 0; j < 4; ++j) { x[j] = *(const f32x4*)(src + 4 * j); mx = fmaxf(fmaxf(fmaxf(mx, fabsf(x[j][0])), fmaxf(fabsf(x[j][1]), fabsf(x[j][2]))), fabsf(x[j][3])); }
#pragma unroll
        for (int o = 1; o < 64; o <<= 1) mx = fmaxf(mx, __shfl_xor(mx, o));
        const float inv = (mx > 0.f) ? 127.f / mx : 0.f;
        unsigned w[4]; const int bias = 128;
#pragma unroll
        for (int j = 0; j < 4; ++j) { const unsigned c0 = (unsigned)(bias + (int)rintf(x[j][0] * inv)) & 0xffu, c1 = (unsigned)(bias + (int)rintf(x[j][1] * inv)) & 0xffu, c2 = (unsigned)(bias + (int)rintf(x[j][2] * inv)) & 0xffu, c3 = (unsigned)(bias + (int)rintf(x[j][3] * inv)) & 0xffu;
            w[j] = c0 | (c1 << 8) | (c2 << 16) | (c3 << 24); }
        unsigned char* dst = tab ? (ws + WS_V + (size_t)lay * PEXP * DM + ((size_t)(F.lane >> 3) * PEXP + e) * 128 + (F.lane & 7) * 16)
                                 : (ws + WS_U + ((size_t)lay * PEXP + e) * DM + 16 * F.lane);
        *(u32x4*)dst = (u32x4){w[0], w[1], w[2], w[3]};
        if (F.lane == 0) ((float*)(ws + (tab ? WS_VS : WS_US)))[lay * PEXP + e] = (mx > 0.f) ? mx / 127.f : 1.f;
    }
}

#ifndef DBG_PRECISE_TOPK
#define DBG_PRECISE_TOPK 0
#endif
__device__ __forceinline__ void norm_mod_phase(const Frame& F, ArgsP Ap, int l, int which, int nrows) {
    unsigned char* ws = Ap->ws;
    const float* MOD = (const float*)(ws + WS_MOD);
    const float* gn = Ap->in[which ? 7 : 6] + l * DM;
    bf16* AB = (bf16*)(ws + WS_AB);
    const bool from_input = (which == 0 && l == 0);
    const float* hlat_ = from_input ? Ap->in[0] : Ap->out; const float* hctx_ = from_input ? Ap->in[2] : (const float*)(ws + WS_HCTX);
#define NM_ROWPTR(r_) (((r_) < NLAT) ? (hlat_ + (size_t)(r_) * DM) : (hctx_ + (size_t)((r_) - NLAT) * DM))
    f32x4 v[4], vn[4];
    if (F.gw < nrows) { const float* hr0 = NM_ROWPTR(F.gw);
#pragma unroll
        for (int j = 0; j < 4; ++j) v[j] = *(const f32x4*)(hr0 + 256 * j + 4 * F.lane); }
    for (int r = F.gw; r < nrows; r += F.ngw) {
        const bool lat = r < NLAT;
        { const int rn = (r + F.ngw < nrows) ? (r + F.ngw) : r; const float* hn = NM_ROWPTR(rn);
#pragma unroll
          for (int j = 0; j < 4; ++j) vn[j] = *(const f32x4*)(hn + 256 * j + 4 * F.lane); }
        const int s = lat ? (r >> 12) : 8;
        const float* mp = MOD + ((size_t)l * 9 + s) * 6144 + (which ? 3 * DM : 0);
        float ss = 0.f;
#pragma unroll
        for (int j = 0; j < 4; ++j) ss += (v[j][0] * v[j][0] + v[j][1] * v[j][1]) + (v[j][2] * v[j][2] + v[j][3] * v[j][3]);
        ss = wave_sum(ss);
        const float rinv = rsqrtf(ss * (1.f / DM) + EPS);
#pragma unroll
        for (int j = 0; j < 4; ++j) { const int c = 256 * j + 4 * F.lane;
            const f32x4 g = *(const f32x4*)(gn + c), sh = *(const f32x4*)(mp + c), sc = *(const f32x4*)(mp + DM + c);
            const f32x4 y = v[j] * rinv * g; const f32x4 a = y * (sc + 1.f) + sh;
            u32x2v o; o.x = pk2(a[0], a[1]); o.y = pk2(a[2], a[3]);
            *(u32x2v*)(AB + (size_t)r * DM + c) = o;
            if (which) { typedef _Float16 h2_t __attribute__((ext_vector_type(2))); const h2_t p0 = {(_Float16)a[0], (_Float16)a[1]}, p1 = {(_Float16)a[2], (_Float16)a[3]};
                u32x2v oh; oh.x = __builtin_bit_cast(unsigned, p0); oh.y = __builtin_bit_cast(unsigned, p1); *(u32x2v*)((unsigned short*)(ws + WS_F16B) + (size_t)r * DM + c) = oh; }
            }
#pragma unroll
        for (int j = 0; j < 4; ++j) v[j] = vn[j];
    }
#undef NM_ROWPTR
}

__device__ __forceinline__ void e2_phase(const Frame& F, ArgsP Ap, int l, int nrows) {
    unsigned char* ws = Ap->ws;
    const bf16* P = (const bf16*)(ws + WS_P);
    bf16* QAN = (bf16*)(ws + WS_AB); bf16* KVAN = QAN + (size_t)NROWS * QRANK;
    bf16* QS = (bf16*)(ws + WS_QS); bf16* KS = (bf16*)(ws + WS_KS);
    const float* qa_g = Ap->in[9] + l * QRANK; const float* kva_g = Ap->in[11] + l * KVRANK;
    const float* sqn_g = Ap->in[15] + l * 64; const float* skn_g = Ap->in[16] + l * 64;
    const float* rts = (const float*)(ws + WS_RTS);
    const int lane = F.lane;
    const int lqa = (lane < 48) ? lane : 47, lkva = (lane < 32) ? lane : 31, lsk = (lane < 16) ? lane : 15;
    u32x4 wqa, wsq, wkva, wsk, nqa, nsq, nkva, nsk;
#define E2_LOAD(A_, B_, C_, D_, r_) do { const bf16* pr_ = P + (size_t)(r_) * DIN; A_ = *(const u32x4*)(pr_ + 8 * lqa); B_ = *(const u32x4*)(pr_ + QRANK + 8 * lane); C_ = *(const u32x4*)(pr_ + 896 + 8 * lkva); D_ = *(const u32x4*)(pr_ + 1184 + 8 * lsk); } while (0)
    if (F.gw < nrows) E2_LOAD(wqa, wsq, wkva, wsk, F.gw);
    for (int r = F.gw; r < nrows; r += F.ngw) {
        const bool lat = r < NLAT; const int pos = r & (SEQ - 1), rp = pos >> 6, cp = pos & 63;
        { const int rn = (r + F.ngw < nrows) ? (r + F.ngw) : r; E2_LOAD(nqa, nsq, nkva, nsk, rn); }
        if (lane >= 48) wqa = (u32x4){0u, 0u, 0u, 0u};
        if (lane >= 32) wkva = (u32x4){0u, 0u, 0u, 0u};
        float x[8];
        { unpack8(wqa, x); float ss = 0.f;
#pragma unroll
          for (int e = 0; e < 8; ++e) ss += x[e] * x[e];
          ss = wave_sum(ss); const float rinv = rsqrtf(ss * (1.f / QRANK) + EPS);
          if (lane < 48) { float y[8];
#pragma unroll
              for (int e = 0; e < 8; ++e) y[e] = x[e] * rinv * qa_g[8 * lane + e];
              *(u32x4*)(QAN + (size_t)r * QRANK + 8 * lane) = pack8(y); } }
        { unpack8(wkva, x); float ss = 0.f;
#pragma unroll
          for (int e = 0; e < 8; ++e) ss += x[e] * x[e];
          ss = wave_sum(ss); const float rinv = rsqrtf(ss * (1.f / KVRANK) + EPS);
          if (lane < 32) { float y[8];
#pragma unroll
              for (int e = 0; e < 8; ++e) y[e] = x[e] * rinv * kva_g[8 * lane + e];
              *(u32x4*)(KVAN + (size_t)r * KVRANK + 8 * lane) = pack8(y); } }
        const int ch = lane & 7;
        const float* tab = rts + (size_t)((ch < 4) ? rp : cp) * 32 + (ch & 1) * 16;
#pragma unroll
        for (int which = 0; which < 2; ++which) {
            unpack8(which ? wsk : wsq, x); float ss = 0.f;
#pragma unroll
            for (int e = 0; e < 8; ++e) ss += x[e] * x[e];
            ss += __shfl_xor(ss, 1); ss += __shfl_xor(ss, 2); ss += __shfl_xor(ss, 4);
            const float rinv = rsqrtf(ss * (1.f / 64.f) + EPS);
            const float* gg = which ? skn_g : sqn_g;
            float y[8], o[8];
#pragma unroll
            for (int e = 0; e < 8; ++e) y[e] = x[e] * rinv * gg[8 * ch + e];
#pragma unroll
            for (int e = 0; e < 8; ++e) { const float py = __shfl_xor(y[e], 2);
                if (lat) { const float cs = tab[2 * e], sn = tab[2 * e + 1]; o[e] = (ch & 2) ? (y[e] * cs + py * sn) : (y[e] * cs - py * sn); } else o[e] = y[e]; }
            if (which == 0) {
#pragma unroll
                for (int e = 0; e < 8; ++e) o[e] *= C_SWA;
                *(u32x4*)(QS + (size_t)r * 512 + 8 * lane) = pack8(o);
            } else if (lane < 16) *(u32x4*)(KS + (size_t)r * 128 + 8 * lane) = pack8(o);
        }
        wqa = nqa; wsq = nsq; wkva = nkva; wsk = nsk;
    }
#undef E2_LOAD
}

__device__ __forceinline__ void e3_phase(const Frame& F, ArgsP Ap, int l, int nrows) {
    unsigned char* ws = Ap->ws;
    const bf16* P = (const bf16*)(ws + WS_P);
    bf16* QM = (bf16*)(ws + WS_QM); bf16* KM = (bf16*)(ws + WS_KM);
    const float* qn_g = Ap->in[13] + l * 96; const float* kn_g = Ap->in[14] + l * 96;
    const float* rtm = (const float*)(ws + WS_RTM);
    const int lane = F.lane, hl = lane / 12, ch = lane % 12, gbase = hl * 12;
    const bool val0 = lane < 60, val1 = (lane < 60) && (5 + hl < 8);
    const int h0 = val0 ? hl : 0, h1 = val1 ? (5 + hl) : 0;
    const int qo0 = h0 * 96 + ch * 8, qo1 = h1 * 96 + ch * 8; const bool krope = ch >= 8; const int kro = 1152 + (krope ? (ch - 8) * 8 : 0);
    u32x4 wq0, wk0, wq1, wk1, nq0, nk0, nq1, nk1;
#define E3_LOAD(A_, B_, C_, D_, r_) do { const bf16* qr_ = QM + (size_t)(r_) * 768; const bf16* kr_ = KM + (size_t)(r_) * 768; const bf16* pr_ = P + (size_t)(r_) * DIN + kro; \
        A_ = *(const u32x4*)(qr_ + qo0); C_ = *(const u32x4*)(qr_ + qo1); B_ = *(const u32x4*)(krope ? pr_ : (kr_ + qo0)); D_ = *(const u32x4*)(krope ? pr_ : (kr_ + qo1)); } while (0)
    if (F.gw < nrows) E3_LOAD(wq0, wk0, wq1, wk1, F.gw);
    for (int r = F.gw; r < nrows; r += F.ngw) {
        const bool lat = r < NLAT; const int pos = r & (SEQ - 1), rp = pos >> 6, cp = pos & 63;
        { const int rn = (r + F.ngw < nrows) ? (r + F.ngw) : r; if (rn != r) E3_LOAD(nq0, nk0, nq1, nk1, rn); }
        const float* tab = rtm + (size_t)((ch < 10) ? rp : cp) * 16;
#pragma unroll
        for (int pass = 0; pass < 2; ++pass) {
            const int head = pass ? h1 : h0; const bool valid = pass ? val1 : val0;
#pragma unroll
            for (int which = 0; which < 2; ++which) {
                u32x4 w = which ? (pass ? wk1 : wk0) : (pass ? wq1 : wq0);
                if (!valid) w = (u32x4){0u, 0u, 0u, 0u};
                bf16* dstp = (which ? KM : QM) + (size_t)r * 768 + head * 96 + ch * 8;
                float x[8]; unpack8(w, x); float ss = 0.f;
#pragma unroll
                for (int e = 0; e < 8; ++e) ss += x[e] * x[e];
                float tot = 0.f;
#pragma unroll
                for (int i = 0; i < 12; ++i) tot += __shfl(ss, (gbase + i) & 63);
                const float rinv = rsqrtf(tot * (1.f / 96.f) + EPS);
                const float* gg = which ? kn_g : qn_g;
                float y[8], o[8];
#pragma unroll
                for (int e = 0; e < 8; ++e) y[e] = x[e] * rinv * gg[8 * ch + e];
#pragma unroll
                for (int e = 0; e < 8; ++e) { const float py = __shfl_xor(y[e], 1);
                    if (lat && ch >= 8) { const float cs = tab[2 * e], sn = tab[2 * e + 1]; o[e] = (ch & 1) ? (y[e] * cs + py * sn) : (y[e] * cs - py * sn); } else o[e] = y[e]; }
                if (which == 0) {
#pragma unroll
                    for (int e = 0; e < 8; ++e) o[e] *= C_MLA;
                }
                if (valid) *(u32x4*)dstp = pack8(o);
            }
        }
        wq0 = nq0; wk0 = nk0; wq1 = nq1; wk1 = nk1;
    }
#undef E3_LOAD
}
#define XB_TMO      128
#define XB_XCNT(j)  (256  + 64 * (j))
#define XB_XSUB(j)  (1280 + 64 * (j))
#define XB_XGEN(j)  (2304 + 64 * (j))
#define XB_TOP      3328
#define XB_TOPGEN   3392
#define XCD_BAR_WORDS 3456
#define XB_SPIN_CAP (1u << 18)

__device__ __forceinline__ unsigned xb_ld(unsigned* p)              { return __hip_atomic_load(p, __ATOMIC_RELAXED, __HIP_MEMORY_SCOPE_AGENT); }
__device__ __forceinline__ unsigned xb_add(unsigned* p, unsigned v) { return __hip_atomic_fetch_add(p, v, __ATOMIC_RELAXED, __HIP_MEMORY_SCOPE_AGENT); }
__device__ __forceinline__ unsigned xb_xcc_id() { return (unsigned)__builtin_amdgcn_s_getreg((3 << 11) | 20) & 0xFu; }
#define XB_SPIN(cond, bar) do { unsigned _sp = 0; while (cond) { __builtin_amdgcn_s_sleep(1); \
    if ((++_sp & 255u) == 0u) { if (xb_ld(&(bar)[XB_TMO])) break; if (_sp > XB_SPIN_CAP) { atomicAdd(&(bar)[XB_TMO], 1u); break; } } } } while (0)

struct XcdBarrier {
    unsigned* bar; unsigned x;
    volatile LAS unsigned* st;
};

__device__ __forceinline__ XcdBarrier xcd_barrier_post(unsigned* bar, volatile LAS unsigned* st, const bool t0) {
    XcdBarrier b; b.bar = bar; b.x = xb_xcc_id(); b.st = st;
    if (t0) (void)xb_add(&bar[XB_XCNT(b.x)], 1u);
    return b;
}
__device__ __forceinline__ void xcd_barrier_complete(unsigned* bar, unsigned x, unsigned& nloc, unsigned& nx) {
    const unsigned G = gridDim.x * gridDim.y * gridDim.z;
    unsigned sum, cnt, mine, sp = 0u;
    for (;;) {
        sum = 0u; cnt = 0u; mine = 0u;
#pragma unroll
        for (unsigned j = 0; j < 16; ++j) { const unsigned c = xb_ld(&bar[XB_XCNT(j)]); sum += c; cnt += (c > 0u) ? 1u : 0u; mine = (j == x) ? c : mine; }
        if (sum == G) break;
        __builtin_amdgcn_s_sleep(1);
        if ((++sp & 255u) == 0u) { if (xb_ld(&bar[XB_TMO])) break; if (sp > XB_SPIN_CAP) { atomicAdd(&bar[XB_TMO], 1u); break; } }
    }
    nloc = mine > 0u ? mine : 1u; nx = cnt > 0u ? cnt : 1u;
}

__device__ __forceinline__ void xcd_barrier(const XcdBarrier& b, const bool t0) {
    asm volatile("s_waitcnt vmcnt(0)" ::: "memory");
    __syncthreads();
    if (t0) {
        unsigned* bar = b.bar;
        __builtin_amdgcn_s_waitcnt(0);
        unsigned nloc = b.st[0], nx = b.st[1];
        if (nloc == 0u) { xcd_barrier_complete(bar, b.x, nloc, nx); b.st[0] = nloc; b.st[1] = nx; }
        const unsigned old = xb_add(&bar[XB_XSUB(b.x)], 1u);
        const unsigned gen = old / nloc;
        if (old + 1u == (gen + 1u) * nloc) {
            __builtin_amdgcn_fence(__ATOMIC_RELEASE, "agent");
            asm volatile("s_waitcnt vmcnt(0)" ::: "memory");
            const unsigned og = xb_add(&bar[XB_TOP], 1u);
            const unsigned tg = og / nx;
            if (og + 1u == (tg + 1u) * nx) xb_add(&bar[XB_TOPGEN], 1u);
            else XB_SPIN(xb_ld(&bar[XB_TOPGEN]) == tg, bar);
            __builtin_amdgcn_fence(__ATOMIC_ACQUIRE, "agent");
            xb_add(&bar[XB_XGEN(b.x)], 1u);
            asm volatile("s_waitcnt vmcnt(0)" ::: "memory");
        } else {
            XB_SPIN(xb_ld(&bar[XB_XGEN(b.x)]) == gen, bar);
            __builtin_amdgcn_fence(__ATOMIC_ACQUIRE, "agent");
            asm volatile("s_waitcnt vmcnt(0)" ::: "memory");
        }
    }
    __syncthreads();
}
namespace att {
constexpr int SHM_V = 64 * 64 * 2, SHM_K = 64 * 256, LDS_ATT = 2 * SHM_V + 2 * SHM_K + 8 * 64 * 4;
#define KSWZ(row, colB) ((row) * 256 + ((colB) ^ (((row) & 7) << 4)))
#define SBAR() __builtin_amdgcn_sched_barrier(0)
__device__ __forceinline__ int crow(int r, int hi) { return (r & 3) + 8 * (r >> 2) + 4 * hi; }
__device__ __forceinline__ int v_st(int k, int c) { const int kk = (k & ~0xC) | ((k & 4) << 1) | ((k & 8) >> 1); return ((kk >> 3) * 2 + (c >> 5)) * 512 + ((kk & 7) * 32 + (c & 31)) * 2; }
__device__ __forceinline__ int v_rd_base(int lane) { return ((lane & 3) << 3) | (((lane >> 2) & 3) << 6) | (((lane >> 4) & 1) << 5) | (((lane >> 5) & 1) << 8); }
constexpr int v_rd_off(int d0, int ks, int half) { return d0 * 512 + ks * 2048 + half * 1024; }
template <int OFF> __device__ __forceinline__ s16x4 tr_read(int vb) {
    s16x4 r; asm volatile("ds_read_b64_tr_b16 %0, %1 offset:%2" : "=&v"(r) : "v"(vb), "i"(OFF) : "memory"); return r;
}
template <int D0> __device__ __forceinline__ void pv_one(f32x16& od, int vb, bf16x8 pa0, bf16x8 pa1, bf16x8 pa2, bf16x8 pa3) {
    const s16x4 l0 = tr_read<v_rd_off(D0, 0, 0)>(vb), h0 = tr_read<v_rd_off(D0, 0, 1)>(vb), l1 = tr_read<v_rd_off(D0, 1, 0)>(vb), h1 = tr_read<v_rd_off(D0, 1, 1)>(vb);
    const s16x4 l2 = tr_read<v_rd_off(D0, 2, 0)>(vb), h2 = tr_read<v_rd_off(D0, 2, 1)>(vb), l3 = tr_read<v_rd_off(D0, 3, 0)>(vb), h3 = tr_read<v_rd_off(D0, 3, 1)>(vb);
    asm volatile("s_waitcnt lgkmcnt(0)" ::: "memory"); SBAR();
#define PK(L, H) (bf16x8){L[0], L[1], L[2], L[3], H[0], H[1], H[2], H[3]}
    od = __builtin_amdgcn_mfma_f32_32x32x16_bf16(pa0, PK(l0, h0), od, 0, 0, 0);
    od = __builtin_amdgcn_mfma_f32_32x32x16_bf16(pa1, PK(l1, h1), od, 0, 0, 0);
    od = __builtin_amdgcn_mfma_f32_32x32x16_bf16(pa2, PK(l2, h2), od, 0, 0, 0);
    od = __builtin_amdgcn_mfma_f32_32x32x16_bf16(pa3, PK(l3, h3), od, 0, 0, 0);
#undef PK
}
__device__ __forceinline__ void pv2(f32x16* o, int vb, bf16x8 pa0, bf16x8 pa1, bf16x8 pa2, bf16x8 pa3) {
    pv_one<0>(o[0], vb, pa0, pa1, pa2, pa3); pv_one<1>(o[1], vb, pa0, pa1, pa2, pa3);
}
template <int ND0> __device__ __forceinline__ void qkt(f32x16& p0, f32x16& p1, const char* Ks, const bf16x8* qr, int r32, int hi) {
    p0 = f32x16{}; p1 = f32x16{};
#pragma unroll
    for (int d0 = 0; d0 < ND0; ++d0) { const int cb = (d0 * 16 + hi * 8) * 2;
        const bf16x8 b0 = *reinterpret_cast<const bf16x8*>(Ks + KSWZ(r32, cb));
        const bf16x8 b1 = *reinterpret_cast<const bf16x8*>(Ks + KSWZ(32 + r32, cb));
        p0 = __builtin_amdgcn_mfma_f32_32x32x16_bf16(b0, qr[d0], p0, 0, 0, 0);
        p1 = __builtin_amdgcn_mfma_f32_32x32x16_bf16(b1, qr[d0], p1, 0, 0, 0); }
}
__device__ __forceinline__ void wmask(f32x16& p0, f32x16& p1, int kp0, int qp, int hi) {
#pragma unroll
    for (int r = 0; r < 16; ++r) { const int d0 = kp0 + crow(r, hi) - qp; const int d1 = d0 + 32;
        if (d0 > 128 || d0 < -128) p0[r] = -INFINITY; if (d1 > 128 || d1 < -128) p1[r] = -INFINITY; }
}
typedef __bf16 abf2_t __attribute__((ext_vector_type(2)));
__device__ __forceinline__ float adot2(unsigned w, float acc) { return __builtin_amdgcn_fdot2_f32_bf16(__builtin_bit_cast(abf2_t, w), __builtin_bit_cast(abf2_t, 0x3F803F80u), acc, false); }
__device__ __forceinline__ void smpack(f32x16& p0, f32x16& p1, float& l_reg, bf16x8& pa0, bf16x8& pa1, bf16x8& pa2, bf16x8& pa3) {
#pragma unroll
    for (int r = 0; r < 16; ++r) p0[r] = __builtin_amdgcn_exp2f(p0[r]);
#pragma unroll
    for (int r = 0; r < 16; ++r) p1[r] = __builtin_amdgcn_exp2f(p1[r]);
    float ps0 = 0.f, ps1 = 0.f;
#define PK4(P, BASE, OUT) do { unsigned a0 = pk2(P[BASE + 0], P[BASE + 1]), a1 = pk2(P[BASE + 2], P[BASE + 3]);   \
    unsigned b0 = pk2(P[BASE + 4], P[BASE + 5]), b1 = pk2(P[BASE + 6], P[BASE + 7]);                              \
    ps0 = adot2(a0, ps0); ps1 = adot2(a1, ps1); ps0 = adot2(b0, ps0); ps1 = adot2(b1, ps1);                     \
    auto r0 = __builtin_amdgcn_permlane32_swap(a0, b0, false, false); auto r1 = __builtin_amdgcn_permlane32_swap(a1, b1, false, false); \
    u32x4 w = {r0[0], r1[0], r0[1], r1[1]}; OUT = *reinterpret_cast<bf16x8*>(&w); } while (0)
    PK4(p0, 0, pa0); PK4(p0, 8, pa1); PK4(p1, 0, pa2); PK4(p1, 8, pa3);
#undef PK4
    l_reg += ps0 + ps1;
}

struct Unit {
    const bf16* Q; int ldq;
    const bf16* K; int ldk;
    const bf16* V; int ldv;
    bf16* O;
    int qrow0;
    int ctx_row0;
    int lat_row0;
    int nt;
    int qpos0;
    int kpos0;
    int masked;
    float l_init;
};

template <int DQK, bool MASKED>
__device__ __forceinline__ void attn_unit(const Unit& U, char* lds, const int tid) {
    constexpr int ND0 = DQK / 16, NCH = DQK / 8;
    const int wid = tid >> 6, lane = tid & 63, r32 = lane & 31, hi = lane >> 5;
    char* V_lds = lds; char* K_lds = lds + 2 * SHM_V;
    float* wsf = (float*)(lds + 2 * SHM_V + 2 * SHM_K) + wid * 64;
    float l_reg = (hi == 0) ? U.l_init : 0.f; f32x16 o[2] = {}; bf16x8 qr[ND0];
    const bf16* Qw = U.Q + (size_t)(U.qrow0 + wid * 32 + r32) * U.ldq + hi * 8;
#pragma unroll
    for (int d0 = 0; d0 < ND0; ++d0) qr[d0] = *reinterpret_cast<const bf16x8*>(Qw + d0 * 16);
    const int vk = tid >> 3, vc = (tid & 7) * 8, vst = v_st(vk, vc);
    const int k0r = tid / NCH, k0c = tid % NCH;
    const bool k1on = (NCH == 12) && (tid < 256);
    const int k1i = k1on ? (tid + 512) : tid, k1r = k1i / NCH, k1c = k1i % NCH;
    const int vb0 = (int)(uintptr_t)V_lds + v_rd_base(lane);
    struct Slot { bf16x8 v, k0, k1; } s0;
    auto tile_row = [&](int t) -> int { return (t < 4) ? (U.ctx_row0 + 64 * t) : (U.lat_row0 + 64 * (t - 4)); };
#define SLOAD(S, t) do { const int kr_ = tile_row(t); \
        S.v = *reinterpret_cast<const bf16x8*>(U.V + (size_t)(kr_ + vk) * U.ldv + vc); \
        S.k0 = *reinterpret_cast<const bf16x8*>(U.K + (size_t)(kr_ + k0r) * U.ldk + k0c * 8); \
        if (NCH == 12) S.k1 = *reinterpret_cast<const bf16x8*>(U.K + (size_t)(kr_ + k1r) * U.ldk + k1c * 8); } while (0)
#define SWRITE(b, S) do { *reinterpret_cast<bf16x8*>(V_lds + (b) * SHM_V + vst) = S.v; \
        *reinterpret_cast<bf16x8*>(K_lds + (b) * SHM_K + KSWZ(k0r, k0c * 16)) = S.k0; \
        if (NCH == 12) { if (k1on) *reinterpret_cast<bf16x8*>(K_lds + (b) * SHM_K + KSWZ(k1r, k1c * 16)) = S.k1; } } while (0)
#define MASK(P0, P1, t) do { if (MASKED && (t) >= 4) wmask(P0, P1, U.kpos0 + 64 * ((t) - 4), U.qpos0 + wid * 32 + r32, hi); } while (0)
    f32x16 pA0, pA1, pB0, pB1; bf16x8 pa0, pa1, pa2, pa3; const int NT = U.nt;
    __syncthreads();
    SLOAD(s0, 0); SWRITE(0, s0); __syncthreads();
    qkt<ND0>(pA0, pA1, K_lds, qr, r32, hi); MASK(pA0, pA1, 0);
    SLOAD(s0, 1);
    SWRITE(1, s0); __syncthreads();
    for (int j = 1; j + 1 < NT; j += 2) {
        SBAR(); qkt<ND0>(pB0, pB1, K_lds + SHM_K, qr, r32, hi); MASK(pB0, pB1, j);
        smpack(pA0, pA1, l_reg, pa0, pa1, pa2, pa3); SBAR();
        SLOAD(s0, j + 1); SBAR();
        pv2(o, vb0, pa0, pa1, pa2, pa3);
        __syncthreads(); SWRITE(0, s0); __syncthreads();
        SBAR(); qkt<ND0>(pA0, pA1, K_lds, qr, r32, hi); MASK(pA0, pA1, j + 1);
        smpack(pB0, pB1, l_reg, pa0, pa1, pa2, pa3); SBAR();
        SLOAD(s0, j + 2); SBAR();
        pv2(o, vb0 + SHM_V, pa0, pa1, pa2, pa3);
        __syncthreads(); SWRITE(1, s0); __syncthreads();
    }
    SBAR(); qkt<ND0>(pB0, pB1, K_lds + SHM_K, qr, r32, hi); MASK(pB0, pB1, NT - 1);
    smpack(pA0, pA1, l_reg, pa0, pa1, pa2, pa3); SBAR();
    pv2(o, vb0, pa0, pa1, pa2, pa3);
    smpack(pB0, pB1, l_reg, pa0, pa1, pa2, pa3); SBAR();
    pv2(o, vb0 + SHM_V, pa0, pa1, pa2, pa3);
    { auto rr = __builtin_amdgcn_permlane32_swap(__float_as_uint(l_reg), __float_as_uint(l_reg), false, false);
      l_reg = __uint_as_float(rr[0]) + __uint_as_float(rr[1]); }
    if (hi == 0) wsf[r32] = l_reg;
    asm volatile("s_waitcnt lgkmcnt(0)" ::: "memory");
    float rli[16];
#pragma unroll
    for (int r = 0; r < 16; ++r) rli[r] = 1.f / wsf[crow(r, hi)];
    bf16* Ow = U.O + (size_t)(U.qrow0 + wid * 32) * 1024;
#pragma unroll
    for (int r = 0; r < 16; ++r) { const int orow = crow(r, hi);
#pragma unroll
        for (int d0 = 0; d0 < 2; ++d0) { const unsigned w = pk2(o[d0][r] * rli[r], 0.f); Ow[(size_t)orow * 1024 + d0 * 32 + r32] = (bf16)(w & 0xffffu); } }
#undef SLOAD
#undef SWRITE
#undef MASK
}
#undef KSWZ
}

__device__ __forceinline__ void attn_phase(const Frame& F, ArgsP Ap, int l, char* lds) {
    unsigned char* ws = Ap->ws;
    const bf16* QM = (const bf16*)(ws + WS_QM); const bf16* KM = (const bf16*)(ws + WS_KM); const bf16* VM = (const bf16*)(ws + WS_VM);
    const bf16* QS = (const bf16*)(ws + WS_QS); const bf16* KS = (const bf16*)(ws + WS_KS); const bf16* VS = (const bf16*)(ws + WS_P) + 1312;
    bf16* OB = (bf16*)(ws + WS_AB);
    const float* sink = Ap->in[17] + l * 8;
    const int nunits = (l == 0) ? 1024 + 64 : 1024;
    for (int u = F.vcu; u < nunits; u += F.G) {
        const bool isl = u < 1024;
        const int i = u >> 8, c = u & 31, b = isl ? ((u & 255) >> 5) : ((u - 1024) >> 3), h = isl ? (2 * i + (c >> 4)) : (u & 7), qb = c & 15;
        att::Unit U; U.Q = QM + h * 96; U.ldq = 768; U.K = KM + h * 96; U.ldk = 768; U.V = VM + h * 64; U.ldv = 512; U.O = OB + h * 64;
        U.qrow0 = isl ? (b * SEQ + qb * 256) : (NLAT + b * CTXL); U.ctx_row0 = NLAT + b * CTXL; U.lat_row0 = b * SEQ; U.nt = isl ? (4 + SEQ / 64) : 4; U.qpos0 = 0; U.kpos0 = 0; U.masked = 0; U.l_init = 0.f;
        att::attn_unit<96, false>(U, lds, F.tid);
    }
    for (int u = F.vcu; u < nunits; u += F.G) {
        const bool isl = u < 1024;
        const int i = u >> 8, c = u & 31, b = isl ? ((u & 255) >> 5) : ((u - 1024) >> 3), h = isl ? (2 * i + (c >> 4)) : (u & 7), qb = c & 15, g = h >> 2;
        const int q0 = qb * 256; int k_lo = q0 - 128; if (k_lo < 0) k_lo = 0; int k_hi = q0 + 256 + 128; if (k_hi > SEQ) k_hi = SEQ;
        att::Unit U; U.Q = QS + h * 64; U.ldq = 512; U.K = KS + g * 64; U.ldk = 128; U.V = VS + g * 64; U.ldv = DIN; U.O = OB + 512 + h * 64;
        U.qrow0 = isl ? (b * SEQ + q0) : (NLAT + b * CTXL); U.ctx_row0 = NLAT + b * CTXL; U.lat_row0 = b * SEQ + k_lo; U.nt = isl ? (4 + (k_hi - k_lo) / 64) : 4; U.qpos0 = q0; U.kpos0 = k_lo; U.masked = 1;
        U.l_init = __builtin_amdgcn_exp2f(sink[h] * LOG2E);
        att::attn_unit<64, true>(U, lds, F.tid);
    }
}

#ifndef DBG_NAIVE_ATTN
#define DBG_NAIVE_ATTN 0
#endif
#if DBG_NAIVE_ATTN
__device__ __forceinline__ void attn_naive_phase(const Frame& F, ArgsP Ap, int l) {
    unsigned char* ws = Ap->ws;
    const bf16* QM = (const bf16*)(ws + WS_QM); const bf16* KM = (const bf16*)(ws + WS_KM); const bf16* VM = (const bf16*)(ws + WS_VM);
    const bf16* QS = (const bf16*)(ws + WS_QS); const bf16* KS = (const bf16*)(ws + WS_KS); const bf16* VS = (const bf16*)(ws + WS_P) + 1312;
    bf16* OB = (bf16*)(ws + WS_AB);
    const float* sink = Ap->in[17] + l * 8;
    const int nrg = ((l == 0) ? NROWS : NLAT) / 64;
    for (int u = F.gw; u < nrg * 8; u += F.ngw) {
        const int h = __builtin_amdgcn_readfirstlane(u & 7), rg = __builtin_amdgcn_readfirstlane(u >> 3), row = rg * 64 + F.lane;
        const bool lat = rg * 64 < NLAT; const int b = lat ? (rg * 64) >> 12 : (rg * 64 - NLAT) >> 8;
        {
            float q[96], o[64]; float lsum = 0.f;
#pragma unroll
            for (int d = 0; d < 96; d += 2) { const unsigned w = *(const unsigned*)(QM + (size_t)row * 768 + h * 96 + d); q[d] = bf_lo(w); q[d + 1] = bf_hi(w); }
#pragma unroll
            for (int d = 0; d < 64; ++d) o[d] = 0.f;
            const int nk = lat ? (CTXL + SEQ) : CTXL;
#pragma unroll 1
            for (int j = 0; j < nk; ++j) { const int kr = (j < CTXL) ? (NLAT + b * CTXL + j) : (b * SEQ + j - CTXL);
                const bf16* kp = KM + (size_t)kr * 768 + h * 96; const bf16* vp = VM + (size_t)kr * 512 + h * 64; float s = 0.f;
#pragma unroll
                for (int d = 0; d < 96; d += 2) { const unsigned w = *(const unsigned*)(kp + d); s = fmaf(q[d], bf_lo(w), s); s = fmaf(q[d + 1], bf_hi(w), s); }
                const float p = exp2f(s); lsum += p;
#pragma unroll
                for (int d = 0; d < 64; d += 2) { const unsigned w = *(const unsigned*)(vp + d); o[d] = fmaf(p, bf_lo(w), o[d]); o[d + 1] = fmaf(p, bf_hi(w), o[d + 1]); } }
            const float rl = 1.f / lsum;
#pragma unroll
            for (int d = 0; d < 64; d += 2) *(unsigned*)(OB + (size_t)row * 1024 + h * 64 + d) = pk2(o[d] * rl, o[d + 1] * rl);
        }
        {
            const int g = h >> 2; const int pos0 = (rg * 64) & (SEQ - 1), pos = pos0 + F.lane;
            float q[64], o[64]; float lsum = exp2f(sink[h] * LOG2E);
#pragma unroll
            for (int d = 0; d < 64; d += 2) { const unsigned w = *(const unsigned*)(QS + (size_t)row * 512 + h * 64 + d); q[d] = bf_lo(w); q[d + 1] = bf_hi(w); }
#pragma unroll
            for (int d = 0; d < 64; ++d) o[d] = 0.f;
            int jlo = pos0 - 128; if (jlo < 0) jlo = 0; int jhi = pos0 + 63 + 128; if (jhi > SEQ - 1) jhi = SEQ - 1;
            const int nk = lat ? (CTXL + (jhi - jlo + 1)) : CTXL;
#pragma unroll 1
            for (int j = 0; j < nk; ++j) { const bool isc = j < CTXL; const int kpos = jlo + j - CTXL; const int kr = isc ? (NLAT + b * CTXL + j) : (b * SEQ + kpos);
                const bf16* kp = KS + (size_t)kr * 128 + g * 64; const bf16* vp = VS + (size_t)kr * DIN + g * 64; float s = 0.f;
#pragma unroll
                for (int d = 0; d < 64; d += 2) { const unsigned w = *(const unsigned*)(kp + d); s = fmaf(q[d], bf_lo(w), s); s = fmaf(q[d + 1], bf_hi(w), s); }
                float p = exp2f(s); if (!isc) { const int dd = kpos - pos; if (dd > 128 || dd < -128) p = 0.f; } lsum += p;
#pragma unroll
                for (int d = 0; d < 64; d += 2) { const unsigned w = *(const unsigned*)(vp + d); o[d] = fmaf(p, bf_lo(w), o[d]); o[d + 1] = fmaf(p, bf_hi(w), o[d + 1]); } }
            const float rl = 1.f / lsum;
#pragma unroll
            for (int d = 0; d < 64; d += 2) *(unsigned*)(OB + (size_t)row * 1024 + 512 + h * 64 + d) = pk2(o[d] * rl, o[d + 1] * rl);
        }
    }
}
#endif
__device__ __forceinline__ unsigned f2key(float f) { const unsigned u = __float_as_uint(f); return (u & 0x80000000u) ? ~u : (u | 0x80000000u); }
__device__ __forceinline__ float key2f(unsigned k) { const unsigned u = (k & 0x80000000u) ? (k & 0x7fffffffu) : ~k; return __uint_as_float(u); }
#define CE_DESC(a, b) do { const unsigned _hi = max(a, b), _lo = min(a, b); a = _hi; b = _lo; } while (0)
__device__ __forceinline__ void sort16_desc(unsigned (&a)[16]) {
#pragma unroll
    for (int k = 2; k <= 16; k <<= 1)
#pragma unroll
        for (int j = k >> 1; j > 0; j >>= 1)
#pragma unroll
            for (int i = 0; i < 16; ++i) { const int p = i ^ j;
                if (p > i) { if ((i & k) == 0) { CE_DESC(a[i], a[p]); } else { CE_DESC(a[p], a[i]); } } }
}
__device__ __forceinline__ void merge16_desc(unsigned (&t)[16], const unsigned (&c)[16]) {
#pragma unroll
    for (int i = 0; i < 16; ++i) t[i] = max(t[i], c[15 - i]);
#pragma unroll
    for (int j = 8; j > 0; j >>= 1)
#pragma unroll
        for (int i = 0; i < 16; ++i) { const int p = i ^ j; if (p > i) CE_DESC(t[i], t[p]); }
}
__device__ __forceinline__ void merge16_partner(unsigned (&t)[16]) {
    unsigned oth[16];
#pragma unroll
    for (int i = 0; i < 16; ++i) oth[i] = (unsigned)__shfl_xor((int)t[i], 32);
    merge16_desc(t, oth);
}

constexpr size_t WS_IDX = WS_P;
constexpr size_t WS_GW = WS_P + (size_t)NROWS * 128 * 2;
constexpr size_t WS_W2 = WS_GW + (size_t)NROWS * 128 * 4;
constexpr size_t WS_USL = WS_W2 + (size_t)NROWS * 128 * 4;
static_assert(WS_USL + (size_t)NROWS * 128 * 4 <= WS_X5, "peer lists inside the P region");

__device__ __forceinline__ void topkc_phase(const Frame& F, ArgsP Ap, int l, int nrows, char* lds) {
    unsigned char* ws = Ap->ws;
    const bf16* QP = (const bf16*)(ws + WS_X5);
    const bf16* PK = (const bf16*)(ws + WS_PKEY) + (size_t)l * 16 * 128 * 128;
    unsigned short* IDX = (unsigned short*)(ws + WS_IDX); float* GW = (float*)(ws + WS_GW); float* USL = (float*)(ws + WS_USL);
    const float* USt = (const float*)(ws + WS_US) + l * PEXP; const float* VSt = (const float*)(ws + WS_VS) + l * PEXP;
    char* Kl = lds;
    unsigned char* sub = (unsigned char*)(lds + 65536) + F.wave * 1024;
    const int lane = F.lane, r32 = lane & 31, hi = lane >> 5;
    const int nunits = (nrows / 256) * 8;
    for (int u = F.bid; u < nunits; u += F.G) {
        const int h = u & 7, rb = u >> 3;
        __syncthreads();
#pragma unroll
        for (int i = 0; i < 8; ++i) { const int ci = F.tid + 512 * i, krow = ci >> 4, ch = ci & 15;
            const u32x4 v = *(const u32x4*)(PK + ((size_t)(2 * h) * 128 + krow) * 128 + ch * 8);
            *(u32x4*)(Kl + krow * 256 + ((ch * 16) ^ ((krow & 7) << 4))) = v; }
        __syncthreads();
        const int row = rb * 256 + F.wave * 32 + r32;
        const unsigned hi4 = (unsigned)hi << 2, hi7 = (unsigned)hi << 7;
        unsigned t0[16], t1[16];
#pragma unroll
        for (int p = 0; p < 2; ++p) {
            const bf16* qrow = QP + (size_t)row * 2048 + (2 * h + p) * 128 + hi * 8;
            bf16x8 bq[8];
#pragma unroll
            for (int s = 0; s < 8; ++s) bq[s] = *reinterpret_cast<const bf16x8*>(qrow + s * 16);
            unsigned top[16];
#pragma unroll
            for (int blk = 0; blk < 4; ++blk) {
                f32x16 acc = f32x16{};
                const char* kb = Kl + (p * 128 + blk * 32 + r32) * 256;
#pragma unroll
                for (int s = 0; s < 8; ++s) { const bf16x8 ka = *reinterpret_cast<const bf16x8*>(kb + (((s * 16 + hi * 8) * 2) ^ ((r32 & 7) << 4)));
                    acc = __builtin_amdgcn_mfma_f32_32x32x16_bf16(ka, bq[s], acc, 0, 0, 0); }
                unsigned c[16];
#pragma unroll
                for (int r = 0; r < 16; ++r) c[r] = ((f2key(acc[r]) & ~127u) | (unsigned)(127 - (blk * 32 + (r & 3) + 8 * (r >> 2)))) ^ hi4;
                sort16_desc(c);
                if (blk == 0) {
#pragma unroll
                    for (int i = 0; i < 16; ++i) top[i] = c[i];
                } else merge16_desc(top, c);
                __builtin_amdgcn_sched_barrier(0);
            }
            merge16_partner(top);
#pragma unroll
            for (int i = 0; i < 16; ++i) { if (p == 0) t0[i] = top[i]; else t1[i] = top[i]; }
        }
        if (hi == 0) { unsigned* sw = (unsigned*)(sub + r32 * 32);
#pragma unroll
            for (int q = 0; q < 4; ++q) {
                sw[q] = (127u - (t0[4 * q] & 127u)) | ((127u - (t0[4 * q + 1] & 127u)) << 8) | ((127u - (t0[4 * q + 2] & 127u)) << 16) | ((127u - (t0[4 * q + 3] & 127u)) << 24);
                sw[4 + q] = (127u - (t1[4 * q] & 127u)) | ((127u - (t1[4 * q + 1] & 127u)) << 8) | ((127u - (t1[4 * q + 2] & 127u)) << 16) | ((127u - (t1[4 * q + 3] & 127u)) << 24); } }
        float f1[16], fa[8];
#pragma unroll
        for (int i = 0; i < 16; ++i) f1[i] = key2f(t1[i] & ~127u);
#pragma unroll
        for (int i = 0; i < 8; ++i) fa[i] = key2f((hi ? t0[8 + i] : t0[i]) & ~127u);
        unsigned top[16];
#pragma unroll
        for (int i = 0; i < 8; ++i) {
            unsigned c[16];
#pragma unroll
            for (int b = 0; b < 16; ++b) c[b] = ((f2key(fa[i] + f1[b]) & ~255u) | (unsigned)(255 - (16 * i + b))) ^ hi7;
            if (i == 0) {
#pragma unroll
                for (int k = 0; k < 16; ++k) top[k] = c[k];
            } else merge16_desc(top, c);
            __builtin_amdgcn_sched_barrier(0);
        }
        merge16_partner(top);
        asm volatile("s_waitcnt lgkmcnt(0)" ::: "memory");
        float cv[16]; float den = 0.f; const float m = key2f(top[0] & ~255u);
#pragma unroll
        for (int i = 0; i < 16; ++i) { cv[i] = __expf(key2f(top[i] & ~255u) - m); den += cv[i]; }
        const float rden = 1.f / den;
        if (hi == 0) {
            unsigned iw[8];
#pragma unroll
            for (int i = 0; i < 16; i += 2) {
                const int fl0 = 255 - (int)(top[i] & 255u), fl1 = 255 - (int)(top[i + 1] & 255u);
                const unsigned e0 = (unsigned)sub[r32 * 32 + (fl0 >> 4)] * PNK + (unsigned)sub[r32 * 32 + 16 + (fl0 & 15)];
                const unsigned e1 = (unsigned)sub[r32 * 32 + (fl1 >> 4)] * PNK + (unsigned)sub[r32 * 32 + 16 + (fl1 & 15)];
                iw[i >> 1] = e0 | (e1 << 16); }
            u32x4* ip = (u32x4*)(IDX + (size_t)row * 128 + h * 16); ip[0] = (u32x4){iw[0], iw[1], iw[2], iw[3]}; ip[1] = (u32x4){iw[4], iw[5], iw[6], iw[7]};
            float us_[16], gv_[16];
#pragma unroll
            for (int i = 0; i < 16; ++i) { const unsigned e_ = (i & 1) ? (iw[i >> 1] >> 16) : (iw[i >> 1] & 0xffffu); us_[i] = USt[e_]; gv_[i] = cv[i] * rden * VSt[e_] * 1024.f; }
            f32x4* gp = (f32x4*)(GW + (size_t)row * 128 + h * 16); f32x4* up = (f32x4*)(USL + (size_t)row * 128 + h * 16);
#pragma unroll
            for (int q = 0; q < 4; ++q) { gp[q] = (f32x4){gv_[4 * q], gv_[4 * q + 1], gv_[4 * q + 2], gv_[4 * q + 3]}; up[q] = (f32x4){us_[4 * q], us_[4 * q + 1], us_[4 * q + 2], us_[4 * q + 3]}; }
        }
    }
}

typedef __bf16 bf16x2_t __attribute__((ext_vector_type(2)));
typedef float f32x2v __attribute__((ext_vector_type(2)));
__device__ __forceinline__ float dot2(unsigned w, unsigned x, float acc) { return __builtin_amdgcn_fdot2_f32_bf16(__builtin_bit_cast(bf16x2_t, w), __builtin_bit_cast(bf16x2_t, x), acc, false); }
__device__ __forceinline__ float dot16(const u32x4 a0, const u32x4 a1, const u32x4 x0, const u32x4 x1) {
    float s0 = dot2(a0.x, x0.x, 0.f), s1 = dot2(a0.y, x0.y, 0.f), s2 = dot2(a0.z, x0.z, 0.f), s3 = dot2(a0.w, x0.w, 0.f);
    s0 = dot2(a1.x, x1.x, s0); s1 = dot2(a1.y, x1.y, s1); s2 = dot2(a1.z, x1.z, s2); s3 = dot2(a1.w, x1.w, s3);
    return (s0 + s1) + (s2 + s3);
}
__device__ __forceinline__ void fma8(float (&o)[8], const u32x4 v, float w) {
    o[0] += w * bf_lo(v.x); o[1] += w * bf_hi(v.x); o[2] += w * bf_lo(v.y); o[3] += w * bf_hi(v.y);
    o[4] += w * bf_lo(v.z); o[5] += w * bf_hi(v.z); o[6] += w * bf_lo(v.w); o[7] += w * bf_hi(v.w);
}

#define DPP_ADD(v, CTRL) ((v) + __builtin_bit_cast(float, __builtin_amdgcn_update_dpp(0, __builtin_bit_cast(int, (v)), (CTRL), 0xF, 0xF, true)))
__device__ __forceinline__ float dpp_sum8(float v) { v = DPP_ADD(v, 0xB1); v = DPP_ADD(v, 0x4E); v = DPP_ADD(v, 0x141); return v; }
__device__ __forceinline__ float dpp_sum16(float v) { v = dpp_sum8(v); v = DPP_ADD(v, 0x140); return v; }
__device__ __forceinline__ float sum_b345(float v) {
    v = DPP_ADD(v, 0x128);
    { unsigned a = __builtin_bit_cast(unsigned, v), b = a; asm volatile("s_nop 1\n\tv_permlane16_swap_b32 %0, %1" : "+v"(a), "+v"(b)); v = __builtin_bit_cast(float, a) + __builtin_bit_cast(float, b); }
    { unsigned a = __builtin_bit_cast(unsigned, v), b = a; asm volatile("s_nop 1\n\tv_permlane32_swap_b32 %0, %1" : "+v"(a), "+v"(b)); v = __builtin_bit_cast(float, a) + __builtin_bit_cast(float, b); }
    return v;
}
__device__ __forceinline__ float gelu_as(float v) {
    const float av = fabsf(v), t = __builtin_amdgcn_rcpf(av * 0.2316418882f + 1.0f);
    float q = t * 0.5307027145f + (-0.7265760135f); q = q * t + 0.7107068705f; q = q * t + (-0.142248368f); q = q * t + 0.127414796f; q = q * t;
    const float e = __builtin_amdgcn_exp2f((v * v) * (-0.72134752044f)); const float m = v * (q * e);
    return v < 0.f ? m : v - m;
}
typedef _Float16 h2_t __attribute__((ext_vector_type(2)));
__device__ __forceinline__ float dot2h(unsigned a, unsigned b, float acc) { return __builtin_amdgcn_fdot2(__builtin_bit_cast(h2_t, a), __builtin_bit_cast(h2_t, b), acc, false); }
constexpr unsigned H_ONES = 0x3C003C00u;
constexpr unsigned H_K64 = 0x64646464u;
constexpr float CODE_BIAS = 1152.f;

__device__ __forceinline__ void pu_phase(const Frame& F, ArgsP Ap, int l, int nrows, char* lds, const int pvar) {
    unsigned char* ws = Ap->ws;
    const unsigned short* IDX = (const unsigned short*)(ws + WS_IDX); const float* GW = (const float*)(ws + WS_GW);
    unsigned short* W16 = (unsigned short*)(ws + (pvar ? WS_W2 + (size_t)NROWS * 128 * 2 : WS_W2));
    const unsigned short* Bh = (const unsigned short*)(ws + WS_F16B);
    const char* Ut = (const char*)(ws + WS_U + (size_t)l * PEXP * DM);
    const float* USL = (const float*)(ws + WS_USL);
    const int lane = F.lane, grp = lane >> 4, li = lane & 15;
    int* l_slot = (int*)(lds + F.wave * 2048); int* l_idx = l_slot + 128; float* l_g = (float*)(l_idx + 128); float* l_us = l_g + 128;
    const bool xs = (F.G % 8) == 0;
    const int wv = xs ? ((F.bid >> 3) * 8 + F.wave) : F.gw, nwv = xs ? (F.G >> 3) * 8 : F.ngw, npass = xs ? 1 : 8;
    const unsigned long long lt = (1ull << lane) - 1ull;
    const unsigned lo2 = (unsigned)lane * 4u, li16 = (unsigned)li * 16u, li32 = (unsigned)li * 32u;
    for (int pass = 0; pass < npass; ++pass) {
        const int c = xs ? (F.bid & 7) : pass;
        unsigned iw = 0u, iwn = 0u; f32x2v gg = {0.f, 0.f}, ggn = {0.f, 0.f}, uu = {0.f, 0.f}, uun = {0.f, 0.f}; u32x4 xv[8], xn[8];
#define PU_LOAD(IW, GG, UU, X, t_) do { IW = *(const unsigned*)((const char*)(IDX + (size_t)(t_) * 128) + lo2); GG = *(const f32x2v*)((const char*)(GW + (size_t)(t_) * 128) + 2 * lo2); UU = *(const f32x2v*)((const char*)(USL + (size_t)(t_) * 128) + 2 * lo2); \
        const char* xr_ = (const char*)(Bh + (size_t)(t_) * DM); _Pragma("unroll") for (int s = 0; s < 4; ++s) { X[2 * s] = *(const u32x4*)(xr_ + s * 512 + li32); X[2 * s + 1] = *(const u32x4*)(xr_ + s * 512 + li32 + 16u); } } while (0)
        int t = wv;
        if (t < nrows) PU_LOAD(iw, gg, uu, xv, t);
        for (; t < nrows; t += nwv) {
            const int i0 = (int)(iw & 0xffffu), i1 = (int)(iw >> 16); const bool m0 = (i0 >> 11) == c, m1 = (i1 >> 11) == c;
            const unsigned long long b0 = __ballot(m0), b1 = __ballot(m1); const int n = (pvar == 1) ? 0 : (__popcll(b0) + __popcll(b1)); const int r0 = __popcll(b0 & lt) + __popcll(b1 & lt);
            if (m0) { l_slot[r0] = 2 * lane; l_idx[r0] = i0; l_g[r0] = gg.x; l_us[r0] = uu.x; }
            if (m1) { const int r1 = r0 + (m0 ? 1 : 0); l_slot[r1] = 2 * lane + 1; l_idx[r1] = i1; l_g[r1] = gg.y; l_us[r1] = uu.y; }
            if (t + nwv < nrows) PU_LOAD(iwn, ggn, uun, xn, t + nwv);
            float bsum = 0.f;
#pragma unroll
            for (int s = 0; s < 8; ++s) { bsum = dot2h(xv[s].x, H_ONES, bsum); bsum = dot2h(xv[s].y, H_ONES, bsum); bsum = dot2h(xv[s].z, H_ONES, bsum); bsum = dot2h(xv[s].w, H_ONES, bsum); }
            asm volatile("s_waitcnt lgkmcnt(0)" ::: "memory");
            u32x4 qa[4], qb[4], sa[4], sb[4];
#define PU_RLOAD(RA, RB, k0_) do { const int kA_ = ((k0_) + grp < n) ? ((k0_) + grp) : (n - 1), kB_ = ((k0_) + 4 + grp < n) ? ((k0_) + 4 + grp) : (n - 1);       \
                const char* uA_ = Ut + ((unsigned)l_idx[kA_] * 1024u + li16); const char* uB_ = Ut + ((unsigned)l_idx[kB_] * 1024u + li16); \
                _Pragma("unroll") for (int s = 0; s < 4; ++s) RA[s] = *(const u32x4*)(uA_ + s * 256); _Pragma("unroll") for (int s = 0; s < 4; ++s) RB[s] = *(const u32x4*)(uB_ + s * 256); } while (0)
#define PU_W(acc0, acc1, w_, xa_, xb_) do { acc0 = dot2h(__builtin_amdgcn_perm(H_K64, (w_), 0x04010400u), (xa_), acc0); acc1 = dot2h(__builtin_amdgcn_perm(H_K64, (w_), 0x04030402u), (xb_), acc1); } while (0)
#define PU_COMP(RA, RB, k0_) do { const int kA_ = ((k0_) + grp < n) ? ((k0_) + grp) : (n - 1), kB_ = ((k0_) + 4 + grp < n) ? ((k0_) + 4 + grp) : (n - 1); \
                float dA0 = 0.f, dA1 = 0.f, dB0 = 0.f, dB1 = 0.f; \
                _Pragma("unroll") for (int s = 0; s < 4; ++s) { PU_W(dA0, dA1, RA[s].x, xv[2 * s].x, xv[2 * s].y); PU_W(dA0, dA1, RA[s].y, xv[2 * s].z, xv[2 * s].w); PU_W(dA0, dA1, RA[s].z, xv[2 * s + 1].x, xv[2 * s + 1].y); PU_W(dA0, dA1, RA[s].w, xv[2 * s + 1].z, xv[2 * s + 1].w); } \
                _Pragma("unroll") for (int s = 0; s < 4; ++s) { PU_W(dB0, dB1, RB[s].x, xv[2 * s].x, xv[2 * s].y); PU_W(dB0, dB1, RB[s].y, xv[2 * s].z, xv[2 * s].w); PU_W(dB0, dB1, RB[s].z, xv[2 * s + 1].x, xv[2 * s + 1].y); PU_W(dB0, dB1, RB[s].w, xv[2 * s + 1].z, xv[2 * s + 1].w); } \
                const float aA_ = l_us[kA_] * dpp_sum16((dA0 + dA1) - CODE_BIAS * bsum), aB_ = l_us[kB_] * dpp_sum16((dB0 + dB1) - CODE_BIAS * bsum); \
                if (li == 0) { \
                    if ((k0_) + grp < n) { const _Float16 hw = (_Float16)(l_g[kA_] * gelu_as(aA_)); W16[(size_t)t * 128 + l_slot[kA_]] = __builtin_bit_cast(unsigned short, hw); } \
                    if ((k0_) + 4 + grp < n) { const _Float16 hw = (_Float16)(l_g[kB_] * gelu_as(aB_)); W16[(size_t)t * 128 + l_slot[kB_]] = __builtin_bit_cast(unsigned short, hw); } } } while (0)
            PU_RLOAD(qa, qb, 0);
#pragma unroll 1
            for (int k0 = 0; k0 < n; k0 += 16) {
                PU_RLOAD(sa, sb, k0 + 8);
                PU_COMP(qa, qb, k0);
                if (k0 + 8 >= n) break;
                PU_RLOAD(qa, qb, k0 + 16);
                PU_COMP(sa, sb, k0 + 8);
            }
#undef PU_RLOAD
#undef PU_W
#undef PU_COMP
            iw = iwn; gg = ggn; uu = uun;
#pragma unroll
            for (int s = 0; s < 8; ++s) xv[s] = xn[s];
        }
#undef PU_LOAD
    }
}

__device__ __forceinline__ void pv_phase(const Frame& F, ArgsP Ap, int l, int nrows, const bool dry, char* lds) {
    unsigned char* ws = Ap->ws;
    const unsigned short* IDX = (const unsigned short*)(ws + WS_IDX); const unsigned short* W16 = (const unsigned short*)(ws + WS_W2);
    const char* Vt = (const char*)(ws + WS_V + (size_t)l * PEXP * DM);
    const float* MOD = (const float*)(ws + WS_MOD) + (size_t)l * 9 * 6144 + 5 * DM;
    float* hlat = dry ? (float*)(ws + WS_X5) : Ap->out; float* hctx = dry ? (float*)(ws + WS_X5) + (size_t)NLAT * DM : (float*)(ws + WS_HCTX);
    float* g2l = (float*)lds;
    const int lane = F.lane, sub = lane >> 3, dch = lane & 7;
    const bool xs = (F.G % 8) == 0;
    const int wv = xs ? ((F.bid >> 3) * 8 + F.wave) : F.gw, nwv = xs ? (F.G >> 3) * 8 : F.ngw, npass = xs ? 1 : 8;
    for (int pass = 0; pass < npass; ++pass) {
        const int s = xs ? (F.bid & 7) : pass;
        const char* vslice = Vt + (size_t)s * PEXP * 128;
        const unsigned dchb = (unsigned)dch * 16u, coffb = (unsigned)(s * 128 + dch * 16) * 4u, subo = (unsigned)sub * 32u;
        __syncthreads();
        for (int i = F.tid; i < 9 * 128; i += 512) g2l[i] = MOD[(size_t)(i >> 7) * 6144 + s * 128 + (i & 127)];
        __syncthreads();
        u32x4 ia0, ib0, ia1, ib1, rA[8], rB[8], wA, wB; f32x4 h0, h1, h2, h3; float o_[16]; float wsum;
#define PV_IDX(IA, IB, t_) do { const char* ib_ = (const char*)(IDX + (size_t)(t_) * 128); IA = *(const u32x4*)(ib_ + subo); IB = *(const u32x4*)(ib_ + subo + 16u); } while (0)
#define PV_ROWS8(R, I) do { const unsigned iw_[4] = {I.x, I.y, I.z, I.w}; \
            _Pragma("unroll") for (int it = 0; it < 8; ++it) { const unsigned e_ = (it & 1) ? (iw_[it >> 1] >> 16) : (iw_[it >> 1] & 0xffffu); R[it] = *(const u32x4*)(vslice + (e_ * 128u + dchb)); } } while (0)
#define PV_ROWSA(IA, t_) do { PV_ROWS8(rA, IA); wA = *(const u32x4*)((const char*)(W16 + (size_t)(t_) * 128) + subo); } while (0)
#define PV_ROWSB(IB, t_) do { PV_ROWS8(rB, IB); wB = *(const u32x4*)((const char*)(W16 + (size_t)(t_) * 128) + subo + 16u); \
            { const char* hr_ = (const char*)(((t_) < NLAT) ? (hlat + (size_t)(t_) * DM) : (hctx + (size_t)((t_) - NLAT) * DM));     \
              h0 = *(const f32x4*)(hr_ + coffb); h1 = *(const f32x4*)(hr_ + coffb + 16u); h2 = *(const f32x4*)(hr_ + coffb + 32u); h3 = *(const f32x4*)(hr_ + coffb + 48u); } } while (0)
#define PV_C4(A_, B_, wp_, base_) do { \
            o_[(base_) + 0] = dot2h(__builtin_amdgcn_perm((B_), (A_), 0x0C040C00u) | 0x64006400u, (wp_), o_[(base_) + 0]); o_[(base_) + 1] = dot2h(__builtin_amdgcn_perm((B_), (A_), 0x0C050C01u) | 0x64006400u, (wp_), o_[(base_) + 1]); \
            o_[(base_) + 2] = dot2h(__builtin_amdgcn_perm((B_), (A_), 0x0C060C02u) | 0x64006400u, (wp_), o_[(base_) + 2]); o_[(base_) + 3] = dot2h(__builtin_amdgcn_perm((B_), (A_), 0x0C070C03u) | 0x64006400u, (wp_), o_[(base_) + 3]); } while (0)
#define PV_SUM8(R, W) do { const unsigned ww_[4] = {W.x, W.y, W.z, W.w}; \
            _Pragma("unroll") for (int m = 0; m < 4; ++m) { const u32x4 ra_ = R[2 * m], rb_ = R[2 * m + 1]; const unsigned wp_ = ww_[m]; wsum = dot2h(wp_, H_ONES, wsum); \
                PV_C4(ra_.x, rb_.x, wp_, 0); PV_C4(ra_.y, rb_.y, wp_, 4); PV_C4(ra_.z, rb_.z, wp_, 8); PV_C4(ra_.w, rb_.w, wp_, 12); } } while (0)
#define PV_FINA() do { _Pragma("unroll") for (int i = 0; i < 16; ++i) o_[i] = 0.f; wsum = 0.f; PV_SUM8(rA, wA); } while (0)
#define PV_FINB(t_) do { PV_SUM8(rB, wB); \
            const float wsr_ = sum_b345(wsum) * CODE_BIAS; \
            _Pragma("unroll") for (int i = 0; i < 16; ++i) o_[i] = (sum_b345(o_[i]) - wsr_) * (1.f / 1024.f); \
            { const bool lat_ = (t_) < NLAT; float* hr_ = (float*)((char*)(lat_ ? (hlat + (size_t)(t_) * DM) : (hctx + (size_t)((t_) - NLAT) * DM)) + coffb); \
                const f32x4* g2_ = (const f32x4*)(g2l + (lat_ ? ((t_) >> 12) : 8) * 128 + dch * 16); \
                  \
                *(f32x4*)hr_ = h0 + g2_[0] * (f32x4){o_[0], o_[1], o_[2], o_[3]}; *(f32x4*)(hr_ + 4) = h1 + g2_[1] * (f32x4){o_[4], o_[5], o_[6], o_[7]}; \
                *(f32x4*)(hr_ + 8) = h2 + g2_[2] * (f32x4){o_[8], o_[9], o_[10], o_[11]}; *(f32x4*)(hr_ + 12) = h3 + g2_[3] * (f32x4){o_[12], o_[13], o_[14], o_[15]}; } } while (0)
        int t = wv;
        if (t < nrows) { PV_IDX(ia0, ib0, t); PV_ROWSA(ia0, t); }
        for (; t + 2 * nwv < nrows; t += 2 * nwv) {
            PV_IDX(ia1, ib1, t + nwv);     PV_ROWSB(ib0, t);       PV_FINA(); PV_ROWSA(ia1, t + nwv);     PV_FINB(t);
            PV_IDX(ia0, ib0, t + 2 * nwv); PV_ROWSB(ib1, t + nwv); PV_FINA(); PV_ROWSA(ia0, t + 2 * nwv); PV_FINB(t + nwv);
        }
        for (; t < nrows; t += 2 * nwv) {
            const int t1 = t + nwv;
            if (t1 < nrows) PV_IDX(ia1, ib1, t1);
            PV_ROWSB(ib0, t); PV_FINA();
            if (t1 < nrows) PV_ROWSA(ia1, t1);
            PV_FINB(t);
            if (t1 < nrows) { PV_ROWSB(ib1, t1); PV_FINA(); PV_FINB(t1); }
        }
#undef PV_IDX
#undef PV_ROWS8
#undef PV_ROWSA
#undef PV_ROWSB
#undef PV_C4
#undef PV_SUM8
#undef PV_FINA
#undef PV_FINB
    }
}
constexpr int PH_PER_LAYER = 12, N_PHASES = 1 + DEPTH * PH_PER_LAYER;
#ifndef MK_ONE_LAUNCH
#define MK_ONE_LAUNCH 0
#endif
#ifndef MK_MASK
#define MK_MASK 0x1FFF
#endif
#define PON(s) (((MK_MASK) >> (s)) & 1)

#ifndef DBG_NAIVE_GEMM
#define DBG_NAIVE_GEMM 0
#endif
#if DBG_NAIVE_GEMM
__device__ __forceinline__ void naive_gemm(const Frame& F, const pg8::Gemm g, int kind, const pg8::EpiStore es, const pg8::EpiResid er) {
    const int ncg = g.N / 64; const int nunits = g.M * ncg;
    for (int u = F.gw; u < nunits; u += F.ngw) {
        const int row = __builtin_amdgcn_readfirstlane(u / ncg), col = (u % ncg) * 64 + F.lane;
        const bf16* ar = g.A + (size_t)row * g.K; const bf16* br = g.Bt + (size_t)col * g.K; float acc = 0.f;
#pragma unroll 1
        for (int k = 0; k < g.K; k += 8) { const u32x4 a = *(const u32x4*)(ar + k), b = *(const u32x4*)(br + k); float x[8], y[8]; unpack8(a, x); unpack8(b, y);
#pragma unroll
            for (int e = 0; e < 8; ++e) acc = fmaf(x[e], y[e], acc); }
        if (kind == 0) { if (col < es.ncols) es.O[(size_t)row * es.ldc + col] = (bf16)(pk2(acc, 0.f) & 0xffffu); }
        else if (kind == 1) { const int head = col >> 7, j = col & 127; bf16* d = (j < 64) ? (es.O + (size_t)row * 768 + head * 96 + j) : (es.VM + (size_t)row * 512 + head * 64 + (j - 64)); *d = (bf16)(pk2(acc, 0.f) & 0xffffu); }
        else { const bool lat = row < er.nlat; const int sample = lat ? (row >> 12) : 8;
            const float* src = lat ? er.hin_lat + (size_t)row * 1024 : er.hin_ctx + (size_t)(row - er.nlat) * 1024; float* dst = lat ? er.hout_lat + (size_t)row * 1024 : er.hout_ctx + (size_t)(row - er.nlat) * 1024;
            dst[col] = src[col] + er.gate[(size_t)sample * 6144 + col] * acc; }
    }
}
#endif

__global__ void __launch_bounds__(512, 2) mk_fwd(Args args_unused) {
    extern __shared__ __attribute__((aligned(16))) unsigned char lds[];
    LAS unsigned char* lds3 = (LAS unsigned char*)lds;
    ArgsP args0 = (ArgsP)__builtin_amdgcn_kernarg_segment_ptr();
    const int ph_lo = args0->ph_lo, ph_hi = args0->ph_hi;
    const int wave_s = __builtin_amdgcn_readfirstlane((int)threadIdx.x >> 6);
#if MK_ONE_LAUNCH == 2
    {
        volatile LAS unsigned* st = (volatile LAS unsigned*)(lds3 + LDS_BYTES - 64);
        if (threadIdx.x < 2) st[threadIdx.x] = 0u;
        __syncthreads();
        (void)xcd_barrier_post((unsigned*)(args0->ws + WS_CTL), st, threadIdx.x == 0);
    }
#endif
#pragma unroll 1
    for (int pi = ph_lo; pi < ph_hi; ++pi) {
        int zv = 0; asm volatile("" : "+v"(zv));
        ArgsP args = args0; asm volatile("" : "+s"(args));
        Frame F;
        F.zv = zv; F.lane = (int)__builtin_amdgcn_mbcnt_hi(~0u, __builtin_amdgcn_mbcnt_lo(~0u, 0u)) + zv; F.wave = wave_s; F.tid = wave_s * 64 + F.lane;
        { int bx = blockIdx.x, gd = gridDim.x; asm volatile("" : "+s"(bx), "+s"(gd)); F.bid = bx; F.G = gd; F.vcu = (gd % 8 == 0) ? (bx % 8) * (gd / 8) + bx / 8 : bx; }
        F.gw = F.bid * 8 + F.wave; F.ngw = F.G * 8;
        unsigned char* ws = args->ws;
        const int phraw = args->prog[pi], ph = phraw & 63, pvar = phraw >> 6;
        int njobs = 0, jkind = 0;
        pg8::Gemm gj[2]; pg8::EpiStore ej[2];
        int l = 0, mrows = NROWS;
        if (ph == 0) { if (PON(12)) p0_prologue(F, args, lds3); }
        else if (ph == 63) {   }
        else {
            const int q = ph - 1, s = q % PH_PER_LAYER; l = q / PH_PER_LAYER;
            mrows = (l == DEPTH - 1) ? NLAT : NROWS;
            switch (s) {
            case 0: if (PON(0)) norm_mod_phase(F, args, l, 0, NROWS); break;
            case 1: if (PON(1)) { njobs = 1;
                gj[0] = pg8::Gemm{(const bf16*)(ws + WS_AB), (const bf16*)(ws + WS_WIN) + (size_t)l * DINP * DM, NROWS, DINP, DM};
                ej[0] = pg8::EpiStore{0, (bf16*)(ws + WS_P), DIN, DIN, nullptr}; } break;
            case 2: if (PON(2)) e2_phase(F, args, l, NROWS); break;
            case 3: if (PON(3)) { njobs = 2;
                gj[0] = pg8::Gemm{(const bf16*)(ws + WS_AB), (const bf16*)(ws + WS_WUQ) + (size_t)l * 768 * QRANK, NROWS, 768, QRANK};
                ej[0] = pg8::EpiStore{0, (bf16*)(ws + WS_QM), 768, 768, nullptr};
                gj[1] = pg8::Gemm{(const bf16*)(ws + WS_AB) + (size_t)NROWS * QRANK, (const bf16*)(ws + WS_WUKV) + (size_t)l * 1024 * KVRANK, NROWS, 1024, KVRANK};
                ej[1] = pg8::EpiStore{1, (bf16*)(ws + WS_KM), 768, 1024, (bf16*)(ws + WS_VM)}; } break;
            case 4: if (PON(4)) e3_phase(F, args, l, NROWS); break;
            case 5: if (PON(5)) {
#if DBG_NAIVE_ATTN
                attn_naive_phase(F, args, l);
#else
                attn_phase(F, args, l, (char*)lds);
#endif
                } break;
            case 6: if (PON(6)) { njobs = 1; jkind = 1;
                gj[0] = pg8::Gemm{(const bf16*)(ws + WS_AB), (const bf16*)(ws + WS_WOUT) + (size_t)l * DM * DM, mrows, DM, DM}; } break;
            case 7: if (PON(7)) norm_mod_phase(F, args, l, 1, mrows); break;
            case 8: if (PON(8)) { njobs = 1;
                gj[0] = pg8::Gemm{(const bf16*)(ws + WS_AB), (const bf16*)(ws + WS_PWQ) + (size_t)l * 2048 * DM, mrows, 2048, DM};
                ej[0] = pg8::EpiStore{0, (bf16*)(ws + WS_X5), 2048, 2048, nullptr}; } break;
            case 9: if (PON(9)) topkc_phase(F, args, l, mrows, (char*)lds); break;
            case 10: if (PON(10)) pu_phase(F, args, l, mrows, (char*)lds, pvar); break;
            default: if (PON(11)) pv_phase(F, args, l, mrows, pvar != 0, (char*)lds); break;
            }
        }
        if (njobs > 0) {
#if DBG_NAIVE_GEMM
            { const pg8::EpiResid ER{(l == 0) ? args->in[0] : args->out, args->in[2], args->out, (float*)(ws + WS_HCTX), (const float*)(ws + WS_MOD) + (size_t)l * 9 * 6144 + 2 * DM, NLAT};
              _Pragma("unroll 1") for (int j = 0; j < njobs; ++j) { const pg8::Gemm g = (j == 0) ? gj[0] : gj[1]; const pg8::EpiStore E = (j == 0) ? ej[0] : ej[1]; naive_gemm(F, g, jkind ? 2 : E.mode, E, ER); } }
#else
            if (jkind == 0) {
#pragma unroll 1
                for (int j = 0; j < njobs; ++j) { __syncthreads();
                    const pg8::Gemm g = (j == 0) ? gj[0] : gj[1]; const pg8::EpiStore E = (j == 0) ? ej[0] : ej[1];
                    pg8::StaticOrder S; S.init(g.M, g.N, F.G, F.bid);
                    pg8::gemm_phase<pg8::EpiStore, pg8::StaticOrder, true, true>(lds3, g, S, E, F.tid); }
            } else { __syncthreads();
                const pg8::Gemm g = gj[0];
                pg8::StaticOrder S; S.init(g.M, g.N, F.G, F.bid);
                pg8::EpiResid E{(l == 0) ? args->in[0] : args->out, args->in[2], args->out, (float*)(ws + WS_HCTX), (const float*)(ws + WS_MOD) + (size_t)l * 9 * 6144 + 2 * DM, NLAT};
                pg8::gemm_phase<pg8::EpiResid, pg8::StaticOrder, true, true>(lds3, g, S, E, F.tid); }
#endif
        }
#if MK_ONE_LAUNCH == 1
        if (pi + 1 < ph_hi) cg::this_grid().sync();
#elif MK_ONE_LAUNCH == 2
        if (pi + 1 < ph_hi) { XcdBarrier xb; xb.bar = (unsigned*)(ws + WS_CTL); xb.x = xb_xcc_id(); xb.st = (volatile LAS unsigned*)(lds3 + LDS_BYTES - 64); xcd_barrier(xb, F.tid == 0); }
#endif
    }
}

extern "C" void kernel_launch(void* const* d_in, const int* in_sizes, int n_in, void* d_out, int out_size, void* d_ws, size_t ws_size, hipStream_t stream) {
    static int grid = 0;
    if (grid == 0) {
        if (n_in != 23 || in_sizes[0] != NLAT * DM || out_size != NLAT * DM || ws_size < WS_END) {
            fprintf(stderr, "kernel_launch: unexpected shapes: n_in %d in0 %d out %d ws %zu (need %zu)\n", n_in, n_in > 0 ? in_sizes[0] : -1, out_size, ws_size, (size_t)WS_END); grid = -1; return; }
        int dev = 0, cus = 0, per_cu = 0;
        if (hipGetDevice(&dev) != hipSuccess || hipDeviceGetAttribute(&cus, hipDeviceAttributeMultiprocessorCount, dev) != hipSuccess) { fprintf(stderr, "kernel_launch: device query failed\n"); grid = -1; return; }
        if (hipFuncSetAttribute((const void*)mk_fwd, hipFuncAttributeMaxDynamicSharedMemorySize, LDS_BYTES) != hipSuccess) { fprintf(stderr, "kernel_launch: hipFuncSetAttribute failed\n"); grid = -1; return; }
        if (hipOccupancyMaxActiveBlocksPerMultiprocessor(&per_cu, (const void*)mk_fwd, 512, LDS_BYTES) != hipSuccess || per_cu < 1) { fprintf(stderr, "kernel_launch: occupancy query says %d\n", per_cu); per_cu = 1; }
        (void)hipGetLastError();
        grid = cus;
    }
    if (grid < 0) return;
    Args a{};
    for (int i = 0; i < 23; ++i) a.in[i] = (const float*)d_in[i];
    a.out = (float*)d_out; a.ws = (unsigned char*)d_ws;
    int np = 0;
#ifdef MK_PROG
    { static const int pr[] = {MK_PROG}; for (int i = 0; i < (int)(sizeof(pr) / sizeof(pr[0])); ++i) a.prog[np++] = (unsigned char)pr[i]; }
#else
    for (int p = 0; p < N_PHASES; ++p) a.prog[np++] = (unsigned char)p;
#endif
#if MK_ONE_LAUNCH == 2
    a.ph_lo = 0; a.ph_hi = np;
    if (hipMemsetAsync((char*)d_ws + WS_CTL, 0, CTL_ZERO_BYTES, stream) != hipSuccess) { fprintf(stderr, "kernel_launch: hipMemsetAsync of the barrier words failed\n"); return; }
    hipLaunchKernelGGL(mk_fwd, dim3(grid), dim3(512), LDS_BYTES, stream, a);
    { const hipError_t le = hipPeekAtLastError(); if (le != hipSuccess) fprintf(stderr, "kernel_launch: launch failed: %s\n", hipGetErrorName(le)); }
#elif MK_ONE_LAUNCH == 1
    a.ph_lo = 0; a.ph_hi = np;
    void* kargs[] = {&a};
    hipError_t e = hipLaunchCooperativeKernel((const void*)mk_fwd, dim3(grid), dim3(512), kargs, LDS_BYTES, stream);
    if (e != hipSuccess) fprintf(stderr, "kernel_launch: cooperative launch failed: %s (grid %d)\n", hipGetErrorString(e), grid);
#else
    for (int p = 0; p < np; ++p) {
        a.ph_lo = p; a.ph_hi = p + 1;
        hipLaunchKernelGGL(mk_fwd, dim3(grid), dim3(512), LDS_BYTES, stream, a);
    }
    const hipError_t le = hipPeekAtLastError();
    if (le != hipSuccess) fprintf(stderr, "kernel_launch: launch failed: %s\n", hipGetErrorName(le));
#endif
}
```

```cpp
#define MK_ONE_LAUNCH 2
#define DBG_PRECISE_TOPK 0
#define DBG_NAIVE_ATTN 0
#define DBG_PRECISE_PEER 0
#define DBG_NAIVE_GEMM 0
#define DBG_ASCALE 1.0f
#define DBG_PSCALE 1.0f
#include <hip/hip_runtime.h>
#include <hip/hip_cooperative_groups.h>
#include <cstdio>
#include <cstdint>
#include <cmath>
namespace cg = cooperative_groups;
namespace pg8 {
#define PG8_LAS __attribute__((address_space(3)))
typedef unsigned short bf16_t;
typedef short bf16x8 __attribute__((ext_vector_type(8)));
typedef float f32x4 __attribute__((ext_vector_type(4)));
typedef unsigned u32x4 __attribute__((ext_vector_type(4)));
constexpr int BM = 256, BK = 64, HALF = 128, HTB = HALF * BK * 2  , STAGE_BYTES = 8 * HTB, NXCD = 8, WGM = 8;

__host__ __device__ __forceinline__ int lds_byte(int r, int c) { const int st = (r >> 4) * 2 + (c >> 5), rr = r & 15, cc = c & 31, ob = rr * 64 + cc * 2; return st * 1024 + (ob ^ (((ob >> 9) & 1) << 5)); }
__host__ __device__ __forceinline__ void stage_rc(int b, int& R, int& C) { const int st = b / 1024, sb = b % 1024, swz = sb ^ (((sb >> 9) & 1) << 5); R = (st >> 1) * 16 + swz / 64; C = (st & 1) * 32 + (swz % 64) / 2; }
__host__ __device__ __forceinline__ int perm32(int rho) { const int n = rho >> 4, i = rho & 15; return 8 * (i >> 2) + 4 * n + (i & 3); }

struct Unit { int pm, pn; };
struct Gemm { const bf16_t* A; const bf16_t* Bt; int M, N, K; };

struct StaticOrder {
    int nM, nN, nwg, G, c;
    __host__ __device__ void init(int M, int N, int G_, int c_) { nM = M / BM; nN = N / BM; nwg = nM * nN; G = G_; c = c_; }
    __host__ __device__ bool next(int i, Unit& u) const {
        const long L = (long)i * G + c; if (L >= nwg) return false;
        int wgid = (int)L; { const int q = nwg / NXCD, r = nwg % NXCD, xcd = wgid % NXCD, off = wgid / NXCD; wgid = (xcd < r ? xcd * (q + 1) : r * (q + 1) + (xcd - r) * q) + off; }
        const int nig = WGM * nN, gid = wgid / nig, fm = gid * WGM, gsz = (nM - fm) < WGM ? (nM - fm) : WGM;
        u.pm = fm + ((wgid % nig) % gsz); u.pn = (wgid % nig) / gsz; return true;
    }
    __device__ __forceinline__ void a_ready(const Unit&) const {}
    __device__ __forceinline__ void done(const Unit&) const {}
};

typedef float cvt_f32x2 __attribute__((ext_vector_type(2))); typedef __bf16 cvt_bf16x2 __attribute__((ext_vector_type(2)));
__device__ __forceinline__ unsigned cvt_pk_bf16(float lo, float hi) { const cvt_f32x2 v = {lo, hi}; const cvt_bf16x2 b = __builtin_convertvector(v, cvt_bf16x2); return __builtin_bit_cast(unsigned, b); }
typedef float f32x2 __attribute__((ext_vector_type(2)));
typedef unsigned u32x2 __attribute__((ext_vector_type(2)));
#ifndef DBG_ASCALE
#define DBG_ASCALE 1.0f
#endif
#ifndef DBG_PSCALE
#define DBG_PSCALE 1.0f
#endif
struct EpiStore {
    static constexpr bool PERM = true, AFTER_DRAIN = false;
    int mode; bf16_t* O; int ldc; int ncols; bf16_t* VM;
    __device__ __forceinline__ void operator()(const f32x4 (&acc)[2][2][4][2], const Unit& u, int wr, int wc, int fr, int fq) const {
        const int row0 = u.pm * BM + wr * 64 + fr;
        bf16_t* base; int rstride, hstride; bool on0, on1;
        if (mode == 0) { const int col0 = u.pn * BM + wc * 32 + 8 * fq; base = O + (size_t)row0 * ldc + col0; rstride = ldc; hstride = HALF; on0 = col0 < ncols; on1 = col0 + HALF < ncols; }
        else {
            const int j = wc * 32 + 8 * fq; const bool isk = wc < 2;
            base = isk ? (O + (size_t)row0 * 768 + (2 * u.pn) * 96 + j) : (VM + (size_t)row0 * 512 + (2 * u.pn) * 64 + (j - 64));
            rstride = isk ? 768 : 512; hstride = isk ? 96 : 64; on0 = true; on1 = true; }
#pragma unroll
        for (int ai = 0; ai < 2; ++ai)
#pragma unroll
            for (int m = 0; m < 4; ++m) { bf16_t* rowp = base + (size_t)(ai * HALF + m * 16) * rstride;
#pragma unroll
                for (int bj = 0; bj < 2; ++bj) {
                    if (bj == 0 ? on0 : on1) { const f32x4 v0 = acc[ai][bj][m][0], v1 = acc[ai][bj][m][1]; u32x4 w;
                        w.x = cvt_pk_bf16(v0[0], v0[1]); w.y = cvt_pk_bf16(v0[2], v0[3]); w.z = cvt_pk_bf16(v1[0], v1[1]); w.w = cvt_pk_bf16(v1[2], v1[3]);
                        *(u32x4*)(rowp + bj * hstride) = w; } } }
    }
};
struct EpiResid {
    static constexpr bool PERM = false, AFTER_DRAIN = false;
    const float* hin_lat; const float* hin_ctx; float* hout_lat; float* hout_ctx; const float* gate; int nlat;
    __device__ __forceinline__ void operator()(const f32x4 (&acc)[2][2][4][2], const Unit& u, int wr, int wc, int fr, int fq) const {
        const int rowt = u.pm * BM; const bool lat = rowt < nlat; const int sample = lat ? (rowt >> 12) : 8;
        const float* src = lat ? hin_lat + (size_t)rowt * 1024 : hin_ctx + (size_t)(rowt - nlat) * 1024;
        float* dst = lat ? hout_lat + (size_t)rowt * 1024 : hout_ctx + (size_t)(rowt - nlat) * 1024;
        const float* g = gate + (size_t)sample * 6144;
        const int col0 = u.pn * BM + wc * 32 + 4 * fq;
#pragma unroll
        for (int bj = 0; bj < 2; ++bj)
#pragma unroll
            for (int n = 0; n < 2; ++n) { const int c = col0 + bj * HALF + n * 16; const f32x4 gv = *(const f32x4*)(g + c);
#pragma unroll
                for (int ai = 0; ai < 2; ++ai)
#pragma unroll
                    for (int m = 0; m < 4; ++m) { const size_t off = (size_t)(ai * HALF + wr * 64 + m * 16 + fr) * 1024 + c;
                        const f32x4 hv = *(const f32x4*)(src + off); *(f32x4*)(dst + off) = hv + gv * acc[ai][bj][m][n] * (float)(DBG_ASCALE); } }
    }
};
template <class Epi, class Sched, bool ALIGN_EPI = false, bool SP2 = false>
__device__ __forceinline__ void gemm_phase(PG8_LAS unsigned char* lds, const Gemm g, const Sched& S, const Epi& E, const int tid_in) {
    const int tid = tid_in, wid = __builtin_amdgcn_readfirstlane(tid >> 6), lane = tid & 63, wr = wid >> 2, wc = wid & 3, fr = lane & 15, fq = lane >> 4;
    const int K = g.K, nt = K / BK;
    unsigned voffA[2], voffB[2];
#pragma unroll
    for (int i = 0; i < 2; ++i) { int R, C; stage_rc(tid * 16 + i * 8192, R, C); const int Rb = Epi::PERM ? ((R & ~31) + perm32(R & 31)) : R;
        voffA[i] = (unsigned)(R * K + C) * 2u; voffB[i] = (unsigned)(Rb * K + C) * 2u; }
    const size_t kstep = (size_t)(BK * 2);
    const size_t hstep = (size_t)HALF * K * 2;
    const size_t tstep = 2 * hstep;
    const unsigned ldsw = (unsigned)wid * 1024u;
    const int aoff = lds_byte(wr * 64 + fr, fq * 8), boff = lds_byte(wc * 32 + fr, fq * 8);
#define PG8_SA(b, h) (((b) * 2 + (h)) * HTB)
#define PG8_SB(b, h) ((4 + (b) * 2 + (h)) * HTB)
#define PG8_STAGE(bufoff, gbase, voff) do { _Pragma("unroll") for (int _i = 0; _i < 2; ++_i) \
        __builtin_amdgcn_global_load_lds((const unsigned*)((const char*)(gbase) + (voff)[_i]), (PG8_LAS unsigned*)(lds + (bufoff) + ldsw + _i * 8192), 16, 0, 0); } while (0)
#define PG8_LDA(dst, b, h) do { _Pragma("unroll") for (int m = 0; m < 4; ++m) _Pragma("unroll") for (int k = 0; k < 2; ++k) dst[m][k] = *(const PG8_LAS bf16x8*)(lds + PG8_SA(b, h) + aoff + m * 2048 + k * 1024); } while (0)
#define PG8_LDB(dst, b, h) do { _Pragma("unroll") for (int n = 0; n < 2; ++n) _Pragma("unroll") for (int k = 0; k < 2; ++k) dst[n][k] = *(const PG8_LAS bf16x8*)(lds + PG8_SB(b, h) + boff + n * 2048 + k * 1024); } while (0)
#define PG8_MMA(ai, bj, At, Bt) do { __builtin_amdgcn_s_setprio(1); _Pragma("unroll") for (int m = 0; m < 4; ++m) _Pragma("unroll") for (int n = 0; n < 2; ++n) _Pragma("unroll") for (int k = 0; k < 2; ++k) \
        acc[ai][bj][m][n] = __builtin_amdgcn_mfma_f32_16x16x32_bf16(Bt[n][k], At[m][k], acc[ai][bj][m][n], 0, 0, 0); __builtin_amdgcn_s_setprio(0); } while (0)
#define PG8_WAIT_V(n) asm volatile("s_waitcnt vmcnt(" #n ")" ::: "memory")
#define PG8_WAIT_L(n) asm volatile("s_waitcnt lgkmcnt(" #n ")" ::: "memory")
#define PG8_BAR __builtin_amdgcn_s_barrier()
#define PG8_SCHED __builtin_amdgcn_sched_barrier(0)
    Unit cur, nxt; int ui = 0;
    if (!S.next(0, cur)) return;
    f32x4 acc[2][2][4][2];
#pragma unroll
    for (int a = 0; a < 2; ++a)
#pragma unroll
        for (int b = 0; b < 2; ++b)
#pragma unroll
            for (int m = 0; m < 4; ++m)
#pragma unroll
                for (int n = 0; n < 2; ++n) acc[a][b][m][n] = (f32x4){0.f, 0.f, 0.f, 0.f};
    bf16x8 At[4][2], B0[2][2], B1[2][2];
    const char* cA = (const char*)g.A + (size_t)cur.pm * tstep; const char* cB = (const char*)g.Bt + (size_t)cur.pn * tstep;
    S.a_ready(cur);
    if constexpr (SP2) {
        PG8_STAGE(PG8_SB(0, 0), cB, voffB); PG8_STAGE(PG8_SB(0, 1), cB + hstep, voffB); PG8_STAGE(PG8_SA(0, 0), cA, voffA); PG8_STAGE(PG8_SA(0, 1), cA + hstep, voffA);
        if (wr == 1) PG8_BAR;
        PG8_WAIT_V(2); PG8_BAR;
        PG8_STAGE(PG8_SB(1, 0), cB + kstep, voffB); PG8_STAGE(PG8_SA(1, 0), cA + kstep, voffA); PG8_STAGE(PG8_SB(1, 1), cB + hstep + kstep, voffB);
        PG8_WAIT_V(6); PG8_BAR;
    } else {
        PG8_STAGE(PG8_SB(0, 0), cB, voffB); PG8_STAGE(PG8_SA(0, 0), cA, voffA); PG8_STAGE(PG8_SB(0, 1), cB + hstep, voffB); PG8_STAGE(PG8_SA(0, 1), cA + hstep, voffA);
        if (wr == 1) PG8_BAR;
        PG8_WAIT_V(4); PG8_BAR;
        PG8_STAGE(PG8_SB(1, 0), cB + kstep, voffB); PG8_STAGE(PG8_SA(1, 0), cA + kstep, voffA); PG8_STAGE(PG8_SB(1, 1), cB + hstep + kstep, voffB);
        PG8_WAIT_V(6); PG8_BAR;
    }
    for (;;) {
        const bool has_next = S.next(ui + 1, nxt);
        const char* nA = has_next ? (const char*)g.A + (size_t)nxt.pm * tstep : cA; const char* nB = has_next ? (const char*)g.Bt + (size_t)nxt.pn * tstep : cB;
        _Pragma("unroll 1") for (int t = 0; t < nt; t += 2) {
            const bool last = (t == nt - 2);
            const char* a1 = cA + (size_t)(t + 1) * kstep;
            const char* a2 = last ? nA : cA + (size_t)(t + 2) * kstep; const char* b2 = last ? nB : cB + (size_t)(t + 2) * kstep;
            const char* a3 = a2 + kstep; const char* b3 = b2 + kstep;
            if (last && has_next) S.a_ready(nxt);
            if constexpr (SP2) {
            PG8_LDB(B0, 0, 0); PG8_LDB(B1, 0, 1); PG8_SCHED; PG8_LDA(At, 0, 0); PG8_STAGE(PG8_SA(1, 1), a1 + hstep, voffA);
            PG8_WAIT_V(8); PG8_WAIT_L(0); PG8_BAR; PG8_MMA(0, 0, At, B0); PG8_MMA(0, 1, At, B1); PG8_BAR; PG8_SCHED;
            PG8_LDA(At, 0, 1); PG8_STAGE(PG8_SB(0, 0), b2, voffB); PG8_STAGE(PG8_SB(0, 1), b2 + hstep, voffB); PG8_STAGE(PG8_SA(0, 0), a2, voffA);
            PG8_WAIT_V(8); PG8_WAIT_L(0); PG8_BAR; PG8_MMA(1, 0, At, B0); PG8_MMA(1, 1, At, B1); PG8_BAR; PG8_SCHED;
            PG8_LDB(B0, 1, 0); PG8_LDB(B1, 1, 1); PG8_SCHED; PG8_LDA(At, 1, 0); PG8_STAGE(PG8_SA(0, 1), a2 + hstep, voffA);
            PG8_WAIT_V(8); PG8_WAIT_L(0); PG8_BAR; PG8_MMA(0, 0, At, B0); PG8_MMA(0, 1, At, B1); PG8_BAR; PG8_SCHED;
            PG8_LDA(At, 1, 1); PG8_STAGE(PG8_SB(1, 0), b3, voffB); PG8_STAGE(PG8_SB(1, 1), b3 + hstep, voffB); PG8_STAGE(PG8_SA(1, 0), a3, voffA);
            PG8_WAIT_V(8); PG8_WAIT_L(0); PG8_BAR; PG8_MMA(1, 0, At, B0); PG8_MMA(1, 1, At, B1); PG8_BAR; PG8_SCHED;
            } else {
            PG8_LDB(B0, 0, 0); PG8_SCHED; PG8_LDA(At, 0, 0); PG8_STAGE(PG8_SA(1, 1), a1 + hstep, voffA);
            PG8_WAIT_L(8); PG8_BAR; PG8_WAIT_L(0); PG8_MMA(0, 0, At, B0); PG8_BAR; PG8_SCHED;
            PG8_LDB(B1, 0, 1); PG8_STAGE(PG8_SB(0, 0), b2, voffB);
            PG8_BAR; PG8_WAIT_L(0); PG8_MMA(0, 1, At, B1); PG8_BAR;
            PG8_LDA(At, 0, 1); PG8_STAGE(PG8_SA(0, 0), a2, voffA);
            PG8_BAR; PG8_WAIT_L(0); PG8_MMA(1, 0, At, B0); PG8_BAR; PG8_SCHED;
            PG8_STAGE(PG8_SB(0, 1), b2 + hstep, voffB);
            PG8_WAIT_V(6); PG8_BAR; PG8_MMA(1, 1, At, B1); PG8_BAR;
            PG8_LDB(B0, 1, 0); PG8_SCHED; PG8_LDA(At, 1, 0); PG8_STAGE(PG8_SA(0, 1), a2 + hstep, voffA);
            PG8_WAIT_L(8); PG8_BAR; PG8_WAIT_L(0); PG8_MMA(0, 0, At, B0); PG8_BAR; PG8_SCHED;
            PG8_LDB(B1, 1, 1); PG8_STAGE(PG8_SB(1, 0), b3, voffB);
            PG8_BAR; PG8_WAIT_L(0); PG8_MMA(0, 1, At, B1); PG8_BAR;
            PG8_LDA(At, 1, 1); PG8_STAGE(PG8_SA(1, 0), a3, voffA);
            PG8_BAR; PG8_WAIT_L(0); PG8_MMA(1, 0, At, B0); PG8_BAR; PG8_SCHED;
            PG8_STAGE(PG8_SB(1, 1), b3 + hstep, voffB);
            PG8_WAIT_V(6); PG8_BAR; PG8_MMA(1, 1, At, B1); PG8_BAR;
            }
        }
        if constexpr (ALIGN_EPI) { if (wr == 0) PG8_BAR; }
        if constexpr (!Epi::AFTER_DRAIN) { E(acc, cur, wr, wc, fr, fq); S.done(cur); }
        if (!has_next) break;
#pragma unroll
        for (int a = 0; a < 2; ++a)
#pragma unroll
            for (int b = 0; b < 2; ++b)
#pragma unroll
                for (int m = 0; m < 4; ++m)
#pragma unroll
                    for (int n = 0; n < 2; ++n) acc[a][b][m][n] = (f32x4){0.f, 0.f, 0.f, 0.f};
        cur = nxt; cA = nA; cB = nB; ++ui;
        if constexpr (ALIGN_EPI) { if (wr == 1) PG8_BAR; }
    }
    PG8_WAIT_V(0);
    if constexpr (!ALIGN_EPI) { if (wr == 0) PG8_BAR; }
    PG8_BAR;
    if constexpr (Epi::AFTER_DRAIN) { E.fused(acc, cur, wr, wc, fr, fq, lds, wid, lane); S.done(cur); }
#undef PG8_SA
#undef PG8_SB
#undef PG8_STAGE
#undef PG8_LDA
#undef PG8_LDB
#undef PG8_MMA
#undef PG8_WAIT_V
#undef PG8_WAIT_L
#undef PG8_BAR
#undef PG8_SCHED
}
}
constexpr int DM = 1024, NB = 8, SEQ = 4096, CTXL = 256, DEPTH = 2;
constexpr int NLAT = NB * SEQ, NCTX = NB * CTXL, NROWS = NLAT + NCTX;
constexpr int DIN = 1440, DINP = 1536, QRANK = 384, KVRANK = 256;
constexpr int PH = 8, PNK = 128, PDH = 128, PTOPK = 16, PEXP = PNK * PNK;
constexpr float EPS = 1e-6f;
constexpr float LOG2E = 1.4426950408889634f;
constexpr float C_MLA = 0.10206207261596577f * LOG2E;
constexpr float C_SWA = 0.125f * LOG2E;

typedef unsigned short bf16;
typedef short bf16x8 __attribute__((ext_vector_type(8)));
typedef short s16x4 __attribute__((ext_vector_type(4)));
typedef float f32x4 __attribute__((ext_vector_type(4)));
typedef float f32x16 __attribute__((ext_vector_type(16)));
typedef unsigned u32x4 __attribute__((ext_vector_type(4)));
typedef unsigned u32x2v __attribute__((ext_vector_type(2)));
#define LAS __attribute__((address_space(3)))

constexpr size_t MiB = 1u << 20;
constexpr size_t WS_CTL = 0, CTL_ZERO_BYTES = 64 * 1024;
constexpr size_t WS_MOD = 1 * MiB;
constexpr size_t WS_RTS = WS_MOD + 512 * 1024;
constexpr size_t WS_RTM = WS_RTS + 64 * 16 * 2 * 4;
constexpr size_t WS_WIN = 2 * MiB;
constexpr size_t WS_WUQ = WS_WIN + 2ull * DINP * DM * 2;
constexpr size_t WS_WUKV = WS_WUQ + 2ull * 768 * QRANK * 2;
constexpr size_t WS_WOUT = WS_WUKV + 2ull * 1024 * KVRANK * 2;
constexpr size_t WS_PWQ = WS_WOUT + 2ull * 1024 * 1024 * 2;
constexpr size_t WS_PKEY = WS_PWQ + 2ull * 2048 * 1024 * 2;
constexpr size_t WS_HCTX = WS_PKEY + 2ull * 8 * 2 * 128 * 128 * 2;
constexpr size_t WS_US = WS_HCTX + (size_t)NCTX * 1024 * 4;
constexpr size_t WS_VS = WS_US + 2ull * PEXP * 4;
constexpr size_t WS_SB = WS_VS + 2ull * PEXP * 4;
constexpr size_t WS_U = 32 * MiB;
constexpr size_t WS_V = WS_U + 32 * MiB;
constexpr size_t WS_F16B = WS_V + 32 * MiB;
constexpr size_t WS_AB = WS_F16B + (size_t)NROWS * 1024 * 2;
constexpr size_t WS_P = WS_AB + (size_t)NROWS * 1024 * 2;
constexpr size_t WS_X5 = WS_P + (size_t)NROWS * DIN * 2;
constexpr size_t WS_QM = WS_X5, WS_KM = WS_QM + (size_t)NROWS * 768 * 2, WS_VM = WS_KM + (size_t)NROWS * 768 * 2, WS_QS = WS_VM + (size_t)NROWS * 512 * 2,
                 WS_KS = WS_QS + (size_t)NROWS * 512 * 2, WS_END = WS_KS + (size_t)NROWS * 128 * 2;
static_assert(WS_SB + (size_t)NROWS * 4 <= WS_U, "ws map (weights)");
static_assert(WS_END <= 512 * MiB, "ws map");
static_assert((size_t)NROWS * 2048 * 2 <= WS_END - WS_X5, "QP overlay");
static_assert((size_t)NROWS * 1024 <= (size_t)NROWS * DIN * 2, "TK overlay");

constexpr int LDS_BYTES = 163840;

__constant__ float ROPE_INV[24] = {1.0f, 0.5623413324356079f, 0.3162277638912201f, 0.17782793939113617f, 0.10000000149011612f, 0.05623413249850273f, 0.03162277489900589f, 0.017782794311642647f, 0.009999999776482582f, 0.005623413249850273f, 0.003162277629598975f, 0.0017782794311642647f, 0.0010000000474974513f, 0.000562341301701963f, 0.0003162277571391314f, 0.00017782794020604342f, 1.0f, 0.3162277638912201f, 0.10000000149011612f, 0.03162277489900589f, 0.009999999776482582f, 0.003162277629598975f, 0.0010000000474974513f, 0.0003162277571391314f};
struct Args {
    const float* in[23]; float* out; unsigned char* ws; int ph_lo, ph_hi; unsigned char prog[48];
};
typedef const __attribute__((address_space(4))) Args* ArgsP;

struct Frame {
    int tid, lane, wave, G, bid, vcu, gw, ngw, zv;
};

__device__ __forceinline__ float bf_lo(unsigned w) { return __uint_as_float(w << 16); }
__device__ __forceinline__ float bf_hi(unsigned w) { return __uint_as_float(w & 0xffff0000u); }
__device__ __forceinline__ unsigned pk2(float lo, float hi) { return pg8::cvt_pk_bf16(lo, hi); }
__device__ __forceinline__ float wave_sum(float v) {
#pragma unroll
    for (int o = 1; o < 64; o <<= 1) v += __shfl_xor(v, o);
    return v;
}
__device__ __forceinline__ void unpack8(const u32x4 w, float (&x)[8]) {
    x[0] = bf_lo(w.x); x[1] = bf_hi(w.x); x[2] = bf_lo(w.y); x[3] = bf_hi(w.y); x[4] = bf_lo(w.z); x[5] = bf_hi(w.z); x[6] = bf_lo(w.w); x[7] = bf_hi(w.w);
}
__device__ __forceinline__ u32x4 pack8(const float (&x)[8]) {
    u32x4 w; w.x = pk2(x[0], x[1]); w.y = pk2(x[2], x[3]); w.z = pk2(x[4], x[5]); w.w = pk2(x[6], x[7]); return w;
}

__device__ __forceinline__ void p0_transpose_item(const float* W, int K, int N, bf16* WT, LAS float* scr, int item, int lane) {
    const int nblk = N / 32, kb = item / nblk, nb = item % nblk, k0 = 64 * kb, n0 = 32 * nb;
#pragma unroll 8
    for (int i = 0; i < 32; ++i) { const int kk = 2 * i + (lane >> 5); scr[kk * 33 + (lane & 31)] = W[(size_t)(k0 + kk) * N + n0 + (lane & 31)]; }
    asm volatile("s_waitcnt lgkmcnt(0)" ::: "memory");
    const int c = lane & 7;
#pragma unroll
    for (int j = 0; j < 4; ++j) { const int n = (lane >> 3) + 8 * j; const LAS float* s = scr + (8 * c) * 33 + n;
        u32x4 o; o.x = pk2(s[0 * 33], s[1 * 33]); o.y = pk2(s[2 * 33], s[3 * 33]); o.z = pk2(s[4 * 33], s[5 * 33]); o.w = pk2(s[6 * 33], s[7 * 33]);
        *(u32x4*)(WT + (size_t)(n0 + n) * K + k0 + 8 * c) = o; }
    asm volatile("s_waitcnt lgkmcnt(0)" ::: "memory");
}

__device__ __forceinline__ void p0_prologue(const Frame& F, ArgsP Ap, LAS unsigned char* lds) {
    unsigned char* ws = Ap->ws;
#ifdef TRTEST
    if (F.bid == 0 && F.wave == 0) {
        LAS unsigned char* tl = lds + 32768; const int l16 = F.lane & 15, kg = F.lane >> 4;
        for (int i = F.lane; i < 512; i += 64) tl[i] = (unsigned char)((i & 127) + 1 + 3 * (i >> 7));
        __builtin_amdgcn_s_waitcnt(0); __builtin_amdgcn_wave_barrier();
        int code = 2;
        for (int hyp = 0; hyp < 2; ++hyp) {
            const int r = (!hyp) ? (l16 & 7) : (l16 >> 1), c = (!hyp) ? (l16 >> 3) : (l16 & 1);
            const unsigned addr = (unsigned)(uintptr_t)(tl + 128 * kg + 16 * r + 8 * c);
            u32x2v res; asm volatile("ds_read_b64_tr_b8 %0, %1\n\ts_waitcnt lgkmcnt(0)" : "=&v"(res) : "v"(addr) : "memory");
            bool ok = true;
            for (int i = 0; i < 8; ++i) { const unsigned got = ((i < 4 ? res.x : res.y) >> (8 * (i & 3))) & 0xffu; ok = ok && (got == (unsigned)(16 * i + l16 + 1 + 3 * kg)); }
            if (__all(ok) && code == 2) code = hyp;
        }
        if (F.lane == 0) ((float*)(ws + WS_CTL + 40000))[0] = (float)code;
    }
    __syncthreads();
#endif
    const float* c_in = Ap->in[1]; const float* cctx_in = Ap->in[3]; const float* ada_w = Ap->in[4]; const float* ada_b = Ap->in[5];
    for (int task = F.bid; task < 192; task += F.G) {
        const int l = task / 96, cc = task % 96;
        LAS float* sl = (LAS float*)lds;
        LAS float* red = (LAS float*)(lds + 9 * 1024 * 4);
        __syncthreads();
        for (int i = F.tid; i < 9 * 1024; i += 512) { const int s = i >> 10, k = i & 1023; const float x = (s < 8) ? c_in[s * 1024 + k] : cctx_in[k]; sl[i] = x / (1.f + __expf(-x)); }
        __syncthreads();
        const int lg = F.lane >> 4, c0 = cc * 64 + (F.lane & 15) * 4; const int kbase = F.wave * 128 + lg * 32;
        f32x4 acc[9];
#pragma unroll
        for (int s = 0; s < 9; ++s) acc[s] = (f32x4){0.f, 0.f, 0.f, 0.f};
        const float* wp = ada_w + ((size_t)l * 1024 + kbase) * 6144 + c0;
#pragma unroll 16
        for (int kk = 0; kk < 32; ++kk) { const f32x4 w = *(const f32x4*)(wp + (size_t)kk * 6144);
#pragma unroll
            for (int s = 0; s < 9; ++s) acc[s] += w * sl[s * 1024 + kbase + kk]; }
#pragma unroll
        for (int s = 0; s < 9; ++s) *(LAS f32x4*)(red + ((F.wave * 4 + lg) * 9 + s) * 64 + (F.lane & 15) * 4) = acc[s];
        __syncthreads();
        float* MOD = (float*)(ws + WS_MOD);
        for (int i = F.tid; i < 9 * 64; i += 512) { const int s = i >> 6, ci = i & 63; float v = ada_b[l * 6144 + cc * 64 + ci];
#pragma unroll
            for (int w = 0; w < 32; ++w) v += red[(w * 9 + s) * 64 + ci];
            MOD[((size_t)l * 9 + s) * 6144 + cc * 64 + ci] = v; }
        __syncthreads();
    }
    __syncthreads();
    if (F.bid == F.G - 1) {
        float* rts = (float*)(ws + WS_RTS); float* rtm = (float*)(ws + WS_RTM);
        for (int i = F.tid; i < 64 * 24; i += 512) {
            const int pos = i / 24, k = i % 24; const float a = (float)pos * ROPE_INV[k];
            const float rev = a * 0.15915494309189535f;
            const float cs = __builtin_amdgcn_cosf(rev), sn = __builtin_amdgcn_sinf(rev);
            if (k < 16) { rts[(pos * 16 + k) * 2] = cs; rts[(pos * 16 + k) * 2 + 1] = sn; } else { rtm[(pos * 8 + (k - 16)) * 2] = cs; rtm[(pos * 8 + (k - 16)) * 2 + 1] = sn; }
        }
    }
    LAS float* scr = (LAS float*)(lds + F.wave * 16384);
    constexpr int I_WIN = (DM / 64) * (DIN / 32), I_WUQ = (QRANK / 64) * (768 / 32), I_WUKV = (KVRANK / 64) * (1024 / 32), I_WOUT = (DM / 64) * (DM / 32), I_PWQ = (DM / 64) * (2048 / 32);
    constexpr int I_L = I_WIN + I_WUQ + I_WUKV + I_WOUT + I_PWQ;
    for (int it = F.gw; it < 2 * I_L; it += F.ngw) {
        const int l = it / I_L; int r = it % I_L;
        if (r < I_WIN) { p0_transpose_item(Ap->in[8] + (size_t)l * DM * DIN, DM, DIN, (bf16*)(ws + WS_WIN) + (size_t)l * DINP * DM, scr, r, F.lane); continue; } r -= I_WIN;
        if (r < I_WUQ) { p0_transpose_item(Ap->in[10] + (size_t)l * QRANK * 768, QRANK, 768, (bf16*)(ws + WS_WUQ) + (size_t)l * 768 * QRANK, scr, r, F.lane); continue; } r -= I_WUQ;
        if (r < I_WUKV) { p0_transpose_item(Ap->in[12] + (size_t)l * KVRANK * 1024, KVRANK, 1024, (bf16*)(ws + WS_WUKV) + (size_t)l * 1024 * KVRANK, scr, r, F.lane); continue; } r -= I_WUKV;
        if (r < I_WOUT) { p0_transpose_item(Ap->in[18] + (size_t)l * DM * DM, DM, DM, (bf16*)(ws + WS_WOUT) + (size_t)l * DM * DM, scr, r, F.lane); continue; } r -= I_WOUT;
        p0_transpose_item(Ap->in[19] + (size_t)l * DM * 2048, DM, 2048, (bf16*)(ws + WS_PWQ) + (size_t)l * 2048 * DM, scr, r, F.lane);
    }
    { const size_t gt = (size_t)F.bid * 512 + F.tid, nt = (size_t)F.G * 512;
      for (size_t i = gt; i < 2ull * 96 * DM / 8; i += nt) { const size_t l = i / (96 * DM / 8), e = i % (96 * DM / 8);
          *(u32x4*)((bf16*)(ws + WS_WIN) + l * DINP * DM + (size_t)DIN * DM + e * 8) = (u32x4){(unsigned)F.zv, (unsigned)F.zv, (unsigned)F.zv, (unsigned)F.zv}; }
      const size_t NKEY8 = 2ull * 8 * 2 * 128 * 128 / 8;
      for (size_t i = gt; i < NKEY8; i += nt) {
          const float* src = Ap->in[20]; bf16* dst = (bf16*)(ws + WS_PKEY);
          const f32x4 a = *(const f32x4*)(src + i * 8), b = *(const f32x4*)(src + i * 8 + 4);
          u32x4 o; o.x = pk2(a[0], a[1]); o.y = pk2(a[2], a[3]); o.z = pk2(b[0], b[1]); o.w = pk2(b[2], b[3]);
          *(u32x4*)(dst + i * 8) = o; }
    }
    f32x4 x[4], xn[4];
#define Q_SRC(rr_) (Ap->in[21 + (rr_) / (2 * PEXP)] + ((size_t)(((rr_) / PEXP) & 1) * PEXP + (rr_) % PEXP) * DM + 16 * F.lane)
    if (F.gw < 2 * 2 * PEXP) { const float* s0 = Q_SRC(F.gw);
#pragma unroll
        for (int j = 0; j < 4; ++j) x[j] = *(const f32x4*)(s0 + 4 * j); }
    for (int rr = F.gw; rr < 2 * 2 * PEXP; rr += F.ngw) {
        const int tab = rr / (2 * PEXP), lay = (rr / PEXP) & 1, e = rr % PEXP;
        { const int rn = (rr + F.ngw < 2 * 2 * PEXP) ? (rr + F.ngw) : rr; const float* sn = Q_SRC(rn);
#pragma unroll
          for (int j = 0; j < 4; ++j) xn[j] = *(const f32x4*)(sn + 4 * j); }
        float mx = 0.f;
#pragma unroll
        for (int j = 0; j < 4; ++j) mx = fmaxf(fmaxf(fmaxf(mx, fabsf(x[j][0])), fmaxf(fabsf(x[j][1]), fabsf(x[j][2]))), fabsf(x[j][3]));
#pragma unroll
        for (int o = 1; o < 64; o <<= 1) mx = fmaxf(mx, __shfl_xor(mx, o));
        const float inv = (mx > 0.f) ? 127.f / mx : 0.f;
        unsigned w[4]; const int bias = 0;
#pragma unroll
        for (int j = 0; j < 4; ++j) { const unsigned c0 = (unsigned)(bias + (int)rintf(x[j][0] * inv)) & 0xffu, c1 = (unsigned)(bias + (int)rintf(x[j][1] * inv)) & 0xffu, c2 = (unsigned)(bias + (int)rintf(x[j][2] * inv)) & 0xffu, c3 = (unsigned)(bias + (int)rintf(x[j][3] * inv)) & 0xffu;
            w[j] = c0 | (c1 << 8) | (c2 << 16) | (c3 << 24); }
        unsigned char* dst = tab ? (ws + WS_V + (size_t)lay * PEXP * DM + ((size_t)(F.lane >> 3) * PEXP + e) * 128 + (F.lane & 7) * 16)
                                 : (ws + WS_U + ((size_t)lay * PEXP + e) * DM + 16 * F.lane);
        *(u32x4*)dst = (u32x4){w[0], w[1], w[2], w[3]};
        if (F.lane == 0) ((float*)(ws + (tab ? WS_VS : WS_US)))[lay * PEXP + e] = (mx > 0.f) ? mx / 127.f : 1.f;
#pragma unroll
        for (int j = 0; j < 4; ++j) x[j] = xn[j];
    }
#undef Q_SRC
}

#ifndef DBG_PRECISE_TOPK
#define DBG_PRECISE_TOPK 0
#endif
__device__ __forceinline__ void norm_mod_phase(const Frame& F, ArgsP Ap, int l, int which, int nrows, char* lds) {
    unsigned char* ws = Ap->ws;
    const float* MOD = (const float*)(ws + WS_MOD);
    const float* gn = Ap->in[which ? 7 : 6] + l * DM;
    bf16* AB = (bf16*)(ws + WS_AB);
    const bool from_input = (which == 0 && l == 0);
    const float* hlat_ = from_input ? Ap->in[0] : Ap->out; const float* hctx_ = from_input ? Ap->in[2] : (const float*)(ws + WS_HCTX);
#define NM_ROWPTR(r_) (((r_) < NLAT) ? (hlat_ + (size_t)(r_) * DM) : (hctx_ + (size_t)((r_) - NLAT) * DM))
    f32x4 v[4], vn[4];
    if (F.gw < nrows) { const float* hr0 = NM_ROWPTR(F.gw);
#pragma unroll
        for (int j = 0; j < 4; ++j) v[j] = *(const f32x4*)(hr0 + 256 * j + 4 * F.lane); }
    for (int r = F.gw; r < nrows; r += F.ngw) {
        const bool lat = r < NLAT;
        { const int rn = (r + F.ngw < nrows) ? (r + F.ngw) : r; const float* hn = NM_ROWPTR(rn);
#pragma unroll
          for (int j = 0; j < 4; ++j) vn[j] = *(const f32x4*)(hn + 256 * j + 4 * F.lane); }
        const int s = lat ? (r >> 12) : 8;
        const float* mp = MOD + ((size_t)l * 9 + s) * 6144 + (which ? 3 * DM : 0);
        float ss = 0.f; f32x4 bq_[4];
#pragma unroll
        for (int j = 0; j < 4; ++j) ss += (v[j][0] * v[j][0] + v[j][1] * v[j][1]) + (v[j][2] * v[j][2] + v[j][3] * v[j][3]);
        ss = wave_sum(ss);
        const float rinv = rsqrtf(ss * (1.f / DM) + EPS);
#pragma unroll
        for (int j = 0; j < 4; ++j) { const int c = 256 * j + 4 * F.lane;
            const f32x4 g = *(const f32x4*)(gn + c), sh = *(const f32x4*)(mp + c), sc = *(const f32x4*)(mp + DM + c);
            const f32x4 y = v[j] * rinv * g; const f32x4 a = y * (sc + 1.f) + sh;
            u32x2v o; o.x = pk2(a[0], a[1]); o.y = pk2(a[2], a[3]);
            *(u32x2v*)(AB + (size_t)r * DM + c) = o;
            if (which) bq_[j] = a;
            }
        if (which) {
            float mx = 0.f;
#pragma unroll
            for (int j = 0; j < 4; ++j) mx = fmaxf(fmaxf(fmaxf(mx, fabsf(bq_[j][0])), fmaxf(fabsf(bq_[j][1]), fabsf(bq_[j][2]))), fabsf(bq_[j][3]));
#pragma unroll
            for (int o = 1; o < 64; o <<= 1) mx = fmaxf(mx, __shfl_xor(mx, o));
            const float inv = (mx > 0.f) ? 127.f / mx : 0.f;
#pragma unroll
            for (int j = 0; j < 4; ++j) { const unsigned c0 = (unsigned)((int)rintf(bq_[j][0] * inv)) & 0xffu, c1 = (unsigned)((int)rintf(bq_[j][1] * inv)) & 0xffu, c2 = (unsigned)((int)rintf(bq_[j][2] * inv)) & 0xffu, c3 = (unsigned)((int)rintf(bq_[j][3] * inv)) & 0xffu;
                *(unsigned*)(ws + WS_F16B + (size_t)r * DM + 256 * j + 4 * F.lane) = c0 | (c1 << 8) | (c2 << 16) | (c3 << 24); }
            if (F.lane == 0) ((float*)(ws + WS_SB))[r] = (mx > 0.f) ? mx / 127.f : 1.f;
        }
#pragma unroll
        for (int j = 0; j < 4; ++j) v[j] = vn[j];
    }
#undef NM_ROWPTR
}

#define E2_DPP(v, CTRL) __builtin_bit_cast(float, __builtin_amdgcn_update_dpp(0, __builtin_bit_cast(int, (v)), (CTRL), 0xF, 0xF, true))
__device__ __forceinline__ void e2_phase(const Frame& F, ArgsP Ap, int l, int nrows, char* lds) {
    unsigned char* ws = Ap->ws;
    const bf16* P = (const bf16*)(ws + WS_P);
    bf16* QAN = (bf16*)(ws + WS_AB); bf16* KVAN = QAN + (size_t)NROWS * QRANK;
    bf16* QS = (bf16*)(ws + WS_QS); bf16* KS = (bf16*)(ws + WS_KS);
    const float* qa_g = Ap->in[9] + l * QRANK; const float* kva_g = Ap->in[11] + l * KVRANK;
    const float* sqn_g = Ap->in[15] + l * 64; const float* skn_g = Ap->in[16] + l * 64;
    float* rt = (float*)lds;
    __syncthreads();
    for (int i = F.tid; i < 64 * 32; i += 512) rt[i] = ((const float*)(ws + WS_RTS))[i];
    __syncthreads();
    const int lane = F.lane;
    const int lqa = (lane < 48) ? lane : 47, lkva = (lane < 32) ? lane : 31, lsk = (lane < 16) ? lane : 15;
    float g_qa[8], g_kva[8], g_sq[8], g_sk[8];
#pragma unroll
    for (int e = 0; e < 8; ++e) { g_qa[e] = qa_g[8 * lqa + e]; g_kva[e] = kva_g[8 * lkva + e]; g_sq[e] = sqn_g[8 * (lane & 7) + e] * C_SWA; g_sk[e] = skn_g[8 * (lane & 7) + e]; }
    u32x4 wqa, wsq, wkva, wsk, nqa, nsq, nkva, nsk;
#define E2_LOAD(A_, B_, C_, D_, r_) do { const bf16* pr_ = P + (size_t)(r_) * DIN; A_ = *(const u32x4*)(pr_ + 8 * lqa); B_ = *(const u32x4*)(pr_ + QRANK + 8 * lane); C_ = *(const u32x4*)(pr_ + 896 + 8 * lkva); D_ = *(const u32x4*)(pr_ + 1184 + 8 * lsk); } while (0)
    if (F.gw < nrows) E2_LOAD(wqa, wsq, wkva, wsk, F.gw);
    for (int r = F.gw; r < nrows; r += F.ngw) {
        const bool lat = r < NLAT; const int pos = r & (SEQ - 1), rp = pos >> 6, cp = pos & 63;
        { const int rn = (r + F.ngw < nrows) ? (r + F.ngw) : r; E2_LOAD(nqa, nsq, nkva, nsk, rn); }
        if (lane >= 48) wqa = (u32x4){0u, 0u, 0u, 0u};
        if (lane >= 32) wkva = (u32x4){0u, 0u, 0u, 0u};
        float x[8];
        { unpack8(wqa, x); float ss = 0.f;
#pragma unroll
          for (int e = 0; e < 8; ++e) ss += x[e] * x[e];
          ss = wave_sum(ss); const float rinv = rsqrtf(ss * (1.f / QRANK) + EPS);
          if (lane < 48) { float y[8];
#pragma unroll
              for (int e = 0; e < 8; ++e) y[e] = x[e] * rinv * g_qa[e];
              *(u32x4*)(QAN + (size_t)r * QRANK + 8 * lane) = pack8(y); } }
        { unpack8(wkva, x); float ss = 0.f;
#pragma unroll
          for (int e = 0; e < 8; ++e) ss += x[e] * x[e];
          ss = wave_sum(ss); const float rinv = rsqrtf(ss * (1.f / KVRANK) + EPS);
          if (lane < 32) { float y[8];
#pragma unroll
              for (int e = 0; e < 8; ++e) y[e] = x[e] * rinv * g_kva[e];
              *(u32x4*)(KVAN + (size_t)r * KVRANK + 8 * lane) = pack8(y); } }
        const int ch = lane & 7;
        const f32x4* tab = (const f32x4*)(rt + ((ch < 4) ? rp : cp) * 32 + (ch & 1) * 16);
        const f32x4 t0 = tab[0], t1 = tab[1], t2 = tab[2], t3 = tab[3];
        const float cs[8] = {t0[0], t0[2], t1[0], t1[2], t2[0], t2[2], t3[0], t3[2]}, sn[8] = {t0[1], t0[3], t1[1], t1[3], t2[1], t2[3], t3[1], t3[3]};
#pragma unroll
        for (int which = 0; which < 2; ++which) {
            unpack8(which ? wsk : wsq, x); float ss = 0.f;
#pragma unroll
            for (int e = 0; e < 8; ++e) ss += x[e] * x[e];
            ss += E2_DPP(ss, 0xB1); ss += E2_DPP(ss, 0x4E); ss += E2_DPP(ss, 0x141);
            const float rinv = rsqrtf(ss * (1.f / 64.f) + EPS);
            float y[8], o[8];
#pragma unroll
            for (int e = 0; e < 8; ++e) y[e] = x[e] * rinv * (which ? g_sk[e] : g_sq[e]);
#pragma unroll
            for (int e = 0; e < 8; ++e) { const float py = E2_DPP(y[e], 0x4E);
                o[e] = lat ? ((ch & 2) ? (y[e] * cs[e] + py * sn[e]) : (y[e] * cs[e] - py * sn[e])) : y[e]; }
            if (which == 0) *(u32x4*)(QS + (size_t)r * 512 + 8 * lane) = pack8(o);
            else if (lane < 16) *(u32x4*)(KS + (size_t)r * 128 + 8 * lane) = pack8(o);
        }
        wqa = nqa; wsq = nsq; wkva = nkva; wsk = nsk;
    }
#undef E2_LOAD
}

#define E3_DPP(v, CTRL) __builtin_bit_cast(float, __builtin_amdgcn_update_dpp(0, __builtin_bit_cast(int, (v)), (CTRL), 0xF, 0xF, true))
__device__ __forceinline__ void e3_phase(const Frame& F, ArgsP Ap, int l, int nrows, const int pvar, char* lds) {
    unsigned char* ws = Ap->ws;
    const bf16* P = (const bf16*)(ws + WS_P);
    bf16* QM = (bf16*)(ws + WS_QM); bf16* KM = (bf16*)(ws + WS_KM);
    bf16* QMo = pvar ? (bf16*)(ws + WS_F16B) : QM; bf16* KMo = pvar ? (bf16*)(ws + WS_F16B) : KM;
    const float* qn_g = Ap->in[13] + l * 96; const float* kn_g = Ap->in[14] + l * 96;
    float* rt = (float*)lds;
    __syncthreads();
    for (int i = F.tid; i < 64 * 16; i += 512) rt[i] = ((const float*)(ws + WS_RTM))[i];
    __syncthreads();
    const int lane = F.lane, hl = lane >> 4, ch = lane & 15; const bool valid = ch < 12; const int chc = valid ? ch : 0;
    const bool krope = valid && ch >= 8; const int kro = 1152 + (krope ? (ch - 8) * 8 : 0);
    const int qo0 = hl * 96 + chc * 8, qo1 = (4 + hl) * 96 + chc * 8;
    float gq[8], gk[8];
#pragma unroll
    for (int e = 0; e < 8; ++e) { gq[e] = qn_g[8 * chc + e] * C_MLA; gk[e] = kn_g[8 * chc + e]; }
    u32x4 wq0, wk0, wq1, wk1, nq0, nk0, nq1, nk1;
#define E3_LOAD(A_, B_, C_, D_, r_) do { const bf16* qr_ = QM + (size_t)(r_) * 768; const bf16* kr_ = KM + (size_t)(r_) * 768; const bf16* pr_ = P + (size_t)(r_) * DIN + kro; \
        A_ = *(const u32x4*)(qr_ + qo0); C_ = *(const u32x4*)(qr_ + qo1); B_ = *(const u32x4*)(krope ? pr_ : (kr_ + qo0)); D_ = *(const u32x4*)(krope ? pr_ : (kr_ + qo1)); } while (0)
    if (F.gw < nrows) E3_LOAD(wq0, wk0, wq1, wk1, F.gw);
    for (int r = F.gw; r < nrows; r += F.ngw) {
        const bool lat = r < NLAT; const int pos = r & (SEQ - 1), rp = pos >> 6, cp = pos & 63;
        { const int rn = (r + F.ngw < nrows) ? (r + F.ngw) : r; if (rn != r) E3_LOAD(nq0, nk0, nq1, nk1, rn); }
        const f32x4* tab = (const f32x4*)(rt + ((ch < 10) ? rp : cp) * 16);
        const f32x4 t0 = tab[0], t1 = tab[1], t2 = tab[2], t3 = tab[3];
        const float cs[8] = {t0[0], t0[2], t1[0], t1[2], t2[0], t2[2], t3[0], t3[2]}, sn[8] = {t0[1], t0[3], t1[1], t1[3], t2[1], t2[3], t3[1], t3[3]};
        const bool rot = lat && krope;
#pragma unroll
        for (int pass = 0; pass < 2; ++pass) {
            const int head = 4 * pass + hl;
#pragma unroll
            for (int which = 0; which < 2; ++which) {
                u32x4 w = which ? (pass ? wk1 : wk0) : (pass ? wq1 : wq0);
                if (!valid) w = (u32x4){0u, 0u, 0u, 0u};
                bf16* dstp = (which ? KMo : QMo) + (size_t)r * 768 + head * 96 + chc * 8;
                float x[8]; unpack8(w, x); float ss = 0.f;
#pragma unroll
                for (int e = 0; e < 8; ++e) ss += x[e] * x[e];
                ss += E3_DPP(ss, 0xB1); ss += E3_DPP(ss, 0x4E); ss += E3_DPP(ss, 0x141); ss += E3_DPP(ss, 0x140);
                const float rinv = rsqrtf(ss * (1.f / 96.f) + EPS);
                float y[8], o[8];
#pragma unroll
                for (int e = 0; e < 8; ++e) y[e] = x[e] * rinv * (which ? gk[e] : gq[e]);
#pragma unroll
                for (int e = 0; e < 8; ++e) { const float py = E3_DPP(y[e], 0xB1);
                    o[e] = rot ? ((ch & 1) ? (y[e] * cs[e] + py * sn[e]) : (y[e] * cs[e] - py * sn[e])) : y[e]; }
                if (valid) *(u32x4*)dstp = pack8(o);
            }
        }
        wq0 = nq0; wk0 = nk0; wq1 = nq1; wk1 = nk1;
    }
#undef E3_LOAD
}
#define XB_TMO      128
#define XB_XCNT(j)  (256  + 64 * (j))
#define XB_XSUB(j)  (1280 + 64 * (j))
#define XB_XGEN(j)  (2304 + 64 * (j))
#define XB_TOP      3328
#define XB_TOPGEN   3392
#define XCD_BAR_WORDS 3456
#define XB_SPIN_CAP (1u << 18)

__device__ __forceinline__ unsigned xb_ld(unsigned* p)              { return __hip_atomic_load(p, __ATOMIC_RELAXED, __HIP_MEMORY_SCOPE_AGENT); }
__device__ __forceinline__ unsigned xb_add(unsigned* p, unsigned v) { return __hip_atomic_fetch_add(p, v, __ATOMIC_RELAXED, __HIP_MEMORY_SCOPE_AGENT); }
__device__ __forceinline__ unsigned xb_xcc_id() { return (unsigned)__builtin_amdgcn_s_getreg((3 << 11) | 20) & 0xFu; }
#define XB_SPIN(cond, bar) do { unsigned _sp = 0; while (cond) { __builtin_amdgcn_s_sleep(1); \
    if ((++_sp & 255u) == 0u) { if (xb_ld(&(bar)[XB_TMO])) break; if (_sp > XB_SPIN_CAP) { atomicAdd(&(bar)[XB_TMO], 1u); break; } } } } while (0)

struct XcdBarrier {
    unsigned* bar; unsigned x;
    volatile LAS unsigned* st;
};

__device__ __forceinline__ XcdBarrier xcd_barrier_post(unsigned* bar, volatile LAS unsigned* st, const bool t0) {
    XcdBarrier b; b.bar = bar; b.x = xb_xcc_id(); b.st = st;
    if (t0) (void)xb_add(&bar[XB_XCNT(b.x)], 1u);
    return b;
}
__device__ __forceinline__ void xcd_barrier_complete(unsigned* bar, unsigned x, unsigned& nloc, unsigned& nx) {
    const unsigned G = gridDim.x * gridDim.y * gridDim.z;
    unsigned sum, cnt, mine, sp = 0u;
    for (;;) {
        sum = 0u; cnt = 0u; mine = 0u;
#pragma unroll
        for (unsigned j = 0; j < 16; ++j) { const unsigned c = xb_ld(&bar[XB_XCNT(j)]); sum += c; cnt += (c > 0u) ? 1u : 0u; mine = (j == x) ? c : mine; }
        if (sum == G) break;
        __builtin_amdgcn_s_sleep(1);
        if ((++sp & 255u) == 0u) { if (xb_ld(&bar[XB_TMO])) break; if (sp > XB_SPIN_CAP) { atomicAdd(&bar[XB_TMO], 1u); break; } }
    }
    nloc = mine > 0u ? mine : 1u; nx = cnt > 0u ? cnt : 1u;
}

template <int NOFENCE = 0> __device__ __forceinline__ void xcd_barrier(const XcdBarrier& b, const bool t0) {
    asm volatile("s_waitcnt vmcnt(0)" ::: "memory");
    __syncthreads();
    if (t0) {
        unsigned* bar = b.bar;
        __builtin_amdgcn_s_waitcnt(0);
        unsigned nloc = b.st[0], nx = b.st[1];
        if (nloc == 0u) { xcd_barrier_complete(bar, b.x, nloc, nx); b.st[0] = nloc; b.st[1] = nx; }
        const unsigned old = xb_add(&bar[XB_XSUB(b.x)], 1u);
        const unsigned gen = old / nloc;
        if (old + 1u == (gen + 1u) * nloc) {
            if (!(NOFENCE & 1)) __builtin_amdgcn_fence(__ATOMIC_RELEASE, "agent");
            asm volatile("s_waitcnt vmcnt(0)" ::: "memory");
            const unsigned og = xb_add(&bar[XB_TOP], 1u);
            const unsigned tg = og / nx;
            if (og + 1u == (tg + 1u) * nx) xb_add(&bar[XB_TOPGEN], 1u);
            else XB_SPIN(xb_ld(&bar[XB_TOPGEN]) == tg, bar);
            if (!(NOFENCE & 2)) __builtin_amdgcn_fence(__ATOMIC_ACQUIRE, "agent");
            xb_add(&bar[XB_XGEN(b.x)], 1u);
            asm volatile("s_waitcnt vmcnt(0)" ::: "memory");
        } else {
            XB_SPIN(xb_ld(&bar[XB_XGEN(b.x)]) == gen, bar);
            if (!(NOFENCE & 2)) __builtin_amdgcn_fence(__ATOMIC_ACQUIRE, "agent");
            asm volatile("s_waitcnt vmcnt(0)" ::: "memory");
        }
    }
    __syncthreads();
}
namespace att {
constexpr int SHM_V = 64 * 64 * 2, SHM_K = 64 * 192, RSET = 3 * SHM_V + 2 * SHM_K, LDS_ATT = 2 * RSET + 8 * 64 * 4 + 256 * 192;
template <int DQK> __device__ __forceinline__ int kswz(int row) { return (DQK == 96) ? ((row >> 2) & 3) : ((row >> 1) & 7); }
#define SBAR() __builtin_amdgcn_sched_barrier(0)
__device__ __forceinline__ int crow(int r, int hi) { return (r & 3) + 8 * (r >> 2) + 4 * hi; }
__device__ __forceinline__ int v_st(int k, int c) { const int kk = (k & ~0xC) | ((k & 4) << 1) | ((k & 8) >> 1); return ((kk >> 3) * 2 + (c >> 5)) * 512 + ((kk & 7) * 32 + (c & 31)) * 2; }
__device__ __forceinline__ int v_rd_base(int lane) { return ((lane & 3) << 3) | (((lane >> 2) & 3) << 6) | (((lane >> 4) & 1) << 5) | (((lane >> 5) & 1) << 8); }
constexpr int v_rd_off(int d0, int ks, int half) { return d0 * 512 + ks * 2048 + half * 1024; }
template <int OFF> __device__ __forceinline__ s16x4 tr_read(int vb) {
    s16x4 r; asm volatile("ds_read_b64_tr_b16 %0, %1 offset:%2" : "=&v"(r) : "v"(vb), "i"(OFF) : "memory"); return r;
}
template <int D0> __device__ __forceinline__ void pv_one(f32x16& od, int vb, bf16x8 pa0, bf16x8 pa1, bf16x8 pa2, bf16x8 pa3) {
    const s16x4 l0 = tr_read<v_rd_off(D0, 0, 0)>(vb), h0 = tr_read<v_rd_off(D0, 0, 1)>(vb), l1 = tr_read<v_rd_off(D0, 1, 0)>(vb), h1 = tr_read<v_rd_off(D0, 1, 1)>(vb);
    const s16x4 l2 = tr_read<v_rd_off(D0, 2, 0)>(vb), h2 = tr_read<v_rd_off(D0, 2, 1)>(vb), l3 = tr_read<v_rd_off(D0, 3, 0)>(vb), h3 = tr_read<v_rd_off(D0, 3, 1)>(vb);
    asm volatile("s_waitcnt lgkmcnt(0)" ::: "memory"); SBAR();
#define PK(L, H) (bf16x8){L[0], L[1], L[2], L[3], H[0], H[1], H[2], H[3]}
    od = __builtin_amdgcn_mfma_f32_32x32x16_bf16(pa0, PK(l0, h0), od, 0, 0, 0);
    od = __builtin_amdgcn_mfma_f32_32x32x16_bf16(pa1, PK(l1, h1), od, 0, 0, 0);
    od = __builtin_amdgcn_mfma_f32_32x32x16_bf16(pa2, PK(l2, h2), od, 0, 0, 0);
    od = __builtin_amdgcn_mfma_f32_32x32x16_bf16(pa3, PK(l3, h3), od, 0, 0, 0);
#undef PK
}
__device__ __forceinline__ void pv2(f32x16* o, int vb, bf16x8 pa0, bf16x8 pa1, bf16x8 pa2, bf16x8 pa3) {
    pv_one<0>(o[0], vb, pa0, pa1, pa2, pa3); pv_one<1>(o[1], vb, pa0, pa1, pa2, pa3);
}
template <int ND0> __device__ __forceinline__ void qkt(f32x16& p0, f32x16& p1, const char* Ks, const bf16x8* qr, int r32, int hi) {
    constexpr int DQK = ND0 * 16, PITCH = DQK * 2;
    p0 = f32x16{}; p1 = f32x16{};
    const char* kr = Ks + r32 * PITCH; const int sw = kswz<DQK>(r32);
#pragma unroll
    for (int d0 = 0; d0 < ND0; ++d0) { const int cb = ((d0 * 2 + hi) ^ sw) * 16;
        const bf16x8 b0 = *reinterpret_cast<const bf16x8*>(kr + cb);
        const bf16x8 b1 = *reinterpret_cast<const bf16x8*>(kr + 32 * PITCH + cb);
        p0 = __builtin_amdgcn_mfma_f32_32x32x16_bf16(b0, qr[d0], p0, 0, 0, 0);
        p1 = __builtin_amdgcn_mfma_f32_32x32x16_bf16(b1, qr[d0], p1, 0, 0, 0); }
}
__device__ __forceinline__ void wmask(f32x16& p0, f32x16& p1, int kp0, int qp, int hi) {
#pragma unroll
    for (int r = 0; r < 16; ++r) { const int d0 = kp0 + crow(r, hi) - qp; const int d1 = d0 + 32;
        if (d0 > 128 || d0 < -128) p0[r] = -INFINITY; if (d1 > 128 || d1 < -128) p1[r] = -INFINITY; }
}
typedef __bf16 abf2_t __attribute__((ext_vector_type(2)));
__device__ __forceinline__ float adot2(unsigned w, float acc) { return __builtin_amdgcn_fdot2_f32_bf16(__builtin_bit_cast(abf2_t, w), __builtin_bit_cast(abf2_t, 0x3F803F80u), acc, false); }
__device__ __forceinline__ void smpack(f32x16& p0, f32x16& p1, float& l_reg, bf16x8& pa0, bf16x8& pa1, bf16x8& pa2, bf16x8& pa3) {
#pragma unroll
    for (int r = 0; r < 16; ++r) p0[r] = __builtin_amdgcn_exp2f(p0[r]);
#pragma unroll
    for (int r = 0; r < 16; ++r) p1[r] = __builtin_amdgcn_exp2f(p1[r]);
    float ps0 = 0.f, ps1 = 0.f;
#define PK4(P, BASE, OUT) do { unsigned a0 = pk2(P[BASE + 0], P[BASE + 1]), a1 = pk2(P[BASE + 2], P[BASE + 3]);   \
    unsigned b0 = pk2(P[BASE + 4], P[BASE + 5]), b1 = pk2(P[BASE + 6], P[BASE + 7]);                              \
    ps0 = adot2(a0, ps0); ps1 = adot2(a1, ps1); ps0 = adot2(b0, ps0); ps1 = adot2(b1, ps1);                     \
    auto r0 = __builtin_amdgcn_permlane32_swap(a0, b0, false, false); auto r1 = __builtin_amdgcn_permlane32_swap(a1, b1, false, false); \
    u32x4 w = {r0[0], r1[0], r0[1], r1[1]}; OUT = *reinterpret_cast<bf16x8*>(&w); } while (0)
    PK4(p0, 0, pa0); PK4(p0, 8, pa1); PK4(p1, 0, pa2); PK4(p1, 8, pa3);
#undef PK4
    l_reg += ps0 + ps1;
}

struct Unit {
    const bf16* Q; int ldq;
    const bf16* K; int ldk;
    const bf16* V; int ldv;
    bf16* O;
    int qrow0;
    int ctx_row0;
    int lat_row0;
    int nt;
    int qpos0;
    int kpos0;
    int masked;
    float l_init;
};

template <int DQK, bool MASKED>
__device__ __forceinline__ void attn_unit(const Unit& U, const Unit& NU, const bool has_next, const int rset, const bool pre, char* lds, const int tid) {
    constexpr int ND0 = DQK / 16, PITCH = DQK * 2, SHM_KT = PITCH * 64;
    const int wid = tid >> 6, lane = tid & 63, r32 = lane & 31, hi = lane >> 5;
    char* V_lds = lds + rset * RSET; char* K_lds = V_lds + 3 * SHM_V;
    float* wsf = (float*)(lds + 2 * RSET) + wid * 64; char* qstage = lds + 2 * RSET + 8 * 64 * 4;
    float l_reg = (hi == 0) ? U.l_init : 0.f; f32x16 o[2] = {}; bf16x8 qr[ND0];
    const bf16* Qw = U.Q + (size_t)(U.qrow0 + wid * 32 + r32) * U.ldq + hi * 8;
    const int L0 = 1024 * wid + 16 * lane;
    const int kr0 = L0 / PITCH, kq0 = ((L0 % PITCH) >> 4) ^ kswz<DQK>(kr0);
    const unsigned koff0 = (unsigned)(kr0 * U.ldk * 2 + kq0 * 16);
    const int L1 = L0 + 8192, kr1 = (L1 / PITCH) & 63, kq1 = ((L1 % PITCH) >> 4) ^ kswz<DQK>(kr1);
    const unsigned koff1 = (unsigned)(kr1 * U.ldk * 2 + kq1 * 16);
    const int vsub = L0 >> 9, vwi = (L0 & 511) >> 1, vkk = (vsub >> 1) * 8 + (vwi >> 5), vk = (vkk & ~0xC) | ((vkk & 4) << 1) | ((vkk & 8) >> 1), vc = (vsub & 1) * 32 + (vwi & 31);
    const unsigned voff = (unsigned)(vk * U.ldv * 2 + vc * 2);
    LAS char* Kl3 = (LAS char*)(uintptr_t)(unsigned)(uintptr_t)(K_lds + 1024 * wid);
    LAS char* Vl3 = (LAS char*)(uintptr_t)(unsigned)(uintptr_t)(V_lds + 1024 * wid);
    const bool k1on = (DQK == 96) && (wid < 4);
    const int vb0 = (int)(uintptr_t)V_lds + v_rd_base(lane);
    auto tile_row = [&](int t) -> int { return (t < 4) ? (U.ctx_row0 + 64 * t) : (U.lat_row0 + 64 * (t - 4)); };
#define ADMA(t, ks, vs) do { const int kr_ = tile_row(t); const char* kb_ = (const char*)(U.K + (size_t)kr_ * U.ldk); const char* vb_ = (const char*)(U.V + (size_t)kr_ * U.ldv); \
        __builtin_amdgcn_global_load_lds((const unsigned*)(kb_ + koff0), (LAS unsigned*)(Kl3 + (ks) * SHM_KT), 16, 0, 0); \
        if (DQK == 96) { if (k1on) __builtin_amdgcn_global_load_lds((const unsigned*)(kb_ + koff1), (LAS unsigned*)(Kl3 + (ks) * SHM_KT + 8192), 16, 0, 0); } \
        __builtin_amdgcn_global_load_lds((const unsigned*)(vb_ + voff), (LAS unsigned*)(Vl3 + (vs) * SHM_V), 16, 0, 0); } while (0)
#define AWAIT() do { asm volatile("s_waitcnt vmcnt(0)" ::: "memory"); __syncthreads(); } while (0)
#define MASK(P0, P1, t) do { if (MASKED && (t) >= 4) wmask(P0, P1, U.kpos0 + 64 * ((t) - 4), U.qpos0 + wid * 32 + r32, hi); } while (0)
    f32x16 pA0, pA1, pB0, pB1; bf16x8 pa0, pa1, pa2, pa3; const int NT = U.nt;
    __syncthreads();
    if (!pre) {
#pragma unroll
        for (int d0 = 0; d0 < ND0; ++d0) qr[d0] = *reinterpret_cast<const bf16x8*>(Qw + d0 * 16);
        ADMA(0, 0, 0); ADMA(1, 1, 1);
    }
    AWAIT();
    if (pre) {
#pragma unroll
        for (int d0 = 0; d0 < ND0; ++d0) qr[d0] = *reinterpret_cast<const bf16x8*>(qstage + (wid * 32 + r32) * PITCH + d0 * 32 + hi * 16);
    }
    qkt<ND0>(pA0, pA1, K_lds, qr, r32, hi); MASK(pA0, pA1, 0);
    int va = 0, vb = 1, vc3 = 2;
    for (int j = 0; j + 2 < NT; j += 2) {
        AWAIT(); ADMA(j + 2, 0, vc3); SBAR();
        qkt<ND0>(pB0, pB1, K_lds + SHM_KT, qr, r32, hi); MASK(pB0, pB1, j + 1);
        smpack(pA0, pA1, l_reg, pa0, pa1, pa2, pa3); SBAR();
        pv2(o, vb0 + va * SHM_V, pa0, pa1, pa2, pa3);
        AWAIT(); ADMA(j + 3, 1, va); SBAR();
        qkt<ND0>(pA0, pA1, K_lds, qr, r32, hi); MASK(pA0, pA1, j + 2);
        smpack(pB0, pB1, l_reg, pa0, pa1, pa2, pa3); SBAR();
        pv2(o, vb0 + vb * SHM_V, pa0, pa1, pa2, pa3);
        { const int t_ = va; va = vc3; vc3 = vb; vb = t_; }
    }
    int npre = 0;
    if (has_next) {
        LAS char* Kn3 = (LAS char*)(uintptr_t)(unsigned)(uintptr_t)(lds + (rset ^ 1) * RSET + 3 * SHM_V + 1024 * wid);
        LAS char* Vn3 = (LAS char*)(uintptr_t)(unsigned)(uintptr_t)(lds + (rset ^ 1) * RSET + 1024 * wid);
#pragma unroll
        for (int t = 0; t < 2; ++t) { const int kr_ = NU.ctx_row0 + 64 * t; const char* kb_ = (const char*)(NU.K + (size_t)kr_ * NU.ldk); const char* vb_ = (const char*)(NU.V + (size_t)kr_ * NU.ldv);
            __builtin_amdgcn_global_load_lds((const unsigned*)(kb_ + koff0), (LAS unsigned*)(Kn3 + t * SHM_KT), 16, 0, 0);
            if (DQK == 96) { if (k1on) __builtin_amdgcn_global_load_lds((const unsigned*)(kb_ + koff1), (LAS unsigned*)(Kn3 + t * SHM_KT + 8192), 16, 0, 0); }
            __builtin_amdgcn_global_load_lds((const unsigned*)(vb_ + voff), (LAS unsigned*)(Vn3 + t * SHM_V), 16, 0, 0); }
        constexpr int NQ = PITCH * 256 / 1024 / 8;
        LAS char* Qn3 = (LAS char*)(uintptr_t)(unsigned)(uintptr_t)(qstage + 1024 * wid);
#pragma unroll
        for (int i = 0; i < NQ; ++i) { const int Lq = 1024 * (wid + 8 * i) + 16 * lane, qrw = Lq / PITCH, qpc = (Lq % PITCH) >> 4;
            __builtin_amdgcn_global_load_lds((const unsigned*)((const char*)(NU.Q + (size_t)(NU.qrow0 + qrw) * NU.ldq) + qpc * 16), (LAS unsigned*)(Qn3 + 8192 * i), 16, 0, 0); }
        npre = 4 + NQ + (k1on ? 2 : 0);
    }
    if (npre == 12) asm volatile("s_waitcnt vmcnt(12)" ::: "memory"); else if (npre == 10) asm volatile("s_waitcnt vmcnt(10)" ::: "memory"); else if (npre == 8) asm volatile("s_waitcnt vmcnt(8)" ::: "memory"); else asm volatile("s_waitcnt vmcnt(0)" ::: "memory");
    __syncthreads(); SBAR();
    qkt<ND0>(pB0, pB1, K_lds + SHM_KT, qr, r32, hi); MASK(pB0, pB1, NT - 1);
    smpack(pA0, pA1, l_reg, pa0, pa1, pa2, pa3); SBAR();
    pv2(o, vb0 + va * SHM_V, pa0, pa1, pa2, pa3);
    smpack(pB0, pB1, l_reg, pa0, pa1, pa2, pa3); SBAR();
    pv2(o, vb0 + vb * SHM_V, pa0, pa1, pa2, pa3);
    { auto rr = __builtin_amdgcn_permlane32_swap(__float_as_uint(l_reg), __float_as_uint(l_reg), false, false);
      l_reg = __uint_as_float(rr[0]) + __uint_as_float(rr[1]); }
    if (hi == 0) wsf[r32] = l_reg;
    asm volatile("s_waitcnt lgkmcnt(0)" ::: "memory");
    float rli[16];
#pragma unroll
    for (int r = 0; r < 16; ++r) rli[r] = 1.f / wsf[crow(r, hi)];
    bf16* Ow = U.O + (size_t)(U.qrow0 + wid * 32) * 1024;
#pragma unroll
    for (int r = 0; r < 16; ++r) { const int orow = crow(r, hi);
#pragma unroll
        for (int d0 = 0; d0 < 2; ++d0) { const unsigned w = pk2(o[d0][r] * rli[r], 0.f); Ow[(size_t)orow * 1024 + d0 * 32 + r32] = (bf16)(w & 0xffffu); } }
#undef ADMA
#undef AWAIT
#undef MASK
}
}

__device__ __forceinline__ void attn_phase(const Frame& F, ArgsP Ap, int l, char* lds, const int pvar) {
    unsigned char* ws = Ap->ws;
    const bf16* QM = (const bf16*)(ws + WS_QM); const bf16* KM = (const bf16*)(ws + WS_KM); const bf16* VM = (const bf16*)(ws + WS_VM);
    const bf16* QS = (const bf16*)(ws + WS_QS); const bf16* KS = (const bf16*)(ws + WS_KS); const bf16* VS = (const bf16*)(ws + WS_P) + 1312;
    bf16* OB = (bf16*)(ws + WS_AB);
    const float* sink = Ap->in[17] + l * 8;
    const int nunits = (l == 0) ? 1024 + 64 : 1024;
    {   auto mk = [&](int u) -> att::Unit {
            const bool isl = u < 1024;
            const int i = u >> 8, c = u & 31, b = isl ? ((u & 255) >> 5) : ((u - 1024) >> 3), h = isl ? (2 * i + (c >> 4)) : (u & 7), qb = c & 15;
            att::Unit U; U.Q = QM + h * 96; U.ldq = 768; U.K = KM + h * 96; U.ldk = 768; U.V = VM + h * 64; U.ldv = 512; U.O = OB + h * 64;
            U.qrow0 = isl ? (b * SEQ + qb * 256) : (NLAT + b * CTXL); U.ctx_row0 = NLAT + b * CTXL; U.lat_row0 = b * SEQ; U.nt = isl ? (4 + SEQ / 64) : 4; U.qpos0 = 0; U.kpos0 = 0; U.masked = 0; U.l_init = 0.f;
            return U; };
        int u = (pvar == 2) ? nunits : F.vcu; int rset = 0; bool pre = false; att::Unit U, NU;
        if (u < nunits) U = mk(u);
        for (; u < nunits; u += F.G) { const bool hn = u + F.G < nunits; NU = mk(hn ? (u + F.G) : u);
            att::attn_unit<96, false>(U, NU, hn, rset, pre, lds, F.tid); pre = hn; rset ^= 1; U = NU; }
    }
    {   auto mk = [&](int u) -> att::Unit {
            const bool isl = u < 1024;
            const int i = u >> 8, c = u & 31, b = isl ? ((u & 255) >> 5) : ((u - 1024) >> 3), h = isl ? (2 * i + (c >> 4)) : (u & 7), qb = c & 15, g = h >> 2;
            const int q0 = qb * 256; int k_lo = q0 - 128; if (k_lo < 0) k_lo = 0; int k_hi = q0 + 256 + 128; if (k_hi > SEQ) k_hi = SEQ;
            att::Unit U; U.Q = QS + h * 64; U.ldq = 512; U.K = KS + g * 64; U.ldk = 128; U.V = VS + g * 64; U.ldv = DIN; U.O = OB + 512 + h * 64;
            U.qrow0 = isl ? (b * SEQ + q0) : (NLAT + b * CTXL); U.ctx_row0 = NLAT + b * CTXL; U.lat_row0 = b * SEQ + k_lo; U.nt = isl ? (4 + (k_hi - k_lo) / 64) : 4; U.qpos0 = q0; U.kpos0 = k_lo; U.masked = 1;
            U.l_init = __builtin_amdgcn_exp2f(sink[h] * LOG2E);
            return U; };
        int u = (pvar == 1) ? nunits : (F.G - 1 - F.vcu); int rset = 0; bool pre = false; att::Unit U, NU;
        if (u < nunits) U = mk(u);
        for (; u < nunits; u += F.G) { const bool hn = u + F.G < nunits; NU = mk(hn ? (u + F.G) : u);
            att::attn_unit<64, true>(U, NU, hn, rset, pre, lds, F.tid); pre = hn; rset ^= 1; U = NU; }
    }
}

#ifndef DBG_NAIVE_ATTN
#define DBG_NAIVE_ATTN 0
#endif
#if DBG_NAIVE_ATTN
__device__ __forceinline__ void attn_naive_phase(const Frame& F, ArgsP Ap, int l) {
    unsigned char* ws = Ap->ws;
    const bf16* QM = (const bf16*)(ws + WS_QM); const bf16* KM = (const bf16*)(ws + WS_KM); const bf16* VM = (const bf16*)(ws + WS_VM);
    const bf16* QS = (const bf16*)(ws + WS_QS); const bf16* KS = (const bf16*)(ws + WS_KS); const bf16* VS = (const bf16*)(ws + WS_P) + 1312;
    bf16* OB = (bf16*)(ws + WS_AB);
    const float* sink = Ap->in[17] + l * 8;
    const int nrg = ((l == 0) ? NROWS : NLAT) / 64;
    for (int u = F.gw; u < nrg * 8; u += F.ngw) {
        const int h = __builtin_amdgcn_readfirstlane(u & 7), rg = __builtin_amdgcn_readfirstlane(u >> 3), row = rg * 64 + F.lane;
        const bool lat = rg * 64 < NLAT; const int b = lat ? (rg * 64) >> 12 : (rg * 64 - NLAT) >> 8;
        {
            float q[96], o[64]; float lsum = 0.f;
#pragma unroll
            for (int d = 0; d < 96; d += 2) { const unsigned w = *(const unsigned*)(QM + (size_t)row * 768 + h * 96 + d); q[d] = bf_lo(w); q[d + 1] = bf_hi(w); }
#pragma unroll
            for (int d = 0; d < 64; ++d) o[d] = 0.f;
            const int nk = lat ? (CTXL + SEQ) : CTXL;
#pragma unroll 1
            for (int j = 0; j < nk; ++j) { const int kr = (j < CTXL) ? (NLAT + b * CTXL + j) : (b * SEQ + j - CTXL);
                const bf16* kp = KM + (size_t)kr * 768 + h * 96; const bf16* vp = VM + (size_t)kr * 512 + h * 64; float s = 0.f;
#pragma unroll
                for (int d = 0; d < 96; d += 2) { const unsigned w = *(const unsigned*)(kp + d); s = fmaf(q[d], bf_lo(w), s); s = fmaf(q[d + 1], bf_hi(w), s); }
                const float p = exp2f(s); lsum += p;
#pragma unroll
                for (int d = 0; d < 64; d += 2) { const unsigned w = *(const unsigned*)(vp + d); o[d] = fmaf(p, bf_lo(w), o[d]); o[d + 1] = fmaf(p, bf_hi(w), o[d + 1]); } }
            const float rl = 1.f / lsum;
#pragma unroll
            for (int d = 0; d < 64; d += 2) *(unsigned*)(OB + (size_t)row * 1024 + h * 64 + d) = pk2(o[d] * rl, o[d + 1] * rl);
        }
        {
            const int g = h >> 2; const int pos0 = (rg * 64) & (SEQ - 1), pos = pos0 + F.lane;
            float q[64], o[64]; float lsum = exp2f(sink[h] * LOG2E);
#pragma unroll
            for (int d = 0; d < 64; d += 2) { const unsigned w = *(const unsigned*)(QS + (size_t)row * 512 + h * 64 + d); q[d] = bf_lo(w); q[d + 1] = bf_hi(w); }
#pragma unroll
            for (int d = 0; d < 64; ++d) o[d] = 0.f;
            int jlo = pos0 - 128; if (jlo < 0) jlo = 0; int jhi = pos0 + 63 + 128; if (jhi > SEQ - 1) jhi = SEQ - 1;
            const int nk = lat ? (CTXL + (jhi - jlo + 1)) : CTXL;
#pragma unroll 1
            for (int j = 0; j < nk; ++j) { const bool isc = j < CTXL; const int kpos = jlo + j - CTXL; const int kr = isc ? (NLAT + b * CTXL + j) : (b * SEQ + kpos);
                const bf16* kp = KS + (size_t)kr * 128 + g * 64; const bf16* vp = VS + (size_t)kr * DIN + g * 64; float s = 0.f;
#pragma unroll
                for (int d = 0; d < 64; d += 2) { const unsigned w = *(const unsigned*)(kp + d); s = fmaf(q[d], bf_lo(w), s); s = fmaf(q[d + 1], bf_hi(w), s); }
                float p = exp2f(s); if (!isc) { const int dd = kpos - pos; if (dd > 128 || dd < -128) p = 0.f; } lsum += p;
#pragma unroll
                for (int d = 0; d < 64; d += 2) { const unsigned w = *(const unsigned*)(vp + d); o[d] = fmaf(p, bf_lo(w), o[d]); o[d + 1] = fmaf(p, bf_hi(w), o[d + 1]); } }
            const float rl = 1.f / lsum;
#pragma unroll
            for (int d = 0; d < 64; d += 2) *(unsigned*)(OB + (size_t)row * 1024 + 512 + h * 64 + d) = pk2(o[d] * rl, o[d + 1] * rl);
        }
    }
}
#endif
__device__ __forceinline__ unsigned f2key(float f) { const unsigned u = __float_as_uint(f); return (u & 0x80000000u) ? ~u : (u | 0x80000000u); }
__device__ __forceinline__ float key2f(unsigned k) { const unsigned u = (k & 0x80000000u) ? (k & 0x7fffffffu) : ~k; return __uint_as_float(u); }
#define CE_DESC(a, b) do { const unsigned _hi = max(a, b), _lo = min(a, b); a = _hi; b = _lo; } while (0)
__device__ __forceinline__ void sort16_desc(unsigned (&a)[16]) {
#pragma unroll
    for (int k = 2; k <= 16; k <<= 1)
#pragma unroll
        for (int j = k >> 1; j > 0; j >>= 1)
#pragma unroll
            for (int i = 0; i < 16; ++i) { const int p = i ^ j;
                if (p > i) { if ((i & k) == 0) { CE_DESC(a[i], a[p]); } else { CE_DESC(a[p], a[i]); } } }
}
__device__ __forceinline__ void merge16_desc(unsigned (&t)[16], const unsigned (&c)[16]) {
#pragma unroll
    for (int i = 0; i < 16; ++i) t[i] = max(t[i], c[15 - i]);
#pragma unroll
    for (int j = 8; j > 0; j >>= 1)
#pragma unroll
        for (int i = 0; i < 16; ++i) { const int p = i ^ j; if (p > i) CE_DESC(t[i], t[p]); }
}
__device__ __forceinline__ void merge16_partner(unsigned (&t)[16]) {
    unsigned oth[16];
#pragma unroll
    for (int i = 0; i < 16; ++i) oth[i] = (unsigned)__shfl_xor((int)t[i], 32);
    merge16_desc(t, oth);
}

constexpr size_t WS_IDX = WS_P;
constexpr size_t WS_GW = WS_P + (size_t)NROWS * 128 * 2;
constexpr size_t WS_W2 = WS_GW + (size_t)NROWS * 128 * 4;
constexpr size_t WS_USL = WS_W2 + (size_t)NROWS * 128 * 4;
constexpr size_t WS_IDXT = WS_USL + (size_t)NROWS * 128 * 4;
static_assert(WS_IDXT + (size_t)NROWS * 128 * 2 <= WS_X5, "peer lists inside the P region");

__device__ __forceinline__ void topkc_phase(const Frame& F, ArgsP Ap, int l, int nrows, char* lds) {
    unsigned char* ws = Ap->ws;
    const bf16* QP = (const bf16*)(ws + WS_X5);
    const bf16* PK = (const bf16*)(ws + WS_PKEY) + (size_t)l * 16 * 128 * 128;
    unsigned short* IDX = (unsigned short*)(ws + WS_IDX); float* GW = (float*)(ws + WS_GW); float* USL = (float*)(ws + WS_USL);
    const float* USt = (const float*)(ws + WS_US) + l * PEXP; const float* VSt = (const float*)(ws + WS_VS) + l * PEXP;
    char* Kl = lds;
    unsigned char* sub = (unsigned char*)(lds + 65536) + F.wave * 1024;
    const int lane = F.lane, r32 = lane & 31, hi = lane >> 5;
    const int nunits = (nrows / 256) * 8;
    for (int u = F.bid; u < nunits; u += F.G) {
        const int h = u & 7, rb = u >> 3;
        __syncthreads();
#pragma unroll
        for (int i = 0; i < 8; ++i) { const int ci = F.tid + 512 * i, krow = ci >> 4, ch = ci & 15;
            const u32x4 v = *(const u32x4*)(PK + ((size_t)(2 * h) * 128 + krow) * 128 + ch * 8);
            *(u32x4*)(Kl + krow * 256 + ((ch * 16) ^ ((krow & 7) << 4))) = v; }
        __syncthreads();
        const int row = rb * 256 + F.wave * 32 + r32;
        const unsigned hi4 = (unsigned)hi << 2, hi7 = (unsigned)hi << 7;
        unsigned t0[16], t1[16];
#pragma unroll
        for (int p = 0; p < 2; ++p) {
            const bf16* qrow = QP + (size_t)row * 2048 + (2 * h + p) * 128 + hi * 8;
            bf16x8 bq[8];
#pragma unroll
            for (int s = 0; s < 8; ++s) bq[s] = *reinterpret_cast<const bf16x8*>(qrow + s * 16);
            unsigned top[16];
#pragma unroll
            for (int blk = 0; blk < 4; ++blk) {
                f32x16 acc = f32x16{};
                const char* kb = Kl + (p * 128 + blk * 32 + r32) * 256;
#pragma unroll
                for (int s = 0; s < 8; ++s) { const bf16x8 ka = *reinterpret_cast<const bf16x8*>(kb + (((s * 16 + hi * 8) * 2) ^ ((r32 & 7) << 4)));
                    acc = __builtin_amdgcn_mfma_f32_32x32x16_bf16(ka, bq[s], acc, 0, 0, 0); }
                unsigned c[16];
#pragma unroll
                for (int r = 0; r < 16; ++r) c[r] = ((f2key(acc[r]) & ~127u) | (unsigned)(127 - (blk * 32 + (r & 3) + 8 * (r >> 2)))) ^ hi4;
                sort16_desc(c);
                if (blk == 0) {
#pragma unroll
                    for (int i = 0; i < 16; ++i) top[i] = c[i];
                } else merge16_desc(top, c);
                __builtin_amdgcn_sched_barrier(0);
            }
            merge16_partner(top);
#pragma unroll
            for (int i = 0; i < 16; ++i) { if (p == 0) t0[i] = top[i]; else t1[i] = top[i]; }
        }
        if (hi == 0) { unsigned* sw = (unsigned*)(sub + r32 * 32);
#pragma unroll
            for (int q = 0; q < 4; ++q) {
                sw[q] = (127u - (t0[4 * q] & 127u)) | ((127u - (t0[4 * q + 1] & 127u)) << 8) | ((127u - (t0[4 * q + 2] & 127u)) << 16) | ((127u - (t0[4 * q + 3] & 127u)) << 24);
                sw[4 + q] = (127u - (t1[4 * q] & 127u)) | ((127u - (t1[4 * q + 1] & 127u)) << 8) | ((127u - (t1[4 * q + 2] & 127u)) << 16) | ((127u - (t1[4 * q + 3] & 127u)) << 24); } }
        float f1[16], fa[8];
#pragma unroll
        for (int i = 0; i < 16; ++i) f1[i] = key2f(t1[i] & ~127u);
#pragma unroll
        for (int i = 0; i < 8; ++i) fa[i] = key2f((hi ? t0[8 + i] : t0[i]) & ~127u);
        unsigned top[16];
        {
#pragma unroll
            for (int b = 0; b < 16; ++b) top[b] = ((f2key(fa[0] + f1[b]) & ~255u) | (unsigned)(255 - b)) ^ hi7;
            __builtin_amdgcn_sched_barrier(0);
            { unsigned c[16] = {((f2key(fa[1] + f1[0]) & ~255u) | 239u) ^ hi7, ((f2key(fa[1] + f1[1]) & ~255u) | 238u) ^ hi7, ((f2key(fa[1] + f1[2]) & ~255u) | 237u) ^ hi7, ((f2key(fa[1] + f1[3]) & ~255u) | 236u) ^ hi7, ((f2key(fa[1] + f1[4]) & ~255u) | 235u) ^ hi7, ((f2key(fa[1] + f1[5]) & ~255u) | 234u) ^ hi7, ((f2key(fa[1] + f1[6]) & ~255u) | 233u) ^ hi7, ((f2key(fa[1] + f1[7]) & ~255u) | 232u) ^ hi7, ((f2key(fa[2] + f1[0]) & ~255u) | 223u) ^ hi7, ((f2key(fa[2] + f1[1]) & ~255u) | 222u) ^ hi7, ((f2key(fa[2] + f1[2]) & ~255u) | 221u) ^ hi7, ((f2key(fa[2] + f1[3]) & ~255u) | 220u) ^ hi7, ((f2key(fa[2] + f1[4]) & ~255u) | 219u) ^ hi7, ((f2key(fa[3] + f1[0]) & ~255u) | 207u) ^ hi7, ((f2key(fa[3] + f1[1]) & ~255u) | 206u) ^ hi7, ((f2key(fa[3] + f1[2]) & ~255u) | 205u) ^ hi7};
              sort16_desc(c); merge16_desc(top, c); }
            __builtin_amdgcn_sched_barrier(0);
            { unsigned c[16] = {((f2key(fa[3] + f1[3]) & ~255u) | 204u) ^ hi7, ((f2key(fa[4] + f1[0]) & ~255u) | 191u) ^ hi7, ((f2key(fa[4] + f1[1]) & ~255u) | 190u) ^ hi7, ((f2key(fa[4] + f1[2]) & ~255u) | 189u) ^ hi7, ((f2key(fa[5] + f1[0]) & ~255u) | 175u) ^ hi7, ((f2key(fa[5] + f1[1]) & ~255u) | 174u) ^ hi7, ((f2key(fa[6] + f1[0]) & ~255u) | 159u) ^ hi7, ((f2key(fa[6] + f1[1]) & ~255u) | 158u) ^ hi7, ((f2key(fa[7] + f1[0]) & ~255u) | 143u) ^ hi7, ((f2key(fa[7] + f1[1]) & ~255u) | 142u) ^ hi7, 0u, 0u, 0u, 0u, 0u, 0u};
              sort16_desc(c); merge16_desc(top, c); }
        }
        merge16_partner(top);
        asm volatile("s_waitcnt lgkmcnt(0)" ::: "memory");
        float cv[16]; float den = 0.f; const float m = key2f(top[0] & ~255u);
#pragma unroll
        for (int i = 0; i < 16; ++i) { cv[i] = __expf(key2f(top[i] & ~255u) - m); den += cv[i]; }
        const float rden = 1.f / den;
        if (hi == 0) {
            unsigned iw[8];
#pragma unroll
            for (int i = 0; i < 16; i += 2) {
                const int fl0 = 255 - (int)(top[i] & 255u), fl1 = 255 - (int)(top[i + 1] & 255u);
                const unsigned e0 = (unsigned)sub[r32 * 32 + (fl0 >> 4)] * PNK + (unsigned)sub[r32 * 32 + 16 + (fl0 & 15)];
                const unsigned e1 = (unsigned)sub[r32 * 32 + (fl1 >> 4)] * PNK + (unsigned)sub[r32 * 32 + 16 + (fl1 & 15)];
                iw[i >> 1] = e0 | (e1 << 16); }
            u32x4* ip = (u32x4*)(IDX + (size_t)row * 128 + h * 16); ip[0] = (u32x4){iw[0], iw[1], iw[2], iw[3]}; ip[1] = (u32x4){iw[4], iw[5], iw[6], iw[7]};
            { unsigned* itp = (unsigned*)((unsigned short*)(ws + WS_IDXT) + (size_t)row * 128 + 2 * h);
#pragma unroll
              for (int i = 0; i < 8; ++i) { const unsigned lo_ = (i & 1) ? (iw[i >> 1] >> 16) : (iw[i >> 1] & 0xffffu), hi_ = (i & 1) ? (iw[4 + (i >> 1)] >> 16) : (iw[4 + (i >> 1)] & 0xffffu);
                  itp[8 * i] = lo_ | (hi_ << 16); } }
            float us_[16], gv_[16];
#pragma unroll
            for (int i = 0; i < 16; ++i) { const unsigned e_ = (i & 1) ? (iw[i >> 1] >> 16) : (iw[i >> 1] & 0xffffu); us_[i] = USt[e_]; gv_[i] = cv[i] * rden * VSt[e_] * 1024.f; }
            f32x4* gp = (f32x4*)(GW + (size_t)row * 128 + h * 16); f32x4* up = (f32x4*)(USL + (size_t)row * 128 + h * 16);
#pragma unroll
            for (int q = 0; q < 4; ++q) { gp[q] = (f32x4){gv_[4 * q], gv_[4 * q + 1], gv_[4 * q + 2], gv_[4 * q + 3]}; up[q] = (f32x4){us_[4 * q], us_[4 * q + 1], us_[4 * q + 2], us_[4 * q + 3]}; }
        }
    }
}

typedef __bf16 bf16x2_t __attribute__((ext_vector_type(2)));
typedef float f32x2v __attribute__((ext_vector_type(2)));
__device__ __forceinline__ float dot2(unsigned w, unsigned x, float acc) { return __builtin_amdgcn_fdot2_f32_bf16(__builtin_bit_cast(bf16x2_t, w), __builtin_bit_cast(bf16x2_t, x), acc, false); }
__device__ __forceinline__ float dot16(const u32x4 a0, const u32x4 a1, const u32x4 x0, const u32x4 x1) {
    float s0 = dot2(a0.x, x0.x, 0.f), s1 = dot2(a0.y, x0.y, 0.f), s2 = dot2(a0.z, x0.z, 0.f), s3 = dot2(a0.w, x0.w, 0.f);
    s0 = dot2(a1.x, x1.x, s0); s1 = dot2(a1.y, x1.y, s1); s2 = dot2(a1.z, x1.z, s2); s3 = dot2(a1.w, x1.w, s3);
    return (s0 + s1) + (s2 + s3);
}
__device__ __forceinline__ void fma8(float (&o)[8], const u32x4 v, float w) {
    o[0] += w * bf_lo(v.x); o[1] += w * bf_hi(v.x); o[2] += w * bf_lo(v.y); o[3] += w * bf_hi(v.y);
    o[4] += w * bf_lo(v.z); o[5] += w * bf_hi(v.z); o[6] += w * bf_lo(v.w); o[7] += w * bf_hi(v.w);
}

#define DPP_ADD(v, CTRL) ((v) + __builtin_bit_cast(float, __builtin_amdgcn_update_dpp(0, __builtin_bit_cast(int, (v)), (CTRL), 0xF, 0xF, true)))
__device__ __forceinline__ float dpp_sum8(float v) { v = DPP_ADD(v, 0xB1); v = DPP_ADD(v, 0x4E); v = DPP_ADD(v, 0x141); return v; }
__device__ __forceinline__ float dpp_sum16(float v) { v = dpp_sum8(v); v = DPP_ADD(v, 0x140); return v; }
__device__ __forceinline__ float sum_b345(float v) {
    v = DPP_ADD(v, 0x128);
    { unsigned a = __builtin_bit_cast(unsigned, v), b = a; asm volatile("s_nop 1\n\tv_permlane16_swap_b32 %0, %1" : "+v"(a), "+v"(b)); v = __builtin_bit_cast(float, a) + __builtin_bit_cast(float, b); }
    { unsigned a = __builtin_bit_cast(unsigned, v), b = a; asm volatile("s_nop 1\n\tv_permlane32_swap_b32 %0, %1" : "+v"(a), "+v"(b)); v = __builtin_bit_cast(float, a) + __builtin_bit_cast(float, b); }
    return v;
}
__device__ __forceinline__ float gelu_as(float v) {
    const float av = fabsf(v), t = __builtin_amdgcn_rcpf(av * 0.2316418882f + 1.0f);
    float q = t * 0.5307027145f + (-0.7265760135f); q = q * t + 0.7107068705f; q = q * t + (-0.142248368f); q = q * t + 0.127414796f; q = q * t;
    const float e = __builtin_amdgcn_exp2f((v * v) * (-0.72134752044f)); const float m = v * (q * e);
    return v < 0.f ? m : v - m;
}
#define NT_LD(T, p) (*(const T*)(p))
__device__ __forceinline__ void nt_st4(float* p, const f32x4 v) { *(f32x4*)p = v; }
typedef _Float16 h2_t __attribute__((ext_vector_type(2)));
__device__ __forceinline__ float dot2h(unsigned a, unsigned b, float acc) { return __builtin_amdgcn_fdot2(__builtin_bit_cast(h2_t, a), __builtin_bit_cast(h2_t, b), acc, false); }
constexpr unsigned H_ONES = 0x3C003C00u;
constexpr unsigned H_K64 = 0x64646464u;
constexpr float CODE_BIAS = 1152.f;

__device__ __forceinline__ void pu_phase(const Frame& F, ArgsP Ap, int l, int nrows, char* lds, const int pvar) {
    unsigned char* ws = Ap->ws;
    const unsigned short* IDX = (const unsigned short*)(ws + WS_IDX); const float* GW = (const float*)(ws + WS_GW); const float* USL = (const float*)(ws + WS_USL);
    unsigned short* W16 = (unsigned short*)(ws + (pvar ? WS_W2 + (size_t)NROWS * 128 * 2 : WS_W2));
    const char* Bq = (const char*)(ws + WS_F16B); const float* SB = (const float*)(ws + WS_SB);
    const char* Ut = (const char*)(ws + WS_U + (size_t)l * PEXP * DM);
    const int lane = F.lane, grp = lane >> 4, li = lane & 15;
    int* l_slot = (int*)(lds + F.wave * 4096); int* l_idx = l_slot + 128; float* l_g = (float*)(l_idx + 128); float* l_us = l_g + 128; float* l_a = l_us + 128;
    const bool xs = (F.G % 8) == 0;
    const int wv = xs ? ((F.bid >> 3) * 8 + F.wave) : F.gw, nwv = xs ? (F.G >> 3) * 8 : F.ngw, npass = xs ? 1 : 8;
    const unsigned long long lt = (1ull << lane) - 1ull;
#ifdef PROBE_IDMASK
    const int idmask = (pvar == 2) ? 0x7807 : 0xffff;
#define PU_IDM(e) ((e) & idmask)
#else
#define PU_IDM(e) (e)
#endif
    const unsigned lo2 = (unsigned)lane * 4u, li16 = (unsigned)li * 16u;
    for (int pass = 0; pass < npass; ++pass) {
        const int c = xs ? (F.bid & 7) : pass;
        unsigned iw = 0u, iwn = 0u; f32x2v gg = {0.f, 0.f}, ggn = {0.f, 0.f}, uu = {0.f, 0.f}, uun = {0.f, 0.f}; u32x4 xv[4], xn[4]; float sb = 0.f, sbn = 0.f;
#define PU_LOAD(IW, GG, UU, X, SBV, t_) do { const char* ip_ = (const char*)(IDX + (size_t)(t_) * 128) + lo2; const char* gp_ = (const char*)(GW + (size_t)(t_) * 128) + 2 * lo2; const char* up_ = (const char*)(USL + (size_t)(t_) * 128) + 2 * lo2; \
        const char* xr_ = Bq + (size_t)(t_) * DM + li16; const float* sp_ = SB + (t_); \
        asm volatile("global_load_dword %0, %1, off" : "=&v"(IW) : "v"(ip_) : "memory"); asm volatile("global_load_dwordx2 %0, %1, off" : "=&v"(GG) : "v"(gp_) : "memory"); asm volatile("global_load_dwordx2 %0, %1, off" : "=&v"(UU) : "v"(up_) : "memory"); \
        asm volatile("global_load_dwordx4 %0, %1, off" : "=&v"(X[0]) : "v"(xr_) : "memory"); asm volatile("global_load_dwordx4 %0, %1, off offset:256" : "=&v"(X[1]) : "v"(xr_) : "memory"); \
        asm volatile("global_load_dwordx4 %0, %1, off offset:512" : "=&v"(X[2]) : "v"(xr_) : "memory"); asm volatile("global_load_dwordx4 %0, %1, off offset:768" : "=&v"(X[3]) : "v"(xr_) : "memory"); \
        asm volatile("global_load_dword %0, %1, off" : "=&v"(SBV) : "v"(sp_) : "memory"); } while (0)
        int t = wv;
        if (t < nrows) { PU_LOAD(iw, gg, uu, xv, sb, t); asm volatile("s_waitcnt vmcnt(0)" ::: "memory"); }
        for (; t < nrows; t += nwv) {
            const int i0 = (int)(iw & 0xffffu), i1 = (int)(iw >> 16); const bool m0 = (i0 >> 11) == c, m1 = (i1 >> 11) == c;
            const unsigned long long b0 = __ballot(m0), b1 = __ballot(m1); const int n = (pvar == 1) ? 0 : (__popcll(b0) + __popcll(b1)); const int r0 = __popcll(b0 & lt) + __popcll(b1 & lt);
            if (m0) { l_slot[r0] = 2 * lane; l_idx[r0] = i0; l_g[r0] = gg.x; l_us[r0] = uu.x; }
            if (m1) { const int r1 = r0 + (m0 ? 1 : 0); l_slot[r1] = 2 * lane + 1; l_idx[r1] = i1; l_g[r1] = gg.y; l_us[r1] = uu.y; }
            if (t + nwv < nrows) PU_LOAD(iwn, ggn, uun, xn, sbn, t + nwv);
            asm volatile("s_waitcnt lgkmcnt(0)" ::: "memory");
            u32x4 qa[4], qb[4], sa[4], sb4[4];
#define PU_RLOAD(RA, RB, k0_) do { const int kA_ = ((k0_) + grp < n) ? ((k0_) + grp) : (n - 1), kB_ = ((k0_) + 4 + grp < n) ? ((k0_) + 4 + grp) : (n - 1);       \
                const char* uA_ = Ut + ((unsigned)PU_IDM(l_idx[kA_]) * 1024u + li16); const char* uB_ = Ut + ((unsigned)PU_IDM(l_idx[kB_]) * 1024u + li16); \
                asm volatile("global_load_dwordx4 %0, %1, off" : "=&v"(RA[0]) : "v"(uA_) : "memory"); asm volatile("global_load_dwordx4 %0, %1, off offset:256" : "=&v"(RA[1]) : "v"(uA_) : "memory"); \
                asm volatile("global_load_dwordx4 %0, %1, off offset:512" : "=&v"(RA[2]) : "v"(uA_) : "memory"); asm volatile("global_load_dwordx4 %0, %1, off offset:768" : "=&v"(RA[3]) : "v"(uA_) : "memory"); \
                asm volatile("global_load_dwordx4 %0, %1, off" : "=&v"(RB[0]) : "v"(uB_) : "memory"); asm volatile("global_load_dwordx4 %0, %1, off offset:256" : "=&v"(RB[1]) : "v"(uB_) : "memory"); \
                asm volatile("global_load_dwordx4 %0, %1, off offset:512" : "=&v"(RB[2]) : "v"(uB_) : "memory"); asm volatile("global_load_dwordx4 %0, %1, off offset:768" : "=&v"(RB[3]) : "v"(uB_) : "memory"); } while (0)
#define PU_D4(acc0, acc1, r_, x_) do { acc0 = __builtin_amdgcn_sdot4((int)(r_).x, (int)(x_).x, acc0, false); acc1 = __builtin_amdgcn_sdot4((int)(r_).y, (int)(x_).y, acc1, false); \
                acc0 = __builtin_amdgcn_sdot4((int)(r_).z, (int)(x_).z, acc0, false); acc1 = __builtin_amdgcn_sdot4((int)(r_).w, (int)(x_).w, acc1, false); } while (0)
#define PU_COMP(RA, RB, k0_) do { const int kA_ = ((k0_) + grp < n) ? ((k0_) + grp) : (n - 1), kB_ = ((k0_) + 4 + grp < n) ? ((k0_) + 4 + grp) : (n - 1); \
                int dA0 = 0, dA1 = 0, dB0 = 0, dB1 = 0; \
                _Pragma("unroll") for (int s = 0; s < 4; ++s) { PU_D4(dA0, dA1, RA[s], xv[s]); PU_D4(dB0, dB1, RB[s], xv[s]); } \
                l_a[kA_] = dpp_sum16((float)(dA0 + dA1)); l_a[kB_] = dpp_sum16((float)(dB0 + dB1)); } while (0)
#define PU_WAIT(N) do { asm volatile("s_waitcnt vmcnt(" #N ")" ::: "memory"); __builtin_amdgcn_sched_barrier(0); } while (0)
            if (n == 0) asm volatile("s_waitcnt vmcnt(0)" ::: "memory");
            if (n > 0) {
                PU_RLOAD(qa, qb, 0);
                if (8 < n) { PU_RLOAD(sa, sb4, 8); PU_WAIT(8); } else PU_WAIT(0);
                PU_COMP(qa, qb, 0);
#pragma unroll 1
                for (int k0 = 8; k0 < n; ) {
                    if (k0 + 8 < n) { PU_RLOAD(qa, qb, k0 + 8); PU_WAIT(8); } else PU_WAIT(0);
                    PU_COMP(sa, sb4, k0); k0 += 8;
                    if (k0 >= n) break;
                    if (k0 + 8 < n) { PU_RLOAD(sa, sb4, k0 + 8); PU_WAIT(8); } else PU_WAIT(0);
                    PU_COMP(qa, qb, k0); k0 += 8;
                }
                for (int kk = lane; kk < n; kk += 64) { const float a_ = (l_us[kk] * sb) * l_a[kk]; const _Float16 hw = (_Float16)(l_g[kk] * gelu_as(a_)); W16[(size_t)t * 128 + l_slot[kk]] = __builtin_bit_cast(unsigned short, hw); }
            }
#undef PU_WAIT
#undef PU_RLOAD
#undef PU_D4
#undef PU_COMP
            iw = iwn; gg = ggn; uu = uun; sb = sbn;
#pragma unroll
            for (int s = 0; s < 4; ++s) xv[s] = xn[s];
        }
#undef PU_LOAD
    }
}

typedef _Float16 pvh2_t __attribute__((ext_vector_type(2)));
typedef int i32x4 __attribute__((ext_vector_type(4)));
template <int OFF> __device__ __forceinline__ u32x2v tr8_read(unsigned a) { u32x2v r; asm volatile("ds_read_b64_tr_b8 %0, %1 offset:%2" : "=&v"(r) : "v"(a), "i"(OFF) : "memory"); return r; }
__device__ __forceinline__ void pv_phase(const Frame& F, ArgsP Ap, int l, int nrows, const int pvar, char* lds) {
    const bool dry = pvar != 0;
#ifdef PROBE_IDMASK
    const unsigned idmask = (pvar == 2) ? 0x7u : 0xffffu;
#define PV_IDM(e) ((e) & idmask)
#else
#define PV_IDM(e) (e)
#endif
    unsigned char* ws = Ap->ws;
    const unsigned short* IDXT = (const unsigned short*)(ws + WS_IDXT); const unsigned* W16 = (const unsigned*)(ws + WS_W2);
    const char* Vt = (const char*)(ws + WS_V + (size_t)l * PEXP * DM);
    const float* MOD = (const float*)(ws + WS_MOD) + (size_t)l * 9 * 6144 + 5 * DM;
    float* hlat = dry ? (float*)(ws + WS_X5) : Ap->out; float* hctx = dry ? (float*)(ws + WS_X5) + (size_t)NLAT * DM : (float*)(ws + WS_HCTX);
    float* g2l = (float*)lds;
    const int lane = F.lane, n16 = lane & 15, kg = lane >> 4, jj = lane >> 3, q = lane & 7;
    char* tileg = lds + 8192 + F.wave * 16384;
    LAS char* tile3 = (LAS char*)(uintptr_t)(unsigned)(uintptr_t)tileg;
    char* wrow = lds + 4608 + F.wave * 128;
    const bool xs = (F.G % 8) == 0;
    const int wv = xs ? ((F.bid >> 3) * 8 + F.wave) : F.gw, nwv = xs ? (F.G >> 3) * 8 : F.ngw, npass = xs ? 1 : 8;
    const unsigned fsw = (unsigned)(((n16 >> 2) & 3) | ((kg & 1) << 2));
    const unsigned pb = (unsigned)(uintptr_t)tileg + (unsigned)((16 * kg + (n16 >> 1)) * 128 + 8 * (n16 & 1));
    const unsigned po0 = (unsigned)((q ^ ((jj >> 1) & 3)) * 16), po1 = po0 ^ 64u;
    const unsigned col0 = (unsigned)(32 * kg + n16);
    for (int pass = 0; pass < npass; ++pass) {
        const int s = xs ? (F.bid & 7) : pass;
        const char* vslice = Vt + (size_t)s * PEXP * 128;
        const unsigned coffb = (unsigned)(s * 128) * 4u + col0 * 4u;
        __syncthreads();
        for (int i = F.tid; i < 9 * 128; i += 512) g2l[i] = MOD[(size_t)(i >> 7) * 6144 + s * 128 + (i & 127)];
        __syncthreads();
        if (wv >= nrows) continue;
        const int K = (nrows - wv + nwv - 1) / nwv, tlast = wv + (K - 1) * nwv;
#define PVM_TOK(k_) (((k_) < K) ? (wv + (k_) * nwv) : tlast)
#define PVM_DMA(I, j) do { const unsigned w_ = ((j) < 8) ? ((((j) >> 1) == 0) ? I##a.x : (((j) >> 1) == 1) ? I##a.y : (((j) >> 1) == 2) ? I##a.z : I##a.w) : (((((j) - 8) >> 1) == 0) ? I##b.x : ((((j) - 8) >> 1) == 1) ? I##b.y : ((((j) - 8) >> 1) == 2) ? I##b.z : I##b.w); \
            const unsigned e_ = PV_IDM(((j) & 1) ? (w_ >> 16) : (w_ & 0xffffu)); \
            __builtin_amdgcn_global_load_lds((const unsigned*)(vslice + (e_ * 128u + ((((j) >> 1) & 1) ? po1 : po0))), (LAS unsigned*)(tile3 + (j) * 1024), 16, 0, 0); } while (0)
#define PVM_DMA8(I, j0) do { PVM_DMA(I, (j0) + 0); PVM_DMA(I, (j0) + 1); PVM_DMA(I, (j0) + 2); PVM_DMA(I, (j0) + 3); PVM_DMA(I, (j0) + 4); PVM_DMA(I, (j0) + 5); PVM_DMA(I, (j0) + 6); PVM_DMA(I, (j0) + 7); } while (0)
#define PVM_HPTR(t_) ((const char*)(((t_) < NLAT) ? (hlat + (size_t)(t_) * DM) : (hctx + (size_t)((t_) - NLAT) * DM)) + coffb)
#define PVM_LOADC(I, W, H, tids_, tw_) do { const char* ib_ = (const char*)(IDXT + (size_t)(tids_) * 128) + jj * 32; const unsigned* wp_ = W16 + (size_t)(tw_) * 64 + lane; const char* hp_ = PVM_HPTR(tw_); \
            asm volatile("global_load_dwordx4 %0, %1, off" : "=&v"(I##a) : "v"(ib_) : "memory"); asm volatile("global_load_dwordx4 %0, %1, off offset:16" : "=&v"(I##b) : "v"(ib_) : "memory"); \
            asm volatile("global_load_dword %0, %1, off" : "=&v"(W) : "v"(wp_) : "memory"); \
            asm volatile("global_load_dword %0, %1, off" : "=&v"(H##0) : "v"(hp_) : "memory"); asm volatile("global_load_dword %0, %1, off offset:64" : "=&v"(H##1) : "v"(hp_) : "memory"); } while (0)
#define PVM_STEP(st, A_, FIRST) do { \
            _Pragma("unroll") for (int nt = 0; nt < 8; ++nt) { const unsigned ad_ = pb + (((unsigned)nt ^ fsw) << 4); \
                const u32x2v lo_ = tr8_read<(st) * 8192>(ad_), hi_ = tr8_read<(st) * 8192 + 1024>(ad_); bop[nt] = (i32x4){(int)lo_.x, (int)lo_.y, (int)hi_.x, (int)hi_.y}; } \
            asm volatile("s_waitcnt lgkmcnt(0)" ::: "memory"); SBARP(); \
            _Pragma("unroll") for (int nt = 0; nt < 8; ++nt) acc[nt] = __builtin_amdgcn_mfma_i32_16x16x64_i8(A_, bop[nt], (FIRST) ? (i32x4){0, 0, 0, 0} : acc[nt], 0, 0, 0); \
            SBARP(); } while (0)
#define PVM_READS(st, BOP) do { \
            _Pragma("unroll") for (int nt = 0; nt < 8; ++nt) { const unsigned ad_ = pb + (((unsigned)nt ^ fsw) << 4); \
                const u32x2v lo_ = tr8_read<(st) * 8192>(ad_), hi_ = tr8_read<(st) * 8192 + 1024>(ad_); BOP[nt] = (i32x4){(int)lo_.x, (int)lo_.y, (int)hi_.x, (int)hi_.y}; } \
            asm volatile("s_waitcnt lgkmcnt(0)" ::: "memory"); SBARP(); } while (0)
#define SBARP() __builtin_amdgcn_sched_barrier(0)
#define PVM_ITER(IX, WX, HX, IY, WY, HY, k_) do { const int t0_ = PVM_TOK(k_), t1_ = PVM_TOK((k_) + 1), t2_ = PVM_TOK((k_) + 2); \
            asm volatile("s_waitcnt vmcnt(2)" ::: "memory"); SBARP();                \
              \
            PVM_READS(0, bop); PVM_DMA8(IX, 0);                                        \
            PVM_READS(1, bop1); PVM_DMA8(IX, 8);                                       \
            PVM_LOADC(IY, WY, HY, t2_, t1_);                                          \
              \
            float ksc_; { const unsigned aw_ = WX & 0x7fff7fffu; unsigned m_ = (aw_ & 0xffffu) > (aw_ >> 16) ? (aw_ & 0xffffu) : (aw_ >> 16); \
                m_ = max(m_, (unsigned)__builtin_amdgcn_update_dpp(0, (int)m_, 0xB1, 0xF, 0xF, true)); m_ = max(m_, (unsigned)__builtin_amdgcn_update_dpp(0, (int)m_, 0x4E, 0xF, 0xF, true)); \
                m_ = max(m_, (unsigned)__builtin_amdgcn_update_dpp(0, (int)m_, 0x141, 0xF, 0xF, true)); m_ = max(m_, (unsigned)__builtin_amdgcn_update_dpp(0, (int)m_, 0x140, 0xF, 0xF, true)); \
                const unsigned mw_ = max(max((unsigned)__builtin_amdgcn_readlane((int)m_, 0), (unsigned)__builtin_amdgcn_readlane((int)m_, 16)), max((unsigned)__builtin_amdgcn_readlane((int)m_, 32), (unsigned)__builtin_amdgcn_readlane((int)m_, 48))); \
                const float mx_ = (float)__builtin_bit_cast(_Float16, (unsigned short)mw_); const float sc_ = (mx_ > 0.f) ? 127.f * __builtin_amdgcn_rcpf(mx_) : 0.f; ksc_ = mx_ * (1.f / (127.f * 1024.f)); \
                const pvh2_t s2_ = {(_Float16)sc_, (_Float16)sc_}; const pvh2_t k2_ = {(_Float16)1536.f, (_Float16)1536.f}; \
                const unsigned qf_ = __builtin_bit_cast(unsigned, __builtin_elementwise_fma(__builtin_bit_cast(pvh2_t, WX), s2_, k2_));        \
                *(unsigned short*)(wrow + 2 * lane) = (unsigned short)((qf_ & 0xffu) | ((qf_ >> 8) & 0xff00u)); } \
            const i32x4 a0_ = *(const i32x4*)(wrow + 16 * kg), a1_ = *(const i32x4*)(wrow + 64 + 16 * kg);        \
            _Pragma("unroll") for (int nt = 0; nt < 8; ++nt) acc[nt] = __builtin_amdgcn_mfma_i32_16x16x64_i8(a0_, bop[nt], (i32x4){0, 0, 0, 0}, 0, 0, 0); \
            _Pragma("unroll") for (int nt = 0; nt < 8; ++nt) acc[nt] = __builtin_amdgcn_mfma_i32_16x16x64_i8(a1_, bop1[nt], acc[nt], 0, 0, 0); \
              \
            { const int v0_ = (kg == 0) ? acc[0][0] : (kg == 1) ? acc[2][0] : (kg == 2) ? acc[4][0] : acc[6][0], v1_ = (kg == 0) ? acc[1][0] : (kg == 1) ? acc[3][0] : (kg == 2) ? acc[5][0] : acc[7][0]; \
              const float* g2_ = g2l + ((t0_ < NLAT) ? (t0_ >> 12) : 8) * 128 + col0; float* hw_ = (float*)PVM_HPTR(t0_); \
              hw_[0] = HX##0 + g2_[0] * ((float)v0_ * ksc_); hw_[16] = HX##1 + g2_[16] * ((float)v1_ * ksc_); } \
            } while (0)
        u32x4 iXa, iXb, iYa, iYb; unsigned wX, wY; float hX0, hX1, hY0, hY1; i32x4 acc[8], bop[8], bop1[8];
        { const char* ib_ = (const char*)(IDXT + (size_t)wv * 128) + jj * 32; iYa = *(const u32x4*)ib_; iYb = *(const u32x4*)(ib_ + 16); }
        PVM_DMA8(iY, 0); PVM_DMA8(iY, 8); PVM_LOADC(iX, wX, hX, PVM_TOK(1), PVM_TOK(0));
        asm volatile("s_waitcnt vmcnt(0)" ::: "memory"); SBARP();
        int k = 0;
        for (; k + 1 < K; k += 2) {
            PVM_ITER(iX, wX, hX, iY, wY, hY, k);
            PVM_ITER(iY, wY, hY, iX, wX, hX, k + 1);
        }
        if (k < K) PVM_ITER(iX, wX, hX, iY, wY, hY, k);
        asm volatile("s_waitcnt vmcnt(0)" ::: "memory");
#undef PVM_TOK
#undef PVM_DMA
#undef PVM_DMA8
#undef PVM_HPTR
#undef PVM_LOADC
#undef PVM_STEP
#undef PVM_READS
#undef PVM_ITER
#undef SBARP
    }
}
constexpr int PH_PER_LAYER = 12, N_PHASES = 1 + DEPTH * PH_PER_LAYER;
#ifndef MK_ONE_LAUNCH
#define MK_ONE_LAUNCH 0
#endif
#ifndef MK_MASK
#define MK_MASK 0x1FFF
#endif
#define PON(s) (((MK_MASK) >> (s)) & 1)

#ifndef DBG_NAIVE_GEMM
#define DBG_NAIVE_GEMM 0
#endif
#if DBG_NAIVE_GEMM
__device__ __forceinline__ void naive_gemm(const Frame& F, const pg8::Gemm g, int kind, const pg8::EpiStore es, const pg8::EpiResid er) {
    const int ncg = g.N / 64; const int nunits = g.M * ncg;
    for (int u = F.gw; u < nunits; u += F.ngw) {
        const int row = __builtin_amdgcn_readfirstlane(u / ncg), col = (u % ncg) * 64 + F.lane;
        const bf16* ar = g.A + (size_t)row * g.K; const bf16* br = g.Bt + (size_t)col * g.K; float acc = 0.f;
#pragma unroll 1
        for (int k = 0; k < g.K; k += 8) { const u32x4 a = *(const u32x4*)(ar + k), b = *(const u32x4*)(br + k); float x[8], y[8]; unpack8(a, x); unpack8(b, y);
#pragma unroll
            for (int e = 0; e < 8; ++e) acc = fmaf(x[e], y[e], acc); }
        if (kind == 0) { if (col < es.ncols) es.O[(size_t)row * es.ldc + col] = (bf16)(pk2(acc, 0.f) & 0xffffu); }
        else if (kind == 1) { const int head = col >> 7, j = col & 127; bf16* d = (j < 64) ? (es.O + (size_t)row * 768 + head * 96 + j) : (es.VM + (size_t)row * 512 + head * 64 + (j - 64)); *d = (bf16)(pk2(acc, 0.f) & 0xffffu); }
        else { const bool lat = row < er.nlat; const int sample = lat ? (row >> 12) : 8;
            const float* src = lat ? er.hin_lat + (size_t)row * 1024 : er.hin_ctx + (size_t)(row - er.nlat) * 1024; float* dst = lat ? er.hout_lat + (size_t)row * 1024 : er.hout_ctx + (size_t)(row - er.nlat) * 1024;
            dst[col] = src[col] + er.gate[(size_t)sample * 6144 + col] * acc; }
    }
}
#endif

__global__ void __launch_bounds__(512, 2) mk_fwd(Args args_unused) {
    extern __shared__ __attribute__((aligned(16))) unsigned char lds[];
    LAS unsigned char* lds3 = (LAS unsigned char*)lds;
    ArgsP args0 = (ArgsP)__builtin_amdgcn_kernarg_segment_ptr();
    const int ph_lo = args0->ph_lo, ph_hi = args0->ph_hi;
    const int wave_s = __builtin_amdgcn_readfirstlane((int)threadIdx.x >> 6);
#if MK_ONE_LAUNCH == 2
    {
        volatile LAS unsigned* st = (volatile LAS unsigned*)(lds3 + LDS_BYTES - 64);
        if (threadIdx.x < 2) st[threadIdx.x] = 0u;
        __syncthreads();
        (void)xcd_barrier_post((unsigned*)(args0->ws + WS_CTL), st, threadIdx.x == 0);
    }
#endif
#if defined(TPROBE)
    unsigned long long tp_start = __builtin_amdgcn_s_memrealtime(), tp_acc = 0ull;
#endif
#pragma unroll 1
    for (int pi = ph_lo; pi < ph_hi; ++pi) {
        int zv = 0; asm volatile("" : "+v"(zv));
        ArgsP args = args0; asm volatile("" : "+s"(args));
        Frame F;
        F.zv = zv; F.lane = (int)__builtin_amdgcn_mbcnt_hi(~0u, __builtin_amdgcn_mbcnt_lo(~0u, 0u)) + zv; F.wave = wave_s; F.tid = wave_s * 64 + F.lane;
        { int bx = blockIdx.x, gd = gridDim.x; asm volatile("" : "+s"(bx), "+s"(gd)); F.bid = bx; F.G = gd; F.vcu = (gd % 8 == 0) ? (bx % 8) * (gd / 8) + bx / 8 : bx; }
        F.gw = F.bid * 8 + F.wave; F.ngw = F.G * 8;
        unsigned char* ws = args->ws;
#if defined(TPROBE)
        const unsigned long long tp_t0 = __builtin_amdgcn_s_memrealtime();
#endif
        const int phraw = args->prog[pi], ph = phraw & 63, pvar = phraw >> 6;
        int njobs = 0, jkind = 0;
        pg8::Gemm gj[2]; pg8::EpiStore ej[2];
        int l = 0, mrows = NROWS;
        if (ph == 0) { if (PON(12)) p0_prologue(F, args, lds3); }
        else if (ph == 63) {   }
        else {
            const int q = ph - 1, s = q % PH_PER_LAYER; l = q / PH_PER_LAYER;
            mrows = (l == DEPTH - 1) ? NLAT : NROWS;
            switch (s) {
            case 0: if (PON(0)) norm_mod_phase(F, args, l, 0, NROWS, (char*)lds); break;
            case 1: if (PON(1)) { njobs = 1;
                gj[0] = pg8::Gemm{(const bf16*)(ws + WS_AB), (const bf16*)(ws + WS_WIN) + (size_t)l * DINP * DM, NROWS, DINP, DM};
                ej[0] = pg8::EpiStore{0, (bf16*)(ws + WS_P), DIN, DIN, nullptr}; } break;
            case 2: if (PON(2)) e2_phase(F, args, l, NROWS, (char*)lds); break;
            case 3: if (PON(3)) { njobs = 2;
                gj[0] = pg8::Gemm{(const bf16*)(ws + WS_AB), (const bf16*)(ws + WS_WUQ) + (size_t)l * 768 * QRANK, NROWS, 768, QRANK};
                ej[0] = pg8::EpiStore{0, (bf16*)(ws + WS_QM), 768, 768, nullptr};
                gj[1] = pg8::Gemm{(const bf16*)(ws + WS_AB) + (size_t)NROWS * QRANK, (const bf16*)(ws + WS_WUKV) + (size_t)l * 1024 * KVRANK, NROWS, 1024, KVRANK};
                ej[1] = pg8::EpiStore{1, (bf16*)(ws + WS_KM), 768, 1024, (bf16*)(ws + WS_VM)}; } break;
            case 4: if (PON(4)) e3_phase(F, args, l, NROWS, pvar, (char*)lds); break;
            case 5: if (PON(5)) {
#if DBG_NAIVE_ATTN
                attn_naive_phase(F, args, l);
#else
                attn_phase(F, args, l, (char*)lds, pvar);
#endif
                } break;
            case 6: if (PON(6)) { njobs = 1; jkind = 1;
                gj[0] = pg8::Gemm{(const bf16*)(ws + WS_AB), (const bf16*)(ws + WS_WOUT) + (size_t)l * DM * DM, mrows, DM, DM}; } break;
            case 7: if (PON(7)) norm_mod_phase(F, args, l, 1, mrows, (char*)lds); break;
            case 8: if (PON(8)) { njobs = 1;
                gj[0] = pg8::Gemm{(const bf16*)(ws + WS_AB), (const bf16*)(ws + WS_PWQ) + (size_t)l * 2048 * DM, mrows, 2048, DM};
                ej[0] = pg8::EpiStore{0, (bf16*)(ws + WS_X5), 2048, 2048, nullptr}; } break;
            case 9: if (PON(9)) topkc_phase(F, args, l, mrows, (char*)lds); break;
            case 10: if (PON(10)) pu_phase(F, args, l, mrows, (char*)lds, pvar); break;
            default: if (PON(11)) pv_phase(F, args, l, mrows, pvar, (char*)lds); break;
            }
        }
        if (njobs > 0) {
#if DBG_NAIVE_GEMM
            { const pg8::EpiResid ER{(l == 0) ? args->in[0] : args->out, args->in[2], args->out, (float*)(ws + WS_HCTX), (const float*)(ws + WS_MOD) + (size_t)l * 9 * 6144 + 2 * DM, NLAT};
              _Pragma("unroll 1") for (int j = 0; j < njobs; ++j) { const pg8::Gemm g = (j == 0) ? gj[0] : gj[1]; const pg8::EpiStore E = (j == 0) ? ej[0] : ej[1]; naive_gemm(F, g, jkind ? 2 : E.mode, E, ER); } }
#else
            if (jkind == 0) {
#pragma unroll 1
                for (int j = 0; j < njobs; ++j) { __syncthreads();
                    const pg8::Gemm g = (j == 0) ? gj[0] : gj[1]; const pg8::EpiStore E = (j == 0) ? ej[0] : ej[1];
                    pg8::StaticOrder S; S.init(g.M, g.N, F.G, (j == 1) ? (F.G - 1 - F.bid) : F.bid);
                    pg8::gemm_phase<pg8::EpiStore, pg8::StaticOrder, true, true>(lds3, g, S, E, F.tid); }
            } else { __syncthreads();
                const pg8::Gemm g = gj[0];
                pg8::StaticOrder S; S.init(g.M, g.N, F.G, F.bid);
                pg8::EpiResid E{(l == 0) ? args->in[0] : args->out, args->in[2], args->out, (float*)(ws + WS_HCTX), (const float*)(ws + WS_MOD) + (size_t)l * 9 * 6144 + 2 * DM, NLAT};
                pg8::gemm_phase<pg8::EpiResid, pg8::StaticOrder, true, true>(lds3, g, S, E, F.tid); }
#endif
        }
#if defined(TPROBE)
        { asm volatile("s_waitcnt vmcnt(0) lgkmcnt(0)" ::: "memory"); const unsigned long long tp_t1 = __builtin_amdgcn_s_memrealtime();
          const int kind_ = (ph == 0) ? 100 : ((ph - 1) % PH_PER_LAYER); if (kind_ == (TPROBE)) tp_acc += tp_t1 - tp_t0; }
#endif
#if MK_ONE_LAUNCH == 1
        if (pi + 1 < ph_hi) cg::this_grid().sync();
#elif MK_ONE_LAUNCH == 2
        if (pi + 1 < ph_hi) { XcdBarrier xb; xb.bar = (unsigned*)(ws + WS_CTL); xb.x = xb_xcc_id(); xb.st = (volatile LAS unsigned*)(lds3 + LDS_BYTES - 64);
#ifdef PROBE_BARRIER
            if (ph == 63 && pvar == 1) xcd_barrier<1>(xb, F.tid == 0); else if (ph == 63 && pvar == 2) xcd_barrier<2>(xb, F.tid == 0); else
#endif
            xcd_barrier<0>(xb, F.tid == 0); }
#endif
    }
#if defined(TPROBE)
    {
        float* fr = (float*)(args0->ws + WS_CTL + 32768);
        if (blockIdx.x == 0 && threadIdx.x == 0) { const unsigned long long tp_end = __builtin_amdgcn_s_memrealtime();
            float frac = (float)tp_acc / (float)(tp_end - tp_start); if ((TPROBE) == 999) frac = 0.5f; __hip_atomic_store(fr, frac, __ATOMIC_RELAXED, __HIP_MEMORY_SCOPE_AGENT); }
        { XcdBarrier xb; xb.bar = (unsigned*)(args0->ws + WS_CTL); xb.x = xb_xcc_id(); xb.st = (volatile LAS unsigned*)(lds3 + LDS_BYTES - 64); xcd_barrier(xb, threadIdx.x == 0); }
        const float frac = __hip_atomic_load(fr, __ATOMIC_RELAXED, __HIP_MEMORY_SCOPE_AGENT);
        for (size_t i = (size_t)blockIdx.x * 512 + threadIdx.x; i < (size_t)NLAT * DM / 4; i += (size_t)gridDim.x * 512) { f32x4 v = ((f32x4*)args0->out)[i]; v += frac; ((f32x4*)args0->out)[i] = v; }
    }
#endif
}

extern "C" void kernel_launch(void* const* d_in, const int* in_sizes, int n_in, void* d_out, int out_size, void* d_ws, size_t ws_size, hipStream_t stream) {
    static int grid = 0;
    if (grid == 0) {
        if (n_in != 23 || in_sizes[0] != NLAT * DM || out_size != NLAT * DM || ws_size < WS_END) {
            fprintf(stderr, "kernel_launch: unexpected shapes: n_in %d in0 %d out %d ws %zu (need %zu)\n", n_in, n_in > 0 ? in_sizes[0] : -1, out_size, ws_size, (size_t)WS_END); grid = -1; return; }
        int dev = 0, cus = 0, per_cu = 0;
        if (hipGetDevice(&dev) != hipSuccess || hipDeviceGetAttribute(&cus, hipDeviceAttributeMultiprocessorCount, dev) != hipSuccess) { fprintf(stderr, "kernel_launch: device query failed\n"); grid = -1; return; }
        if (hipFuncSetAttribute((const void*)mk_fwd, hipFuncAttributeMaxDynamicSharedMemorySize, LDS_BYTES) != hipSuccess) { fprintf(stderr, "kernel_launch: hipFuncSetAttribute failed\n"); grid = -1; return; }
        if (hipOccupancyMaxActiveBlocksPerMultiprocessor(&per_cu, (const void*)mk_fwd, 512, LDS_BYTES) != hipSuccess || per_cu < 1) { fprintf(stderr, "kernel_launch: occupancy query says %d\n", per_cu); per_cu = 1; }
        (void)hipGetLastError();
        grid = cus;
    }
    if (grid < 0) return;
    Args a{};
    for (int i = 0; i < 23; ++i) a.in[i] = (const float*)d_in[i];
    a.out = (float*)d_out; a.ws = (unsigned char*)d_ws;
    int np = 0;
#ifdef MK_PROG
    { static const int pr[] = {MK_PROG}; for (int i = 0; i < (int)(sizeof(pr) / sizeof(pr[0])); ++i) a.prog[np++] = (unsigned char)pr[i]; }
#else
    for (int p = 0; p < N_PHASES; ++p) a.prog[np++] = (unsigned char)p;
#endif
#if MK_ONE_LAUNCH == 2
    a.ph_lo = 0; a.ph_hi = np;
    if (hipMemsetAsync((char*)d_ws + WS_CTL, 0, CTL_ZERO_BYTES, stream) != hipSuccess) { fprintf(stderr, "kernel_launch: hipMemsetAsync of the barrier words failed\n"); return; }
    hipLaunchKernelGGL(mk_fwd, dim3(grid), dim3(512), LDS_BYTES, stream, a);
    { const hipError_t le = hipPeekAtLastError(); if (le != hipSuccess) fprintf(stderr, "kernel_launch: launch failed: %s\n", hipGetErrorName(le)); }
#elif MK_ONE_LAUNCH == 1
    a.ph_lo = 0; a.ph_hi = np;
    void* kargs[] = {&a};
    hipError_t e = hipLaunchCooperativeKernel((const void*)mk_fwd, dim3(grid), dim3(512), kargs, LDS_BYTES, stream);
    if (e != hipSuccess) fprintf(stderr, "kernel_launch: cooperative launch failed: %s (grid %d)\n", hipGetErrorString(e), grid);
#else
    for (int p = 0; p < np; ++p) {
        a.ph_lo = p; a.ph_hi = p + 1;
        hipLaunchKernelGGL(mk_fwd, dim3(grid), dim3(512), LDS_BYTES, stream, a);
    }
    const hipError_t le = hipPeekAtLastError();
    if (le != hipSuccess) fprintf(stderr, "kernel_launch: launch failed: %s\n", hipGetErrorName(le));
#endif
}
```

```cpp
#define MK_ONE_LAUNCH 2
#define DBG_PRECISE_TOPK 0
#define DBG_NAIVE_ATTN 0
#define DBG_PRECISE_PEER 0
#define DBG_NAIVE_GEMM 0
#define DBG_ASCALE 1.0f
#define DBG_PSCALE 1.0f
#include <hip/hip_runtime.h>
#include <hip/hip_cooperative_groups.h>
#include <cstdio>
#include <cstdint>
#include <cmath>
namespace cg = cooperative_groups;
namespace pg8 {
#define PG8_LAS __attribute__((address_space(3)))
typedef unsigned short bf16_t;
typedef short bf16x8 __attribute__((ext_vector_type(8)));
typedef float f32x4 __attribute__((ext_vector_type(4)));
typedef unsigned u32x4 __attribute__((ext_vector_type(4)));
constexpr int BM = 256, BK = 64, HALF = 128, HTB = HALF * BK * 2  , STAGE_BYTES = 8 * HTB, NXCD = 8, WGM = 8;

__host__ __device__ __forceinline__ int lds_byte(int r, int c) { const int st = (r >> 4) * 2 + (c >> 5), rr = r & 15, cc = c & 31, ob = rr * 64 + cc * 2; return st * 1024 + (ob ^ (((ob >> 9) & 1) << 5)); }
__host__ __device__ __forceinline__ void stage_rc(int b, int& R, int& C) { const int st = b / 1024, sb = b % 1024, swz = sb ^ (((sb >> 9) & 1) << 5); R = (st >> 1) * 16 + swz / 64; C = (st & 1) * 32 + (swz % 64) / 2; }
__host__ __device__ __forceinline__ int perm32(int rho) { const int n = rho >> 4, i = rho & 15; return 8 * (i >> 2) + 4 * n + (i & 3); }

struct Unit { int pm, pn; };
struct Gemm { const bf16_t* A; const bf16_t* Bt; int M, N, K; };

struct StaticOrder {
    int nM, nN, nwg, G, c, ilo, ihi;
    __host__ __device__ void init(int M, int N, int G_, int c_) { nM = M / BM; nN = N / BM; nwg = nM * nN; G = G_; c = c_; ilo = 0; ihi = 1 << 20; }
    __host__ __device__ bool next(int i, Unit& u) const {
        if (i + ilo >= ihi) return false;
        const long L = (long)(i + ilo) * G + c; if (L >= nwg) return false;
        if ((nM % NXCD) == 0 && (G % NXCD) == 0) {
            const int xcd = (int)(L % NXCD), off = (int)(L / NXCD), mper = nM / NXCD;
            const int nig = WGM * nN, gid = off / nig, fm = gid * WGM, gsz = (mper - fm) < WGM ? (mper - fm) : WGM;
            u.pm = xcd * mper + fm + ((off % nig) % gsz); u.pn = (off % nig) / gsz; return true; }
        int wgid = (int)L; { const int q = nwg / NXCD, r = nwg % NXCD, xcd = wgid % NXCD, off = wgid / NXCD; wgid = (xcd < r ? xcd * (q + 1) : r * (q + 1) + (xcd - r) * q) + off; }
        const int nig = WGM * nN, gid = wgid / nig, fm = gid * WGM, gsz = (nM - fm) < WGM ? (nM - fm) : WGM;
        u.pm = fm + ((wgid % nig) % gsz); u.pn = (wgid % nig) / gsz; return true;
    }
    __device__ __forceinline__ void a_ready(const Unit&) const {}
    __device__ __forceinline__ void done(const Unit&) const {}
};

typedef float cvt_f32x2 __attribute__((ext_vector_type(2))); typedef __bf16 cvt_bf16x2 __attribute__((ext_vector_type(2)));
__device__ __forceinline__ unsigned cvt_pk_bf16(float lo, float hi) { const cvt_f32x2 v = {lo, hi}; const cvt_bf16x2 b = __builtin_convertvector(v, cvt_bf16x2); return __builtin_bit_cast(unsigned, b); }
typedef float f32x2 __attribute__((ext_vector_type(2)));
typedef unsigned u32x2 __attribute__((ext_vector_type(2)));
#ifndef DBG_ASCALE
#define DBG_ASCALE 1.0f
#endif
#ifndef DBG_PSCALE
#define DBG_PSCALE 1.0f
#endif
struct EpiStore {
    static constexpr bool PERM = true, AFTER_DRAIN = false;
    int mode; bf16_t* O; int ldc; int ncols; bf16_t* VM;
    __device__ __forceinline__ void operator()(const f32x4 (&acc)[2][2][4][2], const Unit& u, int wr, int wc, int fr, int fq) const {
        const int row0 = u.pm * BM + wr * 64 + fr;
        bf16_t* base; int rstride, hstride; bool on0, on1;
        if (mode == 0) { const int col0 = u.pn * BM + wc * 32 + 8 * fq; base = O + (size_t)row0 * ldc + col0; rstride = ldc; hstride = HALF; on0 = col0 < ncols; on1 = col0 + HALF < ncols; }
        else {
            const int j = wc * 32 + 8 * fq; const bool isk = wc < 2;
            base = isk ? (O + (size_t)row0 * 768 + (2 * u.pn) * 96 + j) : (VM + (size_t)row0 * 512 + (2 * u.pn) * 64 + (j - 64));
            rstride = isk ? 768 : 512; hstride = isk ? 96 : 64; on0 = true; on1 = true; }
#pragma unroll
        for (int ai = 0; ai < 2; ++ai)
#pragma unroll
            for (int m = 0; m < 4; ++m) { bf16_t* rowp = base + (size_t)(ai * HALF + m * 16) * rstride;
#pragma unroll
                for (int bj = 0; bj < 2; ++bj) {
                    if (bj == 0 ? on0 : on1) { const f32x4 v0 = acc[ai][bj][m][0], v1 = acc[ai][bj][m][1]; u32x4 w;
                        w.x = cvt_pk_bf16(v0[0], v0[1]); w.y = cvt_pk_bf16(v0[2], v0[3]); w.z = cvt_pk_bf16(v1[0], v1[1]); w.w = cvt_pk_bf16(v1[2], v1[3]);
                        *(u32x4*)(rowp + bj * hstride) = w; } } }
    }
};
struct EpiResid {
    static constexpr bool PERM = false, AFTER_DRAIN = false;
    const float* hin_lat; const float* hin_ctx; float* hout_lat; float* hout_ctx; const float* gate; int nlat;
    __device__ __forceinline__ void operator()(const f32x4 (&acc)[2][2][4][2], const Unit& u, int wr, int wc, int fr, int fq) const {
        const int rowt = u.pm * BM; const bool lat = rowt < nlat; const int sample = lat ? (rowt >> 12) : 8;
        const float* src = lat ? hin_lat + (size_t)rowt * 1024 : hin_ctx + (size_t)(rowt - nlat) * 1024;
        float* dst = lat ? hout_lat + (size_t)rowt * 1024 : hout_ctx + (size_t)(rowt - nlat) * 1024;
        const float* g = gate + (size_t)sample * 6144;
        const int col0 = u.pn * BM + wc * 32 + 4 * fq;
#pragma unroll
        for (int bj = 0; bj < 2; ++bj)
#pragma unroll
            for (int n = 0; n < 2; ++n) { const int c = col0 + bj * HALF + n * 16; const f32x4 gv = *(const f32x4*)(g + c);
#pragma unroll
                for (int ai = 0; ai < 2; ++ai)
#pragma unroll
                    for (int m = 0; m < 4; ++m) { const size_t off = (size_t)(ai * HALF + wr * 64 + m * 16 + fr) * 1024 + c;
                        const f32x4 hv = *(const f32x4*)(src + off); *(f32x4*)(dst + off) = hv + gv * acc[ai][bj][m][n] * (float)(DBG_ASCALE); } }
    }
};
template <class Epi, class Sched, bool ALIGN_EPI = false, bool SP2 = false>
__device__ __forceinline__ void gemm_phase(PG8_LAS unsigned char* lds, const Gemm g, const Sched& S, const Epi& E, const int tid_in) {
    const int tid = tid_in, wid = __builtin_amdgcn_readfirstlane(tid >> 6), lane = tid & 63, wr = wid >> 2, wc = wid & 3, fr = lane & 15, fq = lane >> 4;
    const int K = g.K, nt = K / BK;
    unsigned voffA[2], voffB[2];
#pragma unroll
    for (int i = 0; i < 2; ++i) { int R, C; stage_rc(tid * 16 + i * 8192, R, C); const int Rb = Epi::PERM ? ((R & ~31) + perm32(R & 31)) : R;
        voffA[i] = (unsigned)(R * K + C) * 2u; voffB[i] = (unsigned)(Rb * K + C) * 2u; }
    const size_t kstep = (size_t)(BK * 2);
    const size_t hstep = (size_t)HALF * K * 2;
    const size_t tstep = 2 * hstep;
    const unsigned ldsw = (unsigned)wid * 1024u;
    const int aoff = lds_byte(wr * 64 + fr, fq * 8), boff = lds_byte(wc * 32 + fr, fq * 8);
#define PG8_SA(b, h) (((b) * 2 + (h)) * HTB)
#define PG8_SB(b, h) ((4 + (b) * 2 + (h)) * HTB)
#define PG8_STAGE(bufoff, gbase, voff) do { _Pragma("unroll") for (int _i = 0; _i < 2; ++_i) \
        __builtin_amdgcn_global_load_lds((const unsigned*)((const char*)(gbase) + (voff)[_i]), (PG8_LAS unsigned*)(lds + (bufoff) + ldsw + _i * 8192), 16, 0, 0); } while (0)
#define PG8_LDA(dst, b, h) do { _Pragma("unroll") for (int m = 0; m < 4; ++m) _Pragma("unroll") for (int k = 0; k < 2; ++k) dst[m][k] = *(const PG8_LAS bf16x8*)(lds + PG8_SA(b, h) + aoff + m * 2048 + k * 1024); } while (0)
#define PG8_LDB(dst, b, h) do { _Pragma("unroll") for (int n = 0; n < 2; ++n) _Pragma("unroll") for (int k = 0; k < 2; ++k) dst[n][k] = *(const PG8_LAS bf16x8*)(lds + PG8_SB(b, h) + boff + n * 2048 + k * 1024); } while (0)
#define PG8_MMA(ai, bj, At, Bt) do { __builtin_amdgcn_s_setprio(1); _Pragma("unroll") for (int m = 0; m < 4; ++m) _Pragma("unroll") for (int n = 0; n < 2; ++n) _Pragma("unroll") for (int k = 0; k < 2; ++k) \
        acc[ai][bj][m][n] = __builtin_amdgcn_mfma_f32_16x16x32_bf16(Bt[n][k], At[m][k], acc[ai][bj][m][n], 0, 0, 0); __builtin_amdgcn_s_setprio(0); } while (0)
#define PG8_WAIT_V(n) asm volatile("s_waitcnt vmcnt(" #n ")" ::: "memory")
#define PG8_WAIT_L(n) asm volatile("s_waitcnt lgkmcnt(" #n ")" ::: "memory")
#define PG8_BAR __builtin_amdgcn_s_barrier()
#define PG8_SCHED __builtin_amdgcn_sched_barrier(0)
    Unit cur, nxt; int ui = 0;
    if (!S.next(0, cur)) return;
    f32x4 acc[2][2][4][2];
#pragma unroll
    for (int a = 0; a < 2; ++a)
#pragma unroll
        for (int b = 0; b < 2; ++b)
#pragma unroll
            for (int m = 0; m < 4; ++m)
#pragma unroll
                for (int n = 0; n < 2; ++n) acc[a][b][m][n] = (f32x4){0.f, 0.f, 0.f, 0.f};
    bf16x8 At[4][2], B0[2][2], B1[2][2];
    const char* cA = (const char*)g.A + (size_t)cur.pm * tstep; const char* cB = (const char*)g.Bt + (size_t)cur.pn * tstep;
    S.a_ready(cur);
    if constexpr (SP2) {
        PG8_STAGE(PG8_SB(0, 0), cB, voffB); PG8_STAGE(PG8_SB(0, 1), cB + hstep, voffB); PG8_STAGE(PG8_SA(0, 0), cA, voffA); PG8_STAGE(PG8_SA(0, 1), cA + hstep, voffA);
        if (wr == 1) PG8_BAR;
        PG8_WAIT_V(2); PG8_BAR;
        PG8_STAGE(PG8_SB(1, 0), cB + kstep, voffB); PG8_STAGE(PG8_SA(1, 0), cA + kstep, voffA); PG8_STAGE(PG8_SB(1, 1), cB + hstep + kstep, voffB);
        PG8_WAIT_V(6); PG8_BAR;
    } else {
        PG8_STAGE(PG8_SB(0, 0), cB, voffB); PG8_STAGE(PG8_SA(0, 0), cA, voffA); PG8_STAGE(PG8_SB(0, 1), cB + hstep, voffB); PG8_STAGE(PG8_SA(0, 1), cA + hstep, voffA);
        if (wr == 1) PG8_BAR;
        PG8_WAIT_V(4); PG8_BAR;
        PG8_STAGE(PG8_SB(1, 0), cB + kstep, voffB); PG8_STAGE(PG8_SA(1, 0), cA + kstep, voffA); PG8_STAGE(PG8_SB(1, 1), cB + hstep + kstep, voffB);
        PG8_WAIT_V(6); PG8_BAR;
    }
    for (;;) {
        const bool has_next = S.next(ui + 1, nxt);
        const char* nA = has_next ? (const char*)g.A + (size_t)nxt.pm * tstep : cA; const char* nB = has_next ? (const char*)g.Bt + (size_t)nxt.pn * tstep : cB;
        _Pragma("unroll 1") for (int t = 0; t < nt; t += 2) {
            const bool last = (t == nt - 2);
            const char* a1 = cA + (size_t)(t + 1) * kstep;
            const char* a2 = last ? nA : cA + (size_t)(t + 2) * kstep; const char* b2 = last ? nB : cB + (size_t)(t + 2) * kstep;
            const char* a3 = a2 + kstep; const char* b3 = b2 + kstep;
            if (last && has_next) S.a_ready(nxt);
            if constexpr (SP2) {
            PG8_LDB(B0, 0, 0); PG8_LDB(B1, 0, 1); PG8_SCHED; PG8_LDA(At, 0, 0); PG8_STAGE(PG8_SA(1, 1), a1 + hstep, voffA);
            PG8_WAIT_V(8); PG8_WAIT_L(0); PG8_BAR; PG8_MMA(0, 0, At, B0); PG8_MMA(0, 1, At, B1); PG8_BAR; PG8_SCHED;
            PG8_LDA(At, 0, 1); PG8_STAGE(PG8_SB(0, 0), b2, voffB); PG8_STAGE(PG8_SB(0, 1), b2 + hstep, voffB); PG8_STAGE(PG8_SA(0, 0), a2, voffA);
            PG8_WAIT_V(8); PG8_WAIT_L(0); PG8_BAR; PG8_MMA(1, 0, At, B0); PG8_MMA(1, 1, At, B1); PG8_BAR; PG8_SCHED;
            PG8_LDB(B0, 1, 0); PG8_LDB(B1, 1, 1); PG8_SCHED; PG8_LDA(At, 1, 0); PG8_STAGE(PG8_SA(0, 1), a2 + hstep, voffA);
            PG8_WAIT_V(8); PG8_WAIT_L(0); PG8_BAR; PG8_MMA(0, 0, At, B0); PG8_MMA(0, 1, At, B1); PG8_BAR; PG8_SCHED;
            PG8_LDA(At, 1, 1); PG8_STAGE(PG8_SB(1, 0), b3, voffB); PG8_STAGE(PG8_SB(1, 1), b3 + hstep, voffB); PG8_STAGE(PG8_SA(1, 0), a3, voffA);
            PG8_WAIT_V(8); PG8_WAIT_L(0); PG8_BAR; PG8_MMA(1, 0, At, B0); PG8_MMA(1, 1, At, B1); PG8_BAR; PG8_SCHED;
            } else {
            PG8_LDB(B0, 0, 0); PG8_SCHED; PG8_LDA(At, 0, 0); PG8_STAGE(PG8_SA(1, 1), a1 + hstep, voffA);
            PG8_WAIT_L(8); PG8_BAR; PG8_WAIT_L(0); PG8_MMA(0, 0, At, B0); PG8_BAR; PG8_SCHED;
            PG8_LDB(B1, 0, 1); PG8_STAGE(PG8_SB(0, 0), b2, voffB);
            PG8_BAR; PG8_WAIT_L(0); PG8_MMA(0, 1, At, B1); PG8_BAR;
            PG8_LDA(At, 0, 1); PG8_STAGE(PG8_SA(0, 0), a2, voffA);
            PG8_BAR; PG8_WAIT_L(0); PG8_MMA(1, 0, At, B0); PG8_BAR; PG8_SCHED;
            PG8_STAGE(PG8_SB(0, 1), b2 + hstep, voffB);
            PG8_WAIT_V(6); PG8_BAR; PG8_MMA(1, 1, At, B1); PG8_BAR;
            PG8_LDB(B0, 1, 0); PG8_SCHED; PG8_LDA(At, 1, 0); PG8_STAGE(PG8_SA(0, 1), a2 + hstep, voffA);
            PG8_WAIT_L(8); PG8_BAR; PG8_WAIT_L(0); PG8_MMA(0, 0, At, B0); PG8_BAR; PG8_SCHED;
            PG8_LDB(B1, 1, 1); PG8_STAGE(PG8_SB(1, 0), b3, voffB);
            PG8_BAR; PG8_WAIT_L(0); PG8_MMA(0, 1, At, B1); PG8_BAR;
            PG8_LDA(At, 1, 1); PG8_STAGE(PG8_SA(1, 0), a3, voffA);
            PG8_BAR; PG8_WAIT_L(0); PG8_MMA(1, 0, At, B0); PG8_BAR; PG8_SCHED;
            PG8_STAGE(PG8_SB(1, 1), b3 + hstep, voffB);
            PG8_WAIT_V(6); PG8_BAR; PG8_MMA(1, 1, At, B1); PG8_BAR;
            }
        }
        if constexpr (ALIGN_EPI) { if (wr == 0) PG8_BAR; }
        if constexpr (!Epi::AFTER_DRAIN) { E(acc, cur, wr, wc, fr, fq); S.done(cur); }
        if (!has_next) break;
#pragma unroll
        for (int a = 0; a < 2; ++a)
#pragma unroll
            for (int b = 0; b < 2; ++b)
#pragma unroll
                for (int m = 0; m < 4; ++m)
#pragma unroll
                    for (int n = 0; n < 2; ++n) acc[a][b][m][n] = (f32x4){0.f, 0.f, 0.f, 0.f};
        cur = nxt; cA = nA; cB = nB; ++ui;
        if constexpr (ALIGN_EPI) { if (wr == 1) PG8_BAR; }
    }
    PG8_WAIT_V(0);
    if constexpr (!ALIGN_EPI) { if (wr == 0) PG8_BAR; }
    PG8_BAR;
    if constexpr (Epi::AFTER_DRAIN) { E.fused(acc, cur, wr, wc, fr, fq, lds, wid, lane); S.done(cur); }
#undef PG8_SA
#undef PG8_SB
#undef PG8_STAGE
#undef PG8_LDA
#undef PG8_LDB
#undef PG8_MMA
#undef PG8_WAIT_V
#undef PG8_WAIT_L
#undef PG8_BAR
#undef PG8_SCHED
}
}
constexpr int DM = 1024, NB = 8, SEQ = 4096, CTXL = 256, DEPTH = 2;
constexpr int NLAT = NB * SEQ, NCTX = NB * CTXL, NROWS = NLAT + NCTX;
constexpr int DIN = 1440, DINP = 1536, QRANK = 384, KVRANK = 256;
constexpr int PH = 8, PNK = 128, PDH = 128, PTOPK = 16, PEXP = PNK * PNK;
constexpr float EPS = 1e-6f;
constexpr float LOG2E = 1.4426950408889634f;
constexpr float C_MLA = 0.10206207261596577f * LOG2E;
constexpr float C_SWA = 0.125f * LOG2E;

typedef unsigned short bf16;
typedef short bf16x8 __attribute__((ext_vector_type(8)));
typedef short s16x4 __attribute__((ext_vector_type(4)));
typedef float f32x4 __attribute__((ext_vector_type(4)));
typedef float f32x16 __attribute__((ext_vector_type(16)));
typedef unsigned u32x4 __attribute__((ext_vector_type(4)));
typedef unsigned u32x2v __attribute__((ext_vector_type(2)));
#define LAS __attribute__((address_space(3)))

constexpr size_t MiB = 1u << 20;
constexpr size_t WS_CTL = 0, CTL_ZERO_BYTES = 64 * 1024;
constexpr size_t WS_MOD = 1 * MiB;
constexpr size_t WS_RTS = WS_MOD + 512 * 1024;
constexpr size_t WS_RTM = WS_RTS + 64 * 16 * 2 * 4;
constexpr size_t WS_WIN = 2 * MiB;
constexpr size_t WS_WUQ = WS_WIN + 2ull * DINP * DM * 2;
constexpr size_t WS_WUKV = WS_WUQ + 2ull * 768 * QRANK * 2;
constexpr size_t WS_WOUT = WS_WUKV + 2ull * 1024 * KVRANK * 2;
constexpr size_t WS_PWQ = WS_WOUT + 2ull * 1024 * 1024 * 2;
constexpr size_t WS_PKEY = WS_PWQ + 2ull * 2048 * 1024 * 2;
constexpr size_t WS_HCTX = WS_PKEY + 2ull * 8 * 2 * 128 * 128 * 2;
constexpr size_t WS_US = WS_HCTX + (size_t)NCTX * 1024 * 4;
constexpr size_t WS_VS = WS_US + 2ull * PEXP * 4;
constexpr size_t WS_SB = WS_VS + 2ull * PEXP * 4;
constexpr size_t WS_U = 32 * MiB;
constexpr size_t WS_V = WS_U + 32 * MiB;
constexpr size_t WS_F16B = WS_V + 32 * MiB;
constexpr size_t WS_AB = WS_F16B + (size_t)NROWS * 1024 * 2;
constexpr size_t WS_KVAN = WS_F16B, WS_QAN = WS_F16B + (size_t)NROWS * 1024;
static_assert((size_t)NROWS * KVRANK * 2 <= (size_t)NROWS * 1024 && (size_t)NROWS * QRANK * 2 <= (size_t)NROWS * 1024, "latents inside the b-code region");
constexpr size_t WS_P = WS_AB + (size_t)NROWS * 1024 * 2;
constexpr size_t WS_X5 = WS_P + (size_t)NROWS * DIN * 2;
constexpr size_t WS_QM = WS_X5, WS_KM = WS_QM + (size_t)NROWS * 768 * 2, WS_VM = WS_KM + (size_t)NROWS * 768 * 2, WS_QS = WS_VM + (size_t)NROWS * 512 * 2,
                 WS_KS = WS_QS + (size_t)NROWS * 512 * 2, WS_END = WS_KS + (size_t)NROWS * 128 * 2;
static_assert(WS_SB + (size_t)NROWS * 4 <= WS_U, "ws map (weights)");
static_assert(WS_END <= 512 * MiB, "ws map");
static_assert((size_t)NROWS * 2048 * 2 <= WS_END - WS_X5, "QP overlay");
static_assert((size_t)NROWS * 1024 <= (size_t)NROWS * DIN * 2, "TK overlay");

constexpr int LDS_BYTES = 163840;

__constant__ float ROPE_INV[24] = {1.0f, 0.5623413324356079f, 0.3162277638912201f, 0.17782793939113617f, 0.10000000149011612f, 0.05623413249850273f, 0.03162277489900589f, 0.017782794311642647f, 0.009999999776482582f, 0.005623413249850273f, 0.003162277629598975f, 0.0017782794311642647f, 0.0010000000474974513f, 0.000562341301701963f, 0.0003162277571391314f, 0.00017782794020604342f, 1.0f, 0.3162277638912201f, 0.10000000149011612f, 0.03162277489900589f, 0.009999999776482582f, 0.003162277629598975f, 0.0010000000474974513f, 0.0003162277571391314f};
struct Args {
    const float* in[23]; float* out; unsigned char* ws; int ph_lo, ph_hi; unsigned char prog[48];
};
typedef const __attribute__((address_space(4))) Args* ArgsP;

struct Frame {
    int tid, lane, wave, G, bid, vcu, gw, ngw, zv;
};

__device__ __forceinline__ float bf_lo(unsigned w) { return __uint_as_float(w << 16); }
__device__ __forceinline__ float bf_hi(unsigned w) { return __uint_as_float(w & 0xffff0000u); }
__device__ __forceinline__ unsigned pk2(float lo, float hi) { return pg8::cvt_pk_bf16(lo, hi); }
__device__ __forceinline__ float wave_sum(float v) {
#pragma unroll
    for (int o = 1; o < 64; o <<= 1) v += __shfl_xor(v, o);
    return v;
}
__device__ __forceinline__ void unpack8(const u32x4 w, float (&x)[8]) {
    x[0] = bf_lo(w.x); x[1] = bf_hi(w.x); x[2] = bf_lo(w.y); x[3] = bf_hi(w.y); x[4] = bf_lo(w.z); x[5] = bf_hi(w.z); x[6] = bf_lo(w.w); x[7] = bf_hi(w.w);
}
__device__ __forceinline__ u32x4 pack8(const float (&x)[8]) {
    u32x4 w; w.x = pk2(x[0], x[1]); w.y = pk2(x[2], x[3]); w.z = pk2(x[4], x[5]); w.w = pk2(x[6], x[7]); return w;
}

__device__ __forceinline__ void p0_transpose_item(const float* W, int K, int N, bf16* WT, LAS float* scr, int item, int lane) {
    const int nblk = N / 32, kb = item / nblk, nb = item % nblk, k0 = 64 * kb, n0 = 32 * nb;
#pragma unroll 8
    for (int i = 0; i < 32; ++i) { const int kk = 2 * i + (lane >> 5); scr[kk * 33 + (lane & 31)] = W[(size_t)(k0 + kk) * N + n0 + (lane & 31)]; }
    asm volatile("s_waitcnt lgkmcnt(0)" ::: "memory");
    const int c = lane & 7;
#pragma unroll
    for (int j = 0; j < 4; ++j) { const int n = (lane >> 3) + 8 * j; const LAS float* s = scr + (8 * c) * 33 + n;
        u32x4 o; o.x = pk2(s[0 * 33], s[1 * 33]); o.y = pk2(s[2 * 33], s[3 * 33]); o.z = pk2(s[4 * 33], s[5 * 33]); o.w = pk2(s[6 * 33], s[7 * 33]);
        *(u32x4*)(WT + (size_t)(n0 + n) * K + k0 + 8 * c) = o; }
    asm volatile("s_waitcnt lgkmcnt(0)" ::: "memory");
}

__device__ __forceinline__ void p0_prologue(const Frame& F, ArgsP Ap, LAS unsigned char* lds) {
    unsigned char* ws = Ap->ws;
#ifdef TRTEST
    if (F.bid == 0 && F.wave == 0) {
        LAS unsigned char* tl = lds + 32768; const int l16 = F.lane & 15, kg = F.lane >> 4;
        for (int i = F.lane; i < 512; i += 64) tl[i] = (unsigned char)((i & 127) + 1 + 3 * (i >> 7));
        __builtin_amdgcn_s_waitcnt(0); __builtin_amdgcn_wave_barrier();
        int code = 2;
        for (int hyp = 0; hyp < 2; ++hyp) {
            const int r = (!hyp) ? (l16 & 7) : (l16 >> 1), c = (!hyp) ? (l16 >> 3) : (l16 & 1);
            const unsigned addr = (unsigned)(uintptr_t)(tl + 128 * kg + 16 * r + 8 * c);
            u32x2v res; asm volatile("ds_read_b64_tr_b8 %0, %1\n\ts_waitcnt lgkmcnt(0)" : "=&v"(res) : "v"(addr) : "memory");
            bool ok = true;
            for (int i = 0; i < 8; ++i) { const unsigned got = ((i < 4 ? res.x : res.y) >> (8 * (i & 3))) & 0xffu; ok = ok && (got == (unsigned)(16 * i + l16 + 1 + 3 * kg)); }
            if (__all(ok) && code == 2) code = hyp;
        }
        if (F.lane == 0) ((float*)(ws + WS_CTL + 40000))[0] = (float)code;
    }
    __syncthreads();
#endif
    const float* c_in = Ap->in[1]; const float* cctx_in = Ap->in[3]; const float* ada_w = Ap->in[4]; const float* ada_b = Ap->in[5];
    for (int task = F.bid; task < 192; task += F.G) {
        const int l = task / 96, cc = task % 96;
        LAS float* sl = (LAS float*)lds;
        LAS float* red = (LAS float*)(lds + 9 * 1024 * 4);
        __syncthreads();
        for (int i = F.tid; i < 9 * 1024; i += 512) { const int s = i >> 10, k = i & 1023; const float x = (s < 8) ? c_in[s * 1024 + k] : cctx_in[k]; sl[i] = x / (1.f + __expf(-x)); }
        __syncthreads();
        const int lg = F.lane >> 4, c0 = cc * 64 + (F.lane & 15) * 4; const int kbase = F.wave * 128 + lg * 32;
        f32x4 acc[9];
#pragma unroll
        for (int s = 0; s < 9; ++s) acc[s] = (f32x4){0.f, 0.f, 0.f, 0.f};
        const float* wp = ada_w + ((size_t)l * 1024 + kbase) * 6144 + c0;
#pragma unroll 16
        for (int kk = 0; kk < 32; ++kk) { const f32x4 w = *(const f32x4*)(wp + (size_t)kk * 6144);
#pragma unroll
            for (int s = 0; s < 9; ++s) acc[s] += w * sl[s * 1024 + kbase + kk]; }
#pragma unroll
        for (int s = 0; s < 9; ++s) *(LAS f32x4*)(red + ((F.wave * 4 + lg) * 9 + s) * 64 + (F.lane & 15) * 4) = acc[s];
        __syncthreads();
        float* MOD = (float*)(ws + WS_MOD);
        for (int i = F.tid; i < 9 * 64; i += 512) { const int s = i >> 6, ci = i & 63; float v = ada_b[l * 6144 + cc * 64 + ci];
#pragma unroll
            for (int w = 0; w < 32; ++w) v += red[(w * 9 + s) * 64 + ci];
            MOD[((size_t)l * 9 + s) * 6144 + cc * 64 + ci] = v; }
        __syncthreads();
    }
    __syncthreads();
    if (F.bid == F.G - 1) {
        float* rts = (float*)(ws + WS_RTS); float* rtm = (float*)(ws + WS_RTM);
        for (int i = F.tid; i < 64 * 24; i += 512) {
            const int pos = i / 24, k = i % 24; const float a = (float)pos * ROPE_INV[k];
            const float rev = a * 0.15915494309189535f;
            const float cs = __builtin_amdgcn_cosf(rev), sn = __builtin_amdgcn_sinf(rev);
            if (k < 16) { rts[(pos * 16 + k) * 2] = cs; rts[(pos * 16 + k) * 2 + 1] = sn; } else { rtm[(pos * 8 + (k - 16)) * 2] = cs; rtm[(pos * 8 + (k - 16)) * 2 + 1] = sn; }
        }
    }
    LAS float* scr = (LAS float*)(lds + F.wave * 16384);
    constexpr int I_WIN = (DM / 64) * (DIN / 32), I_WUQ = (QRANK / 64) * (768 / 32), I_WUKV = (KVRANK / 64) * (1024 / 32), I_WOUT = (DM / 64) * (DM / 32), I_PWQ = (DM / 64) * (2048 / 32);
    constexpr int I_L = I_WIN + I_WUQ + I_WUKV + I_WOUT + I_PWQ;
    for (int it = F.gw; it < 2 * I_L; it += F.ngw) {
        const int l = it / I_L; int r = it % I_L;
        if (r < I_WIN) { p0_transpose_item(Ap->in[8] + (size_t)l * DM * DIN, DM, DIN, (bf16*)(ws + WS_WIN) + (size_t)l * DINP * DM, scr, r, F.lane); continue; } r -= I_WIN;
        if (r < I_WUQ) { p0_transpose_item(Ap->in[10] + (size_t)l * QRANK * 768, QRANK, 768, (bf16*)(ws + WS_WUQ) + (size_t)l * 768 * QRANK, scr, r, F.lane); continue; } r -= I_WUQ;
        if (r < I_WUKV) { p0_transpose_item(Ap->in[12] + (size_t)l * KVRANK * 1024, KVRANK, 1024, (bf16*)(ws + WS_WUKV) + (size_t)l * 1024 * KVRANK, scr, r, F.lane); continue; } r -= I_WUKV;
        if (r < I_WOUT) { p0_transpose_item(Ap->in[18] + (size_t)l * DM * DM, DM, DM, (bf16*)(ws + WS_WOUT) + (size_t)l * DM * DM, scr, r, F.lane); continue; } r -= I_WOUT;
        p0_transpose_item(Ap->in[19] + (size_t)l * DM * 2048, DM, 2048, (bf16*)(ws + WS_PWQ) + (size_t)l * 2048 * DM, scr, r, F.lane);
    }
    { const size_t gt = (size_t)F.bid * 512 + F.tid, nt = (size_t)F.G * 512;
      for (size_t i = gt; i < 2ull * 96 * DM / 8; i += nt) { const size_t l = i / (96 * DM / 8), e = i % (96 * DM / 8);
          *(u32x4*)((bf16*)(ws + WS_WIN) + l * DINP * DM + (size_t)DIN * DM + e * 8) = (u32x4){(unsigned)F.zv, (unsigned)F.zv, (unsigned)F.zv, (unsigned)F.zv}; }
      const size_t NKEY8 = 2ull * 8 * 2 * 128 * 128 / 8;
      for (size_t i = gt; i < NKEY8; i += nt) {
          const float* src = Ap->in[20]; bf16* dst = (bf16*)(ws + WS_PKEY);
          const f32x4 a = *(const f32x4*)(src + i * 8), b = *(const f32x4*)(src + i * 8 + 4);
          u32x4 o; o.x = pk2(a[0], a[1]); o.y = pk2(a[2], a[3]); o.z = pk2(b[0], b[1]); o.w = pk2(b[2], b[3]);
          *(u32x4*)(dst + i * 8) = o; }
    }
    f32x4 x[4], xn[4];
#define Q_SRC(rr_) (Ap->in[21 + (rr_) / (2 * PEXP)] + ((size_t)(((rr_) / PEXP) & 1) * PEXP + (rr_) % PEXP) * DM + 16 * F.lane)
    if (F.gw < 2 * 2 * PEXP) { const float* s0 = Q_SRC(F.gw);
#pragma unroll
        for (int j = 0; j < 4; ++j) x[j] = *(const f32x4*)(s0 + 4 * j); }
    for (int rr = F.gw; rr < 2 * 2 * PEXP; rr += F.ngw) {
        const int tab = rr / (2 * PEXP), lay = (rr / PEXP) & 1, e = rr % PEXP;
        { const int rn = (rr + F.ngw < 2 * 2 * PEXP) ? (rr + F.ngw) : rr; const float* sn = Q_SRC(rn);
#pragma unroll
          for (int j = 0; j < 4; ++j) xn[j] = *(const f32x4*)(sn + 4 * j); }
        float mx = 0.f;
#pragma unroll
        for (int j = 0; j < 4; ++j) mx = fmaxf(fmaxf(fmaxf(mx, fabsf(x[j][0])), fmaxf(fabsf(x[j][1]), fabsf(x[j][2]))), fabsf(x[j][3]));
#pragma unroll
        for (int o = 1; o < 64; o <<= 1) mx = fmaxf(mx, __shfl_xor(mx, o));
        const float inv = (mx > 0.f) ? 127.f / mx : 0.f;
        unsigned w[4]; const int bias = 0;
#pragma unroll
        for (int j = 0; j < 4; ++j) { const unsigned c0 = (unsigned)(bias + (int)rintf(x[j][0] * inv)) & 0xffu, c1 = (unsigned)(bias + (int)rintf(x[j][1] * inv)) & 0xffu, c2 = (unsigned)(bias + (int)rintf(x[j][2] * inv)) & 0xffu, c3 = (unsigned)(bias + (int)rintf(x[j][3] * inv)) & 0xffu;
            w[j] = c0 | (c1 << 8) | (c2 << 16) | (c3 << 24); }
        unsigned char* dst = tab ? (ws + WS_V + (size_t)lay * PEXP * DM + ((size_t)(F.lane >> 3) * PEXP + e) * 128 + (F.lane & 7) * 16)
                                 : (ws + WS_U + ((size_t)lay * PEXP + e) * DM + 16 * F.lane);
        *(u32x4*)dst = (u32x4){w[0], w[1], w[2], w[3]};
        if (F.lane == 0) ((float*)(ws + (tab ? WS_VS : WS_US)))[lay * PEXP + e] = (mx > 0.f) ? mx / 127.f : 1.f;
#pragma unroll
        for (int j = 0; j < 4; ++j) x[j] = xn[j];
    }
#undef Q_SRC
}

#ifndef DBG_PRECISE_TOPK
#define DBG_PRECISE_TOPK 0
#endif
__device__ __forceinline__ void norm_mod_phase(const Frame& F, ArgsP Ap, int l, int which, int nrows, char* lds) {
    unsigned char* ws = Ap->ws;
    const float* MOD = (const float*)(ws + WS_MOD);
    const float* gn = Ap->in[which ? 7 : 6] + l * DM;
    bf16* AB = (bf16*)(ws + WS_AB);
    const bool from_input = (which == 0 && l == 0);
    const float* hlat_ = from_input ? Ap->in[0] : Ap->out; const float* hctx_ = from_input ? Ap->in[2] : (const float*)(ws + WS_HCTX);
#define NM_ROWPTR(r_) (((r_) < NLAT) ? (hlat_ + (size_t)(r_) * DM) : (hctx_ + (size_t)((r_) - NLAT) * DM))
    float* lmod = (float*)lds;
    __syncthreads();
    for (int i = F.tid; i < 9 * 2 * DM / 4; i += 512) { const int s = i / (2 * DM / 4), j = i % (2 * DM / 4);
        ((f32x4*)lmod)[i] = *(const f32x4*)(MOD + ((size_t)l * 9 + s) * 6144 + (which ? 3 * DM : 0) + 4 * j); }
    for (int i = F.tid; i < DM / 4; i += 512) ((f32x4*)(lmod + 9 * 2 * DM))[i] = *(const f32x4*)(gn + 4 * i);
    __syncthreads();
    f32x4 v[4], vn[4], vq[4];
    if (F.gw < nrows) { const float* hr0 = NM_ROWPTR(F.gw); const int r1 = (F.gw + F.ngw < nrows) ? (F.gw + F.ngw) : F.gw; const float* hr1 = NM_ROWPTR(r1);
#pragma unroll
        for (int j = 0; j < 4; ++j) v[j] = *(const f32x4*)(hr0 + 256 * j + 4 * F.lane);
#pragma unroll
        for (int j = 0; j < 4; ++j) vn[j] = *(const f32x4*)(hr1 + 256 * j + 4 * F.lane); }
    for (int r = F.gw; r < nrows; r += F.ngw) {
        const bool lat = r < NLAT;
        { const int rq = (r + 2 * F.ngw < nrows) ? (r + 2 * F.ngw) : r; const float* hq = NM_ROWPTR(rq);
#pragma unroll
          for (int j = 0; j < 4; ++j) vq[j] = *(const f32x4*)(hq + 256 * j + 4 * F.lane); }
        const int s = lat ? (r >> 12) : 8;
        const float* mp = lmod + s * 2 * DM; const float* lg = lmod + 9 * 2 * DM;
        float ss = 0.f; f32x4 bq_[4];
#pragma unroll
        for (int j = 0; j < 4; ++j) ss += (v[j][0] * v[j][0] + v[j][1] * v[j][1]) + (v[j][2] * v[j][2] + v[j][3] * v[j][3]);
        ss = wave_sum(ss);
        const float rinv = rsqrtf(ss * (1.f / DM) + EPS);
#pragma unroll
        for (int j = 0; j < 4; ++j) { const int c = 256 * j + 4 * F.lane;
            const f32x4 g = *(const f32x4*)(lg + c), sh = *(const f32x4*)(mp + c), sc = *(const f32x4*)(mp + DM + c);
            const f32x4 y = v[j] * rinv * g; const f32x4 a = y * (sc + 1.f) + sh;
            u32x2v o; o.x = pk2(a[0], a[1]); o.y = pk2(a[2], a[3]);
            *(u32x2v*)(AB + (size_t)r * DM + c) = o;
            if (which) bq_[j] = a;
            }
        if (which) {
            float mx = 0.f;
#pragma unroll
            for (int j = 0; j < 4; ++j) mx = fmaxf(fmaxf(fmaxf(mx, fabsf(bq_[j][0])), fmaxf(fabsf(bq_[j][1]), fabsf(bq_[j][2]))), fabsf(bq_[j][3]));
#pragma unroll
            for (int o = 1; o < 64; o <<= 1) mx = fmaxf(mx, __shfl_xor(mx, o));
            const float inv = (mx > 0.f) ? 127.f / mx : 0.f;
#pragma unroll
            for (int j = 0; j < 4; ++j) { const unsigned c0 = (unsigned)((int)rintf(bq_[j][0] * inv)) & 0xffu, c1 = (unsigned)((int)rintf(bq_[j][1] * inv)) & 0xffu, c2 = (unsigned)((int)rintf(bq_[j][2] * inv)) & 0xffu, c3 = (unsigned)((int)rintf(bq_[j][3] * inv)) & 0xffu;
                *(unsigned*)(ws + WS_F16B + (size_t)r * DM + 256 * j + 4 * F.lane) = c0 | (c1 << 8) | (c2 << 16) | (c3 << 24); }
            if (F.lane == 0) ((float*)(ws + WS_SB))[r] = (mx > 0.f) ? mx / 127.f : 1.f;
        }
#pragma unroll
        for (int j = 0; j < 4; ++j) { v[j] = vn[j]; vn[j] = vq[j]; }
    }
#undef NM_ROWPTR
}

#define E2_DPP(v, CTRL) __builtin_bit_cast(float, __builtin_amdgcn_update_dpp(0, __builtin_bit_cast(int, (v)), (CTRL), 0xF, 0xF, true))
__device__ __forceinline__ void e2_phase(const Frame& F, ArgsP Ap, int l, int nrows, char* lds) {
    unsigned char* ws = Ap->ws;
    const bf16* P = (const bf16*)(ws + WS_P);
    bf16* QAN = (bf16*)(ws + WS_QAN); bf16* KVAN = (bf16*)(ws + WS_KVAN);
    bf16* QS = (bf16*)(ws + WS_QS); bf16* KS = (bf16*)(ws + WS_KS);
    const float* qa_g = Ap->in[9] + l * QRANK; const float* kva_g = Ap->in[11] + l * KVRANK;
    const float* sqn_g = Ap->in[15] + l * 64; const float* skn_g = Ap->in[16] + l * 64;
    float* rt = (float*)lds;
    __syncthreads();
    for (int i = F.tid; i < 64 * 32; i += 512) rt[i] = ((const float*)(ws + WS_RTS))[i];
    __syncthreads();
    const int lane = F.lane;
    const int lqa = (lane < 48) ? lane : 47, lkva = (lane < 32) ? lane : 31, lsk = (lane < 16) ? lane : 15;
    float g_qa[8], g_kva[8], g_sq[8], g_sk[8];
#pragma unroll
    for (int e = 0; e < 8; ++e) { g_qa[e] = qa_g[8 * lqa + e]; g_kva[e] = kva_g[8 * lkva + e]; g_sq[e] = sqn_g[8 * (lane & 7) + e] * C_SWA; g_sk[e] = skn_g[8 * (lane & 7) + e]; }
    u32x4 wqa, wsq, wkva, wsk, nqa, nsq, nkva, nsk;
#define E2_LOAD(A_, B_, C_, D_, r_) do { const bf16* pr_ = P + (size_t)(r_) * DIN; A_ = *(const u32x4*)(pr_ + 8 * lqa); B_ = *(const u32x4*)(pr_ + QRANK + 8 * lane); C_ = *(const u32x4*)(pr_ + 896 + 8 * lkva); D_ = *(const u32x4*)(pr_ + 1184 + 8 * lsk); } while (0)
    if (F.gw < nrows) E2_LOAD(wqa, wsq, wkva, wsk, F.gw);
    for (int r = F.gw; r < nrows; r += F.ngw) {
        const bool lat = r < NLAT; const int pos = r & (SEQ - 1), rp = pos >> 6, cp = pos & 63;
        { const int rn = (r + F.ngw < nrows) ? (r + F.ngw) : r; E2_LOAD(nqa, nsq, nkva, nsk, rn); }
        if (lane >= 48) wqa = (u32x4){0u, 0u, 0u, 0u};
        if (lane >= 32) wkva = (u32x4){0u, 0u, 0u, 0u};
        float x[8];
        { unpack8(wqa, x); float ss = 0.f;
#pragma unroll
          for (int e = 0; e < 8; ++e) ss += x[e] * x[e];
          ss = wave_sum(ss); const float rinv = rsqrtf(ss * (1.f / QRANK) + EPS);
          if (lane < 48) { float y[8];
#pragma unroll
              for (int e = 0; e < 8; ++e) y[e] = x[e] * rinv * g_qa[e];
              *(u32x4*)(QAN + (size_t)r * QRANK + 8 * lane) = pack8(y); } }
        { unpack8(wkva, x); float ss = 0.f;
#pragma unroll
          for (int e = 0; e < 8; ++e) ss += x[e] * x[e];
          ss = wave_sum(ss); const float rinv = rsqrtf(ss * (1.f / KVRANK) + EPS);
          if (lane < 32) { float y[8];
#pragma unroll
              for (int e = 0; e < 8; ++e) y[e] = x[e] * rinv * g_kva[e];
              *(u32x4*)(KVAN + (size_t)r * KVRANK + 8 * lane) = pack8(y); } }
        const int ch = lane & 7;
        const f32x4* tab = (const f32x4*)(rt + ((ch < 4) ? rp : cp) * 32 + (ch & 1) * 16);
        const f32x4 t0 = tab[0], t1 = tab[1], t2 = tab[2], t3 = tab[3];
        const float cs[8] = {t0[0], t0[2], t1[0], t1[2], t2[0], t2[2], t3[0], t3[2]}, sn[8] = {t0[1], t0[3], t1[1], t1[3], t2[1], t2[3], t3[1], t3[3]};
#pragma unroll
        for (int which = 0; which < 2; ++which) {
            unpack8(which ? wsk : wsq, x); float ss = 0.f;
#pragma unroll
            for (int e = 0; e < 8; ++e) ss += x[e] * x[e];
            ss += E2_DPP(ss, 0xB1); ss += E2_DPP(ss, 0x4E); ss += E2_DPP(ss, 0x141);
            const float rinv = rsqrtf(ss * (1.f / 64.f) + EPS);
            float y[8], o[8];
#pragma unroll
            for (int e = 0; e < 8; ++e) y[e] = x[e] * rinv * (which ? g_sk[e] : g_sq[e]);
#pragma unroll
            for (int e = 0; e < 8; ++e) { const float py = E2_DPP(y[e], 0x4E);
                o[e] = lat ? ((ch & 2) ? (y[e] * cs[e] + py * sn[e]) : (y[e] * cs[e] - py * sn[e])) : y[e]; }
            if (which == 0) *(u32x4*)(QS + (size_t)r * 512 + 8 * lane) = pack8(o);
            else if (lane < 16) *(u32x4*)(KS + (size_t)r * 128 + 8 * lane) = pack8(o);
        }
        wqa = nqa; wsq = nsq; wkva = nkva; wsk = nsk;
    }
#undef E2_LOAD
}

#define E3_DPP(v, CTRL) __builtin_bit_cast(float, __builtin_amdgcn_update_dpp(0, __builtin_bit_cast(int, (v)), (CTRL), 0xF, 0xF, true))
__device__ __forceinline__ void e3_phase(const Frame& F, ArgsP Ap, int l, int nrows, const int pvar, char* lds) {
    unsigned char* ws = Ap->ws;
    const bf16* P = (const bf16*)(ws + WS_P);
    bf16* QM = (bf16*)(ws + WS_QM); bf16* KM = (bf16*)(ws + WS_KM);
    bf16* QMo = pvar ? (bf16*)(ws + WS_F16B) : QM; bf16* KMo = pvar ? (bf16*)(ws + WS_F16B) : KM;
    const float* qn_g = Ap->in[13] + l * 96; const float* kn_g = Ap->in[14] + l * 96;
    float* rt = (float*)lds;
    __syncthreads();
    for (int i = F.tid; i < 64 * 16; i += 512) rt[i] = ((const float*)(ws + WS_RTM))[i];
    __syncthreads();
    const int lane = F.lane, hl = lane >> 4, ch = lane & 15; const bool valid = ch < 12; const int chc = valid ? ch : 0;
    const bool krope = valid && ch >= 8; const int kro = 1152 + (krope ? (ch - 8) * 8 : 0);
    const int qo0 = hl * 96 + chc * 8, qo1 = (4 + hl) * 96 + chc * 8;
    float gq[8], gk[8];
#pragma unroll
    for (int e = 0; e < 8; ++e) { gq[e] = qn_g[8 * chc + e] * C_MLA; gk[e] = kn_g[8 * chc + e]; }
    u32x4 wq0, wk0, wq1, wk1, nq0, nk0, nq1, nk1;
#define E3_LOAD(A_, B_, C_, D_, r_) do { const bf16* qr_ = QM + (size_t)(r_) * 768; const bf16* kr_ = KM + (size_t)(r_) * 768; const bf16* pr_ = P + (size_t)(r_) * DIN + kro; \
        A_ = *(const u32x4*)(qr_ + qo0); C_ = *(const u32x4*)(qr_ + qo1); B_ = *(const u32x4*)(krope ? pr_ : (kr_ + qo0)); D_ = *(const u32x4*)(krope ? pr_ : (kr_ + qo1)); } while (0)
    if (F.gw < nrows) E3_LOAD(wq0, wk0, wq1, wk1, F.gw);
    for (int r = F.gw; r < nrows; r += F.ngw) {
        const bool lat = r < NLAT; const int pos = r & (SEQ - 1), rp = pos >> 6, cp = pos & 63;
        { const int rn = (r + F.ngw < nrows) ? (r + F.ngw) : r; if (rn != r) E3_LOAD(nq0, nk0, nq1, nk1, rn); }
        const f32x4* tab = (const f32x4*)(rt + ((ch < 10) ? rp : cp) * 16);
        const f32x4 t0 = tab[0], t1 = tab[1], t2 = tab[2], t3 = tab[3];
        const float cs[8] = {t0[0], t0[2], t1[0], t1[2], t2[0], t2[2], t3[0], t3[2]}, sn[8] = {t0[1], t0[3], t1[1], t1[3], t2[1], t2[3], t3[1], t3[3]};
        const bool rot = lat && krope;
#pragma unroll
        for (int pass = 0; pass < 2; ++pass) {
            const int head = 4 * pass + hl;
#pragma unroll
            for (int which = 0; which < 2; ++which) {
                u32x4 w = which ? (pass ? wk1 : wk0) : (pass ? wq1 : wq0);
                if (!valid) w = (u32x4){0u, 0u, 0u, 0u};
                bf16* dstp = (which ? KMo : QMo) + (size_t)r * 768 + head * 96 + chc * 8;
                float x[8]; unpack8(w, x); float ss = 0.f;
#pragma unroll
                for (int e = 0; e < 8; ++e) ss += x[e] * x[e];
                ss += E3_DPP(ss, 0xB1); ss += E3_DPP(ss, 0x4E); ss += E3_DPP(ss, 0x141); ss += E3_DPP(ss, 0x140);
                const float rinv = rsqrtf(ss * (1.f / 96.f) + EPS);
                float y[8], o[8];
#pragma unroll
                for (int e = 0; e < 8; ++e) y[e] = x[e] * rinv * (which ? gk[e] : gq[e]);
#pragma unroll
                for (int e = 0; e < 8; ++e) { const float py = E3_DPP(y[e], 0xB1);
                    o[e] = rot ? ((ch & 1) ? (y[e] * cs[e] + py * sn[e]) : (y[e] * cs[e] - py * sn[e])) : y[e]; }
                if (valid) *(u32x4*)dstp = pack8(o);
            }
        }
        wq0 = nq0; wk0 = nk0; wq1 = nq1; wk1 = nk1;
    }
#undef E3_LOAD
}
#define XB_TMO      128
#define XB_XCNT(j)  (256  + 64 * (j))
#define XB_XSUB(j)  (1280 + 64 * (j))
#define XB_XGEN(j)  (2304 + 64 * (j))
#define XB_TOP      3328
#define XB_TOPGEN   3392
#define XCD_BAR_WORDS 3456
#define XB_MIS      3520
#define XB_SPIN_CAP (1u << 18)

__device__ __forceinline__ unsigned xb_ld(unsigned* p)              { return __hip_atomic_load(p, __ATOMIC_RELAXED, __HIP_MEMORY_SCOPE_AGENT); }
__device__ __forceinline__ unsigned xb_add(unsigned* p, unsigned v) { return __hip_atomic_fetch_add(p, v, __ATOMIC_RELAXED, __HIP_MEMORY_SCOPE_AGENT); }
__device__ __forceinline__ unsigned xb_xcc_id() { return (unsigned)__builtin_amdgcn_s_getreg((3 << 11) | 20) & 0xFu; }
#define XB_SPIN(cond, bar) do { unsigned _sp = 0; while (cond) { __builtin_amdgcn_s_sleep(1); \
    if ((++_sp & 255u) == 0u) { if (xb_ld(&(bar)[XB_TMO])) break; if (_sp > XB_SPIN_CAP) { atomicAdd(&(bar)[XB_TMO], 1u); break; } } } } while (0)

struct XcdBarrier {
    unsigned* bar; unsigned x;
    volatile LAS unsigned* st;
};

__device__ __forceinline__ XcdBarrier xcd_barrier_post(unsigned* bar, volatile LAS unsigned* st, const bool t0) {
    XcdBarrier b; b.bar = bar; b.x = xb_xcc_id(); b.st = st;
    if (t0) (void)xb_add(&bar[XB_XCNT(b.x)], 1u);
    return b;
}
__device__ __forceinline__ void xcd_barrier_complete(unsigned* bar, unsigned x, unsigned& nloc, unsigned& nx) {
    const unsigned G = gridDim.x * gridDim.y * gridDim.z;
    unsigned sum, cnt, mine, sp = 0u;
    for (;;) {
        sum = 0u; cnt = 0u; mine = 0u;
#pragma unroll
        for (unsigned j = 0; j < 16; ++j) { const unsigned c = xb_ld(&bar[XB_XCNT(j)]); sum += c; cnt += (c > 0u) ? 1u : 0u; mine = (j == x) ? c : mine; }
        if (sum == G) break;
        __builtin_amdgcn_s_sleep(1);
        if ((++sp & 255u) == 0u) { if (xb_ld(&bar[XB_TMO])) break; if (sp > XB_SPIN_CAP) { atomicAdd(&bar[XB_TMO], 1u); break; } }
    }
    nloc = mine > 0u ? mine : 1u; nx = cnt > 0u ? cnt : 1u;
}

template <int NOFENCE = 0, int LOCAL = 0> __device__ __forceinline__ void xcd_barrier(const XcdBarrier& b, const bool t0) {
    asm volatile("s_waitcnt vmcnt(0)" ::: "memory");
    __syncthreads();
    if (t0) {
        unsigned* bar = b.bar;
        __builtin_amdgcn_s_waitcnt(0);
        unsigned nloc = b.st[0], nx = b.st[1];
        if (nloc == 0u) { xcd_barrier_complete(bar, b.x, nloc, nx); b.st[0] = nloc; b.st[1] = nx; }
        const unsigned old = xb_add(&bar[XB_XSUB(b.x)], 1u);
        const unsigned gen = old / nloc;
        if (LOCAL) {
            if (old + 1u == (gen + 1u) * nloc) xb_add(&bar[XB_XGEN(b.x)], 1u);
            else XB_SPIN(xb_ld(&bar[XB_XGEN(b.x)]) == gen, bar);
            __builtin_amdgcn_fence(__ATOMIC_ACQUIRE, "agent");
            asm volatile("s_waitcnt vmcnt(0)" ::: "memory");
        } else if (old + 1u == (gen + 1u) * nloc) {
            if (!(NOFENCE & 1)) __builtin_amdgcn_fence(__ATOMIC_RELEASE, "agent");
            asm volatile("s_waitcnt vmcnt(0)" ::: "memory");
            const unsigned og = xb_add(&bar[XB_TOP], 1u);
            const unsigned tg = og / nx;
            if (og + 1u == (tg + 1u) * nx) xb_add(&bar[XB_TOPGEN], 1u);
            else XB_SPIN(xb_ld(&bar[XB_TOPGEN]) == tg, bar);
            if (!(NOFENCE & 2)) __builtin_amdgcn_fence(__ATOMIC_ACQUIRE, "agent");
            xb_add(&bar[XB_XGEN(b.x)], 1u);
            asm volatile("s_waitcnt vmcnt(0)" ::: "memory");
        } else {
            XB_SPIN(xb_ld(&bar[XB_XGEN(b.x)]) == gen, bar);
            if (!(NOFENCE & 2)) __builtin_amdgcn_fence(__ATOMIC_ACQUIRE, "agent");
            asm volatile("s_waitcnt vmcnt(0)" ::: "memory");
        }
    }
    __syncthreads();
}
namespace att {
constexpr int SHM_V = 64 * 64 * 2, SHM_K = 64 * 192, RSET = 3 * SHM_V + 2 * SHM_K, LDS_ATT = 2 * RSET + 8 * 64 * 4 + 256 * 192;
template <int DQK> __device__ __forceinline__ int kswz(int row) { return (DQK == 96) ? ((row >> 2) & 3) : ((row >> 1) & 7); }
#define SBAR() __builtin_amdgcn_sched_barrier(0)
__device__ __forceinline__ int crow(int r, int hi) { return (r & 3) + 8 * (r >> 2) + 4 * hi; }
__device__ __forceinline__ int v_st(int k, int c) { const int kk = (k & ~0xC) | ((k & 4) << 1) | ((k & 8) >> 1); return ((kk >> 3) * 2 + (c >> 5)) * 512 + ((kk & 7) * 32 + (c & 31)) * 2; }
__device__ __forceinline__ int v_rd_base(int lane) { return ((lane & 3) << 3) | (((lane >> 2) & 3) << 6) | (((lane >> 4) & 1) << 5) | (((lane >> 5) & 1) << 8); }
constexpr int v_rd_off(int d0, int ks, int half) { return d0 * 512 + ks * 2048 + half * 1024; }
template <int OFF> __device__ __forceinline__ s16x4 tr_read(int vb) {
    s16x4 r; asm volatile("ds_read_b64_tr_b16 %0, %1 offset:%2" : "=&v"(r) : "v"(vb), "i"(OFF) : "memory"); return r;
}
template <int D0> __device__ __forceinline__ void pv_one(f32x16& od, int vb, bf16x8 pa0, bf16x8 pa1, bf16x8 pa2, bf16x8 pa3) {
    const s16x4 l0 = tr_read<v_rd_off(D0, 0, 0)>(vb), h0 = tr_read<v_rd_off(D0, 0, 1)>(vb), l1 = tr_read<v_rd_off(D0, 1, 0)>(vb), h1 = tr_read<v_rd_off(D0, 1, 1)>(vb);
    const s16x4 l2 = tr_read<v_rd_off(D0, 2, 0)>(vb), h2 = tr_read<v_rd_off(D0, 2, 1)>(vb), l3 = tr_read<v_rd_off(D0, 3, 0)>(vb), h3 = tr_read<v_rd_off(D0, 3, 1)>(vb);
    asm volatile("s_waitcnt lgkmcnt(0)" ::: "memory"); SBAR();
#define PK(L, H) (bf16x8){L[0], L[1], L[2], L[3], H[0], H[1], H[2], H[3]}
    od = __builtin_amdgcn_mfma_f32_32x32x16_bf16(pa0, PK(l0, h0), od, 0, 0, 0);
    od = __builtin_amdgcn_mfma_f32_32x32x16_bf16(pa1, PK(l1, h1), od, 0, 0, 0);
    od = __builtin_amdgcn_mfma_f32_32x32x16_bf16(pa2, PK(l2, h2), od, 0, 0, 0);
    od = __builtin_amdgcn_mfma_f32_32x32x16_bf16(pa3, PK(l3, h3), od, 0, 0, 0);
#undef PK
}
__device__ __forceinline__ void pv2(f32x16* o, int vb, bf16x8 pa0, bf16x8 pa1, bf16x8 pa2, bf16x8 pa3) {
    pv_one<0>(o[0], vb, pa0, pa1, pa2, pa3); pv_one<1>(o[1], vb, pa0, pa1, pa2, pa3);
}
template <int ND0> __device__ __forceinline__ void qkt(f32x16& p0, f32x16& p1, const char* Ks, const bf16x8* qr, int r32, int hi) {
    constexpr int DQK = ND0 * 16, PITCH = DQK * 2;
    p0 = f32x16{}; p1 = f32x16{};
    const char* kr = Ks + r32 * PITCH; const int sw = kswz<DQK>(r32);
#pragma unroll
    for (int d0 = 0; d0 < ND0; ++d0) { const int cb = ((d0 * 2 + hi) ^ sw) * 16;
        const bf16x8 b0 = *reinterpret_cast<const bf16x8*>(kr + cb);
        const bf16x8 b1 = *reinterpret_cast<const bf16x8*>(kr + 32 * PITCH + cb);
        p0 = __builtin_amdgcn_mfma_f32_32x32x16_bf16(b0, qr[d0], p0, 0, 0, 0);
        p1 = __builtin_amdgcn_mfma_f32_32x32x16_bf16(b1, qr[d0], p1, 0, 0, 0); }
}
__device__ __forceinline__ void wmask(f32x16& p0, f32x16& p1, int kp0, int qp, int hi) {
#pragma unroll
    for (int r = 0; r < 16; ++r) { const int d0 = kp0 + crow(r, hi) - qp; const int d1 = d0 + 32;
        if (d0 > 128 || d0 < -128) p0[r] = -INFINITY; if (d1 > 128 || d1 < -128) p1[r] = -INFINITY; }
}
typedef __bf16 abf2_t __attribute__((ext_vector_type(2)));
__device__ __forceinline__ float adot2(unsigned w, float acc) { return __builtin_amdgcn_fdot2_f32_bf16(__builtin_bit_cast(abf2_t, w), __builtin_bit_cast(abf2_t, 0x3F803F80u), acc, false); }
__device__ __forceinline__ float fadd_s(float a, float b) { float d; asm("v_add_f32 %0, %1, %2" : "=v"(d) : "v"(a), "v"(b)); return d; }
__device__ __forceinline__ void smpack(f32x16& p0, f32x16& p1, float& l_reg, float& l_r1, float& l_r2, float& l_r3, bf16x8& pa0, bf16x8& pa1, bf16x8& pa2, bf16x8& pa3) {
#pragma unroll
    for (int r = 0; r < 16; ++r) p0[r] = __builtin_amdgcn_exp2f(p0[r]);
#pragma unroll
    for (int r = 0; r < 16; ++r) p1[r] = __builtin_amdgcn_exp2f(p1[r]);
    float ps0 = l_reg, ps1 = l_r1, ps2 = l_r2, ps3 = l_r3;
#define PK4(P, BASE, OUT) do { unsigned a0 = pk2(P[BASE + 0], P[BASE + 1]), a1 = pk2(P[BASE + 2], P[BASE + 3]);   \
    unsigned b0 = pk2(P[BASE + 4], P[BASE + 5]), b1 = pk2(P[BASE + 6], P[BASE + 7]);                              \
    ps0 = fadd_s(ps0, P[BASE + 0]); ps1 = fadd_s(ps1, P[BASE + 1]); ps2 = fadd_s(ps2, P[BASE + 2]); ps3 = fadd_s(ps3, P[BASE + 3]); \
    ps0 = fadd_s(ps0, P[BASE + 4]); ps1 = fadd_s(ps1, P[BASE + 5]); ps2 = fadd_s(ps2, P[BASE + 6]); ps3 = fadd_s(ps3, P[BASE + 7]); \
    u32x4 w = {a0, a1, b0, b1}; OUT = *reinterpret_cast<bf16x8*>(&w); } while (0)
    PK4(p0, 0, pa0); PK4(p0, 8, pa1); PK4(p1, 0, pa2); PK4(p1, 8, pa3);
#undef PK4
    l_reg = ps0; l_r1 = ps1; l_r2 = ps2; l_r3 = ps3;
}

struct Unit {
    const bf16* Q; int ldq;
    const bf16* K; int ldk;
    const bf16* V; int ldv;
    bf16* O;
    int qrow0;
    int ctx_row0;
    int lat_row0;
    int nt;
    int qpos0;
    int kpos0;
    int masked;
    float l_init;
};

template <int DQK, bool MASKED>
__device__ __forceinline__ void attn_unit(const Unit& U, const Unit& NU, const bool has_next, const int rset, const bool pre, char* lds, const int tid) {
    constexpr int ND0 = DQK / 16, PITCH = DQK * 2, SHM_KT = PITCH * 64;
    const int wid = tid >> 6, lane = tid & 63, r32 = lane & 31, hi = lane >> 5;
    char* V_lds = lds + rset * RSET; char* K_lds = V_lds + 3 * SHM_V;
    float* wsf = (float*)(lds + 2 * RSET) + wid * 64; char* qstage = lds + 2 * RSET + 8 * 64 * 4;
    float l_reg = (hi == 0) ? U.l_init : 0.f, l_r1 = 0.f, l_r2 = 0.f, l_r3 = 0.f; f32x16 o[2] = {}; bf16x8 qr[ND0];
    const bf16* Qw = U.Q + (size_t)(U.qrow0 + wid * 32 + r32) * U.ldq + hi * 8;
    const int L0 = 1024 * wid + 16 * lane;
    const int kr0 = L0 / PITCH, kq0 = ((L0 % PITCH) >> 4) ^ kswz<DQK>(kr0);
    const unsigned koff0 = (unsigned)(kr0 * U.ldk * 2 + kq0 * 16);
    const int L1 = L0 + 8192, kr1 = (L1 / PITCH) & 63, kq1 = ((L1 % PITCH) >> 4) ^ kswz<DQK>(kr1);
    const unsigned koff1 = (unsigned)(kr1 * U.ldk * 2 + kq1 * 16);
    const int vsub = L0 >> 9, vwi = (L0 & 511) >> 1, vkk = (vsub >> 1) * 8 + (vwi >> 5), vk = vkk, vc = (vsub & 1) * 32 + (vwi & 31);
    const unsigned voff = (unsigned)(vk * U.ldv * 2 + vc * 2);
    LAS char* Kl3 = (LAS char*)(uintptr_t)(unsigned)(uintptr_t)(K_lds + 1024 * wid);
    LAS char* Vl3 = (LAS char*)(uintptr_t)(unsigned)(uintptr_t)(V_lds + 1024 * wid);
    const bool k1on = (DQK == 96) && (wid < 4);
    const int vb0 = (int)(uintptr_t)V_lds + v_rd_base(lane);
    auto tile_row = [&](int t) -> int { return (t < 4) ? (U.ctx_row0 + 64 * t) : (U.lat_row0 + 64 * (t - 4)); };
#define ADMA(t, ks, vs) do { const int kr_ = tile_row(t); const char* kb_ = (const char*)(U.K + (size_t)kr_ * U.ldk); const char* vb_ = (const char*)(U.V + (size_t)kr_ * U.ldv); \
        __builtin_amdgcn_global_load_lds((const unsigned*)(kb_ + koff0), (LAS unsigned*)(Kl3 + (ks) * SHM_KT), 16, 0, 0); \
        if (DQK == 96) { if (k1on) __builtin_amdgcn_global_load_lds((const unsigned*)(kb_ + koff1), (LAS unsigned*)(Kl3 + (ks) * SHM_KT + 8192), 16, 0, 0); } \
        __builtin_amdgcn_global_load_lds((const unsigned*)(vb_ + voff), (LAS unsigned*)(Vl3 + (vs) * SHM_V), 16, 0, 0); } while (0)
#define AWAIT() do { asm volatile("s_waitcnt vmcnt(0)" ::: "memory"); __syncthreads(); } while (0)
#define MASK(P0, P1, t) do { if (MASKED && (t) >= 4 && (t) >= tlo && (t) < thi && !((t) >= ilo && (t) <= ihi)) wmask(P0, P1, U.kpos0 + 64 * ((t) - 4), U.qpos0 + wid * 32 + r32, hi); } while (0)
    int tlo = 4, thi = 1 << 20, ilo = 0, ihi = -1;
    if (MASKED) { const int qw0 = U.qpos0 + __builtin_amdgcn_readfirstlane(wid) * 32 - U.kpos0; const int lo_ = (qw0 - 191 + 63) >> 6, hi_ = (qw0 + 159) >> 6;
        tlo = __builtin_amdgcn_readfirstlane(4 + (lo_ > 0 ? lo_ : 0)); thi = __builtin_amdgcn_readfirstlane(4 + hi_ + 1);
        ilo = __builtin_amdgcn_readfirstlane(4 + ((qw0 - 97 + 63) >> 6)); ihi = __builtin_amdgcn_readfirstlane(4 + ((qw0 + 65) >> 6)); }
#define SPV(P0, P1, vslot, t) do { if (!MASKED || (t) < 4 || ((t) >= tlo && (t) < thi)) { smpack(P0, P1, l_reg, l_r1, l_r2, l_r3, pa0, pa1, pa2, pa3); SBAR(); pv2(o, vb0 + (vslot) * SHM_V, pa0, pa1, pa2, pa3); } } while (0)
    f32x16 pA0, pA1, pB0, pB1; bf16x8 pa0, pa1, pa2, pa3; const int NT = U.nt;
    __syncthreads();
    if (!pre) {
#pragma unroll
        for (int d0 = 0; d0 < ND0; ++d0) qr[d0] = *reinterpret_cast<const bf16x8*>(Qw + d0 * 16);
        ADMA(0, 0, 0); ADMA(1, 1, 1);
    }
    AWAIT();
    if (pre) {
#pragma unroll
        for (int d0 = 0; d0 < ND0; ++d0) qr[d0] = *reinterpret_cast<const bf16x8*>(qstage + (wid * 32 + r32) * PITCH + d0 * 32 + hi * 16);
    }
    qkt<ND0>(pA0, pA1, K_lds, qr, r32, hi); MASK(pA0, pA1, 0);
    int va = 0, vb = 1, vc3 = 2;
    for (int j = 0; j + 2 < NT; j += 2) {
        AWAIT(); ADMA(j + 2, 0, vc3); SBAR();
        qkt<ND0>(pB0, pB1, K_lds + SHM_KT, qr, r32, hi); MASK(pB0, pB1, j + 1);
        SPV(pA0, pA1, va, j);
        AWAIT(); ADMA(j + 3, 1, va); SBAR();
        qkt<ND0>(pA0, pA1, K_lds, qr, r32, hi); MASK(pA0, pA1, j + 2);
        SPV(pB0, pB1, vb, j + 1);
        { const int t_ = va; va = vc3; vc3 = vb; vb = t_; }
    }
    int npre = 0;
    if (has_next) {
        LAS char* Kn3 = (LAS char*)(uintptr_t)(unsigned)(uintptr_t)(lds + (rset ^ 1) * RSET + 3 * SHM_V + 1024 * wid);
        LAS char* Vn3 = (LAS char*)(uintptr_t)(unsigned)(uintptr_t)(lds + (rset ^ 1) * RSET + 1024 * wid);
#pragma unroll
        for (int t = 0; t < 2; ++t) { const int kr_ = NU.ctx_row0 + 64 * t; const char* kb_ = (const char*)(NU.K + (size_t)kr_ * NU.ldk); const char* vb_ = (const char*)(NU.V + (size_t)kr_ * NU.ldv);
            __builtin_amdgcn_global_load_lds((const unsigned*)(kb_ + koff0), (LAS unsigned*)(Kn3 + t * SHM_KT), 16, 0, 0);
            if (DQK == 96) { if (k1on) __builtin_amdgcn_global_load_lds((const unsigned*)(kb_ + koff1), (LAS unsigned*)(Kn3 + t * SHM_KT + 8192), 16, 0, 0); }
            __builtin_amdgcn_global_load_lds((const unsigned*)(vb_ + voff), (LAS unsigned*)(Vn3 + t * SHM_V), 16, 0, 0); }
        constexpr int NQ = PITCH * 256 / 1024 / 8;
        LAS char* Qn3 = (LAS char*)(uintptr_t)(unsigned)(uintptr_t)(qstage + 1024 * wid);
#pragma unroll
        for (int i = 0; i < NQ; ++i) { const int Lq = 1024 * (wid + 8 * i) + 16 * lane, qrw = Lq / PITCH, qpc = (Lq % PITCH) >> 4;
            __builtin_amdgcn_global_load_lds((const unsigned*)((const char*)(NU.Q + (size_t)(NU.qrow0 + qrw) * NU.ldq) + qpc * 16), (LAS unsigned*)(Qn3 + 8192 * i), 16, 0, 0); }
        npre = 4 + NQ + (k1on ? 2 : 0);
    }
    if (npre == 12) asm volatile("s_waitcnt vmcnt(12)" ::: "memory"); else if (npre == 10) asm volatile("s_waitcnt vmcnt(10)" ::: "memory"); else if (npre == 8) asm volatile("s_waitcnt vmcnt(8)" ::: "memory"); else asm volatile("s_waitcnt vmcnt(0)" ::: "memory");
    __syncthreads(); SBAR();
    qkt<ND0>(pB0, pB1, K_lds + SHM_KT, qr, r32, hi); MASK(pB0, pB1, NT - 1);
    SPV(pA0, pA1, va, NT - 2);
    SPV(pB0, pB1, vb, NT - 1);
    l_reg = (l_reg + l_r1) + (l_r2 + l_r3);
    { auto rr = __builtin_amdgcn_permlane32_swap(__float_as_uint(l_reg), __float_as_uint(l_reg), false, false);
      l_reg = __uint_as_float(rr[0]) + __uint_as_float(rr[1]); }
    if (hi == 0) wsf[r32] = l_reg;
    asm volatile("s_waitcnt lgkmcnt(0)" ::: "memory");
    float rli[16];
#pragma unroll
    for (int r = 0; r < 16; ++r) rli[r] = 1.f / wsf[crow(r, hi)];
    bf16* Ow = U.O + (size_t)(U.qrow0 + wid * 32) * 1024;
#pragma unroll
    for (int r = 0; r < 16; ++r) { const int orow = crow(r, hi);
#pragma unroll
        for (int d0 = 0; d0 < 2; ++d0) { const unsigned w = pk2(o[d0][r] * rli[r], 0.f); Ow[(size_t)orow * 1024 + d0 * 32 + r32] = (bf16)(w & 0xffffu); } }
#undef ADMA
#undef AWAIT
#undef MASK
#undef SPV
}
}

__device__ __forceinline__ void attn_phase(const Frame& F, ArgsP Ap, int l, char* lds, const int pvar) {
    unsigned char* ws = Ap->ws;
    const bf16* QM = (const bf16*)(ws + WS_QM); const bf16* KM = (const bf16*)(ws + WS_KM); const bf16* VM = (const bf16*)(ws + WS_VM);
    const bf16* QS = (const bf16*)(ws + WS_QS); const bf16* KS = (const bf16*)(ws + WS_KS); const bf16* VS = (const bf16*)(ws + WS_P) + 1312;
    bf16* OB = (bf16*)(ws + WS_AB);
    const float* sink = Ap->in[17] + l * 8;
    if (__builtin_amdgcn_readfirstlane(F.tid) >= 256) __builtin_amdgcn_s_setprio(1);
    const int nunits = (l == 0) ? 1024 + 64 : 1024;
    {   auto mk = [&](int u) -> att::Unit {
            const bool isl = u < 1024;
            const int i = u >> 8, c = u & 31, b = isl ? ((u & 255) >> 5) : ((u - 1024) >> 3), h = isl ? (2 * i + (c >> 4)) : (u & 7), qb = c & 15;
            att::Unit U; U.Q = QM + h * 96; U.ldq = 768; U.K = KM + h * 96; U.ldk = 768; U.V = VM + h * 64; U.ldv = 512; U.O = OB + h * 64;
            U.qrow0 = isl ? (b * SEQ + qb * 256) : (NLAT + b * CTXL); U.ctx_row0 = NLAT + b * CTXL; U.lat_row0 = b * SEQ; U.nt = isl ? (4 + SEQ / 64) : 4; U.qpos0 = 0; U.kpos0 = 0; U.masked = 0; U.l_init = 0.f;
            return U; };
        int u = (pvar == 2) ? nunits : F.vcu; int rset = 0; bool pre = false; att::Unit U, NU;
        if (u < nunits) U = mk(u);
        for (; u < nunits; u += F.G) { const bool hn = u + F.G < nunits; NU = mk(hn ? (u + F.G) : u);
            att::attn_unit<96, false>(U, NU, hn, rset, pre, lds, F.tid); pre = hn; rset ^= 1; U = NU; }
    }
    {   auto mk = [&](int u) -> att::Unit {
            const bool isl = u < 1024;
            const int i = u >> 8, c = u & 31, b = isl ? ((u & 255) >> 5) : ((u - 1024) >> 3), h = isl ? (2 * i + (c >> 4)) : (u & 7), qb = c & 15, g = h >> 2;
            const int q0 = qb * 256; int k_lo = q0 - 128; if (k_lo < 0) k_lo = 0; int k_hi = q0 + 256 + 128; if (k_hi > SEQ) k_hi = SEQ;
            att::Unit U; U.Q = QS + h * 64; U.ldq = 512; U.K = KS + g * 64; U.ldk = 128; U.V = VS + g * 64; U.ldv = DIN; U.O = OB + 512 + h * 64;
            U.qrow0 = isl ? (b * SEQ + q0) : (NLAT + b * CTXL); U.ctx_row0 = NLAT + b * CTXL; U.lat_row0 = b * SEQ + k_lo; U.nt = isl ? (4 + (k_hi - k_lo) / 64) : 4; U.qpos0 = q0; U.kpos0 = k_lo; U.masked = 1;
            U.l_init = __builtin_amdgcn_exp2f(sink[h] * LOG2E);
            return U; };
        int u = (pvar == 1) ? nunits : ((F.vcu + (F.G >> 2)) % F.G); int rset = 0; bool pre = false; att::Unit U, NU;
        if (u < nunits) U = mk(u);
        for (; u < nunits; u += F.G) { const bool hn = u + F.G < nunits; NU = mk(hn ? (u + F.G) : u);
            att::attn_unit<64, true>(U, NU, hn, rset, pre, lds, F.tid); pre = hn; rset ^= 1; U = NU; }
    }
    __builtin_amdgcn_s_setprio(0);
}

#ifndef DBG_NAIVE_ATTN
#define DBG_NAIVE_ATTN 0
#endif
#if DBG_NAIVE_ATTN
__device__ __forceinline__ void attn_naive_phase(const Frame& F, ArgsP Ap, int l) {
    unsigned char* ws = Ap->ws;
    const bf16* QM = (const bf16*)(ws + WS_QM); const bf16* KM = (const bf16*)(ws + WS_KM); const bf16* VM = (const bf16*)(ws + WS_VM);
    const bf16* QS = (const bf16*)(ws + WS_QS); const bf16* KS = (const bf16*)(ws + WS_KS); const bf16* VS = (const bf16*)(ws + WS_P) + 1312;
    bf16* OB = (bf16*)(ws + WS_AB);
    const float* sink = Ap->in[17] + l * 8;
    const int nrg = ((l == 0) ? NROWS : NLAT) / 64;
    for (int u = F.gw; u < nrg * 8; u += F.ngw) {
        const int h = __builtin_amdgcn_readfirstlane(u & 7), rg = __builtin_amdgcn_readfirstlane(u >> 3), row = rg * 64 + F.lane;
        const bool lat = rg * 64 < NLAT; const int b = lat ? (rg * 64) >> 12 : (rg * 64 - NLAT) >> 8;
        {
            float q[96], o[64]; float lsum = 0.f;
#pragma unroll
            for (int d = 0; d < 96; d += 2) { const unsigned w = *(const unsigned*)(QM + (size_t)row * 768 + h * 96 + d); q[d] = bf_lo(w); q[d + 1] = bf_hi(w); }
#pragma unroll
            for (int d = 0; d < 64; ++d) o[d] = 0.f;
            const int nk = lat ? (CTXL + SEQ) : CTXL;
#pragma unroll 1
            for (int j = 0; j < nk; ++j) { const int kr = (j < CTXL) ? (NLAT + b * CTXL + j) : (b * SEQ + j - CTXL);
                const bf16* kp = KM + (size_t)kr * 768 + h * 96; const bf16* vp = VM + (size_t)kr * 512 + h * 64; float s = 0.f;
#pragma unroll
                for (int d = 0; d < 96; d += 2) { const unsigned w = *(const unsigned*)(kp + d); s = fmaf(q[d], bf_lo(w), s); s = fmaf(q[d + 1], bf_hi(w), s); }
                const float p = exp2f(s); lsum += p;
#pragma unroll
                for (int d = 0; d < 64; d += 2) { const unsigned w = *(const unsigned*)(vp + d); o[d] = fmaf(p, bf_lo(w), o[d]); o[d + 1] = fmaf(p, bf_hi(w), o[d + 1]); } }
            const float rl = 1.f / lsum;
#pragma unroll
            for (int d = 0; d < 64; d += 2) *(unsigned*)(OB + (size_t)row * 1024 + h * 64 + d) = pk2(o[d] * rl, o[d + 1] * rl);
        }
        {
            const int g = h >> 2; const int pos0 = (rg * 64) & (SEQ - 1), pos = pos0 + F.lane;
            float q[64], o[64]; float lsum = exp2f(sink[h] * LOG2E);
#pragma unroll
            for (int d = 0; d < 64; d += 2) { const unsigned w = *(const unsigned*)(QS + (size_t)row * 512 + h * 64 + d); q[d] = bf_lo(w); q[d + 1] = bf_hi(w); }
#pragma unroll
            for (int d = 0; d < 64; ++d) o[d] = 0.f;
            int jlo = pos0 - 128; if (jlo < 0) jlo = 0; int jhi = pos0 + 63 + 128; if (jhi > SEQ - 1) jhi = SEQ - 1;
            const int nk = lat ? (CTXL + (jhi - jlo + 1)) : CTXL;
#pragma unroll 1
            for (int j = 0; j < nk; ++j) { const bool isc = j < CTXL; const int kpos = jlo + j - CTXL; const int kr = isc ? (NLAT + b * CTXL + j) : (b * SEQ + kpos);
                const bf16* kp = KS + (size_t)kr * 128 + g * 64; const bf16* vp = VS + (size_t)kr * DIN + g * 64; float s = 0.f;
#pragma unroll
                for (int d = 0; d < 64; d += 2) { const unsigned w = *(const unsigned*)(kp + d); s = fmaf(q[d], bf_lo(w), s); s = fmaf(q[d + 1], bf_hi(w), s); }
                float p = exp2f(s); if (!isc) { const int dd = kpos - pos; if (dd > 128 || dd < -128) p = 0.f; } lsum += p;
#pragma unroll
                for (int d = 0; d < 64; d += 2) { const unsigned w = *(const unsigned*)(vp + d); o[d] = fmaf(p, bf_lo(w), o[d]); o[d + 1] = fmaf(p, bf_hi(w), o[d + 1]); } }
            const float rl = 1.f / lsum;
#pragma unroll
            for (int d = 0; d < 64; d += 2) *(unsigned*)(OB + (size_t)row * 1024 + 512 + h * 64 + d) = pk2(o[d] * rl, o[d + 1] * rl);
        }
    }
}
#endif
__device__ __forceinline__ unsigned f2key(float f) { return __float_as_uint(f); }
__device__ __forceinline__ float key2f(unsigned k) { return __uint_as_float(k); }
__device__ __forceinline__ unsigned kmaxf(unsigned a, unsigned b) { unsigned d; asm("v_max_f32 %0, %1, %2" : "=v"(d) : "v"(a), "v"(b)); return d; }
__device__ __forceinline__ unsigned kminf(unsigned a, unsigned b) { unsigned d; asm("v_min_f32 %0, %1, %2" : "=v"(d) : "v"(a), "v"(b)); return d; }
#define CE_DESC(a, b) do { const unsigned _hi = kmaxf(a, b), _lo = kminf(a, b); a = _hi; b = _lo; } while (0)
__device__ __forceinline__ void sort16_desc(unsigned (&a)[16]) {
    CE_DESC(a[0], a[13]); CE_DESC(a[1], a[12]); CE_DESC(a[2], a[15]); CE_DESC(a[3], a[14]); CE_DESC(a[4], a[8]); CE_DESC(a[5], a[6]); CE_DESC(a[7], a[11]); CE_DESC(a[9], a[10]);
    CE_DESC(a[0], a[5]); CE_DESC(a[1], a[7]); CE_DESC(a[2], a[9]); CE_DESC(a[3], a[4]); CE_DESC(a[6], a[13]); CE_DESC(a[8], a[14]); CE_DESC(a[10], a[15]); CE_DESC(a[11], a[12]);
    CE_DESC(a[0], a[1]); CE_DESC(a[2], a[3]); CE_DESC(a[4], a[5]); CE_DESC(a[6], a[8]); CE_DESC(a[7], a[9]); CE_DESC(a[10], a[11]); CE_DESC(a[12], a[13]); CE_DESC(a[14], a[15]);
    CE_DESC(a[0], a[2]); CE_DESC(a[1], a[3]); CE_DESC(a[4], a[10]); CE_DESC(a[5], a[11]); CE_DESC(a[6], a[7]); CE_DESC(a[8], a[9]); CE_DESC(a[12], a[14]); CE_DESC(a[13], a[15]);
    CE_DESC(a[1], a[2]); CE_DESC(a[3], a[12]); CE_DESC(a[4], a[6]); CE_DESC(a[5], a[7]); CE_DESC(a[8], a[10]); CE_DESC(a[9], a[11]); CE_DESC(a[13], a[14]);
    CE_DESC(a[1], a[4]); CE_DESC(a[2], a[6]); CE_DESC(a[5], a[8]); CE_DESC(a[7], a[10]); CE_DESC(a[9], a[13]); CE_DESC(a[11], a[14]);
    CE_DESC(a[2], a[4]); CE_DESC(a[3], a[6]); CE_DESC(a[9], a[12]); CE_DESC(a[11], a[13]);
    CE_DESC(a[3], a[5]); CE_DESC(a[6], a[8]); CE_DESC(a[7], a[9]); CE_DESC(a[10], a[12]);
    CE_DESC(a[3], a[4]); CE_DESC(a[5], a[6]); CE_DESC(a[7], a[8]); CE_DESC(a[9], a[10]); CE_DESC(a[11], a[12]);
    CE_DESC(a[6], a[7]); CE_DESC(a[8], a[9]);
}
__device__ __forceinline__ void merge16_desc(unsigned (&t)[16], const unsigned (&c)[16]) {
#pragma unroll
    for (int i = 0; i < 16; ++i) t[i] = kmaxf(t[i], c[15 - i]);
#pragma unroll
    for (int j = 8; j > 0; j >>= 1)
#pragma unroll
        for (int i = 0; i < 16; ++i) { const int p = i ^ j; if (p > i) CE_DESC(t[i], t[p]); }
}
__device__ __forceinline__ void merge16_partner(unsigned (&t)[16]) {
    unsigned oth[16];
#pragma unroll
    for (int i = 0; i < 16; ++i) oth[i] = (unsigned)__shfl_xor((int)t[i], 32);
    merge16_desc(t, oth);
}

constexpr size_t WS_IDX = WS_P;
constexpr size_t WS_GW = WS_P + (size_t)NROWS * 128 * 2;
constexpr size_t WS_W2 = WS_GW + (size_t)NROWS * 128 * 4;
constexpr size_t WS_USL = WS_W2 + (size_t)NROWS * 128 * 4;
constexpr size_t WS_IDXT = WS_USL + (size_t)NROWS * 128 * 4;
static_assert(WS_IDXT + (size_t)NROWS * 128 * 2 <= WS_X5, "peer lists inside the P region");

typedef _Float16 pvh2_t __attribute__((ext_vector_type(2)));
__device__ __forceinline__ void topkc_phase(const Frame& F, ArgsP Ap, int l, int nrows, char* lds) {
    unsigned char* ws = Ap->ws;
    const bf16* QP = (const bf16*)(ws + WS_X5);
    const bf16* PK = (const bf16*)(ws + WS_PKEY) + (size_t)l * 16 * 128 * 128;
    unsigned short* IDX = (unsigned short*)(ws + WS_IDX); float* GW = (float*)(ws + WS_GW); float* USL = (float*)(ws + WS_USL);
    const float* USt = (const float*)(ws + WS_US) + l * PEXP; const float* VSt = (const float*)(ws + WS_VS) + l * PEXP;
    char* Kl = lds;
    unsigned char* sub = (unsigned char*)(lds + 65536) + F.wave * 1024;
    const int lane = F.lane, r32 = lane & 31, hi = lane >> 5;
    const int nunits = (nrows / 256) * 8;
    const bool xs = (F.G & 7) == 0 && ((nrows / 256) & 7) == 0;
    int hcur = -1;
    unsigned* stab = (unsigned*)(lds + 73728);
    for (int i = F.tid; i < PEXP / 4; i += 512) { const f32x4 a = *(const f32x4*)(USt + 4 * i), b = *(const f32x4*)(VSt + 4 * i); u32x4 w;
#pragma unroll
        for (int j = 0; j < 4; ++j) { const pvh2_t hh = {(_Float16)(a[j] * 1024.f), (_Float16)(b[j] * 1024.f)}; w[j] = __builtin_bit_cast(unsigned, hh); }
        *(u32x4*)(stab + 4 * i) = w; }
    const int nux = xs ? nunits / 8 : nunits, ustep = xs ? (F.G >> 3) : F.G;
    const bool qtail = xs && (F.G >> 3) == 32 && (nux & 31) == 8;
    const int nfull = qtail ? (nux & ~31) : nux;
    for (int u = xs ? (F.bid >> 3) : F.bid; u < nfull + (qtail ? 32 : 0); u += ustep) {
        const bool tl = u >= nfull;
        if (tl && F.wave >= 2) break;
        const int h = u & 7, rb = tl ? ((F.bid & 7) * (nrows / 2048) + (nfull >> 3)) : (xs ? ((F.bid & 7) * (nrows / 2048) + (u >> 3)) : (u >> 3));
        if (h != hcur) {
            __syncthreads();
#pragma unroll
            for (int i = 0; i < 8; ++i) { const int ci = F.tid + 512 * i, krow = ci >> 4, ch = ci & 15;
                const u32x4 v = *(const u32x4*)(PK + ((size_t)(2 * h) * 128 + krow) * 128 + ch * 8);
                *(u32x4*)(Kl + krow * 256 + ((ch * 16) ^ ((krow & 7) << 4))) = v; }
            __syncthreads();
            hcur = h; }
        const int row = rb * 256 + (tl ? (F.bid >> 6) * 64 : 0) + F.wave * 32 + r32;
        const unsigned hi4 = (unsigned)hi << 2, hi7 = (unsigned)hi << 7;
        unsigned t0[16], t1[16];
        bf16x8 bqa[2][8];
#pragma unroll
        for (int p = 0; p < 2; ++p) { const bf16* qrow = QP + (size_t)row * 2048 + (2 * h + p) * 128 + hi * 8;
#pragma unroll
            for (int s = 0; s < 8; ++s) bqa[p][s] = *reinterpret_cast<const bf16x8*>(qrow + s * 16); }
#pragma unroll
        for (int p = 0; p < 2; ++p) {
            bf16x8 bq[8];
#pragma unroll
            for (int s = 0; s < 8; ++s) bq[s] = bqa[p][s];
            unsigned top[16];
#pragma unroll
            for (int blk = 0; blk < 4; ++blk) {
                f32x16 acc = f32x16{};
                const char* kb = Kl + (p * 128 + blk * 32 + r32) * 256;
#pragma unroll
                for (int s = 0; s < 8; ++s) { const bf16x8 ka = *reinterpret_cast<const bf16x8*>(kb + (((s * 16 + hi * 8) * 2) ^ ((r32 & 7) << 4)));
                    acc = __builtin_amdgcn_mfma_f32_32x32x16_bf16(ka, bq[s], acc, 0, 0, 0); }
                unsigned c[16];
#pragma unroll
                for (int r = 0; r < 16; ++r) c[r] = ((f2key(acc[r]) & ~127u) | (unsigned)(127 - (blk * 32 + (r & 3) + 8 * (r >> 2)))) ^ hi4;
                sort16_desc(c);
                if (blk == 0) {
#pragma unroll
                    for (int i = 0; i < 16; ++i) top[i] = c[i];
                } else merge16_desc(top, c);
                __builtin_amdgcn_sched_barrier(0);
            }
            merge16_partner(top);
#pragma unroll
            for (int i = 0; i < 16; ++i) { if (p == 0) t0[i] = top[i]; else t1[i] = top[i]; }
        }
        if (hi == 0) { unsigned* sw = (unsigned*)(sub + r32 * 32);
#pragma unroll
            for (int q = 0; q < 4; ++q) {
                sw[q] = (127u - (t0[4 * q] & 127u)) | ((127u - (t0[4 * q + 1] & 127u)) << 8) | ((127u - (t0[4 * q + 2] & 127u)) << 16) | ((127u - (t0[4 * q + 3] & 127u)) << 24);
                sw[4 + q] = (127u - (t1[4 * q] & 127u)) | ((127u - (t1[4 * q + 1] & 127u)) << 8) | ((127u - (t1[4 * q + 2] & 127u)) << 16) | ((127u - (t1[4 * q + 3] & 127u)) << 24); } }
        float f1[16], fa[8];
#pragma unroll
        for (int i = 0; i < 16; ++i) f1[i] = key2f(t1[i] & ~127u);
#pragma unroll
        for (int i = 0; i < 8; ++i) fa[i] = key2f((hi ? t0[8 + i] : t0[i]) & ~127u);
        unsigned top[16];
        {
#pragma unroll
            for (int b = 0; b < 16; ++b) top[b] = ((f2key(fa[0] + f1[b]) & ~255u) | (unsigned)(255 - b)) ^ hi7;
            __builtin_amdgcn_sched_barrier(0);
            { unsigned c[16] = {((f2key(fa[1] + f1[0]) & ~255u) | 239u) ^ hi7, ((f2key(fa[1] + f1[1]) & ~255u) | 238u) ^ hi7, ((f2key(fa[1] + f1[2]) & ~255u) | 237u) ^ hi7, ((f2key(fa[1] + f1[3]) & ~255u) | 236u) ^ hi7, ((f2key(fa[1] + f1[4]) & ~255u) | 235u) ^ hi7, ((f2key(fa[1] + f1[5]) & ~255u) | 234u) ^ hi7, ((f2key(fa[1] + f1[6]) & ~255u) | 233u) ^ hi7, ((f2key(fa[1] + f1[7]) & ~255u) | 232u) ^ hi7, ((f2key(fa[2] + f1[0]) & ~255u) | 223u) ^ hi7, ((f2key(fa[2] + f1[1]) & ~255u) | 222u) ^ hi7, ((f2key(fa[2] + f1[2]) & ~255u) | 221u) ^ hi7, ((f2key(fa[2] + f1[3]) & ~255u) | 220u) ^ hi7, ((f2key(fa[2] + f1[4]) & ~255u) | 219u) ^ hi7, ((f2key(fa[3] + f1[0]) & ~255u) | 207u) ^ hi7, ((f2key(fa[3] + f1[1]) & ~255u) | 206u) ^ hi7, ((f2key(fa[3] + f1[2]) & ~255u) | 205u) ^ hi7};
              sort16_desc(c); merge16_desc(top, c); }
            __builtin_amdgcn_sched_barrier(0);
            { unsigned c[16] = {((f2key(fa[3] + f1[3]) & ~255u) | 204u) ^ hi7, ((f2key(fa[4] + f1[0]) & ~255u) | 191u) ^ hi7, ((f2key(fa[4] + f1[1]) & ~255u) | 190u) ^ hi7, ((f2key(fa[4] + f1[2]) & ~255u) | 189u) ^ hi7, ((f2key(fa[5] + f1[0]) & ~255u) | 175u) ^ hi7, ((f2key(fa[5] + f1[1]) & ~255u) | 174u) ^ hi7, ((f2key(fa[6] + f1[0]) & ~255u) | 159u) ^ hi7, ((f2key(fa[6] + f1[1]) & ~255u) | 158u) ^ hi7, ((f2key(fa[7] + f1[0]) & ~255u) | 143u) ^ hi7, ((f2key(fa[7] + f1[1]) & ~255u) | 142u) ^ hi7, 0xFF800000u, 0xFF800000u, 0xFF800000u, 0xFF800000u, 0xFF800000u, 0xFF800000u};
              sort16_desc(c); merge16_desc(top, c); }
        }
        merge16_partner(top);
        asm volatile("s_waitcnt lgkmcnt(0)" ::: "memory");
        float cv[16]; float den = 0.f; const float m = key2f(top[0] & ~255u);
#pragma unroll
        for (int i = 0; i < 16; ++i) { cv[i] = __expf(key2f(top[i] & ~255u) - m); den += cv[i]; }
        const float rden = 1.f / den;
        if (hi == 0) {
            unsigned iw[8];
#pragma unroll
            for (int i = 0; i < 16; i += 2) {
                const int fl0 = 255 - (int)(top[i] & 255u), fl1 = 255 - (int)(top[i + 1] & 255u);
                const unsigned e0 = (unsigned)sub[r32 * 32 + (fl0 >> 4)] * PNK + (unsigned)sub[r32 * 32 + 16 + (fl0 & 15)];
                const unsigned e1 = (unsigned)sub[r32 * 32 + (fl1 >> 4)] * PNK + (unsigned)sub[r32 * 32 + 16 + (fl1 & 15)];
                iw[i >> 1] = e0 | (e1 << 16); }
            u32x4* ip = (u32x4*)(IDX + (size_t)row * 128 + h * 16); ip[0] = (u32x4){iw[0], iw[1], iw[2], iw[3]}; ip[1] = (u32x4){iw[4], iw[5], iw[6], iw[7]};
            { unsigned* itp = (unsigned*)((unsigned short*)(ws + WS_IDXT) + (size_t)row * 128 + 2 * h);
#pragma unroll
              for (int i = 0; i < 8; ++i) { const unsigned lo_ = (i & 1) ? (iw[i >> 1] >> 16) : (iw[i >> 1] & 0xffffu), hi_ = (i & 1) ? (iw[4 + (i >> 1)] >> 16) : (iw[4 + (i >> 1)] & 0xffffu);
                  itp[8 * i] = lo_ | (hi_ << 16); } }
            float us_[16], gv_[16];
#pragma unroll
            for (int i = 0; i < 16; ++i) { const unsigned e_ = (i & 1) ? (iw[i >> 1] >> 16) : (iw[i >> 1] & 0xffffu); const pvh2_t hh = __builtin_bit_cast(pvh2_t, stab[e_]); us_[i] = (float)hh[0] * (1.f / 1024.f); gv_[i] = cv[i] * rden * (float)hh[1]; }
            f32x4* gp = (f32x4*)(GW + (size_t)row * 128 + h * 16); f32x4* up = (f32x4*)(USL + (size_t)row * 128 + h * 16);
#pragma unroll
            for (int q = 0; q < 4; ++q) { gp[q] = (f32x4){gv_[4 * q], gv_[4 * q + 1], gv_[4 * q + 2], gv_[4 * q + 3]}; up[q] = (f32x4){us_[4 * q], us_[4 * q + 1], us_[4 * q + 2], us_[4 * q + 3]}; }
        }
    }
}

typedef __bf16 bf16x2_t __attribute__((ext_vector_type(2)));
typedef float f32x2v __attribute__((ext_vector_type(2)));
__device__ __forceinline__ float dot2(unsigned w, unsigned x, float acc) { return __builtin_amdgcn_fdot2_f32_bf16(__builtin_bit_cast(bf16x2_t, w), __builtin_bit_cast(bf16x2_t, x), acc, false); }
__device__ __forceinline__ float dot16(const u32x4 a0, const u32x4 a1, const u32x4 x0, const u32x4 x1) {
    float s0 = dot2(a0.x, x0.x, 0.f), s1 = dot2(a0.y, x0.y, 0.f), s2 = dot2(a0.z, x0.z, 0.f), s3 = dot2(a0.w, x0.w, 0.f);
    s0 = dot2(a1.x, x1.x, s0); s1 = dot2(a1.y, x1.y, s1); s2 = dot2(a1.z, x1.z, s2); s3 = dot2(a1.w, x1.w, s3);
    return (s0 + s1) + (s2 + s3);
}
__device__ __forceinline__ void fma8(float (&o)[8], const u32x4 v, float w) {
    o[0] += w * bf_lo(v.x); o[1] += w * bf_hi(v.x); o[2] += w * bf_lo(v.y); o[3] += w * bf_hi(v.y);
    o[4] += w * bf_lo(v.z); o[5] += w * bf_hi(v.z); o[6] += w * bf_lo(v.w); o[7] += w * bf_hi(v.w);
}

#define DPP_ADD(v, CTRL) ((v) + __builtin_bit_cast(float, __builtin_amdgcn_update_dpp(0, __builtin_bit_cast(int, (v)), (CTRL), 0xF, 0xF, true)))
__device__ __forceinline__ float dpp_sum8(float v) { v = DPP_ADD(v, 0xB1); v = DPP_ADD(v, 0x4E); v = DPP_ADD(v, 0x141); return v; }
__device__ __forceinline__ float dpp_sum16(float v) { v = dpp_sum8(v); v = DPP_ADD(v, 0x140); return v; }
__device__ __forceinline__ float sum_b345(float v) {
    v = DPP_ADD(v, 0x128);
    { unsigned a = __builtin_bit_cast(unsigned, v), b = a; asm volatile("s_nop 1\n\tv_permlane16_swap_b32 %0, %1" : "+v"(a), "+v"(b)); v = __builtin_bit_cast(float, a) + __builtin_bit_cast(float, b); }
    { unsigned a = __builtin_bit_cast(unsigned, v), b = a; asm volatile("s_nop 1\n\tv_permlane32_swap_b32 %0, %1" : "+v"(a), "+v"(b)); v = __builtin_bit_cast(float, a) + __builtin_bit_cast(float, b); }
    return v;
}
__device__ __forceinline__ float gelu_as(float v) {
    const float av = fabsf(v), t = __builtin_amdgcn_rcpf(av * 0.2316418882f + 1.0f);
    float q = t * 0.5307027145f + (-0.7265760135f); q = q * t + 0.7107068705f; q = q * t + (-0.142248368f); q = q * t + 0.127414796f; q = q * t;
    const float e = __builtin_amdgcn_exp2f((v * v) * (-0.72134752044f)); const float m = v * (q * e);
    return v < 0.f ? m : v - m;
}
#define NT_LD(T, p) (*(const T*)(p))
__device__ __forceinline__ void nt_st4(float* p, const f32x4 v) { *(f32x4*)p = v; }
typedef _Float16 h2_t __attribute__((ext_vector_type(2)));
__device__ __forceinline__ float dot2h(unsigned a, unsigned b, float acc) { return __builtin_amdgcn_fdot2(__builtin_bit_cast(h2_t, a), __builtin_bit_cast(h2_t, b), acc, false); }
constexpr unsigned H_ONES = 0x3C003C00u;
constexpr unsigned H_K64 = 0x64646464u;
constexpr float CODE_BIAS = 1152.f;

__device__ __forceinline__ void pu_phase(const Frame& F, ArgsP Ap, int l, int nrows, char* lds, const int pvar) {
    unsigned char* ws = Ap->ws;
    const unsigned short* IDX = (const unsigned short*)(ws + WS_IDX); const float* GW = (const float*)(ws + WS_GW); const float* USL = (const float*)(ws + WS_USL);
    unsigned short* W16 = (unsigned short*)(ws + (pvar ? WS_W2 + (size_t)NROWS * 128 * 2 : WS_W2));
    const char* Bq = (const char*)(ws + WS_F16B); const float* SB = (const float*)(ws + WS_SB);
    const char* Ut = (const char*)(ws + WS_U + (size_t)l * PEXP * DM);
    const int lane = F.lane, grp = lane >> 4, li = lane & 15;
    int* l_slot = (int*)(lds + F.wave * 4096); int* l_idx = l_slot + 128; float* l_g = (float*)(l_idx + 128); float* l_us = l_g + 128; float* l_a = l_us + 128;
    const bool xs = (F.G % 8) == 0;
    const int wv = xs ? (((F.bid & 1) ? (F.G >> 3) * 8 : 0) + (F.bid >> 3) * 8 + F.wave) : F.gw, nwv = xs ? (F.G >> 3) * 16 : F.ngw, npass = xs ? 1 : 4;
    const unsigned long long lt = (1ull << lane) - 1ull;
#ifdef PROBE_IDMASK
    const int idmask = (pvar == 2) ? 0x7807 : 0xffff;
#define PU_IDM(e) ((e) & idmask)
#else
#define PU_IDM(e) (e)
#endif
    const unsigned lo2 = (unsigned)lane * 4u, li16 = (unsigned)li * 16u;
    for (int pass = 0; pass < npass; ++pass) {
        const int c = xs ? ((F.bid & 7) >> 1) : pass;
        unsigned iw = 0u, iwn = 0u; f32x2v gg = {0.f, 0.f}, ggn = {0.f, 0.f}, uu = {0.f, 0.f}, uun = {0.f, 0.f}; u32x4 xv[4], xn[4]; float sb = 0.f, sbn = 0.f;
#define PU_LOAD(IW, GG, UU, X, SBV, t_) do { const char* ip_ = (const char*)(IDX + (size_t)(t_) * 128) + lo2; const char* gp_ = (const char*)(GW + (size_t)(t_) * 128) + 2 * lo2; const char* up_ = (const char*)(USL + (size_t)(t_) * 128) + 2 * lo2; \
        const char* xr_ = Bq + (size_t)(t_) * DM + li16; const float* sp_ = SB + (t_); \
        asm volatile("global_load_dword %0, %1, off" : "=&v"(IW) : "v"(ip_) : "memory"); asm volatile("global_load_dwordx2 %0, %1, off" : "=&v"(GG) : "v"(gp_) : "memory"); asm volatile("global_load_dwordx2 %0, %1, off" : "=&v"(UU) : "v"(up_) : "memory"); \
        asm volatile("global_load_dwordx4 %0, %1, off" : "=&v"(X[0]) : "v"(xr_) : "memory"); asm volatile("global_load_dwordx4 %0, %1, off offset:256" : "=&v"(X[1]) : "v"(xr_) : "memory"); \
        asm volatile("global_load_dwordx4 %0, %1, off offset:512" : "=&v"(X[2]) : "v"(xr_) : "memory"); asm volatile("global_load_dwordx4 %0, %1, off offset:768" : "=&v"(X[3]) : "v"(xr_) : "memory"); \
        asm volatile("global_load_dword %0, %1, off" : "=&v"(SBV) : "v"(sp_) : "memory"); } while (0)
        int t = wv;
        if (t < nrows) { PU_LOAD(iw, gg, uu, xv, sb, t); asm volatile("s_waitcnt vmcnt(0)" ::: "memory"); }
        for (; t < nrows; t += nwv) {
            const int i0 = (int)(iw & 0xffffu), i1 = (int)(iw >> 16); const bool m0 = (i0 >> 12) == c, m1 = (i1 >> 12) == c;
            const unsigned long long b0 = __ballot(m0), b1 = __ballot(m1); const int n = (pvar == 1) ? 0 : (__popcll(b0) + __popcll(b1)); const int r0 = __popcll(b0 & lt) + __popcll(b1 & lt);
            if (m0) { l_slot[r0] = 2 * lane; l_idx[r0] = i0; l_g[r0] = gg.x; l_us[r0] = uu.x; }
            if (m1) { const int r1 = r0 + (m0 ? 1 : 0); l_slot[r1] = 2 * lane + 1; l_idx[r1] = i1; l_g[r1] = gg.y; l_us[r1] = uu.y; }
            if (t + nwv < nrows) PU_LOAD(iwn, ggn, uun, xn, sbn, t + nwv);
            asm volatile("s_waitcnt lgkmcnt(0)" ::: "memory");
            u32x4 qa[4], qb[4], sa[4], sb4[4];
#define PU_RLOAD(RA, RB, k0_) do { const int kA_ = ((k0_) + grp < n) ? ((k0_) + grp) : (n - 1), kB_ = ((k0_) + 4 + grp < n) ? ((k0_) + 4 + grp) : (n - 1);       \
                const char* uA_ = Ut + ((unsigned)PU_IDM(l_idx[kA_]) * 1024u + li16); const char* uB_ = Ut + ((unsigned)PU_IDM(l_idx[kB_]) * 1024u + li16); \
                asm volatile("global_load_dwordx4 %0, %1, off" : "=&v"(RA[0]) : "v"(uA_) : "memory"); asm volatile("global_load_dwordx4 %0, %1, off offset:256" : "=&v"(RA[1]) : "v"(uA_) : "memory"); \
                asm volatile("global_load_dwordx4 %0, %1, off offset:512" : "=&v"(RA[2]) : "v"(uA_) : "memory"); asm volatile("global_load_dwordx4 %0, %1, off offset:768" : "=&v"(RA[3]) : "v"(uA_) : "memory"); \
                asm volatile("global_load_dwordx4 %0, %1, off" : "=&v"(RB[0]) : "v"(uB_) : "memory"); asm volatile("global_load_dwordx4 %0, %1, off offset:256" : "=&v"(RB[1]) : "v"(uB_) : "memory"); \
                asm volatile("global_load_dwordx4 %0, %1, off offset:512" : "=&v"(RB[2]) : "v"(uB_) : "memory"); asm volatile("global_load_dwordx4 %0, %1, off offset:768" : "=&v"(RB[3]) : "v"(uB_) : "memory"); } while (0)
#define PU_D4(acc0, acc1, r_, x_) do { acc0 = __builtin_amdgcn_sdot4((int)(r_).x, (int)(x_).x, acc0, false); acc1 = __builtin_amdgcn_sdot4((int)(r_).y, (int)(x_).y, acc1, false); \
                acc0 = __builtin_amdgcn_sdot4((int)(r_).z, (int)(x_).z, acc0, false); acc1 = __builtin_amdgcn_sdot4((int)(r_).w, (int)(x_).w, acc1, false); } while (0)
#define PU_COMP(RA, RB, k0_) do { const int kA_ = ((k0_) + grp < n) ? ((k0_) + grp) : (n - 1), kB_ = ((k0_) + 4 + grp < n) ? ((k0_) + 4 + grp) : (n - 1); \
                int dA0 = 0, dA1 = 0, dB0 = 0, dB1 = 0; \
                _Pragma("unroll") for (int s = 0; s < 4; ++s) { PU_D4(dA0, dA1, RA[s], xv[s]); PU_D4(dB0, dB1, RB[s], xv[s]); } \
                l_a[kA_] = dpp_sum16((float)(dA0 + dA1)); l_a[kB_] = dpp_sum16((float)(dB0 + dB1)); } while (0)
#define PU_WAIT(N) do { asm volatile("s_waitcnt vmcnt(" #N ")" ::: "memory"); __builtin_amdgcn_sched_barrier(0); } while (0)
            if (n == 0) asm volatile("s_waitcnt vmcnt(0)" ::: "memory");
            if (n > 0) {
                PU_RLOAD(qa, qb, 0);
                if (8 < n) { PU_RLOAD(sa, sb4, 8); PU_WAIT(8); } else PU_WAIT(0);
                PU_COMP(qa, qb, 0);
#pragma unroll 1
                for (int k0 = 8; k0 < n; ) {
                    if (k0 + 8 < n) { PU_RLOAD(qa, qb, k0 + 8); PU_WAIT(8); } else PU_WAIT(0);
                    PU_COMP(sa, sb4, k0); k0 += 8;
                    if (k0 >= n) break;
                    if (k0 + 8 < n) { PU_RLOAD(sa, sb4, k0 + 8); PU_WAIT(8); } else PU_WAIT(0);
                    PU_COMP(qa, qb, k0); k0 += 8;
                }
                for (int kk = lane; kk < n; kk += 64) { const float a_ = (l_us[kk] * sb) * l_a[kk]; const _Float16 hw = (_Float16)(l_g[kk] * gelu_as(a_)); W16[(size_t)t * 128 + l_slot[kk]] = __builtin_bit_cast(unsigned short, hw); }
            }
#undef PU_WAIT
#undef PU_RLOAD
#undef PU_D4
#undef PU_COMP
            iw = iwn; gg = ggn; uu = uun; sb = sbn;
#pragma unroll
            for (int s = 0; s < 4; ++s) xv[s] = xn[s];
        }
#undef PU_LOAD
    }
}

typedef _Float16 pvh2_t __attribute__((ext_vector_type(2)));
typedef int i32x4 __attribute__((ext_vector_type(4)));
template <int OFF> __device__ __forceinline__ u32x2v tr8_read(unsigned a) { u32x2v r; asm volatile("ds_read_b64_tr_b8 %0, %1 offset:%2" : "=&v"(r) : "v"(a), "i"(OFF) : "memory"); return r; }
__device__ __forceinline__ void pv_phase(const Frame& F, ArgsP Ap, int l, int nrows, const int pvar, char* lds) {
    const bool dry = pvar != 0;
#ifdef PROBE_IDMASK
    const unsigned idmask = (pvar == 2) ? 0x7u : 0xffffu;
#define PV_IDM(e) ((e) & idmask)
#else
#define PV_IDM(e) (e)
#endif
    unsigned char* ws = Ap->ws;
    const unsigned short* IDXT = (const unsigned short*)(ws + WS_IDXT); const unsigned* W16 = (const unsigned*)(ws + WS_W2);
    const char* Vt = (const char*)(ws + WS_V + (size_t)l * PEXP * DM);
    const float* MOD = (const float*)(ws + WS_MOD) + (size_t)l * 9 * 6144 + 5 * DM;
    float* hlat = dry ? (float*)(ws + WS_X5) : Ap->out; float* hctx = dry ? (float*)(ws + WS_X5) + (size_t)NLAT * DM : (float*)(ws + WS_HCTX);
    float* g2l = (float*)lds;
    const int lane = F.lane, n16 = lane & 15, kg = lane >> 4, jj = lane >> 3, q = lane & 7;
    char* tileg = lds + 8192 + F.wave * 16384;
    LAS char* tile3 = (LAS char*)(uintptr_t)(unsigned)(uintptr_t)tileg;
    char* wrow = lds + 4608 + F.wave * 128;
    const bool xs = (F.G % 8) == 0;
    const int wv = xs ? ((F.bid >> 3) * 8 + F.wave) : F.gw, nwv = xs ? (F.G >> 3) * 8 : F.ngw, npass = xs ? 1 : 8;
    const unsigned fsw = (unsigned)(((n16 >> 2) & 3) | ((kg & 1) << 2));
    const unsigned pb = (unsigned)(uintptr_t)tileg + (unsigned)((16 * kg + (n16 >> 1)) * 128 + 8 * (n16 & 1));
    const unsigned po0 = (unsigned)((q ^ ((jj >> 1) & 3)) * 16), po1 = po0 ^ 64u;
    const unsigned col0 = (unsigned)(32 * kg + n16);
    for (int pass = 0; pass < npass; ++pass) {
        const int s = xs ? (F.bid & 7) : pass;
        const char* vslice = Vt + (size_t)s * PEXP * 128;
        const unsigned coffb = (unsigned)(s * 128) * 4u + col0 * 4u;
        __syncthreads();
        for (int i = F.tid; i < 9 * 128; i += 512) g2l[i] = MOD[(size_t)(i >> 7) * 6144 + s * 128 + (i & 127)];
        __syncthreads();
        if (wv >= nrows) continue;
        const int K = (nrows - wv + nwv - 1) / nwv, tlast = wv + (K - 1) * nwv;
#define PVM_TOK(k_) (((k_) < K) ? (wv + (k_) * nwv) : tlast)
#define PVM_DMA(I, j) do { const unsigned w_ = ((j) < 8) ? ((((j) >> 1) == 0) ? I##a.x : (((j) >> 1) == 1) ? I##a.y : (((j) >> 1) == 2) ? I##a.z : I##a.w) : (((((j) - 8) >> 1) == 0) ? I##b.x : ((((j) - 8) >> 1) == 1) ? I##b.y : ((((j) - 8) >> 1) == 2) ? I##b.z : I##b.w); \
            const unsigned e_ = PV_IDM(((j) & 1) ? (w_ >> 16) : (w_ & 0xffffu)); \
            __builtin_amdgcn_global_load_lds((const unsigned*)(vslice + (e_ * 128u + ((((j) >> 1) & 1) ? po1 : po0))), (LAS unsigned*)(tile3 + (j) * 1024), 16, 0, 0); } while (0)
#define PVM_DMA8(I, j0) do { PVM_DMA(I, (j0) + 0); PVM_DMA(I, (j0) + 1); PVM_DMA(I, (j0) + 2); PVM_DMA(I, (j0) + 3); PVM_DMA(I, (j0) + 4); PVM_DMA(I, (j0) + 5); PVM_DMA(I, (j0) + 6); PVM_DMA(I, (j0) + 7); } while (0)
#define PVM_HPTR(t_) ((const char*)(((t_) < NLAT) ? (hlat + (size_t)(t_) * DM) : (hctx + (size_t)((t_) - NLAT) * DM)) + coffb)
#define PVM_LOADC(I, W, H, tids_, tw_) do { const char* ib_ = (const char*)(IDXT + (size_t)(tids_) * 128) + jj * 32; const unsigned* wp_ = W16 + (size_t)(tw_) * 64 + lane; const char* hp_ = PVM_HPTR(tw_); \
            asm volatile("global_load_dwordx4 %0, %1, off" : "=&v"(I##a) : "v"(ib_) : "memory"); asm volatile("global_load_dwordx4 %0, %1, off offset:16" : "=&v"(I##b) : "v"(ib_) : "memory"); \
            asm volatile("global_load_dword %0, %1, off" : "=&v"(W) : "v"(wp_) : "memory"); \
            asm volatile("global_load_dword %0, %1, off" : "=&v"(H##0) : "v"(hp_) : "memory"); asm volatile("global_load_dword %0, %1, off offset:64" : "=&v"(H##1) : "v"(hp_) : "memory"); } while (0)
#define PVM_STEP(st, A_, FIRST) do { \
            _Pragma("unroll") for (int nt = 0; nt < 8; ++nt) { const unsigned ad_ = pb + (((unsigned)nt ^ fsw) << 4); \
                const u32x2v lo_ = tr8_read<(st) * 8192>(ad_), hi_ = tr8_read<(st) * 8192 + 1024>(ad_); bop[nt] = (i32x4){(int)lo_.x, (int)lo_.y, (int)hi_.x, (int)hi_.y}; } \
            asm volatile("s_waitcnt lgkmcnt(0)" ::: "memory"); SBARP(); \
            _Pragma("unroll") for (int nt = 0; nt < 8; ++nt) acc[nt] = __builtin_amdgcn_mfma_i32_16x16x64_i8(A_, bop[nt], (FIRST) ? (i32x4){0, 0, 0, 0} : acc[nt], 0, 0, 0); \
            SBARP(); } while (0)
#define PVM_READS(st, BOP) do { \
            _Pragma("unroll") for (int nt = 0; nt < 8; ++nt) { const unsigned ad_ = pb + (((unsigned)nt ^ fsw) << 4); \
                const u32x2v lo_ = tr8_read<(st) * 8192>(ad_), hi_ = tr8_read<(st) * 8192 + 1024>(ad_); BOP[nt] = (i32x4){(int)lo_.x, (int)lo_.y, (int)hi_.x, (int)hi_.y}; } \
            asm volatile("s_waitcnt lgkmcnt(0)" ::: "memory"); SBARP(); } while (0)
#define SBARP() __builtin_amdgcn_sched_barrier(0)
#define PVM_ITER(IX, WX, HX, IY, WY, HY, k_) do { const int t0_ = PVM_TOK(k_), t1_ = PVM_TOK((k_) + 1), t2_ = PVM_TOK((k_) + 2); \
            asm volatile("s_waitcnt vmcnt(2)" ::: "memory"); SBARP();                \
              \
            PVM_READS(0, bop); PVM_DMA8(IX, 0);                                        \
            PVM_READS(1, bop1); PVM_DMA8(IX, 8);                                       \
            PVM_LOADC(IY, WY, HY, t2_, t1_);                                          \
              \
            float ksc_; { const unsigned aw_ = WX & 0x7fff7fffu; unsigned m_ = (aw_ & 0xffffu) > (aw_ >> 16) ? (aw_ & 0xffffu) : (aw_ >> 16); \
                m_ = max(m_, (unsigned)__builtin_amdgcn_update_dpp(0, (int)m_, 0xB1, 0xF, 0xF, true)); m_ = max(m_, (unsigned)__builtin_amdgcn_update_dpp(0, (int)m_, 0x4E, 0xF, 0xF, true)); \
                m_ = max(m_, (unsigned)__builtin_amdgcn_update_dpp(0, (int)m_, 0x141, 0xF, 0xF, true)); m_ = max(m_, (unsigned)__builtin_amdgcn_update_dpp(0, (int)m_, 0x140, 0xF, 0xF, true)); \
                const unsigned mw_ = max(max((unsigned)__builtin_amdgcn_readlane((int)m_, 0), (unsigned)__builtin_amdgcn_readlane((int)m_, 16)), max((unsigned)__builtin_amdgcn_readlane((int)m_, 32), (unsigned)__builtin_amdgcn_readlane((int)m_, 48))); \
                const float mx_ = (float)__builtin_bit_cast(_Float16, (unsigned short)mw_); const float sc_ = (mx_ > 0.f) ? 127.f * __builtin_amdgcn_rcpf(mx_) : 0.f; ksc_ = mx_ * (1.f / (127.f * 1024.f)); \
                const pvh2_t s2_ = {(_Float16)sc_, (_Float16)sc_}; const pvh2_t k2_ = {(_Float16)1536.f, (_Float16)1536.f}; \
                const unsigned qf_ = __builtin_bit_cast(unsigned, __builtin_elementwise_fma(__builtin_bit_cast(pvh2_t, WX), s2_, k2_));        \
                *(unsigned short*)(wrow + 2 * lane) = (unsigned short)((qf_ & 0xffu) | ((qf_ >> 8) & 0xff00u)); } \
            const i32x4 a0_ = *(const i32x4*)(wrow + 16 * kg), a1_ = *(const i32x4*)(wrow + 64 + 16 * kg);        \
            _Pragma("unroll") for (int nt = 0; nt < 8; ++nt) acc[nt] = __builtin_amdgcn_mfma_i32_16x16x64_i8(a0_, bop[nt], (i32x4){0, 0, 0, 0}, 0, 0, 0); \
            _Pragma("unroll") for (int nt = 0; nt < 8; ++nt) acc[nt] = __builtin_amdgcn_mfma_i32_16x16x64_i8(a1_, bop1[nt], acc[nt], 0, 0, 0); \
              \
            { const int v0_ = (kg == 0) ? acc[0][0] : (kg == 1) ? acc[2][0] : (kg == 2) ? acc[4][0] : acc[6][0], v1_ = (kg == 0) ? acc[1][0] : (kg == 1) ? acc[3][0] : (kg == 2) ? acc[5][0] : acc[7][0]; \
              const float* g2_ = g2l + ((t0_ < NLAT) ? (t0_ >> 12) : 8) * 128 + col0; float* hw_ = (float*)PVM_HPTR(t0_); \
              hw_[0] = HX##0 + g2_[0] * ((float)v0_ * ksc_); hw_[16] = HX##1 + g2_[16] * ((float)v1_ * ksc_); } \
            } while (0)
        u32x4 iXa, iXb, iYa, iYb; unsigned wX, wY; float hX0, hX1, hY0, hY1; i32x4 acc[8], bop[8], bop1[8];
        { const char* ib_ = (const char*)(IDXT + (size_t)wv * 128) + jj * 32; iYa = *(const u32x4*)ib_; iYb = *(const u32x4*)(ib_ + 16); }
        PVM_DMA8(iY, 0); PVM_DMA8(iY, 8); PVM_LOADC(iX, wX, hX, PVM_TOK(1), PVM_TOK(0));
        asm volatile("s_waitcnt vmcnt(0)" ::: "memory"); SBARP();
        int k = 0;
        for (; k + 1 < K; k += 2) {
            PVM_ITER(iX, wX, hX, iY, wY, hY, k);
            PVM_ITER(iY, wY, hY, iX, wX, hX, k + 1);
        }
        if (k < K) PVM_ITER(iX, wX, hX, iY, wY, hY, k);
        asm volatile("s_waitcnt vmcnt(0)" ::: "memory");
#undef PVM_TOK
#undef PVM_DMA
#undef PVM_DMA8
#undef PVM_HPTR
#undef PVM_LOADC
#undef PVM_STEP
#undef PVM_READS
#undef PVM_ITER
#undef SBARP
    }
}
constexpr int PH_PER_LAYER = 12, N_PHASES = 1 + DEPTH * PH_PER_LAYER;
#ifndef MK_ONE_LAUNCH
#define MK_ONE_LAUNCH 0
#endif
#ifndef MK_MASK
#define MK_MASK 0x1FFF
#endif
#define PON(s) (((MK_MASK) >> (s)) & 1)

#ifndef DBG_NAIVE_GEMM
#define DBG_NAIVE_GEMM 0
#endif
#if DBG_NAIVE_GEMM
__device__ __forceinline__ void naive_gemm(const Frame& F, const pg8::Gemm g, int kind, const pg8::EpiStore es, const pg8::EpiResid er) {
    const int ncg = g.N / 64; const int nunits = g.M * ncg;
    for (int u = F.gw; u < nunits; u += F.ngw) {
        const int row = __builtin_amdgcn_readfirstlane(u / ncg), col = (u % ncg) * 64 + F.lane;
        const bf16* ar = g.A + (size_t)row * g.K; const bf16* br = g.Bt + (size_t)col * g.K; float acc = 0.f;
#pragma unroll 1
        for (int k = 0; k < g.K; k += 8) { const u32x4 a = *(const u32x4*)(ar + k), b = *(const u32x4*)(br + k); float x[8], y[8]; unpack8(a, x); unpack8(b, y);
#pragma unroll
            for (int e = 0; e < 8; ++e) acc = fmaf(x[e], y[e], acc); }
        if (kind == 0) { if (col < es.ncols) es.O[(size_t)row * es.ldc + col] = (bf16)(pk2(acc, 0.f) & 0xffffu); }
        else if (kind == 1) { const int head = col >> 7, j = col & 127; bf16* d = (j < 64) ? (es.O + (size_t)row * 768 + head * 96 + j) : (es.VM + (size_t)row * 512 + head * 64 + (j - 64)); *d = (bf16)(pk2(acc, 0.f) & 0xffffu); }
        else { const bool lat = row < er.nlat; const int sample = lat ? (row >> 12) : 8;
            const float* src = lat ? er.hin_lat + (size_t)row * 1024 : er.hin_ctx + (size_t)(row - er.nlat) * 1024; float* dst = lat ? er.hout_lat + (size_t)row * 1024 : er.hout_ctx + (size_t)(row - er.nlat) * 1024;
            dst[col] = src[col] + er.gate[(size_t)sample * 6144 + col] * acc; }
    }
}
#endif

__global__ void __launch_bounds__(512, 2) mk_fwd(Args args_unused) {
    extern __shared__ __attribute__((aligned(16))) unsigned char lds[];
    LAS unsigned char* lds3 = (LAS unsigned char*)lds;
    ArgsP args0 = (ArgsP)__builtin_amdgcn_kernarg_segment_ptr();
    const int ph_lo = args0->ph_lo, ph_hi = args0->ph_hi;
    const int wave_s = __builtin_amdgcn_readfirstlane((int)threadIdx.x >> 6);
#if MK_ONE_LAUNCH == 2
    {
        volatile LAS unsigned* st = (volatile LAS unsigned*)(lds3 + LDS_BYTES - 64);
        if (threadIdx.x < 2) st[threadIdx.x] = 0u;
        __syncthreads();
        (void)xcd_barrier_post((unsigned*)(args0->ws + WS_CTL), st, threadIdx.x == 0);
        if (threadIdx.x == 0 && xb_xcc_id() != (blockIdx.x & 7u)) (void)xb_add((unsigned*)(args0->ws + WS_CTL) + XB_MIS, 1u);
    }
#endif
#if defined(TPROBE)
    unsigned long long tp_start = __builtin_amdgcn_s_memrealtime(), tp_acc = 0ull;
#endif
    int fastm = -1;
#pragma unroll 1
    for (int pi = ph_lo; pi < ph_hi; ++pi) {
        int zv = 0; asm volatile("" : "+v"(zv));
        ArgsP args = args0; asm volatile("" : "+s"(args));
        Frame F;
        F.zv = zv; F.lane = (int)__builtin_amdgcn_mbcnt_hi(~0u, __builtin_amdgcn_mbcnt_lo(~0u, 0u)) + zv; F.wave = wave_s; F.tid = wave_s * 64 + F.lane;
        { int bx = blockIdx.x, gd = gridDim.x; asm volatile("" : "+s"(bx), "+s"(gd)); F.bid = bx; F.G = gd; F.vcu = (gd % 8 == 0) ? (bx % 8) * (gd / 8) + bx / 8 : bx; }
        F.gw = F.bid * 8 + F.wave; F.ngw = F.G * 8;
        unsigned char* ws = args->ws;
#if defined(TPROBE)
        const unsigned long long tp_t0 = __builtin_amdgcn_s_memrealtime();
#endif
        const int phraw = args->prog[pi], ph = phraw & 63, pvar = phraw >> 6;
        int njobs = 0, jkind = 0;
        pg8::Gemm gj[2]; pg8::EpiStore ej[2];
        int l = 0, mrows = NROWS, jlo = 0, jhi = 1 << 20;
        if (ph == 0) { if (PON(12)) p0_prologue(F, args, lds3); }
        else if (ph == 63) {   }
        else {
            int s; if (ph >= 25) { l = (ph - 25) >> 1; s = 12 + ((ph - 25) & 1); } else { const int q = ph - 1; s = q % PH_PER_LAYER; l = q / PH_PER_LAYER; }
            const bool sp1 = F.G == 256, sp4 = F.G == 256 && l == 0;
            const int tb1 = 6, tb4 = 4;
            mrows = (l == DEPTH - 1) ? NLAT : NROWS;
#define XCHUNK(FX, NRX, nr_) Frame FX = F; int NRX = (nr_); if ((F.G & 7) == 0) { const int ch_ = (nr_) >> 3, x_ = F.bid & 7; FX.gw = x_ * ch_ + (F.bid >> 3) * 8 + F.wave; FX.ngw = (F.G >> 3) * 8; NRX = (x_ + 1) * ch_; }
#define XPART(FX, NRX, nr_, mode_, ntb_) do { const int ch_ = (nr_) >> 3, x_ = F.bid & 7; \
                if ((mode_) == 1) { FX.gw = x_ * ch_ + ((F.bid >> 3) - (ntb_)) * 8 + F.wave; FX.ngw = ((F.G >> 3) - (ntb_)) * 8; NRX = x_ * ch_ + ch_ - 256; } \
                else if ((mode_) == 2) { FX.gw = x_ * ch_ + ch_ - 256 + (F.bid >> 3) * 8 + F.wave; FX.ngw = (F.G >> 3) * 8; NRX = (x_ + 1) * ch_; } } while (0)
            switch (s) {
            case 0: if (PON(0)) { XCHUNK(FX, nrx, NROWS); norm_mod_phase(FX, args, l, 0, nrx, (char*)lds); } break;
            case 1: if (PON(1)) { njobs = 1; if (sp1) jhi = 3;
                gj[0] = pg8::Gemm{(const bf16*)(ws + WS_AB), (const bf16*)(ws + WS_WIN) + (size_t)l * DINP * DM, NROWS, DINP, DM};
                ej[0] = pg8::EpiStore{0, (bf16*)(ws + WS_P), DIN, DIN, nullptr}; } break;
            case 2: case 12: if (PON(2)) {
                if (s == 12 && !sp1) break;
                if (s == 12 && (F.bid >> 3) < tb1) { njobs = 1; jlo = 3;
                    gj[0] = pg8::Gemm{(const bf16*)(ws + WS_AB), (const bf16*)(ws + WS_WIN) + (size_t)l * DINP * DM, NROWS, DINP, DM};
                    ej[0] = pg8::EpiStore{0, (bf16*)(ws + WS_P), DIN, DIN, nullptr}; break; }
                XCHUNK(FX, nrx, NROWS); if (sp1) XPART(FX, nrx, NROWS, (s == 12) ? 1 : 2, tb1);
                e2_phase(FX, args, l, nrx, (char*)lds); } break;
            case 3: if (PON(3)) { njobs = 2;
                gj[0] = pg8::Gemm{(const bf16*)(ws + WS_QAN), (const bf16*)(ws + WS_WUQ) + (size_t)l * 768 * QRANK, NROWS, 768, QRANK};
                ej[0] = pg8::EpiStore{0, (bf16*)(ws + WS_QM), 768, 768, nullptr};
                gj[1] = pg8::Gemm{(const bf16*)(ws + WS_KVAN), (const bf16*)(ws + WS_WUKV) + (size_t)l * 1024 * KVRANK, NROWS, 1024, KVRANK};
                ej[1] = pg8::EpiStore{1, (bf16*)(ws + WS_KM), 768, 1024, (bf16*)(ws + WS_VM)}; } break;
            case 4: if (PON(4)) { XCHUNK(FX, nrx, NROWS); e3_phase(FX, args, l, nrx, pvar, (char*)lds); } break;
            case 5: if (PON(5)) {
#if DBG_NAIVE_ATTN
                attn_naive_phase(F, args, l);
#else
                attn_phase(F, args, l, (char*)lds, pvar);
#endif
                } break;
            case 6: if (PON(6)) { njobs = 1; jkind = 1; if (sp4) jhi = 2;
                gj[0] = pg8::Gemm{(const bf16*)(ws + WS_AB), (const bf16*)(ws + WS_WOUT) + (size_t)l * DM * DM, mrows, DM, DM}; } break;
            case 7: case 13: if (PON(7)) {
                if (s == 13 && !sp4) break;
                if (s == 13 && (F.bid >> 3) < tb4) { njobs = 1; jkind = 1; jlo = 2;
                    gj[0] = pg8::Gemm{(const bf16*)(ws + WS_AB), (const bf16*)(ws + WS_WOUT) + (size_t)l * DM * DM, mrows, DM, DM}; break; }
                XCHUNK(FX, nrx, mrows); if (sp4) XPART(FX, nrx, mrows, (s == 13) ? 1 : 2, tb4);
                norm_mod_phase(FX, args, l, 1, nrx, (char*)lds); } break;
            case 8: if (PON(8)) { njobs = 1;
                gj[0] = pg8::Gemm{(const bf16*)(ws + WS_AB), (const bf16*)(ws + WS_PWQ) + (size_t)l * 2048 * DM, mrows, 2048, DM};
                ej[0] = pg8::EpiStore{0, (bf16*)(ws + WS_X5), 2048, 2048, nullptr}; } break;
            case 9: if (PON(9)) topkc_phase(F, args, l, mrows, (char*)lds); break;
            case 10: if (PON(10)) pu_phase(F, args, l, mrows, (char*)lds, pvar); break;
            default: if (PON(11)) pv_phase(F, args, l, mrows, pvar, (char*)lds); break;
            }
        }
        if (njobs > 0) {
#if DBG_NAIVE_GEMM
            { const pg8::EpiResid ER{(l == 0) ? args->in[0] : args->out, args->in[2], args->out, (float*)(ws + WS_HCTX), (const float*)(ws + WS_MOD) + (size_t)l * 9 * 6144 + 2 * DM, NLAT};
              _Pragma("unroll 1") for (int j = 0; j < njobs; ++j) { const pg8::Gemm g = (j == 0) ? gj[0] : gj[1]; const pg8::EpiStore E = (j == 0) ? ej[0] : ej[1]; naive_gemm(F, g, jkind ? 2 : E.mode, E, ER); } }
#else
            if (jkind == 0) {
#pragma unroll 1
                for (int j = 0; j < njobs; ++j) { __syncthreads();
                    const pg8::Gemm g = (j == 0) ? gj[0] : gj[1]; const pg8::EpiStore E = (j == 0) ? ej[0] : ej[1];
                    pg8::StaticOrder S; S.init(g.M, g.N, F.G, (j == 1) ? (((F.G & 7) == 0) ? ((F.bid & 7) + 8 * ((F.G >> 3) - 1 - (F.bid >> 3))) : (F.G - 1 - F.bid)) : F.bid); S.ilo = jlo; S.ihi = jhi;
                    pg8::gemm_phase<pg8::EpiStore, pg8::StaticOrder, true, true>(lds3, g, S, E, F.tid); }
            } else { __syncthreads();
                const pg8::Gemm g = gj[0];
                pg8::StaticOrder S; S.init(g.M, g.N, F.G, F.bid); S.ilo = jlo; S.ihi = jhi;
                pg8::EpiResid E{(l == 0) ? args->in[0] : args->out, args->in[2], args->out, (float*)(ws + WS_HCTX), (const float*)(ws + WS_MOD) + (size_t)l * 9 * 6144 + 2 * DM, NLAT};
                pg8::gemm_phase<pg8::EpiResid, pg8::StaticOrder, true, true>(lds3, g, S, E, F.tid); }
#endif
        }
#if defined(TPROBE)
        { asm volatile("s_waitcnt vmcnt(0) lgkmcnt(0)" ::: "memory"); const unsigned long long tp_t1 = __builtin_amdgcn_s_memrealtime();
          const int kind_ = (ph == 0) ? 100 : ((ph - 1) % PH_PER_LAYER); if (kind_ == (TPROBE)) tp_acc += tp_t1 - tp_t0; }
#endif
#if MK_ONE_LAUNCH == 1
        if (pi + 1 < ph_hi) cg::this_grid().sync();
#elif MK_ONE_LAUNCH == 2
        if (pi + 1 < ph_hi) { XcdBarrier xb; xb.bar = (unsigned*)(ws + WS_CTL); xb.x = xb_xcc_id(); xb.st = (volatile LAS unsigned*)(lds3 + LDS_BYTES - 64);
#ifdef PROBE_BARRIER
            if (ph == 63 && pvar == 1) xcd_barrier<1>(xb, F.tid == 0); else if (ph == 63 && pvar == 2) xcd_barrier<2>(xb, F.tid == 0); else
#endif
            {
                auto kind_of = [](int raw, int& kl) -> int { const int p_ = raw & 63; if (p_ >= 25 && p_ < 29) { kl = (p_ - 25) >> 1; return 12 + ((p_ - 25) & 1); } if (p_ >= 1 && p_ <= 2 * PH_PER_LAYER) { kl = (p_ - 1) / PH_PER_LAYER; return (p_ - 1) % PH_PER_LAYER; } kl = -1; return -1; };
                int kl0, kl1; const int nraw = (int)args->prog[pi + 1], k0 = kind_of(phraw, kl0), k1 = kind_of(nraw, kl1);
                const bool pair_ok = (k0 == 0 && k1 == 1) || (k0 == 1 && (k1 == 12 || k1 == 2)) || (k0 == 12 && k1 == 2) || (k0 == 2 && k1 == 3) || (k0 == 3 && k1 == 4)
                                  || (k0 == 6 && (k1 == 13 || k1 == 7)) || (k0 == 13 && k1 == 7) || (k0 == 7 && k1 == 8) || (k0 == 8 && k1 == 9);
                const bool loc = fastm > 0 && pvar == 0 && (nraw >> 6) == 0 && kl0 >= 0 && kl0 == kl1 && pair_ok;
                if (loc) xcd_barrier<0, 1>(xb, F.tid == 0); else xcd_barrier<0, 0>(xb, F.tid == 0);
                if (fastm < 0) fastm = ((F.G & 7) == 0 && __builtin_amdgcn_readfirstlane((int)xb_ld(xb.bar + XB_MIS)) == 0) ? 1 : 0; } }
#endif
    }
#if defined(TPROBE)
    {
        float* fr = (float*)(args0->ws + WS_CTL + 32768);
        if (blockIdx.x == 0 && threadIdx.x == 0) { const unsigned long long tp_end = __builtin_amdgcn_s_memrealtime();
            float frac = (float)tp_acc / (float)(tp_end - tp_start); if ((TPROBE) == 999) frac = 0.5f; __hip_atomic_store(fr, frac, __ATOMIC_RELAXED, __HIP_MEMORY_SCOPE_AGENT); }
        { XcdBarrier xb; xb.bar = (unsigned*)(args0->ws + WS_CTL); xb.x = xb_xcc_id(); xb.st = (volatile LAS unsigned*)(lds3 + LDS_BYTES - 64); xcd_barrier(xb, threadIdx.x == 0); }
        const float frac = __hip_atomic_load(fr, __ATOMIC_RELAXED, __HIP_MEMORY_SCOPE_AGENT);
        for (size_t i = (size_t)blockIdx.x * 512 + threadIdx.x; i < (size_t)NLAT * DM / 4; i += (size_t)gridDim.x * 512) { f32x4 v = ((f32x4*)args0->out)[i]; v += frac; ((f32x4*)args0->out)[i] = v; }
    }
#endif
}

extern "C" void kernel_launch(void* const* d_in, const int* in_sizes, int n_in, void* d_out, int out_size, void* d_ws, size_t ws_size, hipStream_t stream) {
    static int grid = 0;
    if (grid == 0) {
        if (n_in != 23 || in_sizes[0] != NLAT * DM || out_size != NLAT * DM || ws_size < WS_END) {
            fprintf(stderr, "kernel_launch: unexpected shapes: n_in %d in0 %d out %d ws %zu (need %zu)\n", n_in, n_in > 0 ? in_sizes[0] : -1, out_size, ws_size, (size_t)WS_END); grid = -1; return; }
        int dev = 0, cus = 0, per_cu = 0;
        if (hipGetDevice(&dev) != hipSuccess || hipDeviceGetAttribute(&cus, hipDeviceAttributeMultiprocessorCount, dev) != hipSuccess) { fprintf(stderr, "kernel_launch: device query failed\n"); grid = -1; return; }
        if (hipFuncSetAttribute((const void*)mk_fwd, hipFuncAttributeMaxDynamicSharedMemorySize, LDS_BYTES) != hipSuccess) { fprintf(stderr, "kernel_launch: hipFuncSetAttribute failed\n"); grid = -1; return; }
        if (hipOccupancyMaxActiveBlocksPerMultiprocessor(&per_cu, (const void*)mk_fwd, 512, LDS_BYTES) != hipSuccess || per_cu < 1) { fprintf(stderr, "kernel_launch: occupancy query says %d\n", per_cu); per_cu = 1; }
        (void)hipGetLastError();
        grid = cus;
    }
    if (grid < 0) return;
    Args a{};
    for (int i = 0; i < 23; ++i) a.in[i] = (const float*)d_in[i];
    a.out = (float*)d_out; a.ws = (unsigned char*)d_ws;
    int np = 0;
#ifdef MK_PROG
    { static const int pr[] = {MK_PROG}; for (int i = 0; i < (int)(sizeof(pr) / sizeof(pr[0])); ++i) a.prog[np++] = (unsigned char)pr[i]; }
#else
    for (int p = 0; p < N_PHASES; ++p) { a.prog[np++] = (unsigned char)p;
        if (p == 2) a.prog[np++] = 25; if (p == 7) a.prog[np++] = 26; if (p == 2 + PH_PER_LAYER) a.prog[np++] = 27; }
#endif
#if MK_ONE_LAUNCH == 2
    a.ph_lo = 0; a.ph_hi = np;
    if (hipMemsetAsync((char*)d_ws + WS_CTL, 0, CTL_ZERO_BYTES, stream) != hipSuccess) { fprintf(stderr, "kernel_launch: hipMemsetAsync of the barrier words failed\n"); return; }
    hipLaunchKernelGGL(mk_fwd, dim3(grid), dim3(512), LDS_BYTES, stream, a);
    { const hipError_t le = hipPeekAtLastError(); if (le != hipSuccess) fprintf(stderr, "kernel_launch: launch failed: %s\n", hipGetErrorName(le)); }
#elif MK_ONE_LAUNCH == 1
    a.ph_lo = 0; a.ph_hi = np;
    void* kargs[] = {&a};
    hipError_t e = hipLaunchCooperativeKernel((const void*)mk_fwd, dim3(grid), dim3(512), kargs, LDS_BYTES, stream);
    if (e != hipSuccess) fprintf(stderr, "kernel_launch: cooperative launch failed: %s (grid %d)\n", hipGetErrorString(e), grid);
#else
    for (int p = 0; p < np; ++p) {
        a.ph_lo = p; a.ph_hi = p + 1;
        hipLaunchKernelGGL(mk_fwd, dim3(grid), dim3(512), LDS_BYTES, stream, a);
    }
    const hipError_t le = hipPeekAtLastError();
    if (le != hipSuccess) fprintf(stderr, "kernel_launch: launch failed: %s\n", hipGetErrorName(le));
#endif
}
```
